# Optimizing an MI355X kernel written in HIP

```python
import math
import jax, jax.numpy as jnp
from jax import lax
import numpy as np

D_MODEL = 1024
BATCH = 32
SEQ = 2048
DEPTH = 4

DA_HEADS = 4
DA_HEAD_DIM = 64
DA_V_DIM = 2 * DA_HEAD_DIM
DA_QK_WIDTH = DA_HEADS * 2 * DA_HEAD_DIM
DA_WIDTH = DA_HEADS * DA_V_DIM
Q_BLOCK = 128
HB_HEADS = 4
HB_HEAD_DIM = 64
HB_WIDTH = HB_HEADS * HB_HEAD_DIM
MAX_NEG_LOGIT = 80.0
GC_HEADS = 4
GC_KEY_DIM = 32
GC_VAL_DIM = 64
GC_KEY_WIDTH = GC_HEADS * GC_KEY_DIM
GC_WIDTH = GC_HEADS * GC_VAL_DIM
GC_GATE_RANK = 16
GC_GATE_NORMALIZER = 16.0
CHUNK = 64
N_BRANCH = 3
D_FF = 4 * D_MODEL
N_MOD = 6
EPS = 1e-6

IN_SIZES = (DA_QK_WIDTH, DA_QK_WIDTH, DA_WIDTH,
            HB_WIDTH, HB_WIDTH, HB_WIDTH, HB_WIDTH, HB_WIDTH,
            GC_KEY_WIDTH, GC_KEY_WIDTH, GC_WIDTH, GC_WIDTH,
            GC_GATE_RANK, GC_GATE_RANK,
            N_BRANCH * D_MODEL)
D_IN = (2 * DA_QK_WIDTH + DA_WIDTH + 5 * HB_WIDTH + 2 * GC_KEY_WIDTH + 2 * GC_WIDTH
        + 2 * GC_GATE_RANK + N_BRANCH * D_MODEL)

kernel_name = "hybrid_diffattn_hgrn2_gla_encoder"


def rms_norm(x, g):
    xf = x.astype(jnp.float32)
    y = xf * lax.rsqrt(jnp.mean(xf * xf, axis=-1, keepdims=True) + EPS)
    return (y * g.astype(jnp.float32)).astype(x.dtype)


def split_cols(t, sizes):
    offs = np.cumsum(sizes)[:-1].tolist()
    return jnp.split(t, offs, axis=-1)


def to_heads(t, n_heads):
    b, s, w = t.shape
    return t.reshape(b, s, n_heads, w // n_heads).transpose(0, 2, 1, 3)


def from_heads(t):
    b, n, s, h = t.shape
    return t.transpose(0, 2, 1, 3).reshape(b, s, n * h)


def alibi_slopes(n):
    return jnp.array([2.0 ** (-8.0 * (i + 1) / n) for i in range(n)], dtype=jnp.float32)


def diff_attention(q, k, v, lam, slopes):
    b, h, _, s, d = q.shape
    nb = s // Q_BLOCK
    scale = d ** -0.5
    q_blocks = jnp.moveaxis(q.reshape(b, h, 2, nb, Q_BLOCK, d), 3, 0)
    starts = jnp.arange(nb, dtype=jnp.int32) * Q_BLOCK
    key_pos = jnp.arange(s, dtype=jnp.int32)

    def one_block(args):
        qb, start = args
        scores = jnp.einsum('bhiqd,bhikd->bhiqk', qb, k).astype(jnp.float32) * scale
        q_pos = start + jnp.arange(Q_BLOCK, dtype=jnp.int32)
        dist = jnp.abs(q_pos[:, None] - key_pos[None, :]).astype(jnp.float32)
        scores = scores - slopes[:, None, None, None] * dist
        p = jax.nn.softmax(scores, axis=-1)
        w = p[:, :, 0] - lam * p[:, :, 1]
        return jnp.einsum('bhqk,bhkv->bhqv', w.astype(v.dtype), v)

    out = lax.map(one_block, (q_blocks, starts))
    return jnp.moveaxis(out, 0, 2).reshape(b, h, s, v.shape[-1])


def chunk_scan(q, k, v, log_a):
    b, h, s, dk = q.shape
    dv = v.shape[-1]
    nc = s // CHUNK

    def to_chunks(t):
        return jnp.moveaxis(t.astype(jnp.float32).reshape(b, h, nc, CHUNK, t.shape[-1]), 2, 0)

    causal_in_chunk = jnp.tril(jnp.ones((CHUNK, CHUNK), dtype=bool))[:, :, None]

    def step(state, inp):
        qc, kc, vc, ac = inp
        cum = jnp.cumsum(ac, axis=2)
        o_inter = jnp.einsum('bhtk,bhkv->bhtv', qc * jnp.exp(cum), state)
        diff = cum[:, :, :, None, :] - cum[:, :, None, :, :]
        decay = jnp.where(causal_in_chunk, jnp.exp(jnp.where(causal_in_chunk, diff, 0.0)), 0.0)
        scores = jnp.einsum('bhtk,bhsk,bhtsk->bhts', qc, kc, decay)
        o_intra = jnp.einsum('bhts,bhsv->bhtv', scores, vc)
        last = cum[:, :, -1:, :]
        new_state = jnp.exp(last[:, :, 0, :])[..., None] * state + jnp.einsum(
            'bhsk,bhsv->bhkv', kc * jnp.exp(last - cum), vc)
        return new_state, o_inter + o_intra

    state0 = jnp.zeros((b, h, dk, dv), jnp.float32)
    _, o = lax.scan(step, state0, (to_chunks(q), to_chunks(k), to_chunks(v), to_chunks(log_a)))
    return jnp.moveaxis(o, 0, 2).reshape(b, h, s, dv)


def bidir_scan(q, k_fwd, k_bwd, v, la_fwd, la_bwd):
    flip = lambda t: jnp.flip(t, axis=2)
    fwd = chunk_scan(q, k_fwd, v, la_fwd)
    bwd = flip(chunk_scan(flip(q), flip(k_bwd), flip(v), flip(la_bwd)))
    return (fwd + bwd).astype(q.dtype)


def mixer_diff_attn(q_cols, k_cols, v_cols, lam_params, subln_g, layer_idx):
    b, s, _ = q_cols.shape

    def qk_heads(t):
        return t.reshape(b, s, DA_HEADS, 2, DA_HEAD_DIM).transpose(0, 2, 3, 1, 4)

    q = qk_heads(q_cols)
    k = qk_heads(k_cols)
    v = to_heads(v_cols, DA_HEADS)
    lam_init = 0.8 - 0.6 * math.exp(-0.3 * layer_idx)
    lp = lam_params.astype(jnp.float32)
    lam = jnp.exp(jnp.sum(lp[0] * lp[1])) - jnp.exp(jnp.sum(lp[2] * lp[3])) + lam_init
    o = diff_attention(q, k, v, lam, alibi_slopes(DA_HEADS))
    o = rms_norm(o, subln_g) * (1.0 - lam_init)
    return from_heads(o)


def mixer_hgrn2(q_cols, f_fwd_cols, f_bwd_cols, i_cols, g_cols, lower_bound, norm_g):
    q = jax.nn.silu(to_heads(q_cols, HB_HEADS)) * HB_HEAD_DIM ** -0.5
    v = to_heads(i_cols, HB_HEADS)

    def forget(cols, lb):
        z = to_heads(cols, HB_HEADS).astype(jnp.float32)
        lbh = lb.reshape(HB_HEADS, 1, HB_HEAD_DIM)
        log_f = jax.nn.log_sigmoid(z) + jnp.log1p(lbh * jnp.exp(jnp.minimum(-z, MAX_NEG_LOGIT)))
        k = (1.0 - lbh) * jax.nn.sigmoid(-z)
        return k, log_f

    k_f, la_f = forget(f_fwd_cols, lower_bound[0])
    k_b, la_b = forget(f_bwd_cols, lower_bound[1])
    o = rms_norm(bidir_scan(q, k_f, k_b, v, la_f, la_b), norm_g)
    return from_heads(o) * jax.nn.silu(g_cols)


def mixer_gla(q_cols, k_cols, v_cols, g_cols, lr_fwd, lr_bwd, gate_w2, gate_b, norm_g):
    q = to_heads(q_cols, GC_HEADS) * GC_KEY_DIM ** -0.5
    k = to_heads(k_cols, GC_HEADS)
    v = to_heads(v_cols, GC_HEADS)

    def log_decay(lr, w2, bias):
        z = (jnp.einsum('bsr,rk->bsk', lr, w2) + bias).astype(jnp.float32)
        return to_heads(jax.nn.log_sigmoid(z) / GC_GATE_NORMALIZER, GC_HEADS)

    la_f = log_decay(lr_fwd, gate_w2[0], gate_b[0])
    la_b = log_decay(lr_bwd, gate_w2[1], gate_b[1])
    o = rms_norm(bidir_scan(q, k, k, v, la_f, la_b), norm_g)
    return from_heads(o) * jax.nn.silu(g_cols)


def setup_inputs(seed: int = 0) -> dict:
    key = jax.random.key(seed)
    ks = jax.random.split(key, 21)
    nrm = lambda k, shape, scale: jax.random.normal(k, shape, jnp.float32) * scale
    gain = lambda k, shape: 1.0 + 0.05 * jax.random.normal(k, shape, jnp.float32)
    return {
        "x": nrm(ks[0], (BATCH, SEQ, D_MODEL), 1.0),
        "c": nrm(ks[1], (BATCH, D_MODEL), 1.0),
        "ada_w": nrm(ks[2], (DEPTH, D_MODEL, N_MOD * D_MODEL), 0.5 * D_MODEL ** -0.5),
        "ada_b": nrm(ks[3], (DEPTH, N_MOD * D_MODEL), 0.02),
        "norm_mix_g": gain(ks[4], (DEPTH, D_MODEL)),
        "norm_mlp_g": gain(ks[5], (DEPTH, D_MODEL)),
        "w_in": nrm(ks[6], (DEPTH, D_MODEL, D_IN), D_MODEL ** -0.5),
        "diff_lambda": nrm(ks[7], (DEPTH, 4, DA_HEAD_DIM), 0.1),
        "diff_subln_g": gain(ks[8], (DEPTH, DA_V_DIM)),
        "hgrn_lb_logits": nrm(ks[9], (DEPTH, 2, HB_WIDTH), 0.1),
        "hgrn_norm_g": gain(ks[10], (DEPTH, HB_HEAD_DIM)),
        "gla_gate_w2": nrm(ks[11], (DEPTH, 2, GC_GATE_RANK, GC_KEY_WIDTH), GC_GATE_RANK ** -0.5),
        "gla_gate_b": nrm(ks[12], (DEPTH, 2, GC_KEY_WIDTH), 0.1),
        "gla_norm_g": gain(ks[13], (DEPTH, GC_VAL_DIM)),
        "w_up_a": nrm(ks[14], (DEPTH, DA_WIDTH, D_MODEL), DA_WIDTH ** -0.5),
        "w_up_b": nrm(ks[15], (DEPTH, HB_WIDTH, D_MODEL), HB_WIDTH ** -0.5),
        "w_up_c": nrm(ks[16], (DEPTH, GC_WIDTH, D_MODEL), GC_WIDTH ** -0.5),
        "w_out": nrm(ks[17], (DEPTH, D_MODEL, D_MODEL), D_MODEL ** -0.5),
        "mlp_w1": nrm(ks[18], (DEPTH, D_MODEL, D_FF), D_MODEL ** -0.5),
        "mlp_w2": nrm(ks[19], (DEPTH, D_FF, D_MODEL), D_FF ** -0.5),
        "final_norm_g": gain(ks[20], (D_MODEL,)),
    }


def reference(x, c, ada_w, ada_b, norm_mix_g, norm_mlp_g, w_in, diff_lambda, diff_subln_g,
              hgrn_lb_logits, hgrn_norm_g, gla_gate_w2, gla_gate_b, gla_norm_g,
              w_up_a, w_up_b, w_up_c, w_out, mlp_w1, mlp_w2, final_norm_g):
    lb_w = jax.nn.softmax(hgrn_lb_logits.astype(jnp.float32), axis=0)
    lower_bounds = jnp.cumsum(lb_w, axis=0) - lb_w[0:1]
    cond = jax.nn.silu(c)
    for l in range(DEPTH):
        mod = cond @ ada_w[l] + ada_b[l]
        sh_m, sc_m, gt_m, sh_f, sc_f, gt_f = [t[:, None, :] for t in jnp.split(mod, N_MOD, axis=-1)]

        h = rms_norm(x, norm_mix_g[l]) * (1.0 + sc_m) + sh_m
        proj = jnp.einsum('bsd,de->bse', h, w_in[l])
        (a_q, a_k, a_v, b_q, b_ff, b_fb, b_i, b_g,
         c_q, c_k, c_v, c_g, c_lrf, c_lrb, gates) = split_cols(proj, IN_SIZES)
        o_a = mixer_diff_attn(a_q, a_k, a_v, diff_lambda[l], diff_subln_g[l], l)
        o_b = mixer_hgrn2(b_q, b_ff, b_fb, b_i, b_g, lower_bounds[l], hgrn_norm_g[l])
        o_c = mixer_gla(c_q, c_k, c_v, c_g, c_lrf, c_lrb, gla_gate_w2[l], gla_gate_b[l], gla_norm_g[l])
        g_a, g_b, g_c = jnp.split(jax.nn.sigmoid(gates), N_BRANCH, axis=-1)
        merged = g_a * (o_a @ w_up_a[l]) + g_b * (o_b @ w_up_b[l]) + g_c * (o_c @ w_up_c[l])
        x = x + gt_m * (merged @ w_out[l])

        h = rms_norm(x, norm_mlp_g[l]) * (1.0 + sc_f) + sh_f
        x = x + gt_f * (jnp.square(jax.nn.relu(h @ mlp_w1[l])) @ mlp_w2[l])
    return rms_norm(x, final_norm_g)
```

```cpp
#include <hip/hip_runtime.h>
#include <hip/hip_cooperative_groups.h>
#include <cstdio>
#include <cstdint>
namespace cg = cooperative_groups;

#define LAS __attribute__((address_space(3)))
typedef unsigned short bf16_t;
typedef short bf16x8 __attribute__((ext_vector_type(8)));
typedef float f32x4 __attribute__((ext_vector_type(4)));
typedef float f32x2 __attribute__((ext_vector_type(2)));
typedef float f32x16 __attribute__((ext_vector_type(16)));
typedef unsigned u32x4 __attribute__((ext_vector_type(4)));
typedef short s16x4 __attribute__((ext_vector_type(4)));
typedef unsigned char uchar;

constexpr int D = 1024, SEQ = 2048, BATCH = 32, DEPTH = 4, DIN = 6688, LDP = 6912, DFF = 4096, NMOD = 6;
constexpr int GB = 16, TG = GB * SEQ, NGRP = BATCH / GB;
constexpr int CQ = 0, CK = 512, CV = 1024, BQ = 1536, BFF = 1792, BFB = 2048, BI = 2304, BG = 2560;
constexpr int GQ = 2816, GK = 2944, GV = 3072, GG = 3328, GLF = 3584, GLB = 3600, GATE = 3616;
constexpr float EPS = 1e-6f, LOG2E = 1.4426950408889634f;
constexpr float QSCALE = 0.125f * LOG2E;

constexpr size_t MiB = 1u << 20;
constexpr size_t WS_CTL = 0;
constexpr size_t WS_MOD = 1 * MiB;
constexpr size_t WS_WIN = 4 * MiB;
constexpr size_t WS_WUP = 58 * MiB;
constexpr size_t WS_WOUT = 66 * MiB;
constexpr size_t WS_W1 = 74 * MiB;
constexpr size_t WS_W2 = 106 * MiB;
constexpr size_t WS_HB = 138 * MiB;
constexpr size_t WS_OCAT = 202 * MiB;
constexpr size_t WS_OFWD = 266 * MiB;
constexpr size_t WS_PROJ = 330 * MiB;
constexpr size_t WS_U = 762 * MiB;
constexpr size_t WS_END = 1018 * MiB;
constexpr int LDS_BYTES = 148 * 1024;

__device__ __forceinline__ unsigned f2bf(float f) { unsigned u = __builtin_bit_cast(unsigned, f); return (u + 0x7fffu + ((u >> 16) & 1u)) >> 16; }
__device__ __forceinline__ unsigned pk2(float lo, float hi) { return f2bf(lo) | (f2bf(hi) << 16); }
__device__ __forceinline__ float bf2f(bf16_t v) { return __builtin_bit_cast(float, (unsigned)v << 16); }
__device__ __forceinline__ float bflo(unsigned u) { return __builtin_bit_cast(float, u << 16); }
__device__ __forceinline__ float bfhi(unsigned u) { return __builtin_bit_cast(float, u & 0xffff0000u); }
typedef __bf16 bf16x2_t __attribute__((ext_vector_type(2)));
__device__ __forceinline__ unsigned cvt_pk_bf16(float lo, float hi) { f32x2 v = {lo, hi}; bf16x2_t b = __builtin_convertvector(v, bf16x2_t); return __builtin_bit_cast(unsigned, b); }
__device__ __forceinline__ float wave_sum(float v) {
#pragma unroll
    for (int o = 1; o < 64; o <<= 1) v += __shfl_xor(v, o);
    return v;
}
__device__ __forceinline__ int tid_fresh() { int t = threadIdx.x; asm volatile("" : "+v"(t)); return t; }
__device__ __forceinline__ float sigmoidf_(float z) { return 1.f / (1.f + __expf(-z)); }

namespace pg8 {
constexpr int BM = 256, BK = 64, HALF = 128, HTB = HALF * BK * 2, STAGE_BYTES = 8 * HTB, NXCD = 8, WGM = 8;
__host__ __device__ __forceinline__ int lds_byte(int r, int c) { const int st = (r >> 4) * 2 + (c >> 5), rr = r & 15, cc = c & 31, ob = rr * 64 + cc * 2; return st * 1024 + (ob ^ (((ob >> 9) & 1) << 5)); }
__host__ __device__ __forceinline__ void stage_rc(int b, int& R, int& C) { const int st = b / 1024, sb = b % 1024, swz = sb ^ (((sb >> 9) & 1) << 5); R = (st >> 1) * 16 + swz / 64; C = (st & 1) * 32 + (swz % 64) / 2; }
__host__ __device__ __forceinline__ int perm32(int rho) { const int n = rho >> 4, i = rho & 15; return 8 * (i >> 2) + 4 * n + (i & 3); }

struct Unit { int pm, pn, koff, nt, seg; };
struct Gemm { const bf16_t* A; const bf16_t* Bt; int K; };

struct Order {
    int nM, nN, nwg, G, c, nseg, ntfull;
    __device__ void init(int M, int N, int K, int G_, int c_, int nseg_) { nM = M / BM; nN = N / BM; nwg = nM * nN; G = G_; c = c_; nseg = nseg_; ntfull = K / BK; }
    __device__ bool next(int i, Unit& u) const {
        int ti = i, seg = 0;
        if (nseg == 3) { ti = i / 3; seg = i - ti * 3; }
        const long L = (long)ti * G + c; if (L >= nwg) return false;
        int wgid = (int)L; { const int q = nwg / NXCD, r = nwg % NXCD, xcd = wgid % NXCD, off = wgid / NXCD; wgid = (xcd < r ? xcd * (q + 1) : r * (q + 1) + (xcd - r) * q) + off; }
        const int nig = WGM * nN, gid = wgid / nig, fm = gid * WGM, gsz = (nM - fm) < WGM ? (nM - fm) : WGM;
        u.pm = fm + ((wgid % nig) % gsz); u.pn = (wgid % nig) / gsz; u.seg = seg;
        if (nseg == 3) { u.koff = seg == 0 ? 0 : (seg == 1 ? 512 : 768); u.nt = seg == 0 ? 8 : 4; } else { u.koff = 0; u.nt = ntfull; }
        return true;
    }
};

struct EpiProj {
    bf16_t* O;
    __device__ __forceinline__ bool zero_after(const Unit&) const { return true; }
    __device__ __forceinline__ void operator()(f32x4 (&acc)[2][2][4][2], const Unit& u, int wr, int wc, int fr, int fq) const {
        const int row0 = u.pm * BM + wr * 64 + fr, col0 = u.pn * BM + wc * 32 + 8 * fq;
        const float sc = (u.pn < 2) ? QSCALE : 1.f;
#pragma unroll
        for (int ai = 0; ai < 2; ++ai)
#pragma unroll
            for (int m = 0; m < 4; ++m) { bf16_t* rowp = O + (size_t)(row0 + ai * HALF + m * 16) * LDP + col0;
#pragma unroll
                for (int bj = 0; bj < 2; ++bj) { f32x4 v0 = acc[ai][bj][m][0] * sc, v1 = acc[ai][bj][m][1] * sc;
                    u32x4 w; w.x = cvt_pk_bf16(v0[0], v0[1]); w.y = cvt_pk_bf16(v0[2], v0[3]); w.z = cvt_pk_bf16(v1[0], v1[1]); w.w = cvt_pk_bf16(v1[2], v1[3]);
                    *(u32x4*)(rowp + bj * HALF) = w; } }
    }
};
struct EpiRelu2 {
    bf16_t* O;
    __device__ __forceinline__ bool zero_after(const Unit&) const { return true; }
    __device__ __forceinline__ void operator()(f32x4 (&acc)[2][2][4][2], const Unit& u, int wr, int wc, int fr, int fq) const {
        const int row0 = u.pm * BM + wr * 64 + fr, col0 = u.pn * BM + wc * 32 + 8 * fq;
#pragma unroll
        for (int ai = 0; ai < 2; ++ai)
#pragma unroll
            for (int m = 0; m < 4; ++m) { bf16_t* rowp = O + (size_t)(row0 + ai * HALF + m * 16) * DFF + col0;
#pragma unroll
                for (int bj = 0; bj < 2; ++bj) { f32x4 v0 = acc[ai][bj][m][0], v1 = acc[ai][bj][m][1];
#pragma unroll
                    for (int j = 0; j < 4; ++j) { float a = fmaxf(v0[j], 0.f), b = fmaxf(v1[j], 0.f); v0[j] = a * a; v1[j] = b * b; }
                    u32x4 w; w.x = cvt_pk_bf16(v0[0], v0[1]); w.y = cvt_pk_bf16(v0[2], v0[3]); w.z = cvt_pk_bf16(v1[0], v1[1]); w.w = cvt_pk_bf16(v1[2], v1[3]);
                    *(u32x4*)(rowp + bj * HALF) = w; } }
    }
};
struct EpiRes {
    const float* base; float* out; const float* gate;
    __device__ __forceinline__ bool zero_after(const Unit&) const { return true; }
    __device__ __forceinline__ void operator()(f32x4 (&acc)[2][2][4][2], const Unit& u, int wr, int wc, int fr, int fq) const {
        const int row0 = u.pm * BM + wr * 64 + fr, col0 = u.pn * BM + wc * 32 + 8 * fq;
        const float* gp = gate + (size_t)((u.pm * BM) >> 11) * (NMOD * D) + col0;
#pragma unroll
        for (int bj = 0; bj < 2; ++bj) {
            const f32x4 g0 = *(const f32x4*)(gp + bj * HALF), g1 = *(const f32x4*)(gp + bj * HALF + 4);
#pragma unroll
            for (int ai = 0; ai < 2; ++ai) {
#pragma unroll
                for (int m = 0; m < 4; ++m) { const size_t off = (size_t)(row0 + ai * HALF + m * 16) * D + col0 + bj * HALF;
                    const f32x4 b0 = *(const f32x4*)(base + off), b1 = *(const f32x4*)(base + off + 4);
                    *(f32x4*)(out + off) = b0 + g0 * acc[ai][bj][m][0];
                    *(f32x4*)(out + off + 4) = b1 + g1 * acc[ai][bj][m][1];
                    if (m & 1) asm volatile("" ::: "memory"); }
            }
        }
    }
};
struct EpiMerge {
    const bf16_t* proj; bf16_t* O;
    __device__ __forceinline__ bool zero_after(const Unit& u) const { return u.seg == 2; }
    __device__ __forceinline__ void operator()(f32x4 (&acc)[2][2][4][2], const Unit& u, int wr, int wc, int fr, int fq) const {
        const int row0 = u.pm * BM + wr * 64 + fr, col0 = u.pn * BM + wc * 32 + 8 * fq;
        const int seg = u.seg;
#pragma unroll
        for (int ai = 0; ai < 2; ++ai)
#pragma unroll
            for (int m = 0; m < 4; ++m) { const size_t row = (size_t)(row0 + ai * HALF + m * 16); const bf16_t* gp = proj + row * LDP + GATE + col0;
#pragma unroll
                for (int bj = 0; bj < 2; ++bj) {
                    if (seg < 2) {
                        const u32x4 ga = *(const u32x4*)(gp + seg * D + bj * HALF), gb = *(const u32x4*)(gp + (seg + 1) * D + bj * HALF);
                        float r[8];
#pragma unroll
                        for (int j = 0; j < 4; ++j) {
                            const float a0 = fminf(fmaxf(bflo(ga[j]), -40.f), 40.f), a1 = fminf(fmaxf(bfhi(ga[j]), -40.f), 40.f);
                            const float b0 = fminf(fmaxf(bflo(gb[j]), -40.f), 40.f), b1 = fminf(fmaxf(bfhi(gb[j]), -40.f), 40.f);
                            r[2 * j] = (1.f + __expf(-b0)) * __builtin_amdgcn_rcpf(1.f + __expf(-a0));
                            r[2 * j + 1] = (1.f + __expf(-b1)) * __builtin_amdgcn_rcpf(1.f + __expf(-a1)); }
                        acc[ai][bj][m][0] = acc[ai][bj][m][0] * (f32x4){r[0], r[1], r[2], r[3]};
                        acc[ai][bj][m][1] = acc[ai][bj][m][1] * (f32x4){r[4], r[5], r[6], r[7]};
                    } else {
                        const u32x4 gc = *(const u32x4*)(gp + 2 * D + bj * HALF);
                        float r[8];
#pragma unroll
                        for (int j = 0; j < 4; ++j) {
                            const float c0 = fminf(fmaxf(bflo(gc[j]), -40.f), 40.f), c1 = fminf(fmaxf(bfhi(gc[j]), -40.f), 40.f);
                            r[2 * j] = __builtin_amdgcn_rcpf(1.f + __expf(-c0)); r[2 * j + 1] = __builtin_amdgcn_rcpf(1.f + __expf(-c1)); }
                        const f32x4 v0 = acc[ai][bj][m][0] * (f32x4){r[0], r[1], r[2], r[3]}, v1 = acc[ai][bj][m][1] * (f32x4){r[4], r[5], r[6], r[7]};
                        u32x4 w; w.x = cvt_pk_bf16(v0[0], v0[1]); w.y = cvt_pk_bf16(v0[2], v0[3]); w.z = cvt_pk_bf16(v1[0], v1[1]); w.w = cvt_pk_bf16(v1[2], v1[3]);
                        *(u32x4*)(O + row * D + col0 + bj * HALF) = w;
                    } } }
    }
};

template <class Epi, bool ALIGN_EPI = true>
__device__ __forceinline__ void gemm_phase(LAS uchar* lds, const Gemm g, const Order& S, const Epi& E) {
    const int tid = tid_fresh(), wid = __builtin_amdgcn_readfirstlane(tid >> 6), lane = tid & 63, wr = wid >> 2, wc = wid & 3, fr = lane & 15, fq = lane >> 4;
    const int K = g.K;
    unsigned voffA[2], voffB[2];
#pragma unroll
    for (int i = 0; i < 2; ++i) { int R, C; stage_rc(tid * 16 + i * 8192, R, C); const int Rb = (R & ~31) + perm32(R & 31);
        voffA[i] = (unsigned)(R * K + C) * 2u; voffB[i] = (unsigned)(Rb * K + C) * 2u; }
    const size_t kstep = (size_t)(BK * 2);
    const size_t hstep = (size_t)HALF * K * 2;
    const size_t tstep = 2 * hstep;
    const unsigned ldsw = (unsigned)wid * 1024u;
    const int aoff = lds_byte(wr * 64 + fr, fq * 8), boff = lds_byte(wc * 32 + fr, fq * 8);
#define PG8_SA(b, h) (((b) * 2 + (h)) * HTB)
#define PG8_SB(b, h) ((4 + (b) * 2 + (h)) * HTB)
#define PG8_STAGE(bufoff, gbase, voff) do { _Pragma("unroll") for (int _i = 0; _i < 2; ++_i) \
        __builtin_amdgcn_global_load_lds((const unsigned*)((const char*)(gbase) + (voff)[_i]), (LAS unsigned*)(lds + (bufoff) + ldsw + _i * 8192), 16, 0, 0); } while (0)
#define PG8_LDA(dst, b, h) do { _Pragma("unroll") for (int m = 0; m < 4; ++m) _Pragma("unroll") for (int k = 0; k < 2; ++k) dst[m][k] = *(const LAS bf16x8*)(lds + PG8_SA(b, h) + aoff + m * 2048 + k * 1024); } while (0)
#define PG8_LDB(dst, b, h) do { _Pragma("unroll") for (int n = 0; n < 2; ++n) _Pragma("unroll") for (int k = 0; k < 2; ++k) dst[n][k] = *(const LAS bf16x8*)(lds + PG8_SB(b, h) + boff + n * 2048 + k * 1024); } while (0)
#define PG8_MMA(ai, bj, At, Bt) do { __builtin_amdgcn_s_setprio(1); _Pragma("unroll") for (int m = 0; m < 4; ++m) _Pragma("unroll") for (int n = 0; n < 2; ++n) _Pragma("unroll") for (int k = 0; k < 2; ++k) \
        acc[ai][bj][m][n] = __builtin_amdgcn_mfma_f32_16x16x32_bf16(Bt[n][k], At[m][k], acc[ai][bj][m][n], 0, 0, 0); __builtin_amdgcn_s_setprio(0); } while (0)
#define PG8_WAIT_V(n) asm volatile("s_waitcnt vmcnt(" #n ")" ::: "memory")
#define PG8_WAIT_L(n) asm volatile("s_waitcnt lgkmcnt(" #n ")" ::: "memory")
#define PG8_BAR __builtin_amdgcn_s_barrier()
#define PG8_SCHED __builtin_amdgcn_sched_barrier(0)
    Unit cur, nxt; int ui = 0;
    if (!S.next(0, cur)) return;
    f32x4 acc[2][2][4][2];
#pragma unroll
    for (int a = 0; a < 2; ++a)
#pragma unroll
        for (int b = 0; b < 2; ++b)
#pragma unroll
            for (int m = 0; m < 4; ++m)
#pragma unroll
                for (int n = 0; n < 2; ++n) acc[a][b][m][n] = (f32x4){0.f, 0.f, 0.f, 0.f};
    bf16x8 At[4][2], B0[2][2], B1[2][2];
    const char* cA = (const char*)g.A + (size_t)cur.pm * tstep + (size_t)cur.koff * 2; const char* cB = (const char*)g.Bt + (size_t)cur.pn * tstep + (size_t)cur.koff * 2;
    PG8_STAGE(PG8_SB(0, 0), cB, voffB); PG8_STAGE(PG8_SB(0, 1), cB + hstep, voffB); PG8_STAGE(PG8_SA(0, 0), cA, voffA); PG8_STAGE(PG8_SA(0, 1), cA + hstep, voffA);
    if (wr == 1) PG8_BAR;
    PG8_WAIT_V(2); PG8_BAR;
    PG8_STAGE(PG8_SB(1, 0), cB + kstep, voffB); PG8_STAGE(PG8_SA(1, 0), cA + kstep, voffA); PG8_STAGE(PG8_SB(1, 1), cB + hstep + kstep, voffB);
    PG8_WAIT_V(6); PG8_BAR;
    for (;;) {
        const bool has_next = S.next(ui + 1, nxt);
        const char* nA = has_next ? (const char*)g.A + (size_t)nxt.pm * tstep + (size_t)nxt.koff * 2 : cA; const char* nB = has_next ? (const char*)g.Bt + (size_t)nxt.pn * tstep + (size_t)nxt.koff * 2 : cB;
        const int nt = cur.nt;
        for (int t = 0; t < nt; t += 2) {
            const bool last = (t == nt - 2);
            const char* a1 = cA + (size_t)(t + 1) * kstep;
            const char* a2 = last ? nA : cA + (size_t)(t + 2) * kstep; const char* b2 = last ? nB : cB + (size_t)(t + 2) * kstep;
            const char* a3 = a2 + kstep; const char* b3 = b2 + kstep;
            PG8_LDB(B0, 0, 0); PG8_LDB(B1, 0, 1); PG8_SCHED; PG8_LDA(At, 0, 0); PG8_STAGE(PG8_SA(1, 1), a1 + hstep, voffA);
            PG8_WAIT_V(8); PG8_WAIT_L(0); PG8_BAR; PG8_MMA(0, 0, At, B0); PG8_MMA(0, 1, At, B1); PG8_BAR; PG8_SCHED;
            PG8_LDA(At, 0, 1); PG8_STAGE(PG8_SB(0, 0), b2, voffB); PG8_STAGE(PG8_SB(0, 1), b2 + hstep, voffB); PG8_STAGE(PG8_SA(0, 0), a2, voffA);
            PG8_WAIT_V(8); PG8_WAIT_L(0); PG8_BAR; PG8_MMA(1, 0, At, B0); PG8_MMA(1, 1, At, B1); PG8_BAR; PG8_SCHED;
            PG8_LDB(B0, 1, 0); PG8_LDB(B1, 1, 1); PG8_SCHED; PG8_LDA(At, 1, 0); PG8_STAGE(PG8_SA(0, 1), a2 + hstep, voffA);
            PG8_WAIT_V(8); PG8_WAIT_L(0); PG8_BAR; PG8_MMA(0, 0, At, B0); PG8_MMA(0, 1, At, B1); PG8_BAR; PG8_SCHED;
            PG8_LDA(At, 1, 1); PG8_STAGE(PG8_SB(1, 0), b3, voffB); PG8_STAGE(PG8_SB(1, 1), b3 + hstep, voffB); PG8_STAGE(PG8_SA(1, 0), a3, voffA);
            PG8_WAIT_V(8); PG8_WAIT_L(0); PG8_BAR; PG8_MMA(1, 0, At, B0); PG8_MMA(1, 1, At, B1); PG8_BAR; PG8_SCHED;
        }
        if constexpr (ALIGN_EPI) { if (wr == 0) PG8_BAR; }
        E(acc, cur, wr, wc, fr, fq);
        if (!has_next) break;
        if (E.zero_after(cur)) {
#pragma unroll
            for (int a = 0; a < 2; ++a)
#pragma unroll
                for (int b = 0; b < 2; ++b)
#pragma unroll
                    for (int m = 0; m < 4; ++m)
#pragma unroll
                        for (int n = 0; n < 2; ++n) acc[a][b][m][n] = (f32x4){0.f, 0.f, 0.f, 0.f};
        }
        cur = nxt; cA = nA; cB = nB; ++ui;
        if constexpr (ALIGN_EPI) { if (wr == 1) PG8_BAR; }
    }
    PG8_WAIT_V(0);
    if constexpr (!ALIGN_EPI) { if (wr == 0) PG8_BAR; }
    PG8_BAR;
#undef PG8_SA
#undef PG8_SB
#undef PG8_STAGE
#undef PG8_LDA
#undef PG8_LDB
#undef PG8_MMA
#undef PG8_WAIT_V
#undef PG8_WAIT_L
#undef PG8_BAR
#undef PG8_SCHED
}
}

__device__ __forceinline__ int crow(int r, int hi) { return (r & 3) + 8 * (r >> 2) + 4 * hi; }
__device__ __forceinline__ s16x4 vtr(const LAS uchar* p) { return __builtin_bit_cast(s16x4, __builtin_amdgcn_ds_read_tr16_b64_v4i16((LAS s16x4*)p)); }
__device__ __forceinline__ float xhalf_max(float m) { auto rr = __builtin_amdgcn_permlane32_swap(__builtin_bit_cast(unsigned, m), __builtin_bit_cast(unsigned, m), false, false); return fmaxf(__builtin_bit_cast(float, rr[0]), __builtin_bit_cast(float, rr[1])); }
__device__ __forceinline__ float xhalf_sum(float m) { auto rr = __builtin_amdgcn_permlane32_swap(__builtin_bit_cast(unsigned, m), __builtin_bit_cast(unsigned, m), false, false); return __builtin_bit_cast(float, rr[0]) + __builtin_bit_cast(float, rr[1]); }

constexpr int ATT_SLOT = 32768, ATT_WSF = 65536;
__device__ __forceinline__ void attn_unit(LAS uchar* lds, const bf16_t* proj, bf16_t* ocat, int bl, int h, int qb, float lam, float laminit, const float* sg) {
    const int tid = tid_fresh(), lane = tid & 63, r32 = lane & 31, hi = lane >> 5;
    const int wave = __builtin_amdgcn_readfirstlane(tid >> 6), mi = wave >> 2, rb = wave & 3;
    const size_t rowbase = (size_t)bl * SEQ;
    const int q0 = qb * 128 + rb * 32;
    const float m2 = exp2f(-2.f * (float)(h + 1)) * LOG2E;
    bf16x8 qf[4];
    { const bf16_t* qp = proj + (rowbase + q0 + r32) * LDP + CQ + h * 128 + mi * 64 + hi * 8;
#pragma unroll
      for (int d0 = 0; d0 < 4; ++d0) qf[d0] = *(const bf16x8*)(qp + d0 * 16); }
    const bf16_t* ksrc0 = proj + (rowbase + lane) * LDP + CK + h * 128 + wave * 8;
    const bf16_t* ksrc1 = ksrc0 + 64;
    const bf16_t* vsrc0 = proj + (rowbase + 16 * (wave & 3) + (lane >> 2)) * LDP + CV + h * 128 + (wave >> 2) * 32 + (lane & 3) * 8;
    const bf16_t* vsrc1 = vsrc0 + 64;
#define ATT_ISSUE(t, sb) do { const size_t go_ = (size_t)(t) * 64 * LDP; LAS uchar* s_ = lds + (sb); \
        __builtin_amdgcn_global_load_lds((const unsigned*)(ksrc0 + go_), (LAS unsigned*)(s_ + wave * 1024), 16, 0, 0); \
        __builtin_amdgcn_global_load_lds((const unsigned*)(ksrc1 + go_), (LAS unsigned*)(s_ + (wave + 8) * 1024), 16, 0, 0); \
        __builtin_amdgcn_global_load_lds((const unsigned*)(vsrc0 + go_), (LAS unsigned*)(s_ + 16384 + wave * 1024), 16, 0, 0); \
        __builtin_amdgcn_global_load_lds((const unsigned*)(vsrc1 + go_), (LAS unsigned*)(s_ + 16384 + (wave + 8) * 1024), 16, 0, 0); } while (0)
    LAS float* wsf = (LAS float*)(lds + ATT_WSF) + wave * 64;
    f32x16 o[4];
#pragma unroll
    for (int d = 0; d < 4; ++d)
#pragma unroll
        for (int r = 0; r < 16; ++r) o[d][r] = 0.f;
    float mhat = 0.f;
    f32x16 ol;
#pragma unroll
    for (int r = 0; r < 16; ++r) ol[r] = 0.f;
    const bf16x8 ones = (bf16x8){0x3F80, 0x3F80, 0x3F80, 0x3F80, 0x3F80, 0x3F80, 0x3F80, 0x3F80};
    const int kfo = (mi * 8 + hi) * 1024 + r32 * 16;
    const int vfo = 16384 + ((lane >> 4) & 1) * 32 + (lane & 3) * 8 + (4 * hi + ((lane & 15) >> 2)) * 64;
    ATT_ISSUE(0, 0);
    for (int t = 0; t < SEQ / 64; ++t) {
        __syncthreads();
        if (t + 1 < SEQ / 64) ATT_ISSUE(t + 1, ((t + 1) & 1) * ATT_SLOT);
        const LAS uchar* sl = lds + (t & 1) * ATT_SLOT;
        const float dq = (float)(q0 + r32 - 64 * t - 4 * hi);
        f32x16 p0, p1;
#pragma unroll
        for (int r = 0; r < 16; ++r) { const float kc = (float)((r & 3) + 8 * (r >> 2));
            p0[r] = __builtin_fmaf(-m2, __builtin_fabsf(dq - kc), -mhat); p1[r] = __builtin_fmaf(-m2, __builtin_fabsf(dq - kc - 32.f), -mhat); }
#pragma unroll
        for (int d0 = 0; d0 < 4; ++d0) {
            const bf16x8 a0 = *(const LAS bf16x8*)(sl + kfo + d0 * 2048), a1 = *(const LAS bf16x8*)(sl + kfo + d0 * 2048 + 512);
            p0 = __builtin_amdgcn_mfma_f32_32x32x16_bf16(a0, qf[d0], p0, 0, 0, 0);
            p1 = __builtin_amdgcn_mfma_f32_32x32x16_bf16(a1, qf[d0], p1, 0, 0, 0); }
        float rm = fmaxf(p0[0], p1[0]);
#pragma unroll
        for (int r = 1; r < 16; ++r) rm = fmaxf(rm, fmaxf(p0[r], p1[r]));
        rm = xhalf_max(rm);
        const bool first = (t == 0);
        if (first || __any(rm > 8.f)) {
            const float dl = first ? rm : fmaxf(rm, 0.f);
            mhat += dl;
#pragma unroll
            for (int r = 0; r < 16; ++r) { p0[r] -= dl; p1[r] -= dl; }
            if (!first) {
                const float f = __builtin_amdgcn_exp2f(-dl);
                if (hi == 0) wsf[r32] = f;
                float fr_[16];
#pragma unroll
                for (int r = 0; r < 16; ++r) fr_[r] = wsf[crow(r, hi)];
#pragma unroll
                for (int d = 0; d < 4; ++d)
#pragma unroll
                    for (int r = 0; r < 16; ++r) o[d][r] *= fr_[r];
#pragma unroll
                for (int r = 0; r < 16; ++r) ol[r] *= fr_[r];
            }
        }
#pragma unroll
        for (int r = 0; r < 16; ++r) { p0[r] = __builtin_amdgcn_exp2f(p0[r]); p1[r] = __builtin_amdgcn_exp2f(p1[r]); }
        u32x4 pw[4];
#pragma unroll
        for (int j = 0; j < 4; ++j) { pw[0][j] = cvt_pk_bf16(p0[2 * j], p0[2 * j + 1]); pw[1][j] = cvt_pk_bf16(p0[8 + 2 * j], p0[8 + 2 * j + 1]);
                                      pw[2][j] = cvt_pk_bf16(p1[2 * j], p1[2 * j + 1]); pw[3][j] = cvt_pk_bf16(p1[8 + 2 * j], p1[8 + 2 * j + 1]); }
#pragma unroll
        for (int d = 0; d < 4; ++d)
#pragma unroll
            for (int ks = 0; ks < 4; ++ks) {
                const s16x4 lo = vtr(sl + vfo + d * 4096 + ks * 1024), hh = vtr(sl + vfo + d * 4096 + ks * 1024 + 512);
                const bf16x8 vf = (bf16x8){lo[0], lo[1], lo[2], lo[3], hh[0], hh[1], hh[2], hh[3]};
                o[d] = __builtin_amdgcn_mfma_f32_32x32x16_bf16(__builtin_bit_cast(bf16x8, pw[ks]), vf, o[d], 0, 0, 0); }
#pragma unroll
        for (int ks = 0; ks < 4; ++ks) ol = __builtin_amdgcn_mfma_f32_32x32x16_bf16(__builtin_bit_cast(bf16x8, pw[ks]), ones, ol, 0, 0, 0);
    }
#undef ATT_ISSUE
    float fr_[16];
#pragma unroll
    for (int r = 0; r < 16; ++r) fr_[r] = (mi == 0 ? 1.f : lam) / ol[r];
    __syncthreads();
    LAS float* X = (LAS float*)lds + rb * 4096;
    if (mi == 1) {
#pragma unroll
        for (int d = 0; d < 4; ++d)
#pragma unroll
            for (int r = 0; r < 16; ++r) X[(d * 16 + r) * 64 + lane] = o[d][r] * fr_[r];
    }
    __syncthreads();
    if (mi == 0) {
        float ss[16];
#pragma unroll
        for (int r = 0; r < 16; ++r) ss[r] = 0.f;
#pragma unroll
        for (int d = 0; d < 4; ++d)
#pragma unroll
            for (int r = 0; r < 16; ++r) { const float v = o[d][r] * fr_[r] - X[(d * 16 + r) * 64 + lane]; o[d][r] = v; ss[r] += v * v; }
#pragma unroll
        for (int r = 0; r < 16; ++r) {
#pragma unroll
            for (int s = 1; s < 32; s <<= 1) ss[r] += __shfl_xor(ss[r], s);
            ss[r] = rsqrtf(ss[r] * (1.f / 128.f) + EPS) * (1.f - laminit); }
        float gv[4];
#pragma unroll
        for (int d = 0; d < 4; ++d) gv[d] = sg[d * 32 + r32];
#pragma unroll
        for (int r = 0; r < 16; ++r) { bf16_t* op = ocat + (rowbase + q0 + crow(r, hi)) * D + h * 128 + r32;
#pragma unroll
            for (int d = 0; d < 4; ++d) op[d * 32] = (bf16_t)f2bf(o[d][r] * ss[r] * gv[d]); }
    }
    __syncthreads();
}

template <int DK, bool HG>
__device__ __forceinline__ void scan_item(LAS uchar* lds, const bf16_t* proj, float* ofwd, bf16_t* ocat, int bl, int h, const float* lb  ,
                                          const float* normg  , const float* w2  , const float* gbias  ) {
    constexpr int KPW = DK / 8;
    LAS float* sA = (LAS float*)lds;
    LAS float* sK = sA + 16 * DK;
    LAS float* sQ = sK + 16 * DK;
    LAS float* sV = sQ + 16 * DK;
    LAS float* sP = sV + 16 * 64;
    const int tid = tid_fresh(), lane = tid & 63, wave = __builtin_amdgcn_readfirstlane(tid >> 6);
    const int ps = tid >> 5, pi = tid & 31;
    const size_t rowbase = (size_t)bl * SEQ;
    const float ng = normg[lane];
    __syncthreads();
    for (int dir = 0; dir < 2; ++dir) {
        float lb0 = 0.f, lb1 = 0.f, w2c[16], bias = 0.f;
        if (HG) { lb0 = lb[dir * 256 + h * 64 + pi]; lb1 = lb[dir * 256 + h * 64 + pi + 32]; }
        else {
#pragma unroll
            for (int r = 0; r < 16; ++r) w2c[r] = w2[(dir * 16 + r) * 128 + h * 32 + pi];
            bias = gbias[dir * 128 + h * 32 + pi]; }
        float S[KPW];
#pragma unroll
        for (int j = 0; j < KPW; ++j) S[j] = 0.f;
        const int sw = dir == 0 ? wave : 7 - wave;
        bf16_t rz0 = 0, rz1 = 0, rq0 = 0, rq1 = 0, rv0 = 0, rv1 = 0, rk0 = 0; u32x4 rl0 = {0, 0, 0, 0}, rl1 = {0, 0, 0, 0};
        bf16_t rg[2] = {0, 0}; float rof[2] = {0.f, 0.f};
#define SCAN_LOAD(blk) do { const int tok_ = dir == 0 ? (blk) * 16 + ps : 2047 - ((blk) * 16 + ps); const bf16_t* pr_ = proj + (rowbase + tok_) * LDP; \
        if (HG) { const int zc_ = (dir == 0 ? BFF : BFB) + h * 64 + pi; rz0 = pr_[zc_]; rz1 = pr_[zc_ + 32]; rq0 = pr_[BQ + h * 64 + pi]; rq1 = pr_[BQ + h * 64 + pi + 32]; rv0 = pr_[BI + h * 64 + pi]; rv1 = pr_[BI + h * 64 + pi + 32]; } \
        else { const u32x4* lp_ = (const u32x4*)(pr_ + (dir == 0 ? GLF : GLB)); rl0 = lp_[0]; rl1 = lp_[1]; rk0 = pr_[GK + h * 32 + pi]; rq0 = pr_[GQ + h * 32 + pi]; rv0 = pr_[GV + h * 64 + pi]; rv1 = pr_[GV + h * 64 + pi + 32]; } \
        if (dir == 1) { _Pragma("unroll") for (int j2_ = 0; j2_ < 2; ++j2_) { const int t2_ = 2047 - ((blk) * 16 + sw + 8 * j2_); \
            rg[j2_] = proj[(rowbase + t2_) * LDP + (HG ? BG : GG) + h * 64 + lane]; rof[j2_] = ofwd[(rowbase + t2_) * 512 + (HG ? 0 : 256) + h * 64 + lane]; } } } while (0)
        SCAN_LOAD(0);
        for (int blk = 0; blk < SEQ / 16; ++blk) {
            if (HG) {
                const float z0 = bf2f(rz0), z1 = bf2f(rz1);
                const float s0 = 1.f / (1.f + __expf(-z0)), s1 = 1.f / (1.f + __expf(-z1));
                sA[ps * 64 + pi] = s0 * (1.f + lb0 * __expf(fminf(-z0, 80.f))); sA[ps * 64 + pi + 32] = s1 * (1.f + lb1 * __expf(fminf(-z1, 80.f)));
                sK[ps * 64 + pi] = (1.f - lb0) / (1.f + __expf(z0)); sK[ps * 64 + pi + 32] = (1.f - lb1) / (1.f + __expf(z1));
                const float q0 = bf2f(rq0), q1 = bf2f(rq1);
                sQ[ps * 64 + pi] = q0 / (1.f + __expf(-q0)) * 0.125f; sQ[ps * 64 + pi + 32] = q1 / (1.f + __expf(-q1)) * 0.125f;
            } else {
                float z = bias;
#pragma unroll
                for (int j = 0; j < 4; ++j) { z += bflo(rl0[j]) * w2c[2 * j] + bfhi(rl0[j]) * w2c[2 * j + 1]; z += bflo(rl1[j]) * w2c[8 + 2 * j] + bfhi(rl1[j]) * w2c[8 + 2 * j + 1]; }
                const float ls = fminf(z, 0.f) - __logf(1.f + __expf(-fabsf(z)));
                sA[ps * 32 + pi] = __expf(ls * (1.f / 16.f));
                sK[ps * 32 + pi] = bf2f(rk0);
                sQ[ps * 32 + pi] = bf2f(rq0) * 0.17677669529663687f;
            }
            sV[ps * 64 + pi] = bf2f(rv0); sV[ps * 64 + pi + 32] = bf2f(rv1);
            const bf16_t cg0 = rg[0], cg1 = rg[1]; const float cf0 = rof[0], cf1 = rof[1];
            __syncthreads();
            if (blk + 1 < SEQ / 16) SCAN_LOAD(blk + 1);
#pragma unroll 4
            for (int s = 0; s < 16; ++s) {
                const float v = sV[s * 64 + lane];
                float a[KPW], kk[KPW], q[KPW];
#pragma unroll
                for (int j4 = 0; j4 < KPW / 4; ++j4) {
                    const f32x4 a4 = *(const LAS f32x4*)(sA + s * DK + wave * KPW + j4 * 4), k4 = *(const LAS f32x4*)(sK + s * DK + wave * KPW + j4 * 4), q4 = *(const LAS f32x4*)(sQ + s * DK + wave * KPW + j4 * 4);
#pragma unroll
                    for (int j = 0; j < 4; ++j) { a[j4 * 4 + j] = a4[j]; kk[j4 * 4 + j] = k4[j]; q[j4 * 4 + j] = q4[j]; } }
                float op = 0.f;
#pragma unroll
                for (int j = 0; j < KPW; ++j) { S[j] = __builtin_fmaf(a[j], S[j], kk[j] * v); op = __builtin_fmaf(q[j], S[j], op); }
                sP[(s * 8 + wave) * 64 + lane] = op;
            }
            __syncthreads();
#pragma unroll
            for (int j2 = 0; j2 < 2; ++j2) {
                const int s = sw + 8 * j2; const int tok = dir == 0 ? blk * 16 + s : 2047 - (blk * 16 + s);
                float sum = 0.f;
#pragma unroll
                for (int w = 0; w < 8; ++w) sum += sP[(s * 8 + w) * 64 + lane];
                if (dir == 0) ofwd[(rowbase + tok) * 512 + (HG ? 0 : 256) + h * 64 + lane] = sum;
                else {
                    const float tot = sum + (j2 == 0 ? cf0 : cf1);
                    const float ssq = wave_sum(tot * tot);
                    const float gvv = bf2f(j2 == 0 ? cg0 : cg1);
                    const float outv = tot * rsqrtf(ssq * (1.f / 64.f) + EPS) * ng * (gvv / (1.f + __expf(-gvv)));
                    ocat[(rowbase + tok) * D + (HG ? 512 : 768) + h * 64 + lane] = (bf16_t)f2bf(outv);
                }
            }
        }
#undef SCAN_LOAD
        __syncthreads();
    }
}

__device__ __forceinline__ void norm_rows_mod(const float* src, bf16_t* dst, const float* g, const float* modl  , int grow0, int shoff, int scoff) {
    const int tid = tid_fresh(), lane = tid & 63, gw = blockIdx.x * 8 + __builtin_amdgcn_readfirstlane(tid >> 6), NGW = gridDim.x * 8;
    for (int m = gw; m < TG; m += NGW) {
        const int b = (grow0 + m) >> 11;
        const f32x4* xr = (const f32x4*)(src + (size_t)m * D) + lane;
        const f32x4* gr = (const f32x4*)g + lane; const f32x4* sh = (const f32x4*)(modl + (size_t)b * (NMOD * D) + shoff) + lane; const f32x4* sc = (const f32x4*)(modl + (size_t)b * (NMOD * D) + scoff) + lane;
        f32x4 v[4]; float s = 0.f;
#pragma unroll
        for (int j = 0; j < 4; ++j) { v[j] = xr[64 * j]; s += (v[j].x * v[j].x + v[j].y * v[j].y) + (v[j].z * v[j].z + v[j].w * v[j].w); }
        const float r = rsqrtf(wave_sum(s) * (1.f / D) + EPS);
        unsigned long long* o8 = (unsigned long long*)(dst + (size_t)m * D) + lane;
#pragma unroll
        for (int j = 0; j < 4; ++j) { const f32x4 y = v[j] * r * gr[64 * j] * (1.f + sc[64 * j]) + sh[64 * j];
            o8[64 * j] = (unsigned long long)pk2(y.x, y.y) | ((unsigned long long)pk2(y.z, y.w) << 32); }
    }
}
__device__ __forceinline__ void norm_rows_final(float* x, const float* g) {
    const int tid = tid_fresh(), lane = tid & 63, gw = blockIdx.x * 8 + __builtin_amdgcn_readfirstlane(tid >> 6), NGW = gridDim.x * 8;
    for (int m = gw; m < TG; m += NGW) {
        f32x4* xr = (f32x4*)(x + (size_t)m * D) + lane; const f32x4* gr = (const f32x4*)g + lane;
        f32x4 v[4]; float s = 0.f;
#pragma unroll
        for (int j = 0; j < 4; ++j) { v[j] = xr[64 * j]; s += (v[j].x * v[j].x + v[j].y * v[j].y) + (v[j].z * v[j].z + v[j].w * v[j].w); }
        const float r = rsqrtf(wave_sum(s) * (1.f / D) + EPS);
#pragma unroll
        for (int j = 0; j < 4; ++j) xr[64 * j] = v[j] * r * gr[64 * j];
    }
}

__device__ __forceinline__ void transpose_item(const float* W, int ldw, bf16_t* WT, int ldt, int row_off, int k_off, LAS float* scr, int kb, int nb, int lane) {
    const int k0 = 64 * kb, n0 = 32 * nb;
#pragma unroll 8
    for (int i = 0; i < 32; ++i) { const int kk = 2 * i + (lane >> 5); scr[kk * 33 + (lane & 31)] = W[(size_t)(k0 + kk) * ldw + n0 + (lane & 31)]; }
    asm volatile("s_waitcnt lgkmcnt(0)" ::: "memory");
    const int c = lane & 7;
#pragma unroll
    for (int j = 0; j < 4; ++j) { const int n = (lane >> 3) + 8 * j; const LAS float* s = scr + (8 * c) * 33 + n;
        u32x4 o; o.x = pk2(s[0 * 33], s[1 * 33]); o.y = pk2(s[2 * 33], s[3 * 33]); o.z = pk2(s[4 * 33], s[5 * 33]); o.w = pk2(s[6 * 33], s[7 * 33]);
        *(u32x4*)(WT + (size_t)(row_off + n0 + n) * ldt + k_off + k0 + 8 * c) = o; }
    asm volatile("s_waitcnt lgkmcnt(0)" ::: "memory");
}

struct Args { const void* p[24]; };
enum { P_X = 0, P_C, P_ADAW, P_ADAB, P_NMIXG, P_NMLPG, P_WIN, P_DLAM, P_DSUBG, P_HLB, P_HNG, P_GW2, P_GB, P_GNG, P_WUA, P_WUB, P_WUC, P_WOUT, P_W1, P_W2, P_FNG, P_OUT, P_WS };
typedef const unsigned long long __attribute__((address_space(4)))* kargp_t;
__device__ __forceinline__ const void* karg(int i) { kargp_t kp = (kargp_t)__builtin_amdgcn_kernarg_segment_ptr(); asm volatile("" : "+s"(kp)); return (const void*)kp[i]; }
#define GRID_SYNC() do { asm volatile("s_waitcnt vmcnt(0) lgkmcnt(0)" ::: "memory"); __builtin_amdgcn_fence(__ATOMIC_RELEASE, ""); asm volatile("s_waitcnt vmcnt(0)" ::: "memory"); __syncthreads(); grid.sync(); \
    __builtin_amdgcn_fence(__ATOMIC_ACQUIRE, ""); asm volatile("s_waitcnt vmcnt(0)" ::: "memory"); __syncthreads(); } while (0)
#define KF(i) ((const float*)karg(i))
#define KWS() ((uchar*)karg(P_WS))

__global__ void __launch_bounds__(512, 2) fwd_megakernel(Args a_unused) {
    extern __shared__ __attribute__((aligned(16))) uchar lds_raw[];
    LAS uchar* lds = (LAS uchar*)lds_raw;
    cg::grid_group grid = cg::this_grid();
    {
    const int tid = tid_fresh(), lane = tid & 63, wave = __builtin_amdgcn_readfirstlane(tid >> 6);

    if (blockIdx.x == 0) {
        unsigned* ctl = (unsigned*)(KWS() + WS_CTL); float* ctlf = (float*)ctl;
        for (int i = tid; i < 1024; i += 512) ctl[i] = 0u;
        if (tid < 4) {
            const float* lp = KF(P_DLAM) + tid * 256; float s1 = 0.f, s2 = 0.f;
            for (int d = 0; d < 64; ++d) { s1 += lp[d] * lp[64 + d]; s2 += lp[128 + d] * lp[192 + d]; }
            const float li = 0.8f - 0.6f * expf(-0.3f * (float)tid);
            ctlf[1024 + tid] = expf(s1) - expf(s2) + li; ctlf[1028 + tid] = li;
        }
        {
            const float* lg = KF(P_HLB); const int j = tid;
            float v[4], mx = -1e30f;
#pragma unroll
            for (int l = 0; l < 4; ++l) { v[l] = lg[l * 512 + j]; mx = fmaxf(mx, v[l]); }
            float den = 0.f;
#pragma unroll
            for (int l = 0; l < 4; ++l) { v[l] = expf(v[l] - mx); den += v[l]; }
            float cum = 0.f; const float w0 = v[0] / den;
#pragma unroll
            for (int l = 0; l < 4; ++l) { cum += v[l] / den; ctlf[2048 + l * 512 + j] = cum - w0; }
        }
        {
            float* pv = ctlf + 8192;
            const float* s0 = KF(P_NMIXG); for (int i = tid; i < 4096; i += 512) pv[i] = s0[i];
            const float* s1 = KF(P_NMLPG); for (int i = tid; i < 4096; i += 512) pv[4096 + i] = s1[i];
            const float* s2 = KF(P_DSUBG); for (int i = tid; i < 512; i += 512) pv[8192 + i] = s2[i];
            const float* s3 = KF(P_HNG); for (int i = tid; i < 256; i += 512) pv[8704 + i] = s3[i];
            const float* s4 = KF(P_GW2); for (int i = tid; i < 16384; i += 512) pv[8960 + i] = s4[i];
            const float* s5 = KF(P_GB); for (int i = tid; i < 1024; i += 512) pv[25344 + i] = s5[i];
            const float* s6 = KF(P_GNG); for (int i = tid; i < 256; i += 512) pv[26368 + i] = s6[i];
            const float* s7 = KF(P_FNG); for (int i = tid; i < 1024; i += 512) pv[26624 + i] = s7[i];
        }
    }
#ifndef NO_MOD
    {
        LAS float* cond = (LAS float*)lds; LAS float* red = (LAS float*)(lds + 131072);
        float* mod = (float*)(KWS() + WS_MOD);
        const float* cin = KF(P_C); const float* adaw = KF(P_ADAW); const float* adab = KF(P_ADAB);
        bool loaded = false;
        for (int it = blockIdx.x; it < 4 * 96; it += gridDim.x) {
            if (!loaded) { for (int i = tid; i < 32 * 1024; i += 512) { const float cv = cin[i]; cond[i] = cv / (1.f + __expf(-cv)); } loaded = true; __syncthreads(); }
            const int l = it / 96, n0 = (it % 96) * 64;
            const float* W = adaw + (size_t)l * D * (NMOD * D) + n0 + lane;
            float acc[32];
#pragma unroll
            for (int b = 0; b < 32; ++b) acc[b] = 0.f;
            for (int k4 = 0; k4 < 32; ++k4) {
                const int k = wave * 128 + k4 * 4;
                const float w0 = W[(size_t)k * (NMOD * D)], w1 = W[(size_t)(k + 1) * (NMOD * D)], w2v = W[(size_t)(k + 2) * (NMOD * D)], w3 = W[(size_t)(k + 3) * (NMOD * D)];
#pragma unroll
                for (int b = 0; b < 32; ++b) { const f32x4 c4 = *(const LAS f32x4*)(cond + b * 1024 + k); acc[b] += c4.x * w0 + c4.y * w1 + c4.z * w2v + c4.w * w3; }
            }
#pragma unroll
            for (int rd = 0; rd < 4; ++rd) {
                __syncthreads();
#pragma unroll
                for (int bb = 0; bb < 8; ++bb) red[(wave * 8 + bb) * 64 + lane] = acc[rd * 8 + bb];
                __syncthreads();
                float s = 0.f;
#pragma unroll
                for (int w = 0; w < 8; ++w) s += red[(w * 8 + wave) * 64 + lane];
                const int b = rd * 8 + wave;
                mod[((size_t)l * 32 + b) * (NMOD * D) + n0 + lane] = s + adab[l * (NMOD * D) + n0 + lane];
            }
        }
        __syncthreads();
    }
#endif
#ifndef NO_WT
    {
        LAS float* scr = (LAS float*)(lds + wave * 8704);
        const int gw = blockIdx.x * 8 + wave, NGW = gridDim.x * 8;
        uchar* ws = KWS();
        bf16_t* win_t = (bf16_t*)(ws + WS_WIN); bf16_t* wup_t = (bf16_t*)(ws + WS_WUP); bf16_t* wout_t = (bf16_t*)(ws + WS_WOUT);
        bf16_t* w1_t = (bf16_t*)(ws + WS_W1); bf16_t* w2_t = (bf16_t*)(ws + WS_W2);
        constexpr int I_IN = 16 * 209, I_UA = 8 * 32, I_UB = 4 * 32, I_UC = 4 * 32, I_O = 16 * 32, I_1 = 16 * 128, I_2 = 64 * 32;
        constexpr int I_L = I_IN + I_UA + I_UB + I_UC + I_O + I_1 + I_2;
        for (int it = gw; it < 4 * I_L; it += NGW) {
            const int l = it / I_L; int r = it % I_L;
            if (r < I_IN) { transpose_item(KF(P_WIN) + (size_t)l * D * DIN, DIN, win_t + (size_t)l * LDP * D, D, 0, 0, scr, r / 209, r % 209, lane); continue; } r -= I_IN;
            if (r < I_UA) { transpose_item(KF(P_WUA) + (size_t)l * 512 * D, D, wup_t + (size_t)l * D * D, D, 0, 0, scr, r / 32, r % 32, lane); continue; } r -= I_UA;
            if (r < I_UB) { transpose_item(KF(P_WUB) + (size_t)l * 256 * D, D, wup_t + (size_t)l * D * D, D, 0, 512, scr, r / 32, r % 32, lane); continue; } r -= I_UB;
            if (r < I_UC) { transpose_item(KF(P_WUC) + (size_t)l * 256 * D, D, wup_t + (size_t)l * D * D, D, 0, 768, scr, r / 32, r % 32, lane); continue; } r -= I_UC;
            if (r < I_O) { transpose_item(KF(P_WOUT) + (size_t)l * D * D, D, wout_t + (size_t)l * D * D, D, 0, 0, scr, r / 32, r % 32, lane); continue; } r -= I_O;
            if (r < I_1) { transpose_item(KF(P_W1) + (size_t)l * D * DFF, DFF, w1_t + (size_t)l * DFF * D, D, 0, 0, scr, r / 128, r % 128, lane); continue; } r -= I_1;
            transpose_item(KF(P_W2) + (size_t)l * DFF * D, D, w2_t + (size_t)l * D * DFF, DFF, 0, 0, scr, r / 32, r % 32, lane);
        }
        for (int i = blockIdx.x * 512 + tid; i < 4 * 28672; i += gridDim.x * 512) { const int l = i / 28672, r = i % 28672;
            *(u32x4*)(win_t + (size_t)l * LDP * D + (size_t)DIN * D + (size_t)r * 8) = (u32x4){0u, 0u, 0u, 0u}; }
    }
#endif
    }
    GRID_SYNC();

    for (int grp = 0; grp < NGRP; ++grp) {
        for (int l = 0; l < DEPTH; ++l) {
            {
                uchar* ws = KWS(); const float* pv = (const float*)(ws + WS_CTL) + 8192;
                const float* src = (l == 0 ? KF(P_X) : (const float*)karg(P_OUT)) + (size_t)grp * TG * D;
                norm_rows_mod(src, (bf16_t*)(ws + WS_HB), pv + l * D, (const float*)(ws + WS_MOD) + (size_t)l * 32 * (NMOD * D), grp * TG, 0, D);
            }
            GRID_SYNC();
            { uchar* ws = KWS(); pg8::Gemm g{(const bf16_t*)(ws + WS_HB), (const bf16_t*)(ws + WS_WIN) + (size_t)l * LDP * D, D}; pg8::Order S; S.init(TG, LDP, D, gridDim.x, blockIdx.x, 1); pg8::EpiProj E{(bf16_t*)(ws + WS_PROJ)};
#ifndef NO_EPIPROJ
              pg8::gemm_phase<pg8::EpiProj>(lds, g, S, E);
#endif
            }
            GRID_SYNC();
            {
                uchar* ws = KWS(); const float* ctlf = (const float*)(ws + WS_CTL); const float* pv = ctlf + 8192;
                const int xq = blockIdx.x & 7; unsigned* ctr = (unsigned*)(ws + WS_CTL) + ((grp * DEPTH + l) * 8 + xq) * 4;
                const float lam = ctlf[1024 + l], laminit = ctlf[1028 + l];
                const bf16_t* PROJ = (const bf16_t*)(ws + WS_PROJ); bf16_t* OCAT = (bf16_t*)(ws + WS_OCAT); float* OFWD = (float*)(ws + WS_OFWD);
                LAS int* itm = (LAS int*)(lds + 147456 - 64);
                const int tid = tid_fresh();
                for (;;) {
                    __syncthreads();
                    if (tid == 0) itm[0] = (int)atomicAdd(ctr, 1u);
                    __syncthreads();
                    const int it = itm[0];
                    constexpr int NPQ = GB * 4 / 8;
                    if (it >= 2 * NPQ + NPQ * 16) break;
#ifndef NO_SCAN
                    if (it < NPQ) { const int p = it * 8 + xq;
                        scan_item<64, true>(lds, PROJ, OFWD, OCAT, p >> 2, p & 3, ctlf + 2048 + l * 512, pv + 8704 + l * 64, nullptr, nullptr);
                    } else if (it < 2 * NPQ) { const int p = (it - NPQ) * 8 + xq;
                        scan_item<32, false>(lds, PROJ, OFWD, OCAT, p >> 2, p & 3, nullptr, pv + 26368 + l * 64, pv + 8960 + l * 4096, pv + 25344 + l * 256);
                    } else
#endif
                    { const int u = it - 2 * NPQ, p = (u >> 4) * 8 + xq;
#ifndef NO_ATTN
                        if (it >= 2 * NPQ) attn_unit(lds, PROJ, OCAT, p >> 2, p & 3, u & 15, lam, laminit, pv + 8192 + l * 128);
#endif
                    }
                }
            }
            GRID_SYNC();
            { uchar* ws = KWS(); pg8::Gemm g{(const bf16_t*)(ws + WS_OCAT), (const bf16_t*)(ws + WS_WUP) + (size_t)l * D * D, D}; pg8::Order S; S.init(TG, D, D, gridDim.x, blockIdx.x, 3); pg8::EpiMerge E{(const bf16_t*)(ws + WS_PROJ), (bf16_t*)(ws + WS_HB)};
#ifndef NO_EPIMERGE
              pg8::gemm_phase<pg8::EpiMerge>(lds, g, S, E);
#endif
            }
            GRID_SYNC();
            { uchar* ws = KWS(); pg8::Gemm g{(const bf16_t*)(ws + WS_HB), (const bf16_t*)(ws + WS_WOUT) + (size_t)l * D * D, D}; pg8::Order S; S.init(TG, D, D, gridDim.x, blockIdx.x, 1);
              float* xg = (float*)karg(P_OUT) + (size_t)grp * TG * D;
              pg8::EpiRes E{l == 0 ? KF(P_X) + (size_t)grp * TG * D : xg, xg, (const float*)(ws + WS_MOD) + ((size_t)l * 32 + grp * GB) * (NMOD * D) + 2 * D};
#ifndef NO_EPIRES
              pg8::gemm_phase<pg8::EpiRes>(lds, g, S, E);
#endif
            }
            GRID_SYNC();
            {
                uchar* ws = KWS(); const float* pv = (const float*)(ws + WS_CTL) + 8192;
                norm_rows_mod((const float*)karg(P_OUT) + (size_t)grp * TG * D, (bf16_t*)(ws + WS_HB), pv + 4096 + l * D, (const float*)(ws + WS_MOD) + (size_t)l * 32 * (NMOD * D), grp * TG, 3 * D, 4 * D);
            }
            GRID_SYNC();
            { uchar* ws = KWS(); pg8::Gemm g{(const bf16_t*)(ws + WS_HB), (const bf16_t*)(ws + WS_W1) + (size_t)l * DFF * D, D}; pg8::Order S; S.init(TG, DFF, D, gridDim.x, blockIdx.x, 1); pg8::EpiRelu2 E{(bf16_t*)(ws + WS_U)};
#ifndef NO_EPIRELU2
              pg8::gemm_phase<pg8::EpiRelu2>(lds, g, S, E);
#endif
            }
            GRID_SYNC();
            { uchar* ws = KWS(); pg8::Gemm g{(const bf16_t*)(ws + WS_U), (const bf16_t*)(ws + WS_W2) + (size_t)l * D * DFF, DFF}; pg8::Order S; S.init(TG, D, DFF, gridDim.x, blockIdx.x, 1);
              float* xg = (float*)karg(P_OUT) + (size_t)grp * TG * D;
              pg8::EpiRes E{xg, xg, (const float*)(ws + WS_MOD) + ((size_t)l * 32 + grp * GB) * (NMOD * D) + 5 * D};
#ifndef NO_EPIRES
              pg8::gemm_phase<pg8::EpiRes>(lds, g, S, E);
#endif
            }
            GRID_SYNC();
        }
        norm_rows_final((float*)karg(P_OUT) + (size_t)grp * TG * D, (const float*)(KWS() + WS_CTL) + 8192 + 26624);
    }
}

extern "C" void kernel_launch(void* const* d_in, const int* in_sizes, int n_in, void* d_out, int out_size, void* d_ws, size_t ws_size, hipStream_t stream) {
    static int grid = 0;
    if (grid == 0) {
        if (n_in != 21 || ws_size < WS_END) { fprintf(stderr, "kernel_launch: unexpected n_in %d / ws %zu\n", n_in, ws_size); grid = -1; return; }
        int dev = 0, cus = 0, per_cu = 0;
        if (hipGetDevice(&dev) != hipSuccess || hipDeviceGetAttribute(&cus, hipDeviceAttributeMultiprocessorCount, dev) != hipSuccess) { grid = -1; return; }
        if (hipFuncSetAttribute((const void*)fwd_megakernel, hipFuncAttributeMaxDynamicSharedMemorySize, LDS_BYTES) != hipSuccess) { fprintf(stderr, "kernel_launch: hipFuncSetAttribute failed\n"); grid = -1; return; }
        if (hipOccupancyMaxActiveBlocksPerMultiprocessor(&per_cu, (const void*)fwd_megakernel, 512, LDS_BYTES) != hipSuccess || per_cu < 1) { fprintf(stderr, "kernel_launch: occupancy query says %d\n", per_cu); per_cu = 1; }
        (void)hipGetLastError();
        grid = cus;
    }
    if (grid < 0) return;
    Args a{};
    for (int i = 0; i < 21; ++i) a.p[i] = d_in[i];
    a.p[21] = d_out; a.p[22] = d_ws; a.p[23] = nullptr;
    void* args[] = {&a};
    hipError_t e = hipLaunchCooperativeKernel((void*)fwd_megakernel, dim3(grid), dim3(512), args, LDS_BYTES, stream);
    if (e != hipSuccess) fprintf(stderr, "kernel_launch: cooperative launch failed: %s (grid %d)\n", hipGetErrorString(e), grid);
}
```

```cpp
#include <hip/hip_runtime.h>
#include <hip/hip_cooperative_groups.h>
#include <cstdio>
#include <cstdint>
namespace cg = cooperative_groups;

#define LAS __attribute__((address_space(3)))
typedef unsigned short bf16_t;
typedef short bf16x8 __attribute__((ext_vector_type(8)));
typedef float f32x4 __attribute__((ext_vector_type(4)));
typedef float f32x2 __attribute__((ext_vector_type(2)));
typedef float f32x16 __attribute__((ext_vector_type(16)));
typedef unsigned u32x4 __attribute__((ext_vector_type(4)));
typedef short s16x4 __attribute__((ext_vector_type(4)));
typedef unsigned char uchar;

constexpr int D = 1024, SEQ = 2048, BATCH = 32, DEPTH = 4, DIN = 6688, LDP = 6912, DFF = 4096, NMOD = 6;
constexpr int GB = 16, TG = GB * SEQ, NGRP = BATCH / GB;
constexpr int CQ = 0, CK = 512, CV = 1024, BQ = 1536, BFF = 1792, BFB = 2048, BI = 2304, BG = 2560;
constexpr int GQ = 2816, GK = 2944, GV = 3072, GG = 3328, GLF = 3584, GLB = 3600, GATE = 3616;
constexpr float EPS = 1e-6f, LOG2E = 1.4426950408889634f;
constexpr float QSCALE = 0.125f * LOG2E;

constexpr size_t MiB = 1u << 20;
constexpr size_t WS_CTL = 0;
constexpr size_t WS_MOD = 1 * MiB;
constexpr size_t WS_WIN = 4 * MiB;
constexpr size_t WS_WUP = 58 * MiB;
constexpr size_t WS_WOUT = 66 * MiB;
constexpr size_t WS_W1 = 74 * MiB;
constexpr size_t WS_W2 = 106 * MiB;
constexpr size_t WS_HB = 138 * MiB;
constexpr size_t WS_OCAT = 202 * MiB;
constexpr size_t WS_OFWD = 266 * MiB;
constexpr size_t WS_PROJ = 330 * MiB;
constexpr size_t WS_U = WS_PROJ;
constexpr size_t WS_END = 762 * MiB;
constexpr int LDS_BYTES = 148 * 1024;

__device__ __forceinline__ unsigned f2bf(float f) { unsigned u = __builtin_bit_cast(unsigned, f); return (u + 0x7fffu + ((u >> 16) & 1u)) >> 16; }
__device__ __forceinline__ unsigned pk2(float lo, float hi) { return f2bf(lo) | (f2bf(hi) << 16); }
__device__ __forceinline__ float bf2f(bf16_t v) { return __builtin_bit_cast(float, (unsigned)v << 16); }
__device__ __forceinline__ float bflo(unsigned u) { return __builtin_bit_cast(float, u << 16); }
__device__ __forceinline__ float bfhi(unsigned u) { return __builtin_bit_cast(float, u & 0xffff0000u); }
typedef __bf16 bf16x2_t __attribute__((ext_vector_type(2)));
__device__ __forceinline__ unsigned cvt_pk_bf16(float lo, float hi) { f32x2 v = {lo, hi}; bf16x2_t b = __builtin_convertvector(v, bf16x2_t); return __builtin_bit_cast(unsigned, b); }
__device__ __forceinline__ float wave_sum(float v) {
#pragma unroll
    for (int o = 1; o < 64; o <<= 1) v += __shfl_xor(v, o);
    return v;
}
__device__ __forceinline__ int tid_fresh() { int t = threadIdx.x; asm volatile("" : "+v"(t)); return t; }
__device__ __forceinline__ float sigmoidf_(float z) { return 1.f / (1.f + __expf(-z)); }

namespace pg8 {
constexpr int BM = 256, BK = 64, HALF = 128, HTB = HALF * BK * 2, STAGE_BYTES = 8 * HTB, NXCD = 8, WGM = 8;
__host__ __device__ __forceinline__ int lds_byte(int r, int c) { const int st = (r >> 4) * 2 + (c >> 5), rr = r & 15, cc = c & 31, ob = rr * 64 + cc * 2; return st * 1024 + (ob ^ (((ob >> 9) & 1) << 5)); }
__host__ __device__ __forceinline__ void stage_rc(int b, int& R, int& C) { const int st = b / 1024, sb = b % 1024, swz = sb ^ (((sb >> 9) & 1) << 5); R = (st >> 1) * 16 + swz / 64; C = (st & 1) * 32 + (swz % 64) / 2; }
__host__ __device__ __forceinline__ int perm32(int rho) { const int n = rho >> 4, i = rho & 15; return 8 * (i >> 2) + 4 * n + (i & 3); }

struct Unit { int pm, pn, koff, nt, seg; };
struct Gemm { const bf16_t* A; const bf16_t* Bt; int K; };

struct Order {
    int nM, nN, nwg, G, c, nseg, ntfull;
    __device__ void init(int M, int N, int K, int G_, int c_, int nseg_) { nM = M / BM; nN = N / BM; nwg = nM * nN; G = G_; c = c_; nseg = nseg_; ntfull = K / BK; }
    __device__ bool next(int i, Unit& u) const {
        int ti = i, seg = 0;
        if (nseg == 3) { ti = i / 3; seg = i - ti * 3; }
        const long L = (long)ti * G + c; if (L >= nwg) return false;
        int wgid = (int)L; { const int q = nwg / NXCD, r = nwg % NXCD, xcd = wgid % NXCD, off = wgid / NXCD; wgid = (xcd < r ? xcd * (q + 1) : r * (q + 1) + (xcd - r) * q) + off; }
        const int nig = WGM * nN, gid = wgid / nig, fm = gid * WGM, gsz = (nM - fm) < WGM ? (nM - fm) : WGM;
        u.pm = fm + ((wgid % nig) % gsz); u.pn = (wgid % nig) / gsz; u.seg = seg;
        if (nseg == 3) { u.koff = seg == 0 ? 0 : (seg == 1 ? 512 : 768); u.nt = seg == 0 ? 8 : 4; } else { u.koff = 0; u.nt = ntfull; }
        return true;
    }
};

struct EpiProj {
    bf16_t* O;
    __device__ __forceinline__ bool zero_after(const Unit&) const { return true; }
    __device__ __forceinline__ void operator()(f32x4 (&acc)[2][2][4][2], const Unit& u, int wr, int wc, int fr, int fq) const {
        const int row0 = u.pm * BM + wr * 64 + fr, col0 = u.pn * BM + wc * 32 + 8 * fq;
        const float sc = (u.pn < 2) ? QSCALE : 1.f;
#pragma unroll
        for (int ai = 0; ai < 2; ++ai)
#pragma unroll
            for (int m = 0; m < 4; ++m) { bf16_t* rowp = O + (size_t)(row0 + ai * HALF + m * 16) * LDP + col0;
#pragma unroll
                for (int bj = 0; bj < 2; ++bj) { f32x4 v0 = acc[ai][bj][m][0] * sc, v1 = acc[ai][bj][m][1] * sc;
                    u32x4 w; w.x = cvt_pk_bf16(v0[0], v0[1]); w.y = cvt_pk_bf16(v0[2], v0[3]); w.z = cvt_pk_bf16(v1[0], v1[1]); w.w = cvt_pk_bf16(v1[2], v1[3]);
                    *(u32x4*)(rowp + bj * HALF) = w; } }
    }
};
struct EpiRelu2 {
    bf16_t* O;
    __device__ __forceinline__ bool zero_after(const Unit&) const { return true; }
    __device__ __forceinline__ void operator()(f32x4 (&acc)[2][2][4][2], const Unit& u, int wr, int wc, int fr, int fq) const {
        const int row0 = u.pm * BM + wr * 64 + fr, col0 = u.pn * BM + wc * 32 + 8 * fq;
#pragma unroll
        for (int ai = 0; ai < 2; ++ai)
#pragma unroll
            for (int m = 0; m < 4; ++m) { bf16_t* rowp = O + (size_t)(row0 + ai * HALF + m * 16) * DFF + col0;
#pragma unroll
                for (int bj = 0; bj < 2; ++bj) { f32x4 v0 = acc[ai][bj][m][0], v1 = acc[ai][bj][m][1];
#pragma unroll
                    for (int j = 0; j < 4; ++j) { float a = fmaxf(v0[j], 0.f), b = fmaxf(v1[j], 0.f); v0[j] = a * a; v1[j] = b * b; }
                    u32x4 w; w.x = cvt_pk_bf16(v0[0], v0[1]); w.y = cvt_pk_bf16(v0[2], v0[3]); w.z = cvt_pk_bf16(v1[0], v1[1]); w.w = cvt_pk_bf16(v1[2], v1[3]);
                    *(u32x4*)(rowp + bj * HALF) = w; } }
    }
};
struct EpiRes {
    const float* base; float* out; const float* gate;
    __device__ __forceinline__ bool zero_after(const Unit&) const { return true; }
    __device__ __forceinline__ void operator()(f32x4 (&acc)[2][2][4][2], const Unit& u, int wr, int wc, int fr, int fq) const {
        const int row0 = u.pm * BM + wr * 64 + fr, col0 = u.pn * BM + wc * 32 + 8 * fq;
        const float* gp = gate + (size_t)((u.pm * BM) >> 11) * (NMOD * D) + col0;
#pragma unroll
        for (int bj = 0; bj < 2; ++bj) {
            const f32x4 g0 = *(const f32x4*)(gp + bj * HALF), g1 = *(const f32x4*)(gp + bj * HALF + 4);
#pragma unroll
            for (int ai = 0; ai < 2; ++ai) {
#pragma unroll
                for (int m = 0; m < 4; ++m) { const size_t off = (size_t)(row0 + ai * HALF + m * 16) * D + col0 + bj * HALF;
                    const f32x4 b0 = *(const f32x4*)(base + off), b1 = *(const f32x4*)(base + off + 4);
                    *(f32x4*)(out + off) = b0 + g0 * acc[ai][bj][m][0];
                    *(f32x4*)(out + off + 4) = b1 + g1 * acc[ai][bj][m][1];
                    if (m & 1) asm volatile("" ::: "memory"); }
            }
        }
    }
};
struct EpiMerge {
    const bf16_t* proj; bf16_t* O;
    __device__ __forceinline__ bool zero_after(const Unit& u) const { return u.seg == 2; }
    __device__ __forceinline__ void operator()(f32x4 (&acc)[2][2][4][2], const Unit& u, int wr, int wc, int fr, int fq) const {
        const int row0 = u.pm * BM + wr * 64 + fr, col0 = u.pn * BM + wc * 32 + 8 * fq;
        const int seg = u.seg;
#pragma unroll
        for (int ai = 0; ai < 2; ++ai)
#pragma unroll
            for (int m = 0; m < 4; ++m) { const size_t row = (size_t)(row0 + ai * HALF + m * 16); const bf16_t* gp = proj + row * LDP + GATE + col0;
#pragma unroll
                for (int bj = 0; bj < 2; ++bj) {
                    if (seg < 2) {
                        const u32x4 ga = *(const u32x4*)(gp + seg * D + bj * HALF), gb = *(const u32x4*)(gp + (seg + 1) * D + bj * HALF);
                        float r[8];
#pragma unroll
                        for (int j = 0; j < 4; ++j) {
                            const float a0 = fminf(fmaxf(bflo(ga[j]), -40.f), 40.f), a1 = fminf(fmaxf(bfhi(ga[j]), -40.f), 40.f);
                            const float b0 = fminf(fmaxf(bflo(gb[j]), -40.f), 40.f), b1 = fminf(fmaxf(bfhi(gb[j]), -40.f), 40.f);
                            r[2 * j] = (1.f + __expf(-b0)) * __builtin_amdgcn_rcpf(1.f + __expf(-a0));
                            r[2 * j + 1] = (1.f + __expf(-b1)) * __builtin_amdgcn_rcpf(1.f + __expf(-a1)); }
                        acc[ai][bj][m][0] = acc[ai][bj][m][0] * (f32x4){r[0], r[1], r[2], r[3]};
                        acc[ai][bj][m][1] = acc[ai][bj][m][1] * (f32x4){r[4], r[5], r[6], r[7]};
                    } else {
                        const u32x4 gc = *(const u32x4*)(gp + 2 * D + bj * HALF);
                        float r[8];
#pragma unroll
                        for (int j = 0; j < 4; ++j) {
                            const float c0 = fminf(fmaxf(bflo(gc[j]), -40.f), 40.f), c1 = fminf(fmaxf(bfhi(gc[j]), -40.f), 40.f);
                            r[2 * j] = __builtin_amdgcn_rcpf(1.f + __expf(-c0)); r[2 * j + 1] = __builtin_amdgcn_rcpf(1.f + __expf(-c1)); }
                        const f32x4 v0 = acc[ai][bj][m][0] * (f32x4){r[0], r[1], r[2], r[3]}, v1 = acc[ai][bj][m][1] * (f32x4){r[4], r[5], r[6], r[7]};
                        u32x4 w; w.x = cvt_pk_bf16(v0[0], v0[1]); w.y = cvt_pk_bf16(v0[2], v0[3]); w.z = cvt_pk_bf16(v1[0], v1[1]); w.w = cvt_pk_bf16(v1[2], v1[3]);
                        *(u32x4*)(O + row * D + col0 + bj * HALF) = w;
                    } } }
    }
};

template <class Epi, bool ALIGN_EPI = true>
__device__ __forceinline__ void gemm_phase(LAS uchar* lds, const Gemm g, const Order& S, const Epi& E) {
    const int tid = tid_fresh(), wid = __builtin_amdgcn_readfirstlane(tid >> 6), lane = tid & 63, wr = wid >> 2, wc = wid & 3, fr = lane & 15, fq = lane >> 4;
    const int K = g.K;
    unsigned voffA[2], voffB[2];
#pragma unroll
    for (int i = 0; i < 2; ++i) { int R, C; stage_rc(tid * 16 + i * 8192, R, C); const int Rb = (R & ~31) + perm32(R & 31);
        voffA[i] = (unsigned)(R * K + C) * 2u; voffB[i] = (unsigned)(Rb * K + C) * 2u; }
    const size_t kstep = (size_t)(BK * 2);
    const size_t hstep = (size_t)HALF * K * 2;
    const size_t tstep = 2 * hstep;
    const unsigned ldsw = (unsigned)wid * 1024u;
    const int aoff = lds_byte(wr * 64 + fr, fq * 8), boff = lds_byte(wc * 32 + fr, fq * 8);
#define PG8_SA(b, h) (((b) * 2 + (h)) * HTB)
#define PG8_SB(b, h) ((4 + (b) * 2 + (h)) * HTB)
#define PG8_STAGE(bufoff, gbase, voff) do { _Pragma("unroll") for (int _i = 0; _i < 2; ++_i) \
        __builtin_amdgcn_global_load_lds((const unsigned*)((const char*)(gbase) + (voff)[_i]), (LAS unsigned*)(lds + (bufoff) + ldsw + _i * 8192), 16, 0, 0); } while (0)
#define PG8_LDA(dst, b, h) do { _Pragma("unroll") for (int m = 0; m < 4; ++m) _Pragma("unroll") for (int k = 0; k < 2; ++k) dst[m][k] = *(const LAS bf16x8*)(lds + PG8_SA(b, h) + aoff + m * 2048 + k * 1024); } while (0)
#define PG8_LDB(dst, b, h) do { _Pragma("unroll") for (int n = 0; n < 2; ++n) _Pragma("unroll") for (int k = 0; k < 2; ++k) dst[n][k] = *(const LAS bf16x8*)(lds + PG8_SB(b, h) + boff + n * 2048 + k * 1024); } while (0)
#define PG8_MMA(ai, bj, At, Bt) do { __builtin_amdgcn_s_setprio(1); _Pragma("unroll") for (int m = 0; m < 4; ++m) _Pragma("unroll") for (int n = 0; n < 2; ++n) _Pragma("unroll") for (int k = 0; k < 2; ++k) \
        acc[ai][bj][m][n] = __builtin_amdgcn_mfma_f32_16x16x32_bf16(Bt[n][k], At[m][k], acc[ai][bj][m][n], 0, 0, 0); __builtin_amdgcn_s_setprio(0); } while (0)
#define PG8_WAIT_V(n) asm volatile("s_waitcnt vmcnt(" #n ")" ::: "memory")
#define PG8_WAIT_L(n) asm volatile("s_waitcnt lgkmcnt(" #n ")" ::: "memory")
#define PG8_BAR __builtin_amdgcn_s_barrier()
#define PG8_SCHED __builtin_amdgcn_sched_barrier(0)
    Unit cur, nxt; int ui = 0;
    if (!S.next(0, cur)) return;
    f32x4 acc[2][2][4][2];
#pragma unroll
    for (int a = 0; a < 2; ++a)
#pragma unroll
        for (int b = 0; b < 2; ++b)
#pragma unroll
            for (int m = 0; m < 4; ++m)
#pragma unroll
                for (int n = 0; n < 2; ++n) acc[a][b][m][n] = (f32x4){0.f, 0.f, 0.f, 0.f};
    bf16x8 At[4][2], B0[2][2], B1[2][2];
    const char* cA = (const char*)g.A + (size_t)cur.pm * tstep + (size_t)cur.koff * 2; const char* cB = (const char*)g.Bt + (size_t)cur.pn * tstep + (size_t)cur.koff * 2;
    PG8_STAGE(PG8_SB(0, 0), cB, voffB); PG8_STAGE(PG8_SB(0, 1), cB + hstep, voffB); PG8_STAGE(PG8_SA(0, 0), cA, voffA); PG8_STAGE(PG8_SA(0, 1), cA + hstep, voffA);
    if (wr == 1) PG8_BAR;
    PG8_WAIT_V(2); PG8_BAR;
    PG8_STAGE(PG8_SB(1, 0), cB + kstep, voffB); PG8_STAGE(PG8_SA(1, 0), cA + kstep, voffA); PG8_STAGE(PG8_SB(1, 1), cB + hstep + kstep, voffB);
    PG8_WAIT_V(6); PG8_BAR;
    for (;;) {
        const bool has_next = S.next(ui + 1, nxt);
        const char* nA = has_next ? (const char*)g.A + (size_t)nxt.pm * tstep + (size_t)nxt.koff * 2 : cA; const char* nB = has_next ? (const char*)g.Bt + (size_t)nxt.pn * tstep + (size_t)nxt.koff * 2 : cB;
        const int nt = cur.nt;
        for (int t = 0; t < nt; t += 2) {
            const bool last = (t == nt - 2);
            const char* a1 = cA + (size_t)(t + 1) * kstep;
            const char* a2 = last ? nA : cA + (size_t)(t + 2) * kstep; const char* b2 = last ? nB : cB + (size_t)(t + 2) * kstep;
            const char* a3 = a2 + kstep; const char* b3 = b2 + kstep;
            PG8_LDB(B0, 0, 0); PG8_LDB(B1, 0, 1); PG8_SCHED; PG8_LDA(At, 0, 0); PG8_STAGE(PG8_SA(1, 1), a1 + hstep, voffA);
            PG8_WAIT_V(8); PG8_WAIT_L(0); PG8_BAR; PG8_MMA(0, 0, At, B0); PG8_MMA(0, 1, At, B1); PG8_BAR; PG8_SCHED;
            PG8_LDA(At, 0, 1); PG8_STAGE(PG8_SB(0, 0), b2, voffB); PG8_STAGE(PG8_SB(0, 1), b2 + hstep, voffB); PG8_STAGE(PG8_SA(0, 0), a2, voffA);
            PG8_WAIT_V(8); PG8_WAIT_L(0); PG8_BAR; PG8_MMA(1, 0, At, B0); PG8_MMA(1, 1, At, B1); PG8_BAR; PG8_SCHED;
            PG8_LDB(B0, 1, 0); PG8_LDB(B1, 1, 1); PG8_SCHED; PG8_LDA(At, 1, 0); PG8_STAGE(PG8_SA(0, 1), a2 + hstep, voffA);
            PG8_WAIT_V(8); PG8_WAIT_L(0); PG8_BAR; PG8_MMA(0, 0, At, B0); PG8_MMA(0, 1, At, B1); PG8_BAR; PG8_SCHED;
            PG8_LDA(At, 1, 1); PG8_STAGE(PG8_SB(1, 0), b3, voffB); PG8_STAGE(PG8_SB(1, 1), b3 + hstep, voffB); PG8_STAGE(PG8_SA(1, 0), a3, voffA);
            PG8_WAIT_V(8); PG8_WAIT_L(0); PG8_BAR; PG8_MMA(1, 0, At, B0); PG8_MMA(1, 1, At, B1); PG8_BAR; PG8_SCHED;
        }
        if constexpr (ALIGN_EPI) { if (wr == 0) PG8_BAR; }
        E(acc, cur, wr, wc, fr, fq);
        if (!has_next) break;
        if (E.zero_after(cur)) {
#pragma unroll
            for (int a = 0; a < 2; ++a)
#pragma unroll
                for (int b = 0; b < 2; ++b)
#pragma unroll
                    for (int m = 0; m < 4; ++m)
#pragma unroll
                        for (int n = 0; n < 2; ++n) acc[a][b][m][n] = (f32x4){0.f, 0.f, 0.f, 0.f};
        }
        cur = nxt; cA = nA; cB = nB; ++ui;
        if constexpr (ALIGN_EPI) { if (wr == 1) PG8_BAR; }
    }
    PG8_WAIT_V(0);
    if constexpr (!ALIGN_EPI) { if (wr == 0) PG8_BAR; }
    PG8_BAR;
#undef PG8_SA
#undef PG8_SB
#undef PG8_STAGE
#undef PG8_LDA
#undef PG8_LDB
#undef PG8_MMA
#undef PG8_WAIT_V
#undef PG8_WAIT_L
#undef PG8_BAR
#undef PG8_SCHED
}
}

__device__ __forceinline__ int crow(int r, int hi) { return (r & 3) + 8 * (r >> 2) + 4 * hi; }
__device__ __forceinline__ s16x4 vtr(const LAS uchar* p) { return __builtin_bit_cast(s16x4, __builtin_amdgcn_ds_read_tr16_b64_v4i16((LAS s16x4*)p)); }
__device__ __forceinline__ float xhalf_max(float m) { auto rr = __builtin_amdgcn_permlane32_swap(__builtin_bit_cast(unsigned, m), __builtin_bit_cast(unsigned, m), false, false); return fmaxf(__builtin_bit_cast(float, rr[0]), __builtin_bit_cast(float, rr[1])); }
__device__ __forceinline__ float xhalf_sum(float m) { auto rr = __builtin_amdgcn_permlane32_swap(__builtin_bit_cast(unsigned, m), __builtin_bit_cast(unsigned, m), false, false); return __builtin_bit_cast(float, rr[0]) + __builtin_bit_cast(float, rr[1]); }

constexpr int ATT_SLOT = 32768, ATT_WSF = 65536;
__device__ __forceinline__ void attn_unit(LAS uchar* lds, const bf16_t* proj, bf16_t* ocat, int bl, int h, int qb, float lam, float laminit, const float* sg) {
    const int tid = tid_fresh(), lane = tid & 63, r32 = lane & 31, hi = lane >> 5;
    const int wave = __builtin_amdgcn_readfirstlane(tid >> 6), mi = wave >> 2, rb = wave & 3;
    const size_t rowbase = (size_t)bl * SEQ;
    const int q0 = qb * 128 + rb * 32;
    const float m2 = exp2f(-2.f * (float)(h + 1)) * LOG2E;
    bf16x8 qf[4];
    { const bf16_t* qp = proj + (rowbase + q0 + r32) * LDP + CQ + h * 128 + mi * 64 + hi * 8;
#pragma unroll
      for (int d0 = 0; d0 < 4; ++d0) qf[d0] = *(const bf16x8*)(qp + d0 * 16); }
    const bf16_t* ksrc0 = proj + (rowbase + lane) * LDP + CK + h * 128 + wave * 8;
    const bf16_t* ksrc1 = ksrc0 + 64;
    const bf16_t* vsrc0 = proj + (rowbase + 16 * (wave & 3) + (lane >> 2)) * LDP + CV + h * 128 + (wave >> 2) * 32 + (lane & 3) * 8;
    const bf16_t* vsrc1 = vsrc0 + 64;
#define ATT_ISSUE(t, sb) do { const size_t go_ = (size_t)(t) * 64 * LDP; LAS uchar* s_ = lds + (sb); \
        __builtin_amdgcn_global_load_lds((const unsigned*)(ksrc0 + go_), (LAS unsigned*)(s_ + wave * 1024), 16, 0, 0); \
        __builtin_amdgcn_global_load_lds((const unsigned*)(ksrc1 + go_), (LAS unsigned*)(s_ + (wave + 8) * 1024), 16, 0, 0); \
        __builtin_amdgcn_global_load_lds((const unsigned*)(vsrc0 + go_), (LAS unsigned*)(s_ + 16384 + wave * 1024), 16, 0, 0); \
        __builtin_amdgcn_global_load_lds((const unsigned*)(vsrc1 + go_), (LAS unsigned*)(s_ + 16384 + (wave + 8) * 1024), 16, 0, 0); } while (0)
    LAS float* wsf = (LAS float*)(lds + ATT_WSF) + wave * 64;
    f32x16 o[4];
#pragma unroll
    for (int d = 0; d < 4; ++d)
#pragma unroll
        for (int r = 0; r < 16; ++r) o[d][r] = 0.f;
    float mhat = 0.f;
    f32x16 ol;
#pragma unroll
    for (int r = 0; r < 16; ++r) ol[r] = 0.f;
    const bf16x8 ones = (bf16x8){0x3F80, 0x3F80, 0x3F80, 0x3F80, 0x3F80, 0x3F80, 0x3F80, 0x3F80};
    const int kfo = (mi * 8 + hi) * 1024 + r32 * 16;
    const int vfo = 16384 + ((lane >> 4) & 1) * 32 + (lane & 3) * 8 + (4 * hi + ((lane & 15) >> 2)) * 64;
    ATT_ISSUE(0, 0);
    for (int t = 0; t < SEQ / 64; ++t) {
        __syncthreads();
        if (t + 1 < SEQ / 64) ATT_ISSUE(t + 1, ((t + 1) & 1) * ATT_SLOT);
        const LAS uchar* sl = lds + (t & 1) * ATT_SLOT;
        const float dq = (float)(q0 + r32 - 64 * t - 4 * hi);
        f32x16 p0, p1;
#pragma unroll
        for (int r = 0; r < 16; ++r) { const float kc = (float)((r & 3) + 8 * (r >> 2));
            p0[r] = __builtin_fmaf(-m2, __builtin_fabsf(dq - kc), -mhat); p1[r] = __builtin_fmaf(-m2, __builtin_fabsf(dq - kc - 32.f), -mhat); }
#pragma unroll
        for (int d0 = 0; d0 < 4; ++d0) {
            const bf16x8 a0 = *(const LAS bf16x8*)(sl + kfo + d0 * 2048), a1 = *(const LAS bf16x8*)(sl + kfo + d0 * 2048 + 512);
            p0 = __builtin_amdgcn_mfma_f32_32x32x16_bf16(a0, qf[d0], p0, 0, 0, 0);
            p1 = __builtin_amdgcn_mfma_f32_32x32x16_bf16(a1, qf[d0], p1, 0, 0, 0); }
        float rm = fmaxf(p0[0], p1[0]);
#pragma unroll
        for (int r = 1; r < 16; ++r) rm = fmaxf(rm, fmaxf(p0[r], p1[r]));
        rm = xhalf_max(rm);
        const bool first = (t == 0);
        if (first || __any(rm > 8.f)) {
            const float dl = first ? rm : fmaxf(rm, 0.f);
            mhat += dl;
#pragma unroll
            for (int r = 0; r < 16; ++r) { p0[r] -= dl; p1[r] -= dl; }
            if (!first) {
                const float f = __builtin_amdgcn_exp2f(-dl);
                if (hi == 0) wsf[r32] = f;
                float fr_[16];
#pragma unroll
                for (int r = 0; r < 16; ++r) fr_[r] = wsf[crow(r, hi)];
#pragma unroll
                for (int d = 0; d < 4; ++d)
#pragma unroll
                    for (int r = 0; r < 16; ++r) o[d][r] *= fr_[r];
#pragma unroll
                for (int r = 0; r < 16; ++r) ol[r] *= fr_[r];
            }
        }
#pragma unroll
        for (int r = 0; r < 16; ++r) { p0[r] = __builtin_amdgcn_exp2f(p0[r]); p1[r] = __builtin_amdgcn_exp2f(p1[r]); }
        u32x4 pw[4];
#pragma unroll
        for (int j = 0; j < 4; ++j) { pw[0][j] = cvt_pk_bf16(p0[2 * j], p0[2 * j + 1]); pw[1][j] = cvt_pk_bf16(p0[8 + 2 * j], p0[8 + 2 * j + 1]);
                                      pw[2][j] = cvt_pk_bf16(p1[2 * j], p1[2 * j + 1]); pw[3][j] = cvt_pk_bf16(p1[8 + 2 * j], p1[8 + 2 * j + 1]); }
#pragma unroll
        for (int d = 0; d < 4; ++d)
#pragma unroll
            for (int ks = 0; ks < 4; ++ks) {
                const s16x4 lo = vtr(sl + vfo + d * 4096 + ks * 1024), hh = vtr(sl + vfo + d * 4096 + ks * 1024 + 512);
                const bf16x8 vf = (bf16x8){lo[0], lo[1], lo[2], lo[3], hh[0], hh[1], hh[2], hh[3]};
                o[d] = __builtin_amdgcn_mfma_f32_32x32x16_bf16(__builtin_bit_cast(bf16x8, pw[ks]), vf, o[d], 0, 0, 0); }
#pragma unroll
        for (int ks = 0; ks < 4; ++ks) ol = __builtin_amdgcn_mfma_f32_32x32x16_bf16(__builtin_bit_cast(bf16x8, pw[ks]), ones, ol, 0, 0, 0);
    }
#undef ATT_ISSUE
    float fr_[16];
#pragma unroll
    for (int r = 0; r < 16; ++r) fr_[r] = (mi == 0 ? 1.f : lam) / ol[r];
    __syncthreads();
    LAS float* X = (LAS float*)lds + rb * 4096;
    if (mi == 1) {
#pragma unroll
        for (int d = 0; d < 4; ++d)
#pragma unroll
            for (int r = 0; r < 16; ++r) X[(d * 16 + r) * 64 + lane] = o[d][r] * fr_[r];
    }
    __syncthreads();
    if (mi == 0) {
        float ss[16];
#pragma unroll
        for (int r = 0; r < 16; ++r) ss[r] = 0.f;
#pragma unroll
        for (int d = 0; d < 4; ++d)
#pragma unroll
            for (int r = 0; r < 16; ++r) { const float v = o[d][r] * fr_[r] - X[(d * 16 + r) * 64 + lane]; o[d][r] = v; ss[r] += v * v; }
#pragma unroll
        for (int r = 0; r < 16; ++r) {
#pragma unroll
            for (int s = 1; s < 32; s <<= 1) ss[r] += __shfl_xor(ss[r], s);
            ss[r] = rsqrtf(ss[r] * (1.f / 128.f) + EPS) * (1.f - laminit); }
        float gv[4];
#pragma unroll
        for (int d = 0; d < 4; ++d) gv[d] = sg[d * 32 + r32];
#pragma unroll
        for (int r = 0; r < 16; ++r) { bf16_t* op = ocat + (rowbase + q0 + crow(r, hi)) * D + h * 128 + r32;
#pragma unroll
            for (int d = 0; d < 4; ++d) op[d * 32] = (bf16_t)f2bf(o[d][r] * ss[r] * gv[d]); }
    }
    __syncthreads();
}

template <int DK, bool HG>
__device__ __forceinline__ void scan_item(LAS uchar* lds, const bf16_t* proj, float* ofwd, bf16_t* ocat, int bl, int h, const float* lb  ,
                                          const float* normg  , const float* w2  , const float* gbias  ) {
    constexpr int KPW = DK / 8;
    LAS float* sA = (LAS float*)lds;
    LAS float* sK = sA + 16 * DK;
    LAS float* sQ = sK + 16 * DK;
    LAS float* sV = sQ + 16 * DK;
    LAS float* sP = sV + 16 * 64;
    const int tid = tid_fresh(), lane = tid & 63, wave = __builtin_amdgcn_readfirstlane(tid >> 6);
    const int ps = tid >> 5, pi = tid & 31;
    const size_t rowbase = (size_t)bl * SEQ;
    const float ng = normg[lane];
    __syncthreads();
    for (int dir = 0; dir < 2; ++dir) {
        float lb0 = 0.f, lb1 = 0.f, w2c[16], bias = 0.f;
        if (HG) { lb0 = lb[dir * 256 + h * 64 + pi]; lb1 = lb[dir * 256 + h * 64 + pi + 32]; }
        else {
#pragma unroll
            for (int r = 0; r < 16; ++r) w2c[r] = w2[(dir * 16 + r) * 128 + h * 32 + pi];
            bias = gbias[dir * 128 + h * 32 + pi]; }
        float S[KPW];
#pragma unroll
        for (int j = 0; j < KPW; ++j) S[j] = 0.f;
        const int sw = dir == 0 ? wave : 7 - wave;
        bf16_t rz0 = 0, rz1 = 0, rq0 = 0, rq1 = 0, rv0 = 0, rv1 = 0, rk0 = 0; u32x4 rl0 = {0, 0, 0, 0}, rl1 = {0, 0, 0, 0};
        bf16_t rg[2] = {0, 0}; float rof[2] = {0.f, 0.f};
#define SCAN_LOAD(blk) do { const int tok_ = dir == 0 ? (blk) * 16 + ps : 2047 - ((blk) * 16 + ps); const bf16_t* pr_ = proj + (rowbase + tok_) * LDP; \
        if (HG) { const int zc_ = (dir == 0 ? BFF : BFB) + h * 64 + pi; rz0 = pr_[zc_]; rz1 = pr_[zc_ + 32]; rq0 = pr_[BQ + h * 64 + pi]; rq1 = pr_[BQ + h * 64 + pi + 32]; rv0 = pr_[BI + h * 64 + pi]; rv1 = pr_[BI + h * 64 + pi + 32]; } \
        else { const u32x4* lp_ = (const u32x4*)(pr_ + (dir == 0 ? GLF : GLB)); rl0 = lp_[0]; rl1 = lp_[1]; rk0 = pr_[GK + h * 32 + pi]; rq0 = pr_[GQ + h * 32 + pi]; rv0 = pr_[GV + h * 64 + pi]; rv1 = pr_[GV + h * 64 + pi + 32]; } \
        if (dir == 1) { _Pragma("unroll") for (int j2_ = 0; j2_ < 2; ++j2_) { const int t2_ = 2047 - ((blk) * 16 + sw + 8 * j2_); \
            rg[j2_] = proj[(rowbase + t2_) * LDP + (HG ? BG : GG) + h * 64 + lane]; rof[j2_] = ofwd[(rowbase + t2_) * 512 + (HG ? 0 : 256) + h * 64 + lane]; } } } while (0)
        SCAN_LOAD(0);
        for (int blk = 0; blk < SEQ / 16; ++blk) {
            if (HG) {
                const float z0 = bf2f(rz0), z1 = bf2f(rz1);
                const float s0 = 1.f / (1.f + __expf(-z0)), s1 = 1.f / (1.f + __expf(-z1));
                sA[ps * 64 + pi] = s0 * (1.f + lb0 * __expf(fminf(-z0, 80.f))); sA[ps * 64 + pi + 32] = s1 * (1.f + lb1 * __expf(fminf(-z1, 80.f)));
                sK[ps * 64 + pi] = (1.f - lb0) / (1.f + __expf(z0)); sK[ps * 64 + pi + 32] = (1.f - lb1) / (1.f + __expf(z1));
                const float q0 = bf2f(rq0), q1 = bf2f(rq1);
                sQ[ps * 64 + pi] = q0 / (1.f + __expf(-q0)) * 0.125f; sQ[ps * 64 + pi + 32] = q1 / (1.f + __expf(-q1)) * 0.125f;
            } else {
                float z = bias;
#pragma unroll
                for (int j = 0; j < 4; ++j) { z += bflo(rl0[j]) * w2c[2 * j] + bfhi(rl0[j]) * w2c[2 * j + 1]; z += bflo(rl1[j]) * w2c[8 + 2 * j] + bfhi(rl1[j]) * w2c[8 + 2 * j + 1]; }
                const float ls = fminf(z, 0.f) - __logf(1.f + __expf(-fabsf(z)));
                sA[ps * 32 + pi] = __expf(ls * (1.f / 16.f));
                sK[ps * 32 + pi] = bf2f(rk0);
                sQ[ps * 32 + pi] = bf2f(rq0) * 0.17677669529663687f;
            }
            sV[ps * 64 + pi] = bf2f(rv0); sV[ps * 64 + pi + 32] = bf2f(rv1);
            const bf16_t cg0 = rg[0], cg1 = rg[1]; const float cf0 = rof[0], cf1 = rof[1];
            __syncthreads();
            if (blk + 1 < SEQ / 16) SCAN_LOAD(blk + 1);
#pragma unroll 4
            for (int s = 0; s < 16; ++s) {
                const float v = sV[s * 64 + lane];
                float a[KPW], kk[KPW], q[KPW];
#pragma unroll
                for (int j4 = 0; j4 < KPW / 4; ++j4) {
                    const f32x4 a4 = *(const LAS f32x4*)(sA + s * DK + wave * KPW + j4 * 4), k4 = *(const LAS f32x4*)(sK + s * DK + wave * KPW + j4 * 4), q4 = *(const LAS f32x4*)(sQ + s * DK + wave * KPW + j4 * 4);
#pragma unroll
                    for (int j = 0; j < 4; ++j) { a[j4 * 4 + j] = a4[j]; kk[j4 * 4 + j] = k4[j]; q[j4 * 4 + j] = q4[j]; } }
                float op = 0.f;
#pragma unroll
                for (int j = 0; j < KPW; ++j) { S[j] = __builtin_fmaf(a[j], S[j], kk[j] * v); op = __builtin_fmaf(q[j], S[j], op); }
                sP[(s * 8 + wave) * 64 + lane] = op;
            }
            __syncthreads();
#pragma unroll
            for (int j2 = 0; j2 < 2; ++j2) {
                const int s = sw + 8 * j2; const int tok = dir == 0 ? blk * 16 + s : 2047 - (blk * 16 + s);
                float sum = 0.f;
#pragma unroll
                for (int w = 0; w < 8; ++w) sum += sP[(s * 8 + w) * 64 + lane];
                if (dir == 0) ofwd[(rowbase + tok) * 512 + (HG ? 0 : 256) + h * 64 + lane] = sum;
                else {
                    const float tot = sum + (j2 == 0 ? cf0 : cf1);
                    const float ssq = wave_sum(tot * tot);
                    const float gvv = bf2f(j2 == 0 ? cg0 : cg1);
                    const float outv = tot * rsqrtf(ssq * (1.f / 64.f) + EPS) * ng * (gvv / (1.f + __expf(-gvv)));
                    ocat[(rowbase + tok) * D + (HG ? 512 : 768) + h * 64 + lane] = (bf16_t)f2bf(outv);
                }
            }
        }
#undef SCAN_LOAD
        __syncthreads();
    }
}

__device__ __forceinline__ void norm_rows_mod(const float* src, bf16_t* dst, const float* g, const float* modl  , int grow0, int shoff, int scoff) {
    const int tid = tid_fresh(), lane = tid & 63, gw = blockIdx.x * 8 + __builtin_amdgcn_readfirstlane(tid >> 6), NGW = gridDim.x * 8;
    for (int m = gw; m < TG; m += NGW) {
        const int b = (grow0 + m) >> 11;
        const f32x4* xr = (const f32x4*)(src + (size_t)m * D) + lane;
        const f32x4* gr = (const f32x4*)g + lane; const f32x4* sh = (const f32x4*)(modl + (size_t)b * (NMOD * D) + shoff) + lane; const f32x4* sc = (const f32x4*)(modl + (size_t)b * (NMOD * D) + scoff) + lane;
        f32x4 v[4]; float s = 0.f;
#pragma unroll
        for (int j = 0; j < 4; ++j) { v[j] = xr[64 * j]; s += (v[j].x * v[j].x + v[j].y * v[j].y) + (v[j].z * v[j].z + v[j].w * v[j].w); }
        const float r = rsqrtf(wave_sum(s) * (1.f / D) + EPS);
        unsigned long long* o8 = (unsigned long long*)(dst + (size_t)m * D) + lane;
#pragma unroll
        for (int j = 0; j < 4; ++j) { const f32x4 y = v[j] * r * gr[64 * j] * (1.f + sc[64 * j]) + sh[64 * j];
            o8[64 * j] = (unsigned long long)pk2(y.x, y.y) | ((unsigned long long)pk2(y.z, y.w) << 32); }
    }
}
__device__ __forceinline__ void norm_rows_final(float* x, const float* g) {
    const int tid = tid_fresh(), lane = tid & 63, gw = blockIdx.x * 8 + __builtin_amdgcn_readfirstlane(tid >> 6), NGW = gridDim.x * 8;
    for (int m = gw; m < TG; m += NGW) {
        f32x4* xr = (f32x4*)(x + (size_t)m * D) + lane; const f32x4* gr = (const f32x4*)g + lane;
        f32x4 v[4]; float s = 0.f;
#pragma unroll
        for (int j = 0; j < 4; ++j) { v[j] = xr[64 * j]; s += (v[j].x * v[j].x + v[j].y * v[j].y) + (v[j].z * v[j].z + v[j].w * v[j].w); }
        const float r = rsqrtf(wave_sum(s) * (1.f / D) + EPS);
#pragma unroll
        for (int j = 0; j < 4; ++j) xr[64 * j] = v[j] * r * gr[64 * j];
    }
}

__device__ __forceinline__ void transpose_item(const float* W, int ldw, bf16_t* WT, int ldt, int row_off, int k_off, LAS float* scr, int kb, int nb, int lane) {
    const int k0 = 64 * kb, n0 = 32 * nb;
#pragma unroll 8
    for (int i = 0; i < 32; ++i) { const int kk = 2 * i + (lane >> 5); scr[kk * 33 + (lane & 31)] = W[(size_t)(k0 + kk) * ldw + n0 + (lane & 31)]; }
    asm volatile("s_waitcnt lgkmcnt(0)" ::: "memory");
    const int c = lane & 7;
#pragma unroll
    for (int j = 0; j < 4; ++j) { const int n = (lane >> 3) + 8 * j; const LAS float* s = scr + (8 * c) * 33 + n;
        u32x4 o; o.x = pk2(s[0 * 33], s[1 * 33]); o.y = pk2(s[2 * 33], s[3 * 33]); o.z = pk2(s[4 * 33], s[5 * 33]); o.w = pk2(s[6 * 33], s[7 * 33]);
        *(u32x4*)(WT + (size_t)(row_off + n0 + n) * ldt + k_off + k0 + 8 * c) = o; }
    asm volatile("s_waitcnt lgkmcnt(0)" ::: "memory");
}

struct Args { const void* p[24]; };
enum { P_X = 0, P_C, P_ADAW, P_ADAB, P_NMIXG, P_NMLPG, P_WIN, P_DLAM, P_DSUBG, P_HLB, P_HNG, P_GW2, P_GB, P_GNG, P_WUA, P_WUB, P_WUC, P_WOUT, P_W1, P_W2, P_FNG, P_OUT, P_WS };
typedef const unsigned long long __attribute__((address_space(4)))* kargp_t;
__device__ __forceinline__ const void* karg(int i) { kargp_t kp = (kargp_t)__builtin_amdgcn_kernarg_segment_ptr(); asm volatile("" : "+s"(kp)); return (const void*)kp[i]; }
#define GRID_SYNC() do { asm volatile("s_waitcnt vmcnt(0) lgkmcnt(0)" ::: "memory"); __syncthreads(); grid.sync(); \
    if (threadIdx.x < 64) { __builtin_amdgcn_fence(__ATOMIC_ACQUIRE, "agent"); asm volatile("s_waitcnt vmcnt(0)" ::: "memory"); } __syncthreads(); } while (0)
#define KF(i) ((const float*)karg(i))
#define KWS() ((uchar*)karg(P_WS))

__global__ void __launch_bounds__(512, 2) fwd_megakernel(Args a_unused) {
    extern __shared__ __attribute__((aligned(16))) uchar lds_raw[];
    LAS uchar* lds = (LAS uchar*)lds_raw;
    cg::grid_group grid = cg::this_grid();
    {
    const int tid = tid_fresh(), lane = tid & 63, wave = __builtin_amdgcn_readfirstlane(tid >> 6);

    if (blockIdx.x == 0) {
        unsigned* ctl = (unsigned*)(KWS() + WS_CTL); float* ctlf = (float*)ctl;
        for (int i = tid; i < 1024; i += 512) ctl[i] = 0u;
        if (tid < 4) {
            const float* lp = KF(P_DLAM) + tid * 256; float s1 = 0.f, s2 = 0.f;
            for (int d = 0; d < 64; ++d) { s1 += lp[d] * lp[64 + d]; s2 += lp[128 + d] * lp[192 + d]; }
            const float li = 0.8f - 0.6f * expf(-0.3f * (float)tid);
            ctlf[1024 + tid] = expf(s1) - expf(s2) + li; ctlf[1028 + tid] = li;
        }
        {
            const float* lg = KF(P_HLB); const int j = tid;
            float v[4], mx = -1e30f;
#pragma unroll
            for (int l = 0; l < 4; ++l) { v[l] = lg[l * 512 + j]; mx = fmaxf(mx, v[l]); }
            float den = 0.f;
#pragma unroll
            for (int l = 0; l < 4; ++l) { v[l] = expf(v[l] - mx); den += v[l]; }
            float cum = 0.f; const float w0 = v[0] / den;
#pragma unroll
            for (int l = 0; l < 4; ++l) { cum += v[l] / den; ctlf[2048 + l * 512 + j] = cum - w0; }
        }
        {
            float* pv = ctlf + 8192;
            const float* s0 = KF(P_NMIXG); for (int i = tid; i < 4096; i += 512) pv[i] = s0[i];
            const float* s1 = KF(P_NMLPG); for (int i = tid; i < 4096; i += 512) pv[4096 + i] = s1[i];
            const float* s2 = KF(P_DSUBG); for (int i = tid; i < 512; i += 512) pv[8192 + i] = s2[i];
            const float* s3 = KF(P_HNG); for (int i = tid; i < 256; i += 512) pv[8704 + i] = s3[i];
            const float* s4 = KF(P_GW2); for (int i = tid; i < 16384; i += 512) pv[8960 + i] = s4[i];
            const float* s5 = KF(P_GB); for (int i = tid; i < 1024; i += 512) pv[25344 + i] = s5[i];
            const float* s6 = KF(P_GNG); for (int i = tid; i < 256; i += 512) pv[26368 + i] = s6[i];
            const float* s7 = KF(P_FNG); for (int i = tid; i < 1024; i += 512) pv[26624 + i] = s7[i];
        }
    }
#ifndef NO_MOD
    {
        LAS float* cond = (LAS float*)lds; LAS float* red = (LAS float*)(lds + 131072);
        float* mod = (float*)(KWS() + WS_MOD);
        const float* cin = KF(P_C); const float* adaw = KF(P_ADAW); const float* adab = KF(P_ADAB);
        bool loaded = false;
        for (int it = blockIdx.x; it < 4 * 96; it += gridDim.x) {
            if (!loaded) { for (int i = tid; i < 32 * 1024; i += 512) { const float cv = cin[i]; cond[i] = cv / (1.f + __expf(-cv)); } loaded = true; __syncthreads(); }
            const int l = it / 96, n0 = (it % 96) * 64;
            const float* W = adaw + (size_t)l * D * (NMOD * D) + n0 + lane;
            float acc[32];
#pragma unroll
            for (int b = 0; b < 32; ++b) acc[b] = 0.f;
            for (int k4 = 0; k4 < 32; ++k4) {
                const int k = wave * 128 + k4 * 4;
                const float w0 = W[(size_t)k * (NMOD * D)], w1 = W[(size_t)(k + 1) * (NMOD * D)], w2v = W[(size_t)(k + 2) * (NMOD * D)], w3 = W[(size_t)(k + 3) * (NMOD * D)];
#pragma unroll
                for (int b = 0; b < 32; ++b) { const f32x4 c4 = *(const LAS f32x4*)(cond + b * 1024 + k); acc[b] += c4.x * w0 + c4.y * w1 + c4.z * w2v + c4.w * w3; }
            }
#pragma unroll
            for (int rd = 0; rd < 4; ++rd) {
                __syncthreads();
#pragma unroll
                for (int bb = 0; bb < 8; ++bb) red[(wave * 8 + bb) * 64 + lane] = acc[rd * 8 + bb];
                __syncthreads();
                float s = 0.f;
#pragma unroll
                for (int w = 0; w < 8; ++w) s += red[(w * 8 + wave) * 64 + lane];
                const int b = rd * 8 + wave;
                mod[((size_t)l * 32 + b) * (NMOD * D) + n0 + lane] = s + adab[l * (NMOD * D) + n0 + lane];
            }
        }
        __syncthreads();
    }
#endif
#ifndef NO_WT
    {
        LAS float* scr = (LAS float*)(lds + wave * 8704);
        const int gw = blockIdx.x * 8 + wave, NGW = gridDim.x * 8;
        uchar* ws = KWS();
        bf16_t* win_t = (bf16_t*)(ws + WS_WIN); bf16_t* wup_t = (bf16_t*)(ws + WS_WUP); bf16_t* wout_t = (bf16_t*)(ws + WS_WOUT);
        bf16_t* w1_t = (bf16_t*)(ws + WS_W1); bf16_t* w2_t = (bf16_t*)(ws + WS_W2);
        constexpr int I_IN = 16 * 209, I_UA = 8 * 32, I_UB = 4 * 32, I_UC = 4 * 32, I_O = 16 * 32, I_1 = 16 * 128, I_2 = 64 * 32;
        constexpr int I_L = I_IN + I_UA + I_UB + I_UC + I_O + I_1 + I_2;
        for (int it = gw; it < 4 * I_L; it += NGW) {
            const int l = it / I_L; int r = it % I_L;
            if (r < I_IN) { transpose_item(KF(P_WIN) + (size_t)l * D * DIN, DIN, win_t + (size_t)l * LDP * D, D, 0, 0, scr, r / 209, r % 209, lane); continue; } r -= I_IN;
            if (r < I_UA) { transpose_item(KF(P_WUA) + (size_t)l * 512 * D, D, wup_t + (size_t)l * D * D, D, 0, 0, scr, r / 32, r % 32, lane); continue; } r -= I_UA;
            if (r < I_UB) { transpose_item(KF(P_WUB) + (size_t)l * 256 * D, D, wup_t + (size_t)l * D * D, D, 0, 512, scr, r / 32, r % 32, lane); continue; } r -= I_UB;
            if (r < I_UC) { transpose_item(KF(P_WUC) + (size_t)l * 256 * D, D, wup_t + (size_t)l * D * D, D, 0, 768, scr, r / 32, r % 32, lane); continue; } r -= I_UC;
            if (r < I_O) { transpose_item(KF(P_WOUT) + (size_t)l * D * D, D, wout_t + (size_t)l * D * D, D, 0, 0, scr, r / 32, r % 32, lane); continue; } r -= I_O;
            if (r < I_1) { transpose_item(KF(P_W1) + (size_t)l * D * DFF, DFF, w1_t + (size_t)l * DFF * D, D, 0, 0, scr, r / 128, r % 128, lane); continue; } r -= I_1;
            transpose_item(KF(P_W2) + (size_t)l * DFF * D, D, w2_t + (size_t)l * D * DFF, DFF, 0, 0, scr, r / 32, r % 32, lane);
        }
        for (int i = blockIdx.x * 512 + tid; i < 4 * 28672; i += gridDim.x * 512) { const int l = i / 28672, r = i % 28672;
            *(u32x4*)(win_t + (size_t)l * LDP * D + (size_t)DIN * D + (size_t)r * 8) = (u32x4){0u, 0u, 0u, 0u}; }
    }
#endif
    }
    GRID_SYNC();

    for (int grp = 0; grp < NGRP; ++grp) {
        for (int l = 0; l < DEPTH; ++l) {
            {
                uchar* ws = KWS(); const float* pv = (const float*)(ws + WS_CTL) + 8192;
                const float* src = (l == 0 ? KF(P_X) : (const float*)karg(P_OUT)) + (size_t)grp * TG * D;
                norm_rows_mod(src, (bf16_t*)(ws + WS_HB), pv + l * D, (const float*)(ws + WS_MOD) + (size_t)l * 32 * (NMOD * D), grp * TG, 0, D);
            }
            GRID_SYNC();
            { uchar* ws = KWS(); pg8::Gemm g{(const bf16_t*)(ws + WS_HB), (const bf16_t*)(ws + WS_WIN) + (size_t)l * LDP * D, D}; pg8::Order S; S.init(TG, LDP, D, gridDim.x, blockIdx.x, 1); pg8::EpiProj E{(bf16_t*)(ws + WS_PROJ)};
#ifndef NO_EPIPROJ
              pg8::gemm_phase<pg8::EpiProj>(lds, g, S, E);
#endif
            }
            GRID_SYNC();
            {
                uchar* ws = KWS(); const float* ctlf = (const float*)(ws + WS_CTL); const float* pv = ctlf + 8192;
                const int xq = blockIdx.x & 7; unsigned* ctr = (unsigned*)(ws + WS_CTL) + ((grp * DEPTH + l) * 8 + xq) * 4;
                const float lam = ctlf[1024 + l], laminit = ctlf[1028 + l];
                const bf16_t* PROJ = (const bf16_t*)(ws + WS_PROJ); bf16_t* OCAT = (bf16_t*)(ws + WS_OCAT); float* OFWD = (float*)(ws + WS_OFWD);
                LAS int* itm = (LAS int*)(lds + 147456 - 64);
                const int tid = tid_fresh();
                for (;;) {
                    __syncthreads();
                    if (tid == 0) itm[0] = (int)atomicAdd(ctr, 1u);
                    __syncthreads();
                    const int it = itm[0];
                    constexpr int NPQ = GB * 4 / 8;
                    if (it >= 2 * NPQ + NPQ * 16) break;
#ifndef NO_SCAN
                    if (it < NPQ) { const int p = it * 8 + xq;
                        scan_item<64, true>(lds, PROJ, OFWD, OCAT, p >> 2, p & 3, ctlf + 2048 + l * 512, pv + 8704 + l * 64, nullptr, nullptr);
                    } else if (it < 2 * NPQ) { const int p = (it - NPQ) * 8 + xq;
                        scan_item<32, false>(lds, PROJ, OFWD, OCAT, p >> 2, p & 3, nullptr, pv + 26368 + l * 64, pv + 8960 + l * 4096, pv + 25344 + l * 256);
                    } else
#endif
                    { const int u = it - 2 * NPQ, p = (u >> 4) * 8 + xq;
#ifndef NO_ATTN
                        if (it >= 2 * NPQ) attn_unit(lds, PROJ, OCAT, p >> 2, p & 3, u & 15, lam, laminit, pv + 8192 + l * 128);
#endif
                    }
                }
            }
            GRID_SYNC();
            { uchar* ws = KWS(); pg8::Gemm g{(const bf16_t*)(ws + WS_OCAT), (const bf16_t*)(ws + WS_WUP) + (size_t)l * D * D, D}; pg8::Order S; S.init(TG, D, D, gridDim.x, blockIdx.x, 3); pg8::EpiMerge E{(const bf16_t*)(ws + WS_PROJ), (bf16_t*)(ws + WS_HB)};
#ifndef NO_EPIMERGE
              pg8::gemm_phase<pg8::EpiMerge>(lds, g, S, E);
#endif
            }
            GRID_SYNC();
            { uchar* ws = KWS(); pg8::Gemm g{(const bf16_t*)(ws + WS_HB), (const bf16_t*)(ws + WS_WOUT) + (size_t)l * D * D, D}; pg8::Order S; S.init(TG, D, D, gridDim.x, blockIdx.x, 1);
              float* xg = (float*)karg(P_OUT) + (size_t)grp * TG * D;
              pg8::EpiRes E{l == 0 ? KF(P_X) + (size_t)grp * TG * D : xg, xg, (const float*)(ws + WS_MOD) + ((size_t)l * 32 + grp * GB) * (NMOD * D) + 2 * D};
#ifndef NO_EPIRES
              pg8::gemm_phase<pg8::EpiRes>(lds, g, S, E);
#endif
            }
            GRID_SYNC();
            {
                uchar* ws = KWS(); const float* pv = (const float*)(ws + WS_CTL) + 8192;
                norm_rows_mod((const float*)karg(P_OUT) + (size_t)grp * TG * D, (bf16_t*)(ws + WS_HB), pv + 4096 + l * D, (const float*)(ws + WS_MOD) + (size_t)l * 32 * (NMOD * D), grp * TG, 3 * D, 4 * D);
            }
            GRID_SYNC();
            { uchar* ws = KWS(); pg8::Gemm g{(const bf16_t*)(ws + WS_HB), (const bf16_t*)(ws + WS_W1) + (size_t)l * DFF * D, D}; pg8::Order S; S.init(TG, DFF, D, gridDim.x, blockIdx.x, 1); pg8::EpiRelu2 E{(bf16_t*)(ws + WS_U)};
#ifndef NO_EPIRELU2
              pg8::gemm_phase<pg8::EpiRelu2>(lds, g, S, E);
#endif
            }
            GRID_SYNC();
            { uchar* ws = KWS(); pg8::Gemm g{(const bf16_t*)(ws + WS_U), (const bf16_t*)(ws + WS_W2) + (size_t)l * D * DFF, DFF}; pg8::Order S; S.init(TG, D, DFF, gridDim.x, blockIdx.x, 1);
              float* xg = (float*)karg(P_OUT) + (size_t)grp * TG * D;
              pg8::EpiRes E{xg, xg, (const float*)(ws + WS_MOD) + ((size_t)l * 32 + grp * GB) * (NMOD * D) + 5 * D};
#ifndef NO_EPIRES
              pg8::gemm_phase<pg8::EpiRes>(lds, g, S, E);
#endif
            }
            GRID_SYNC();
        }
        norm_rows_final((float*)karg(P_OUT) + (size_t)grp * TG * D, (const float*)(KWS() + WS_CTL) + 8192 + 26624);
    }
}

extern "C" void kernel_launch(void* const* d_in, const int* in_sizes, int n_in, void* d_out, int out_size, void* d_ws, size_t ws_size, hipStream_t stream) {
    static int grid = 0;
    if (grid == 0) {
        if (n_in != 21 || ws_size < WS_END) { fprintf(stderr, "kernel_launch: unexpected n_in %d / ws %zu\n", n_in, ws_size); grid = -1; return; }
        int dev = 0, cus = 0, per_cu = 0;
        if (hipGetDevice(&dev) != hipSuccess || hipDeviceGetAttribute(&cus, hipDeviceAttributeMultiprocessorCount, dev) != hipSuccess) { grid = -1; return; }
        if (hipFuncSetAttribute((const void*)fwd_megakernel, hipFuncAttributeMaxDynamicSharedMemorySize, LDS_BYTES) != hipSuccess) { fprintf(stderr, "kernel_launch: hipFuncSetAttribute failed\n"); grid = -1; return; }
        if (hipOccupancyMaxActiveBlocksPerMultiprocessor(&per_cu, (const void*)fwd_megakernel, 512, LDS_BYTES) != hipSuccess || per_cu < 1) { fprintf(stderr, "kernel_launch: occupancy query says %d\n", per_cu); per_cu = 1; }
        (void)hipGetLastError();
        grid = cus;
    }
    if (grid < 0) return;
    Args a{};
    for (int i = 0; i < 21; ++i) a.p[i] = d_in[i];
    a.p[21] = d_out; a.p[22] = d_ws; a.p[23] = nullptr;
    void* args[] = {&a};
    hipError_t e = hipLaunchCooperativeKernel((void*)fwd_megakernel, dim3(grid), dim3(512), args, LDS_BYTES, stream);
    if (e != hipSuccess) fprintf(stderr, "kernel_launch: cooperative launch failed: %s (grid %d)\n", hipGetErrorString(e), grid);
}
```

```cpp
#include <hip/hip_runtime.h>
#include <hip/hip_cooperative_groups.h>
#include <cstdio>
#include <cstdint>
namespace cg = cooperative_groups;

#define LAS __attribute__((address_space(3)))
typedef unsigned short bf16_t;
typedef short bf16x8 __attribute__((ext_vector_type(8)));
typedef float f32x4 __attribute__((ext_vector_type(4)));
typedef float f32x2 __attribute__((ext_vector_type(2)));
typedef float f32x16 __attribute__((ext_vector_type(16)));
typedef unsigned u32x4 __attribute__((ext_vector_type(4)));
typedef short s16x4 __attribute__((ext_vector_type(4)));
typedef unsigned char uchar;

constexpr int D = 1024, SEQ = 2048, BATCH = 32, DEPTH = 4, DIN = 6688, LDP = 6912, DFF = 4096, NMOD = 6;
constexpr int GB = 16, TG = GB * SEQ, NGRP = BATCH / GB;
constexpr int CQ = 0, CK = 512, CV = 1024, BQ = 1536, BFF = 1792, BFB = 2048, BI = 2304, BG = 2560;
constexpr int GQ = 2816, GK = 2944, GV = 3072, GG = 3328, GLF = 3584, GLB = 3600, GATE = 3616;
constexpr float EPS = 1e-6f, LOG2E = 1.4426950408889634f;
constexpr float QSCALE = 0.125f * LOG2E;

constexpr size_t MiB = 1u << 20;
constexpr size_t WS_CTL = 0;
constexpr size_t WS_MOD = 1 * MiB;
constexpr size_t WS_WIN = 4 * MiB;
constexpr size_t WS_WUP = 58 * MiB;
constexpr size_t WS_WOUT = 66 * MiB;
constexpr size_t WS_W1 = 74 * MiB;
constexpr size_t WS_W2 = 106 * MiB;
constexpr size_t WS_HB = 138 * MiB;
constexpr size_t WS_OCAT = 202 * MiB;
constexpr size_t WS_OFWD = 266 * MiB;
constexpr size_t WS_PROJ = 330 * MiB;
constexpr size_t WS_U = WS_PROJ;
constexpr size_t WS_OBWD = 762 * MiB;
constexpr size_t WS_END = 826 * MiB;
constexpr int LDS_BYTES = 148 * 1024;

__device__ __forceinline__ unsigned f2bf(float f) { unsigned u = __builtin_bit_cast(unsigned, f); return (u + 0x7fffu + ((u >> 16) & 1u)) >> 16; }
__device__ __forceinline__ unsigned pk2(float lo, float hi) { return f2bf(lo) | (f2bf(hi) << 16); }
__device__ __forceinline__ float bf2f(bf16_t v) { return __builtin_bit_cast(float, (unsigned)v << 16); }
__device__ __forceinline__ float bflo(unsigned u) { return __builtin_bit_cast(float, u << 16); }
__device__ __forceinline__ float bfhi(unsigned u) { return __builtin_bit_cast(float, u & 0xffff0000u); }
typedef __bf16 bf16x2_t __attribute__((ext_vector_type(2)));
__device__ __forceinline__ unsigned cvt_pk_bf16(float lo, float hi) { f32x2 v = {lo, hi}; bf16x2_t b = __builtin_convertvector(v, bf16x2_t); return __builtin_bit_cast(unsigned, b); }
__device__ __forceinline__ float wave_sum(float v) {
#pragma unroll
    for (int o = 1; o < 64; o <<= 1) v += __shfl_xor(v, o);
    return v;
}
__device__ __forceinline__ int tid_fresh() { int t = threadIdx.x; asm volatile("" : "+v"(t)); return t; }
__device__ __forceinline__ float sigmoidf_(float z) { return 1.f / (1.f + __expf(-z)); }

namespace pg8 {
constexpr int BM = 256, BK = 64, HALF = 128, HTB = HALF * BK * 2, STAGE_BYTES = 8 * HTB, NXCD = 8, WGM = 8;
__host__ __device__ __forceinline__ int lds_byte(int r, int c) { const int st = (r >> 4) * 2 + (c >> 5), rr = r & 15, cc = c & 31, ob = rr * 64 + cc * 2; return st * 1024 + (ob ^ (((ob >> 9) & 1) << 5)); }
__host__ __device__ __forceinline__ void stage_rc(int b, int& R, int& C) { const int st = b / 1024, sb = b % 1024, swz = sb ^ (((sb >> 9) & 1) << 5); R = (st >> 1) * 16 + swz / 64; C = (st & 1) * 32 + (swz % 64) / 2; }
__host__ __device__ __forceinline__ int perm32(int rho) { const int n = rho >> 4, i = rho & 15; return 8 * (i >> 2) + 4 * n + (i & 3); }

struct Unit { int pm, pn, koff, nt, seg; };
struct Gemm { const bf16_t* A; const bf16_t* Bt; int K; };

struct Order {
    int nM, nN, nwg, G, c, nseg, ntfull;
    __device__ void init(int M, int N, int K, int G_, int c_, int nseg_) { nM = M / BM; nN = N / BM; nwg = nM * nN; G = G_; c = c_; nseg = nseg_; ntfull = K / BK; }
    __device__ bool next(int i, Unit& u) const {
        int ti = i, seg = 0;
        if (nseg == 3) { ti = i / 3; seg = i - ti * 3; }
        const long L = (long)ti * G + c; if (L >= nwg) return false;
        int wgid = (int)L; { const int q = nwg / NXCD, r = nwg % NXCD, xcd = wgid % NXCD, off = wgid / NXCD; wgid = (xcd < r ? xcd * (q + 1) : r * (q + 1) + (xcd - r) * q) + off; }
        const int nig = WGM * nN, gid = wgid / nig, fm = gid * WGM, gsz = (nM - fm) < WGM ? (nM - fm) : WGM;
        u.pm = fm + ((wgid % nig) % gsz); u.pn = (wgid % nig) / gsz; u.seg = seg;
        if (nseg == 3) { u.koff = seg == 0 ? 0 : (seg == 1 ? 512 : 768); u.nt = seg == 0 ? 8 : 4; } else { u.koff = 0; u.nt = ntfull; }
        return true;
    }
};

struct EpiProj {
    bf16_t* O;
    __device__ __forceinline__ bool zero_after(const Unit&) const { return true; }
    __device__ __forceinline__ void operator()(f32x4 (&acc)[2][2][4][2], const Unit& u, int wr, int wc, int fr, int fq) const {
        const int row0 = u.pm * BM + wr * 64 + fr, col0 = u.pn * BM + wc * 32 + 8 * fq;
        const float sc = (u.pn < 2) ? QSCALE : 1.f;
#pragma unroll
        for (int ai = 0; ai < 2; ++ai)
#pragma unroll
            for (int m = 0; m < 4; ++m) { bf16_t* rowp = O + (size_t)(row0 + ai * HALF + m * 16) * LDP + col0;
#pragma unroll
                for (int bj = 0; bj < 2; ++bj) { f32x4 v0 = acc[ai][bj][m][0] * sc, v1 = acc[ai][bj][m][1] * sc;
                    u32x4 w; w.x = cvt_pk_bf16(v0[0], v0[1]); w.y = cvt_pk_bf16(v0[2], v0[3]); w.z = cvt_pk_bf16(v1[0], v1[1]); w.w = cvt_pk_bf16(v1[2], v1[3]);
                    *(u32x4*)(rowp + bj * HALF) = w; } }
    }
};
struct EpiRelu2 {
    bf16_t* O;
    __device__ __forceinline__ bool zero_after(const Unit&) const { return true; }
    __device__ __forceinline__ void operator()(f32x4 (&acc)[2][2][4][2], const Unit& u, int wr, int wc, int fr, int fq) const {
        const int row0 = u.pm * BM + wr * 64 + fr, col0 = u.pn * BM + wc * 32 + 8 * fq;
#pragma unroll
        for (int ai = 0; ai < 2; ++ai)
#pragma unroll
            for (int m = 0; m < 4; ++m) { bf16_t* rowp = O + (size_t)(row0 + ai * HALF + m * 16) * DFF + col0;
#pragma unroll
                for (int bj = 0; bj < 2; ++bj) { f32x4 v0 = acc[ai][bj][m][0], v1 = acc[ai][bj][m][1];
#pragma unroll
                    for (int j = 0; j < 4; ++j) { float a = fmaxf(v0[j], 0.f), b = fmaxf(v1[j], 0.f); v0[j] = a * a; v1[j] = b * b; }
                    u32x4 w; w.x = cvt_pk_bf16(v0[0], v0[1]); w.y = cvt_pk_bf16(v0[2], v0[3]); w.z = cvt_pk_bf16(v1[0], v1[1]); w.w = cvt_pk_bf16(v1[2], v1[3]);
                    *(u32x4*)(rowp + bj * HALF) = w; } }
    }
};
struct EpiRes {
    const float* base; float* out; const float* gate;
    __device__ __forceinline__ bool zero_after(const Unit&) const { return true; }
    __device__ __forceinline__ void operator()(f32x4 (&acc)[2][2][4][2], const Unit& u, int wr, int wc, int fr, int fq) const {
        const int row0 = u.pm * BM + wr * 64 + fr, col0 = u.pn * BM + wc * 32 + 8 * fq;
        const float* gp = gate + (size_t)((u.pm * BM) >> 11) * (NMOD * D) + col0;
#pragma unroll
        for (int bj = 0; bj < 2; ++bj) {
            const f32x4 g0 = *(const f32x4*)(gp + bj * HALF), g1 = *(const f32x4*)(gp + bj * HALF + 4);
#pragma unroll
            for (int ai = 0; ai < 2; ++ai) {
#pragma unroll
                for (int m = 0; m < 4; ++m) { const size_t off = (size_t)(row0 + ai * HALF + m * 16) * D + col0 + bj * HALF;
                    const f32x4 b0 = *(const f32x4*)(base + off), b1 = *(const f32x4*)(base + off + 4);
                    *(f32x4*)(out + off) = b0 + g0 * acc[ai][bj][m][0];
                    *(f32x4*)(out + off + 4) = b1 + g1 * acc[ai][bj][m][1];
                    if (m & 1) asm volatile("" ::: "memory"); }
            }
        }
    }
};
struct EpiMerge {
    const bf16_t* proj; bf16_t* O;
    __device__ __forceinline__ bool zero_after(const Unit& u) const { return u.seg == 2; }
    __device__ __forceinline__ void operator()(f32x4 (&acc)[2][2][4][2], const Unit& u, int wr, int wc, int fr, int fq) const {
        const int row0 = u.pm * BM + wr * 64 + fr, col0 = u.pn * BM + wc * 32 + 8 * fq;
        const int seg = u.seg;
#pragma unroll
        for (int ai = 0; ai < 2; ++ai)
#pragma unroll
            for (int m = 0; m < 4; ++m) { const size_t row = (size_t)(row0 + ai * HALF + m * 16); const bf16_t* gp = proj + row * LDP + GATE + col0;
#pragma unroll
                for (int bj = 0; bj < 2; ++bj) {
                    if (seg < 2) {
                        const u32x4 ga = *(const u32x4*)(gp + seg * D + bj * HALF), gb = *(const u32x4*)(gp + (seg + 1) * D + bj * HALF);
                        float r[8];
#pragma unroll
                        for (int j = 0; j < 4; ++j) {
                            const float a0 = fminf(fmaxf(bflo(ga[j]), -40.f), 40.f), a1 = fminf(fmaxf(bfhi(ga[j]), -40.f), 40.f);
                            const float b0 = fminf(fmaxf(bflo(gb[j]), -40.f), 40.f), b1 = fminf(fmaxf(bfhi(gb[j]), -40.f), 40.f);
                            r[2 * j] = (1.f + __expf(-b0)) * __builtin_amdgcn_rcpf(1.f + __expf(-a0));
                            r[2 * j + 1] = (1.f + __expf(-b1)) * __builtin_amdgcn_rcpf(1.f + __expf(-a1)); }
                        acc[ai][bj][m][0] = acc[ai][bj][m][0] * (f32x4){r[0], r[1], r[2], r[3]};
                        acc[ai][bj][m][1] = acc[ai][bj][m][1] * (f32x4){r[4], r[5], r[6], r[7]};
                    } else {
                        const u32x4 gc = *(const u32x4*)(gp + 2 * D + bj * HALF);
                        float r[8];
#pragma unroll
                        for (int j = 0; j < 4; ++j) {
                            const float c0 = fminf(fmaxf(bflo(gc[j]), -40.f), 40.f), c1 = fminf(fmaxf(bfhi(gc[j]), -40.f), 40.f);
                            r[2 * j] = __builtin_amdgcn_rcpf(1.f + __expf(-c0)); r[2 * j + 1] = __builtin_amdgcn_rcpf(1.f + __expf(-c1)); }
                        const f32x4 v0 = acc[ai][bj][m][0] * (f32x4){r[0], r[1], r[2], r[3]}, v1 = acc[ai][bj][m][1] * (f32x4){r[4], r[5], r[6], r[7]};
                        u32x4 w; w.x = cvt_pk_bf16(v0[0], v0[1]); w.y = cvt_pk_bf16(v0[2], v0[3]); w.z = cvt_pk_bf16(v1[0], v1[1]); w.w = cvt_pk_bf16(v1[2], v1[3]);
                        *(u32x4*)(O + row * D + col0 + bj * HALF) = w;
                    } } }
    }
};

template <class Epi, bool ALIGN_EPI = true>
__device__ __forceinline__ void gemm_phase(LAS uchar* lds, const Gemm g, const Order& S, const Epi& E) {
    const int tid = tid_fresh(), wid = __builtin_amdgcn_readfirstlane(tid >> 6), lane = tid & 63, wr = wid >> 2, wc = wid & 3, fr = lane & 15, fq = lane >> 4;
    const int K = g.K;
    unsigned voffA[2], voffB[2];
#pragma unroll
    for (int i = 0; i < 2; ++i) { int R, C; stage_rc(tid * 16 + i * 8192, R, C); const int Rb = (R & ~31) + perm32(R & 31);
        voffA[i] = (unsigned)(R * K + C) * 2u; voffB[i] = (unsigned)(Rb * K + C) * 2u; }
    const size_t kstep = (size_t)(BK * 2);
    const size_t hstep = (size_t)HALF * K * 2;
    const size_t tstep = 2 * hstep;
    const unsigned ldsw = (unsigned)wid * 1024u;
    const int aoff = lds_byte(wr * 64 + fr, fq * 8), boff = lds_byte(wc * 32 + fr, fq * 8);
#define PG8_SA(b, h) (((b) * 2 + (h)) * HTB)
#define PG8_SB(b, h) ((4 + (b) * 2 + (h)) * HTB)
#define PG8_STAGE(bufoff, gbase, voff) do { _Pragma("unroll") for (int _i = 0; _i < 2; ++_i) \
        __builtin_amdgcn_global_load_lds((const unsigned*)((const char*)(gbase) + (voff)[_i]), (LAS unsigned*)(lds + (bufoff) + ldsw + _i * 8192), 16, 0, 0); } while (0)
#define PG8_LDA(dst, b, h) do { _Pragma("unroll") for (int m = 0; m < 4; ++m) _Pragma("unroll") for (int k = 0; k < 2; ++k) dst[m][k] = *(const LAS bf16x8*)(lds + PG8_SA(b, h) + aoff + m * 2048 + k * 1024); } while (0)
#define PG8_LDB(dst, b, h) do { _Pragma("unroll") for (int n = 0; n < 2; ++n) _Pragma("unroll") for (int k = 0; k < 2; ++k) dst[n][k] = *(const LAS bf16x8*)(lds + PG8_SB(b, h) + boff + n * 2048 + k * 1024); } while (0)
#define PG8_MMA(ai, bj, At, Bt) do { __builtin_amdgcn_s_setprio(1); _Pragma("unroll") for (int m = 0; m < 4; ++m) _Pragma("unroll") for (int n = 0; n < 2; ++n) _Pragma("unroll") for (int k = 0; k < 2; ++k) \
        acc[ai][bj][m][n] = __builtin_amdgcn_mfma_f32_16x16x32_bf16(Bt[n][k], At[m][k], acc[ai][bj][m][n], 0, 0, 0); __builtin_amdgcn_s_setprio(0); } while (0)
#define PG8_WAIT_V(n) asm volatile("s_waitcnt vmcnt(" #n ")" ::: "memory")
#define PG8_WAIT_L(n) asm volatile("s_waitcnt lgkmcnt(" #n ")" ::: "memory")
#define PG8_BAR __builtin_amdgcn_s_barrier()
#define PG8_SCHED __builtin_amdgcn_sched_barrier(0)
    Unit cur, nxt; int ui = 0;
    if (!S.next(0, cur)) return;
    f32x4 acc[2][2][4][2];
#pragma unroll
    for (int a = 0; a < 2; ++a)
#pragma unroll
        for (int b = 0; b < 2; ++b)
#pragma unroll
            for (int m = 0; m < 4; ++m)
#pragma unroll
                for (int n = 0; n < 2; ++n) acc[a][b][m][n] = (f32x4){0.f, 0.f, 0.f, 0.f};
    bf16x8 At[4][2], B0[2][2], B1[2][2];
    const char* cA = (const char*)g.A + (size_t)cur.pm * tstep + (size_t)cur.koff * 2; const char* cB = (const char*)g.Bt + (size_t)cur.pn * tstep + (size_t)cur.koff * 2;
    PG8_STAGE(PG8_SB(0, 0), cB, voffB); PG8_STAGE(PG8_SB(0, 1), cB + hstep, voffB); PG8_STAGE(PG8_SA(0, 0), cA, voffA); PG8_STAGE(PG8_SA(0, 1), cA + hstep, voffA);
    if (wr == 1) PG8_BAR;
    PG8_WAIT_V(2); PG8_BAR;
    PG8_STAGE(PG8_SB(1, 0), cB + kstep, voffB); PG8_STAGE(PG8_SA(1, 0), cA + kstep, voffA); PG8_STAGE(PG8_SB(1, 1), cB + hstep + kstep, voffB);
    PG8_WAIT_V(6); PG8_BAR;
    for (;;) {
        const bool has_next = S.next(ui + 1, nxt);
        const char* nA = has_next ? (const char*)g.A + (size_t)nxt.pm * tstep + (size_t)nxt.koff * 2 : cA; const char* nB = has_next ? (const char*)g.Bt + (size_t)nxt.pn * tstep + (size_t)nxt.koff * 2 : cB;
        const int nt = cur.nt;
        for (int t = 0; t < nt; t += 2) {
            const bool last = (t == nt - 2);
            const char* a1 = cA + (size_t)(t + 1) * kstep;
            const char* a2 = last ? nA : cA + (size_t)(t + 2) * kstep; const char* b2 = last ? nB : cB + (size_t)(t + 2) * kstep;
            const char* a3 = a2 + kstep; const char* b3 = b2 + kstep;
            PG8_LDB(B0, 0, 0); PG8_LDB(B1, 0, 1); PG8_SCHED; PG8_LDA(At, 0, 0); PG8_STAGE(PG8_SA(1, 1), a1 + hstep, voffA);
            PG8_WAIT_V(8); PG8_WAIT_L(0); PG8_BAR; PG8_MMA(0, 0, At, B0); PG8_MMA(0, 1, At, B1); PG8_BAR; PG8_SCHED;
            PG8_LDA(At, 0, 1); PG8_STAGE(PG8_SB(0, 0), b2, voffB); PG8_STAGE(PG8_SB(0, 1), b2 + hstep, voffB); PG8_STAGE(PG8_SA(0, 0), a2, voffA);
            PG8_WAIT_V(8); PG8_WAIT_L(0); PG8_BAR; PG8_MMA(1, 0, At, B0); PG8_MMA(1, 1, At, B1); PG8_BAR; PG8_SCHED;
            PG8_LDB(B0, 1, 0); PG8_LDB(B1, 1, 1); PG8_SCHED; PG8_LDA(At, 1, 0); PG8_STAGE(PG8_SA(0, 1), a2 + hstep, voffA);
            PG8_WAIT_V(8); PG8_WAIT_L(0); PG8_BAR; PG8_MMA(0, 0, At, B0); PG8_MMA(0, 1, At, B1); PG8_BAR; PG8_SCHED;
            PG8_LDA(At, 1, 1); PG8_STAGE(PG8_SB(1, 0), b3, voffB); PG8_STAGE(PG8_SB(1, 1), b3 + hstep, voffB); PG8_STAGE(PG8_SA(1, 0), a3, voffA);
            PG8_WAIT_V(8); PG8_WAIT_L(0); PG8_BAR; PG8_MMA(1, 0, At, B0); PG8_MMA(1, 1, At, B1); PG8_BAR; PG8_SCHED;
        }
        if constexpr (ALIGN_EPI) { if (wr == 0) PG8_BAR; }
        E(acc, cur, wr, wc, fr, fq);
        if (!has_next) break;
        if (E.zero_after(cur)) {
#pragma unroll
            for (int a = 0; a < 2; ++a)
#pragma unroll
                for (int b = 0; b < 2; ++b)
#pragma unroll
                    for (int m = 0; m < 4; ++m)
#pragma unroll
                        for (int n = 0; n < 2; ++n) acc[a][b][m][n] = (f32x4){0.f, 0.f, 0.f, 0.f};
        }
        cur = nxt; cA = nA; cB = nB; ++ui;
        if constexpr (ALIGN_EPI) { if (wr == 1) PG8_BAR; }
    }
    PG8_WAIT_V(0);
    if constexpr (!ALIGN_EPI) { if (wr == 0) PG8_BAR; }
    PG8_BAR;
#undef PG8_SA
#undef PG8_SB
#undef PG8_STAGE
#undef PG8_LDA
#undef PG8_LDB
#undef PG8_MMA
#undef PG8_WAIT_V
#undef PG8_WAIT_L
#undef PG8_BAR
#undef PG8_SCHED
}
}

__device__ __forceinline__ int crow(int r, int hi) { return (r & 3) + 8 * (r >> 2) + 4 * hi; }
__device__ __forceinline__ s16x4 vtr(const LAS uchar* p) { return __builtin_bit_cast(s16x4, __builtin_amdgcn_ds_read_tr16_b64_v4i16((LAS s16x4*)p)); }
__device__ __forceinline__ float xhalf_max(float m) { auto rr = __builtin_amdgcn_permlane32_swap(__builtin_bit_cast(unsigned, m), __builtin_bit_cast(unsigned, m), false, false); return fmaxf(__builtin_bit_cast(float, rr[0]), __builtin_bit_cast(float, rr[1])); }
__device__ __forceinline__ float xhalf_sum(float m) { auto rr = __builtin_amdgcn_permlane32_swap(__builtin_bit_cast(unsigned, m), __builtin_bit_cast(unsigned, m), false, false); return __builtin_bit_cast(float, rr[0]) + __builtin_bit_cast(float, rr[1]); }

__device__ __forceinline__ void glds16(const void* gsrc, unsigned lds_dst) { unsigned keep;
    asm volatile("s_mov_b32 %0, m0\n\ts_mov_b32 m0, %2\n\ts_nop 0\n\tglobal_load_lds_dwordx4 %1, off\n\ts_mov_b32 m0, %0" : "=&s"(keep) : "v"(gsrc), "s"(lds_dst) : "memory"); }
constexpr int ATT_SLOT = 32768, ATT_WSF = 98304;
__device__ __forceinline__ void attn_unit(LAS uchar* lds, const bf16_t* proj, bf16_t* ocat, int bl, int h, int qb, float lam, float laminit, const float* sg) {
    const int tid = tid_fresh(), lane = tid & 63, r32 = lane & 31, hi = lane >> 5;
    const int wave = __builtin_amdgcn_readfirstlane(tid >> 6), mi = wave >> 2, rb = wave & 3;
    const size_t rowbase = (size_t)bl * SEQ;
    const int q0 = qb * 128 + rb * 32;
    const float m2 = exp2f(-2.f * (float)(h + 1)) * LOG2E;
    bf16x8 qf[4];
    { const bf16_t* qp = proj + (rowbase + q0 + r32) * LDP + CQ + h * 128 + mi * 64 + hi * 8;
#pragma unroll
      for (int d0 = 0; d0 < 4; ++d0) qf[d0] = *(const bf16x8*)(qp + d0 * 16); }
    const bf16_t* ksrc0 = proj + (rowbase + lane) * LDP + CK + h * 128 + wave * 8;
    const bf16_t* ksrc1 = ksrc0 + 64;
    const bf16_t* vsrc0 = proj + (rowbase + 16 * (wave & 3) + (lane >> 2)) * LDP + CV + h * 128 + (wave >> 2) * 32 + (lane & 3) * 8;
    const bf16_t* vsrc1 = vsrc0 + 64;
    const unsigned lds0 = (unsigned)(uintptr_t)lds + (unsigned)wave * 1024u;
#define ATT_ISSUE(t, sb) do { const size_t go_ = (size_t)(t) * 64 * LDP; const unsigned d_ = (unsigned)__builtin_amdgcn_readfirstlane((int)(lds0 + (unsigned)(sb))); \
        glds16(ksrc0 + go_, d_); glds16(ksrc1 + go_, d_ + 8192u); glds16(vsrc0 + go_, d_ + 16384u); glds16(vsrc1 + go_, d_ + 24576u); } while (0)
    LAS float* wsf = (LAS float*)(lds + ATT_WSF) + wave * 64;
    f32x16 o[4];
#pragma unroll
    for (int d = 0; d < 4; ++d)
#pragma unroll
        for (int r = 0; r < 16; ++r) o[d][r] = 0.f;
    float mhat = 0.f;
    f32x16 ol;
#pragma unroll
    for (int r = 0; r < 16; ++r) ol[r] = 0.f;
    const bf16x8 ones = (bf16x8){0x3F80, 0x3F80, 0x3F80, 0x3F80, 0x3F80, 0x3F80, 0x3F80, 0x3F80};
    const int kfo = (mi * 8 + hi) * 1024 + r32 * 16;
    const int vfo = 16384 + ((lane >> 4) & 1) * 32 + (lane & 3) * 8 + (4 * hi + ((lane & 15) >> 2)) * 64;
    ATT_ISSUE(0, 0); ATT_ISSUE(1, ATT_SLOT);
    int slot_c = 0, slot_n = 2 * ATT_SLOT;
    for (int t = 0; t < SEQ / 64; ++t) {
        if (t + 1 < SEQ / 64) asm volatile("s_waitcnt vmcnt(4) lgkmcnt(0)" ::: "memory"); else asm volatile("s_waitcnt vmcnt(0) lgkmcnt(0)" ::: "memory");
        __builtin_amdgcn_s_barrier();
        asm volatile("" ::: "memory");
        if (t + 2 < SEQ / 64) ATT_ISSUE(t + 2, slot_n);
        const LAS uchar* sl = lds + slot_c;
        { const int nx = slot_c + ATT_SLOT; slot_n = slot_c; slot_c = (nx == 3 * ATT_SLOT) ? 0 : nx; }
        const float dq = (float)(q0 + r32 - 64 * t - 4 * hi);
        f32x16 p0, p1;
#pragma unroll
        for (int r = 0; r < 16; ++r) { const float kc = (float)((r & 3) + 8 * (r >> 2));
            p0[r] = __builtin_fmaf(-m2, __builtin_fabsf(dq - kc), -mhat); p1[r] = __builtin_fmaf(-m2, __builtin_fabsf(dq - kc - 32.f), -mhat); }
#pragma unroll
        for (int d0 = 0; d0 < 4; ++d0) {
            const bf16x8 a0 = *(const LAS bf16x8*)(sl + kfo + d0 * 2048), a1 = *(const LAS bf16x8*)(sl + kfo + d0 * 2048 + 512);
            p0 = __builtin_amdgcn_mfma_f32_32x32x16_bf16(a0, qf[d0], p0, 0, 0, 0);
            p1 = __builtin_amdgcn_mfma_f32_32x32x16_bf16(a1, qf[d0], p1, 0, 0, 0); }
        float rm = fmaxf(p0[0], p1[0]);
#pragma unroll
        for (int r = 1; r < 16; ++r) rm = fmaxf(rm, fmaxf(p0[r], p1[r]));
        rm = xhalf_max(rm);
        const bool first = (t == 0);
        if (first || __any(rm > 8.f)) {
            const float dl = first ? rm : fmaxf(rm, 0.f);
            mhat += dl;
#pragma unroll
            for (int r = 0; r < 16; ++r) { p0[r] -= dl; p1[r] -= dl; }
            if (!first) {
                const float f = __builtin_amdgcn_exp2f(-dl);
                if (hi == 0) wsf[r32] = f;
                float fr_[16];
#pragma unroll
                for (int r = 0; r < 16; ++r) fr_[r] = wsf[crow(r, hi)];
#pragma unroll
                for (int d = 0; d < 4; ++d)
#pragma unroll
                    for (int r = 0; r < 16; ++r) o[d][r] *= fr_[r];
#pragma unroll
                for (int r = 0; r < 16; ++r) ol[r] *= fr_[r];
            }
        }
#pragma unroll
        for (int r = 0; r < 16; ++r) { p0[r] = __builtin_amdgcn_exp2f(p0[r]); p1[r] = __builtin_amdgcn_exp2f(p1[r]); }
        u32x4 pw[4];
#pragma unroll
        for (int j = 0; j < 4; ++j) { pw[0][j] = cvt_pk_bf16(p0[2 * j], p0[2 * j + 1]); pw[1][j] = cvt_pk_bf16(p0[8 + 2 * j], p0[8 + 2 * j + 1]);
                                      pw[2][j] = cvt_pk_bf16(p1[2 * j], p1[2 * j + 1]); pw[3][j] = cvt_pk_bf16(p1[8 + 2 * j], p1[8 + 2 * j + 1]); }
#pragma unroll
        for (int d = 0; d < 4; ++d)
#pragma unroll
            for (int ks = 0; ks < 4; ++ks) {
                const s16x4 lo = vtr(sl + vfo + d * 4096 + ks * 1024), hh = vtr(sl + vfo + d * 4096 + ks * 1024 + 512);
                const bf16x8 vf = (bf16x8){lo[0], lo[1], lo[2], lo[3], hh[0], hh[1], hh[2], hh[3]};
                o[d] = __builtin_amdgcn_mfma_f32_32x32x16_bf16(__builtin_bit_cast(bf16x8, pw[ks]), vf, o[d], 0, 0, 0); }
#pragma unroll
        for (int ks = 0; ks < 4; ++ks) ol = __builtin_amdgcn_mfma_f32_32x32x16_bf16(__builtin_bit_cast(bf16x8, pw[ks]), ones, ol, 0, 0, 0);
    }
#undef ATT_ISSUE
    float fr_[16];
#pragma unroll
    for (int r = 0; r < 16; ++r) fr_[r] = (mi == 0 ? 1.f : lam) / ol[r];
    __syncthreads();
    LAS float* X = (LAS float*)lds + rb * 4096;
    if (mi == 1) {
#pragma unroll
        for (int d = 0; d < 4; ++d)
#pragma unroll
            for (int r = 0; r < 16; ++r) X[(d * 16 + r) * 64 + lane] = o[d][r] * fr_[r];
    }
    __syncthreads();
    if (mi == 0) {
        float ss[16];
#pragma unroll
        for (int r = 0; r < 16; ++r) ss[r] = 0.f;
#pragma unroll
        for (int d = 0; d < 4; ++d)
#pragma unroll
            for (int r = 0; r < 16; ++r) { const float v = o[d][r] * fr_[r] - X[(d * 16 + r) * 64 + lane]; o[d][r] = v; ss[r] += v * v; }
#pragma unroll
        for (int r = 0; r < 16; ++r) {
#pragma unroll
            for (int s = 1; s < 32; s <<= 1) ss[r] += __shfl_xor(ss[r], s);
            ss[r] = rsqrtf(ss[r] * (1.f / 128.f) + EPS) * (1.f - laminit); }
        float gv[4];
#pragma unroll
        for (int d = 0; d < 4; ++d) gv[d] = sg[d * 32 + r32];
#pragma unroll
        for (int r = 0; r < 16; ++r) { bf16_t* op = ocat + (rowbase + q0 + crow(r, hi)) * D + h * 128 + r32;
#pragma unroll
            for (int d = 0; d < 4; ++d) op[d * 32] = (bf16_t)f2bf(o[d][r] * ss[r] * gv[d]); }
    }
    __syncthreads();
}

template <int DK, bool HG>
__device__ __forceinline__ void scan_item(LAS uchar* lds, const bf16_t* proj, float* oraw0, float* oraw1, bf16_t* ocat, unsigned* done, int bl, int h, int dir, const float* lb  ,
                                          const float* normg  , const float* w2  , const float* gbias  ) {
    constexpr int KPW = DK / 8, TB = 32, NS = TB / 16, NR = TB / 8, GS = 4;
    LAS float* sA = (LAS float*)lds;
    LAS float* sK = sA + TB * DK;
    LAS float* sQ = sK + TB * DK;
    LAS float* sV = sQ + TB * DK;
    LAS float* sP = sV + TB * 64;
    const int tid = tid_fresh(), lane = tid & 63, wave = __builtin_amdgcn_readfirstlane(tid >> 6);
    const int ps = tid >> 5, pi = tid & 31;
    const size_t rowbase = (size_t)bl * SEQ;
    float* oraw = dir == 0 ? oraw0 : oraw1;
    __syncthreads();
    {
        float lb0 = 0.f, lb1 = 0.f, w2c[16], bias = 0.f;
        if (HG) { lb0 = lb[dir * 256 + h * 64 + pi]; lb1 = lb[dir * 256 + h * 64 + pi + 32]; }
        else {
#pragma unroll
            for (int r = 0; r < 16; ++r) w2c[r] = w2[(dir * 16 + r) * 128 + h * 32 + pi];
            bias = gbias[dir * 128 + h * 32 + pi]; }
        f32x2 S[KPW / 2];
#pragma unroll
        for (int j = 0; j < KPW / 2; ++j) S[j] = (f32x2){0.f, 0.f};
        bf16_t rz0[NS], rz1[NS], rq0[NS], rq1[NS], rv0[NS], rv1[NS], rk0[NS]; u32x4 rl0[NS], rl1[NS];
#pragma unroll
        for (int i = 0; i < NS; ++i) { rz0[i] = rz1[i] = rq0[i] = rq1[i] = rv0[i] = rv1[i] = rk0[i] = 0; rl0[i] = rl1[i] = (u32x4){0, 0, 0, 0}; }
#define SCAN_LOAD(blk) do { _Pragma("unroll") for (int i_ = 0; i_ < NS; ++i_) { const int st_ = (blk) * TB + ps + 16 * i_; const int tok_ = dir == 0 ? st_ : 2047 - st_; const bf16_t* pr_ = proj + (rowbase + tok_) * LDP; \
        if (HG) { const int zc_ = (dir == 0 ? BFF : BFB) + h * 64 + pi; rz0[i_] = pr_[zc_]; rz1[i_] = pr_[zc_ + 32]; rq0[i_] = pr_[BQ + h * 64 + pi]; rq1[i_] = pr_[BQ + h * 64 + pi + 32]; rv0[i_] = pr_[BI + h * 64 + pi]; rv1[i_] = pr_[BI + h * 64 + pi + 32]; } \
        else { const u32x4* lp_ = (const u32x4*)(pr_ + (dir == 0 ? GLF : GLB)); rl0[i_] = lp_[0]; rl1[i_] = lp_[1]; rk0[i_] = pr_[GK + h * 32 + pi]; rq0[i_] = pr_[GQ + h * 32 + pi]; rv0[i_] = pr_[GV + h * 64 + pi]; rv1[i_] = pr_[GV + h * 64 + pi + 32]; } } } while (0)
        SCAN_LOAD(0);
        for (int blk = 0; blk < SEQ / TB; ++blk) {
#pragma unroll
            for (int i = 0; i < NS; ++i) {
                const int st = ps + 16 * i;
                if (HG) {
                    const float z0 = bf2f(rz0[i]), z1 = bf2f(rz1[i]);
                    const float s0 = 1.f / (1.f + __expf(-z0)), s1 = 1.f / (1.f + __expf(-z1));
                    sA[st * 64 + pi] = s0 * (1.f + lb0 * __expf(fminf(-z0, 80.f))); sA[st * 64 + pi + 32] = s1 * (1.f + lb1 * __expf(fminf(-z1, 80.f)));
                    sK[st * 64 + pi] = (1.f - lb0) / (1.f + __expf(z0)); sK[st * 64 + pi + 32] = (1.f - lb1) / (1.f + __expf(z1));
                    const float q0 = bf2f(rq0[i]), q1 = bf2f(rq1[i]);
                    sQ[st * 64 + pi] = q0 / (1.f + __expf(-q0)) * 0.125f; sQ[st * 64 + pi + 32] = q1 / (1.f + __expf(-q1)) * 0.125f;
                } else {
                    float z = bias;
#pragma unroll
                    for (int j = 0; j < 4; ++j) { z += bflo(rl0[i][j]) * w2c[2 * j] + bfhi(rl0[i][j]) * w2c[2 * j + 1]; z += bflo(rl1[i][j]) * w2c[8 + 2 * j] + bfhi(rl1[i][j]) * w2c[8 + 2 * j + 1]; }
                    const float ls = fminf(z, 0.f) - __logf(1.f + __expf(-fabsf(z)));
                    sA[st * 32 + pi] = __expf(ls * (1.f / 16.f));
                    sK[st * 32 + pi] = bf2f(rk0[i]);
                    sQ[st * 32 + pi] = bf2f(rq0[i]) * 0.17677669529663687f;
                }
                sV[st * 64 + pi] = bf2f(rv0[i]); sV[st * 64 + pi + 32] = bf2f(rv1[i]);
            }
            __syncthreads();
            if (blk + 1 < SEQ / TB) SCAN_LOAD(blk + 1);
            for (int s0_ = 0; s0_ < TB; s0_ += GS) {
                float vv[GS]; f32x4 a4[GS][KPW / 4], k4[GS][KPW / 4], q4[GS][KPW / 4];
#pragma unroll
                for (int g = 0; g < GS; ++g) { const int s = s0_ + g; vv[g] = sV[s * 64 + lane];
#pragma unroll
                    for (int j4 = 0; j4 < KPW / 4; ++j4) { a4[g][j4] = *(const LAS f32x4*)(sA + s * DK + wave * KPW + j4 * 4); k4[g][j4] = *(const LAS f32x4*)(sK + s * DK + wave * KPW + j4 * 4); q4[g][j4] = *(const LAS f32x4*)(sQ + s * DK + wave * KPW + j4 * 4); } }
                float po[GS];
#pragma unroll
                for (int g = 0; g < GS; ++g) {
                    f32x2 op = (f32x2){0.f, 0.f};
#pragma unroll
                    for (int j4 = 0; j4 < KPW / 4; ++j4) {
                        const f32x2 kv0 = (f32x2){k4[g][j4][0], k4[g][j4][1]} * vv[g], kv1 = (f32x2){k4[g][j4][2], k4[g][j4][3]} * vv[g];
                        S[2 * j4] = __builtin_elementwise_fma((f32x2){a4[g][j4][0], a4[g][j4][1]}, S[2 * j4], kv0);
                        S[2 * j4 + 1] = __builtin_elementwise_fma((f32x2){a4[g][j4][2], a4[g][j4][3]}, S[2 * j4 + 1], kv1);
                        op = __builtin_elementwise_fma((f32x2){q4[g][j4][0], q4[g][j4][1]}, S[2 * j4], op);
                        op = __builtin_elementwise_fma((f32x2){q4[g][j4][2], q4[g][j4][3]}, S[2 * j4 + 1], op); }
                    po[g] = op[0] + op[1]; }
#pragma unroll
                for (int g = 0; g < GS; ++g) sP[((s0_ + g) * 8 + wave) * 64 + lane] = po[g];
            }
            __syncthreads();
#pragma unroll
            for (int j2 = 0; j2 < NR; ++j2) {
                const int s = wave + 8 * j2; const int tok = dir == 0 ? blk * TB + s : 2047 - (blk * TB + s);
                float sum = 0.f;
#pragma unroll
                for (int w = 0; w < 8; ++w) sum += sP[(s * 8 + w) * 64 + lane];
                oraw[(rowbase + tok) * 512 + (HG ? 0 : 256) + h * 64 + lane] = sum;
            }
        }
#undef SCAN_LOAD
    }
    asm volatile("s_waitcnt vmcnt(0)" ::: "memory");
    __syncthreads();
    LAS unsigned* flg = (LAS unsigned*)(lds + 147456 - 128);
    if (tid == 0) { __builtin_amdgcn_fence(__ATOMIC_RELEASE, "agent"); asm volatile("s_waitcnt vmcnt(0)" ::: "memory");
        const unsigned old = __hip_atomic_fetch_add(done, 1u, __ATOMIC_RELAXED, __HIP_MEMORY_SCOPE_AGENT);
        __builtin_amdgcn_fence(__ATOMIC_ACQUIRE, "agent"); asm volatile("s_waitcnt vmcnt(0)" ::: "memory");
        flg[0] = old; }
    __syncthreads();
    if (flg[0] == 1u) {
        if (lane == 0 && tid != 0) { __builtin_amdgcn_fence(__ATOMIC_ACQUIRE, "agent"); asm volatile("s_waitcnt vmcnt(0)" ::: "memory"); }
        __syncthreads();
        const float ng = normg[lane];
        for (int t = wave; t < SEQ; t += 8) {
            const size_t o = (rowbase + t) * 512 + (HG ? 0 : 256) + h * 64 + lane;
            const float tot = __hip_atomic_load(oraw0 + o, __ATOMIC_RELAXED, __HIP_MEMORY_SCOPE_AGENT) + __hip_atomic_load(oraw1 + o, __ATOMIC_RELAXED, __HIP_MEMORY_SCOPE_AGENT);
            const float ssq = wave_sum(tot * tot);
            const float gvv = bf2f(proj[(rowbase + t) * LDP + (HG ? BG : GG) + h * 64 + lane]);
            const float outv = tot * rsqrtf(ssq * (1.f / 64.f) + EPS) * ng * (gvv / (1.f + __expf(-gvv)));
            ocat[(rowbase + t) * D + (HG ? 512 : 768) + h * 64 + lane] = (bf16_t)f2bf(outv);
        }
    }
    __syncthreads();
}

__device__ __forceinline__ void norm_rows_mod(const float* src, bf16_t* dst, const float* g, const float* modl  , int grow0, int shoff, int scoff) {
    const int tid = tid_fresh(), lane = tid & 63, gw = blockIdx.x * 8 + __builtin_amdgcn_readfirstlane(tid >> 6), NGW = gridDim.x * 8;
    for (int m = gw; m < TG; m += NGW) {
        const int b = (grow0 + m) >> 11;
        const f32x4* xr = (const f32x4*)(src + (size_t)m * D) + lane;
        const f32x4* gr = (const f32x4*)g + lane; const f32x4* sh = (const f32x4*)(modl + (size_t)b * (NMOD * D) + shoff) + lane; const f32x4* sc = (const f32x4*)(modl + (size_t)b * (NMOD * D) + scoff) + lane;
        f32x4 v[4]; float s = 0.f;
#pragma unroll
        for (int j = 0; j < 4; ++j) { v[j] = xr[64 * j]; s += (v[j].x * v[j].x + v[j].y * v[j].y) + (v[j].z * v[j].z + v[j].w * v[j].w); }
        const float r = rsqrtf(wave_sum(s) * (1.f / D) + EPS);
        unsigned long long* o8 = (unsigned long long*)(dst + (size_t)m * D) + lane;
#pragma unroll
        for (int j = 0; j < 4; ++j) { const f32x4 y = v[j] * r * gr[64 * j] * (1.f + sc[64 * j]) + sh[64 * j];
            o8[64 * j] = (unsigned long long)pk2(y.x, y.y) | ((unsigned long long)pk2(y.z, y.w) << 32); }
    }
}
__device__ __forceinline__ void norm_rows_final(float* x, const float* g) {
    const int tid = tid_fresh(), lane = tid & 63, gw = blockIdx.x * 8 + __builtin_amdgcn_readfirstlane(tid >> 6), NGW = gridDim.x * 8;
    for (int m = gw; m < TG; m += NGW) {
        f32x4* xr = (f32x4*)(x + (size_t)m * D) + lane; const f32x4* gr = (const f32x4*)g + lane;
        f32x4 v[4]; float s = 0.f;
#pragma unroll
        for (int j = 0; j < 4; ++j) { v[j] = xr[64 * j]; s += (v[j].x * v[j].x + v[j].y * v[j].y) + (v[j].z * v[j].z + v[j].w * v[j].w); }
        const float r = rsqrtf(wave_sum(s) * (1.f / D) + EPS);
#pragma unroll
        for (int j = 0; j < 4; ++j) xr[64 * j] = v[j] * r * gr[64 * j];
    }
}

__device__ __forceinline__ void transpose_item(const float* W, int ldw, bf16_t* WT, int ldt, int row_off, int k_off, LAS float* scr, int kb, int nb, int lane) {
    const int k0 = 64 * kb, n0 = 32 * nb;
#pragma unroll 8
    for (int i = 0; i < 32; ++i) { const int kk = 2 * i + (lane >> 5); scr[kk * 33 + (lane & 31)] = W[(size_t)(k0 + kk) * ldw + n0 + (lane & 31)]; }
    asm volatile("s_waitcnt lgkmcnt(0)" ::: "memory");
    const int c = lane & 7;
#pragma unroll
    for (int j = 0; j < 4; ++j) { const int n = (lane >> 3) + 8 * j; const LAS float* s = scr + (8 * c) * 33 + n;
        u32x4 o; o.x = pk2(s[0 * 33], s[1 * 33]); o.y = pk2(s[2 * 33], s[3 * 33]); o.z = pk2(s[4 * 33], s[5 * 33]); o.w = pk2(s[6 * 33], s[7 * 33]);
        *(u32x4*)(WT + (size_t)(row_off + n0 + n) * ldt + k_off + k0 + 8 * c) = o; }
    asm volatile("s_waitcnt lgkmcnt(0)" ::: "memory");
}

struct Args { const void* p[24]; };
enum { P_X = 0, P_C, P_ADAW, P_ADAB, P_NMIXG, P_NMLPG, P_WIN, P_DLAM, P_DSUBG, P_HLB, P_HNG, P_GW2, P_GB, P_GNG, P_WUA, P_WUB, P_WUC, P_WOUT, P_W1, P_W2, P_FNG, P_OUT, P_WS };
typedef const unsigned long long __attribute__((address_space(4)))* kargp_t;
__device__ __forceinline__ const void* karg(int i) { kargp_t kp = (kargp_t)__builtin_amdgcn_kernarg_segment_ptr(); asm volatile("" : "+s"(kp)); return (const void*)kp[i]; }
#define GRID_SYNC() do { asm volatile("s_waitcnt vmcnt(0) lgkmcnt(0)" ::: "memory"); __syncthreads(); grid.sync(); \
    if (threadIdx.x < 64) { __builtin_amdgcn_fence(__ATOMIC_ACQUIRE, "agent"); asm volatile("s_waitcnt vmcnt(0)" ::: "memory"); } __syncthreads(); } while (0)
#define KF(i) ((const float*)karg(i))
#define KWS() ((uchar*)karg(P_WS))

__global__ void __launch_bounds__(512, 2) fwd_megakernel(Args a_unused) {
    extern __shared__ __attribute__((aligned(16))) uchar lds_raw[];
    LAS uchar* lds = (LAS uchar*)lds_raw;
    cg::grid_group grid = cg::this_grid();
    {
    const int tid = tid_fresh(), lane = tid & 63, wave = __builtin_amdgcn_readfirstlane(tid >> 6);

    if (blockIdx.x == 0) {
        unsigned* ctl = (unsigned*)(KWS() + WS_CTL); float* ctlf = (float*)ctl;
        for (int i = tid; i < 1024; i += 512) { ctl[i] = 0u; ctl[40960 + i] = 0u; }
        if (tid < 4) {
            const float* lp = KF(P_DLAM) + tid * 256; float s1 = 0.f, s2 = 0.f;
            for (int d = 0; d < 64; ++d) { s1 += lp[d] * lp[64 + d]; s2 += lp[128 + d] * lp[192 + d]; }
            const float li = 0.8f - 0.6f * expf(-0.3f * (float)tid);
            ctlf[1024 + tid] = expf(s1) - expf(s2) + li; ctlf[1028 + tid] = li;
        }
        {
            const float* lg = KF(P_HLB); const int j = tid;
            float v[4], mx = -1e30f;
#pragma unroll
            for (int l = 0; l < 4; ++l) { v[l] = lg[l * 512 + j]; mx = fmaxf(mx, v[l]); }
            float den = 0.f;
#pragma unroll
            for (int l = 0; l < 4; ++l) { v[l] = expf(v[l] - mx); den += v[l]; }
            float cum = 0.f; const float w0 = v[0] / den;
#pragma unroll
            for (int l = 0; l < 4; ++l) { cum += v[l] / den; ctlf[2048 + l * 512 + j] = cum - w0; }
        }
        {
            float* pv = ctlf + 8192;
            const float* s0 = KF(P_NMIXG); for (int i = tid; i < 4096; i += 512) pv[i] = s0[i];
            const float* s1 = KF(P_NMLPG); for (int i = tid; i < 4096; i += 512) pv[4096 + i] = s1[i];
            const float* s2 = KF(P_DSUBG); for (int i = tid; i < 512; i += 512) pv[8192 + i] = s2[i];
            const float* s3 = KF(P_HNG); for (int i = tid; i < 256; i += 512) pv[8704 + i] = s3[i];
            const float* s4 = KF(P_GW2); for (int i = tid; i < 16384; i += 512) pv[8960 + i] = s4[i];
            const float* s5 = KF(P_GB); for (int i = tid; i < 1024; i += 512) pv[25344 + i] = s5[i];
            const float* s6 = KF(P_GNG); for (int i = tid; i < 256; i += 512) pv[26368 + i] = s6[i];
            const float* s7 = KF(P_FNG); for (int i = tid; i < 1024; i += 512) pv[26624 + i] = s7[i];
        }
    }
#ifndef NO_MOD
    {
        LAS float* cond = (LAS float*)lds; LAS float* red = (LAS float*)(lds + 131072);
        float* mod = (float*)(KWS() + WS_MOD);
        const float* cin = KF(P_C); const float* adaw = KF(P_ADAW); const float* adab = KF(P_ADAB);
        bool loaded = false;
        for (int it = blockIdx.x; it < 4 * 96; it += gridDim.x) {
            if (!loaded) { for (int i = tid; i < 32 * 1024; i += 512) { const float cv = cin[i]; cond[i] = cv / (1.f + __expf(-cv)); } loaded = true; __syncthreads(); }
            const int l = it / 96, n0 = (it % 96) * 64;
            const float* W = adaw + (size_t)l * D * (NMOD * D) + n0 + lane;
            float acc[32];
#pragma unroll
            for (int b = 0; b < 32; ++b) acc[b] = 0.f;
            for (int k4 = 0; k4 < 32; ++k4) {
                const int k = wave * 128 + k4 * 4;
                const float w0 = W[(size_t)k * (NMOD * D)], w1 = W[(size_t)(k + 1) * (NMOD * D)], w2v = W[(size_t)(k + 2) * (NMOD * D)], w3 = W[(size_t)(k + 3) * (NMOD * D)];
#pragma unroll
                for (int b = 0; b < 32; ++b) { const f32x4 c4 = *(const LAS f32x4*)(cond + b * 1024 + k); acc[b] += c4.x * w0 + c4.y * w1 + c4.z * w2v + c4.w * w3; }
            }
#pragma unroll
            for (int rd = 0; rd < 4; ++rd) {
                __syncthreads();
#pragma unroll
                for (int bb = 0; bb < 8; ++bb) red[(wave * 8 + bb) * 64 + lane] = acc[rd * 8 + bb];
                __syncthreads();
                float s = 0.f;
#pragma unroll
                for (int w = 0; w < 8; ++w) s += red[(w * 8 + wave) * 64 + lane];
                const int b = rd * 8 + wave;
                mod[((size_t)l * 32 + b) * (NMOD * D) + n0 + lane] = s + adab[l * (NMOD * D) + n0 + lane];
            }
        }
        __syncthreads();
    }
#endif
#ifndef NO_WT
    {
        LAS float* scr = (LAS float*)(lds + wave * 8704);
        const int gw = blockIdx.x * 8 + wave, NGW = gridDim.x * 8;
        uchar* ws = KWS();
        bf16_t* win_t = (bf16_t*)(ws + WS_WIN); bf16_t* wup_t = (bf16_t*)(ws + WS_WUP); bf16_t* wout_t = (bf16_t*)(ws + WS_WOUT);
        bf16_t* w1_t = (bf16_t*)(ws + WS_W1); bf16_t* w2_t = (bf16_t*)(ws + WS_W2);
        constexpr int I_IN = 16 * 209, I_UA = 8 * 32, I_UB = 4 * 32, I_UC = 4 * 32, I_O = 16 * 32, I_1 = 16 * 128, I_2 = 64 * 32;
        constexpr int I_L = I_IN + I_UA + I_UB + I_UC + I_O + I_1 + I_2;
        for (int it = gw; it < 4 * I_L; it += NGW) {
            const int l = it / I_L; int r = it % I_L;
            if (r < I_IN) { transpose_item(KF(P_WIN) + (size_t)l * D * DIN, DIN, win_t + (size_t)l * LDP * D, D, 0, 0, scr, r / 209, r % 209, lane); continue; } r -= I_IN;
            if (r < I_UA) { transpose_item(KF(P_WUA) + (size_t)l * 512 * D, D, wup_t + (size_t)l * D * D, D, 0, 0, scr, r / 32, r % 32, lane); continue; } r -= I_UA;
            if (r < I_UB) { transpose_item(KF(P_WUB) + (size_t)l * 256 * D, D, wup_t + (size_t)l * D * D, D, 0, 512, scr, r / 32, r % 32, lane); continue; } r -= I_UB;
            if (r < I_UC) { transpose_item(KF(P_WUC) + (size_t)l * 256 * D, D, wup_t + (size_t)l * D * D, D, 0, 768, scr, r / 32, r % 32, lane); continue; } r -= I_UC;
            if (r < I_O) { transpose_item(KF(P_WOUT) + (size_t)l * D * D, D, wout_t + (size_t)l * D * D, D, 0, 0, scr, r / 32, r % 32, lane); continue; } r -= I_O;
            if (r < I_1) { transpose_item(KF(P_W1) + (size_t)l * D * DFF, DFF, w1_t + (size_t)l * DFF * D, D, 0, 0, scr, r / 128, r % 128, lane); continue; } r -= I_1;
            transpose_item(KF(P_W2) + (size_t)l * DFF * D, D, w2_t + (size_t)l * D * DFF, DFF, 0, 0, scr, r / 32, r % 32, lane);
        }
        for (int i = blockIdx.x * 512 + tid; i < 4 * 28672; i += gridDim.x * 512) { const int l = i / 28672, r = i % 28672;
            *(u32x4*)(win_t + (size_t)l * LDP * D + (size_t)DIN * D + (size_t)r * 8) = (u32x4){0u, 0u, 0u, 0u}; }
    }
#endif
    }
    GRID_SYNC();

    for (int grp = 0; grp < NGRP; ++grp) {
        for (int l = 0; l < DEPTH; ++l) {
            {
                uchar* ws = KWS(); const float* pv = (const float*)(ws + WS_CTL) + 8192;
                const float* src = (l == 0 ? KF(P_X) : (const float*)karg(P_OUT)) + (size_t)grp * TG * D;
                norm_rows_mod(src, (bf16_t*)(ws + WS_HB), pv + l * D, (const float*)(ws + WS_MOD) + (size_t)l * 32 * (NMOD * D), grp * TG, 0, D);
            }
            GRID_SYNC();
            { uchar* ws = KWS(); pg8::Gemm g{(const bf16_t*)(ws + WS_HB), (const bf16_t*)(ws + WS_WIN) + (size_t)l * LDP * D, D}; pg8::Order S; S.init(TG, LDP, D, gridDim.x, blockIdx.x, 1); pg8::EpiProj E{(bf16_t*)(ws + WS_PROJ)};
#ifndef NO_EPIPROJ
              pg8::gemm_phase<pg8::EpiProj>(lds, g, S, E);
#endif
            }
            GRID_SYNC();
            {
                uchar* ws = KWS(); const float* ctlf = (const float*)(ws + WS_CTL); const float* pv = ctlf + 8192;
                const int xq = blockIdx.x & 7; unsigned* ctr = (unsigned*)(ws + WS_CTL) + ((grp * DEPTH + l) * 8 + xq) * 4;
                const float lam = ctlf[1024 + l], laminit = ctlf[1028 + l];
                const bf16_t* PROJ = (const bf16_t*)(ws + WS_PROJ); bf16_t* OCAT = (bf16_t*)(ws + WS_OCAT); float* OFWD = (float*)(ws + WS_OFWD);
                LAS int* itm = (LAS int*)(lds + 147456 - 64);
                const int tid = tid_fresh();
                for (;;) {
                    __syncthreads();
                    if (tid == 0) itm[0] = (int)atomicAdd(ctr, 1u);
                    __syncthreads();
                    const int it = itm[0];
                    constexpr int NPQ = GB * 4 / 8;
                    if (it >= 4 * NPQ + NPQ * 16) break;
                    float* OBWD = (float*)(ws + WS_OBWD);
                    if (it < 2 * NPQ) { const int p = (it >> 1) * 8 + xq; unsigned* dn = (unsigned*)(ws + WS_CTL) + 40960 + (((grp * DEPTH + l) * GB * 4 + p) * 2);
                        scan_item<64, true>(lds, PROJ, OFWD, OBWD, OCAT, dn, p >> 2, p & 3, it & 1, ctlf + 2048 + l * 512, pv + 8704 + l * 64, nullptr, nullptr);
                    } else if (it < 4 * NPQ) { const int i2 = it - 2 * NPQ; const int p = (i2 >> 1) * 8 + xq; unsigned* dn = (unsigned*)(ws + WS_CTL) + 40960 + (((grp * DEPTH + l) * GB * 4 + p) * 2 + 1);
                        scan_item<32, false>(lds, PROJ, OFWD, OBWD, OCAT, dn, p >> 2, p & 3, i2 & 1, nullptr, pv + 26368 + l * 64, pv + 8960 + l * 4096, pv + 25344 + l * 256);
                    } else { const int u = it - 4 * NPQ, p = (u >> 4) * 8 + xq;
                        attn_unit(lds, PROJ, OCAT, p >> 2, p & 3, u & 15, lam, laminit, pv + 8192 + l * 128);
                    }
                }
            }
            GRID_SYNC();
            { uchar* ws = KWS(); pg8::Gemm g{(const bf16_t*)(ws + WS_OCAT), (const bf16_t*)(ws + WS_WUP) + (size_t)l * D * D, D}; pg8::Order S; S.init(TG, D, D, gridDim.x, blockIdx.x, 3); pg8::EpiMerge E{(const bf16_t*)(ws + WS_PROJ), (bf16_t*)(ws + WS_HB)};
#ifndef NO_EPIMERGE
              pg8::gemm_phase<pg8::EpiMerge>(lds, g, S, E);
#endif
            }
            GRID_SYNC();
            { uchar* ws = KWS(); pg8::Gemm g{(const bf16_t*)(ws + WS_HB), (const bf16_t*)(ws + WS_WOUT) + (size_t)l * D * D, D}; pg8::Order S; S.init(TG, D, D, gridDim.x, blockIdx.x, 1);
              float* xg = (float*)karg(P_OUT) + (size_t)grp * TG * D;
              pg8::EpiRes E{l == 0 ? KF(P_X) + (size_t)grp * TG * D : xg, xg, (const float*)(ws + WS_MOD) + ((size_t)l * 32 + grp * GB) * (NMOD * D) + 2 * D};
#ifndef NO_EPIRES
              pg8::gemm_phase<pg8::EpiRes>(lds, g, S, E);
#endif
            }
            GRID_SYNC();
            {
                uchar* ws = KWS(); const float* pv = (const float*)(ws + WS_CTL) + 8192;
                norm_rows_mod((const float*)karg(P_OUT) + (size_t)grp * TG * D, (bf16_t*)(ws + WS_HB), pv + 4096 + l * D, (const float*)(ws + WS_MOD) + (size_t)l * 32 * (NMOD * D), grp * TG, 3 * D, 4 * D);
            }
            GRID_SYNC();
            { uchar* ws = KWS(); pg8::Gemm g{(const bf16_t*)(ws + WS_HB), (const bf16_t*)(ws + WS_W1) + (size_t)l * DFF * D, D}; pg8::Order S; S.init(TG, DFF, D, gridDim.x, blockIdx.x, 1); pg8::EpiRelu2 E{(bf16_t*)(ws + WS_U)};
#ifndef NO_EPIRELU2
              pg8::gemm_phase<pg8::EpiRelu2>(lds, g, S, E);
#endif
            }
            GRID_SYNC();
            { uchar* ws = KWS(); pg8::Gemm g{(const bf16_t*)(ws + WS_U), (const bf16_t*)(ws + WS_W2) + (size_t)l * D * DFF, DFF}; pg8::Order S; S.init(TG, D, DFF, gridDim.x, blockIdx.x, 1);
              float* xg = (float*)karg(P_OUT) + (size_t)grp * TG * D;
              pg8::EpiRes E{xg, xg, (const float*)(ws + WS_MOD) + ((size_t)l * 32 + grp * GB) * (NMOD * D) + 5 * D};
#ifndef NO_EPIRES
              pg8::gemm_phase<pg8::EpiRes>(lds, g, S, E);
#endif
            }
            GRID_SYNC();
        }
        norm_rows_final((float*)karg(P_OUT) + (size_t)grp * TG * D, (const float*)(KWS() + WS_CTL) + 8192 + 26624);
    }
}

extern "C" void kernel_launch(void* const* d_in, const int* in_sizes, int n_in, void* d_out, int out_size, void* d_ws, size_t ws_size, hipStream_t stream) {
    static int grid = 0;
    if (grid == 0) {
        if (n_in != 21 || ws_size < WS_END) { fprintf(stderr, "kernel_launch: unexpected n_in %d / ws %zu\n", n_in, ws_size); grid = -1; return; }
        int dev = 0, cus = 0, per_cu = 0;
        if (hipGetDevice(&dev) != hipSuccess || hipDeviceGetAttribute(&cus, hipDeviceAttributeMultiprocessorCount, dev) != hipSuccess) { grid = -1; return; }
        if (hipFuncSetAttribute((const void*)fwd_megakernel, hipFuncAttributeMaxDynamicSharedMemorySize, LDS_BYTES) != hipSuccess) { fprintf(stderr, "kernel_launch: hipFuncSetAttribute failed\n"); grid = -1; return; }
        if (hipOccupancyMaxActiveBlocksPerMultiprocessor(&per_cu, (const void*)fwd_megakernel, 512, LDS_BYTES) != hipSuccess || per_cu < 1) { fprintf(stderr, "kernel_launch: occupancy query says %d\n", per_cu); per_cu = 1; }
        (void)hipGetLastError();
        grid = cus;
    }
    if (grid < 0) return;
    Args a{};
    for (int i = 0; i < 21; ++i) a.p[i] = d_in[i];
    a.p[21] = d_out; a.p[22] = d_ws; a.p[23] = nullptr;
    void* args[] = {&a};
    hipError_t e = hipLaunchCooperativeKernel((void*)fwd_megakernel, dim3(grid), dim3(512), args, LDS_BYTES, stream);
    if (e != hipSuccess) fprintf(stderr, "kernel_launch: cooperative launch failed: %s (grid %d)\n", hipGetErrorString(e), grid);
}
```

```cpp
#include <hip/hip_runtime.h>
#include <hip/hip_cooperative_groups.h>
#include <cstdio>
#include <cstdint>
namespace cg = cooperative_groups;

#define LAS __attribute__((address_space(3)))
typedef unsigned short bf16_t;
typedef short bf16x8 __attribute__((ext_vector_type(8)));
typedef float f32x4 __attribute__((ext_vector_type(4)));
typedef float f32x2 __attribute__((ext_vector_type(2)));
typedef float f32x16 __attribute__((ext_vector_type(16)));
typedef unsigned u32x4 __attribute__((ext_vector_type(4)));
typedef short s16x4 __attribute__((ext_vector_type(4)));
typedef unsigned char uchar;

constexpr int D = 1024, SEQ = 2048, BATCH = 32, DEPTH = 4, DIN = 6688, LDP = 6912, DFF = 4096, NMOD = 6;
constexpr int GB = 16, TG = GB * SEQ, NGRP = BATCH / GB;
constexpr int CQ = 0, CK = 512, CV = 1024, BQ = 1536, BFF = 1792, BFB = 2048, BI = 2304, BG = 2560;
constexpr int GQ = 2816, GK = 2944, GV = 3072, GG = 3328, GLF = 3584, GLB = 3600, GATE = 3616;
constexpr float EPS = 1e-6f, LOG2E = 1.4426950408889634f;
constexpr float QSCALE = 0.125f * LOG2E;

constexpr size_t MiB = 1u << 20;
constexpr size_t WS_CTL = 0;
constexpr size_t WS_MOD = 1 * MiB;
constexpr size_t WS_WIN = 4 * MiB;
constexpr size_t WS_WUP = 58 * MiB;
constexpr size_t WS_WOUT = 66 * MiB;
constexpr size_t WS_W1 = 74 * MiB;
constexpr size_t WS_W2 = 106 * MiB;
constexpr size_t WS_HB = 138 * MiB;
constexpr size_t WS_OCAT = 202 * MiB;
constexpr size_t WS_OFWD = 266 * MiB;
constexpr size_t WS_PROJ = 330 * MiB;
constexpr size_t WS_U = WS_PROJ;
constexpr size_t WS_OBWD = 762 * MiB;
constexpr size_t WS_END = 826 * MiB;
constexpr int LDS_BYTES = 148 * 1024;

__device__ __forceinline__ unsigned f2bf(float f) { unsigned u = __builtin_bit_cast(unsigned, f); return (u + 0x7fffu + ((u >> 16) & 1u)) >> 16; }
__device__ __forceinline__ unsigned pk2(float lo, float hi) { return f2bf(lo) | (f2bf(hi) << 16); }
__device__ __forceinline__ float bf2f(bf16_t v) { return __builtin_bit_cast(float, (unsigned)v << 16); }
__device__ __forceinline__ float bflo(unsigned u) { return __builtin_bit_cast(float, u << 16); }
__device__ __forceinline__ float bfhi(unsigned u) { return __builtin_bit_cast(float, u & 0xffff0000u); }
typedef __bf16 bf16x2_t __attribute__((ext_vector_type(2)));
__device__ __forceinline__ unsigned cvt_pk_bf16(float lo, float hi) { f32x2 v = {lo, hi}; bf16x2_t b = __builtin_convertvector(v, bf16x2_t); return __builtin_bit_cast(unsigned, b); }
__device__ __forceinline__ float wave_sum(float v) {
#pragma unroll
    for (int o = 1; o < 64; o <<= 1) v += __shfl_xor(v, o);
    return v;
}
__device__ __forceinline__ int tid_fresh() { int t = threadIdx.x; asm volatile("" : "+v"(t)); return t; }
__device__ __forceinline__ float sigmoidf_(float z) { return 1.f / (1.f + __expf(-z)); }

namespace pg8 {
constexpr int BM = 256, BK = 64, HALF = 128, HTB = HALF * BK * 2, STAGE_BYTES = 8 * HTB, NXCD = 8, WGM = 8;
__host__ __device__ __forceinline__ int lds_byte(int r, int c) { const int st = (r >> 4) * 2 + (c >> 5), rr = r & 15, cc = c & 31, ob = rr * 64 + cc * 2; return st * 1024 + (ob ^ (((ob >> 9) & 1) << 5)); }
__host__ __device__ __forceinline__ void stage_rc(int b, int& R, int& C) { const int st = b / 1024, sb = b % 1024, swz = sb ^ (((sb >> 9) & 1) << 5); R = (st >> 1) * 16 + swz / 64; C = (st & 1) * 32 + (swz % 64) / 2; }
__host__ __device__ __forceinline__ int perm32(int rho) { const int n = rho >> 4, i = rho & 15; return 8 * (i >> 2) + 4 * n + (i & 3); }

struct Unit { int pm, pn, koff, nt, seg; };
struct Gemm { const bf16_t* A; const bf16_t* Bt; int K; };

struct Order {
    int nM, nN, nwg, G, c, nseg, ntfull;
    __device__ void init(int M, int N, int K, int G_, int c_, int nseg_) { nM = M / BM; nN = N / BM; nwg = nM * nN; G = G_; c = c_; nseg = nseg_; ntfull = K / BK; }
    __device__ bool next(int i, Unit& u) const {
        int ti = i, seg = 0;
        if (nseg == 3) { ti = i / 3; seg = i - ti * 3; }
        const long L = (long)ti * G + c; if (L >= nwg) return false;
        int wgid = (int)L; { const int q = nwg / NXCD, r = nwg % NXCD, xcd = wgid % NXCD, off = wgid / NXCD; wgid = (xcd < r ? xcd * (q + 1) : r * (q + 1) + (xcd - r) * q) + off; }
        const int nig = WGM * nN, gid = wgid / nig, fm = gid * WGM, gsz = (nM - fm) < WGM ? (nM - fm) : WGM;
        u.pm = fm + ((wgid % nig) % gsz); u.pn = (wgid % nig) / gsz; u.seg = seg;
        if (nseg == 3) { u.koff = seg == 0 ? 0 : (seg == 1 ? 512 : 768); u.nt = seg == 0 ? 8 : 4; } else { u.koff = 0; u.nt = ntfull; }
        return true;
    }
};

struct EpiProj {
    bf16_t* O;
    __device__ __forceinline__ bool zero_after(const Unit&) const { return true; }
    __device__ __forceinline__ void operator()(f32x4 (&acc)[2][2][4][2], const Unit& u, int wr, int wc, int fr, int fq) const {
        const int row0 = u.pm * BM + wr * 64 + fr, col0 = u.pn * BM + wc * 32 + 8 * fq;
        const float sc = (u.pn < 2) ? QSCALE : 1.f;
#pragma unroll
        for (int ai = 0; ai < 2; ++ai)
#pragma unroll
            for (int m = 0; m < 4; ++m) { bf16_t* rowp = O + (size_t)(row0 + ai * HALF + m * 16) * LDP + col0;
#pragma unroll
                for (int bj = 0; bj < 2; ++bj) { f32x4 v0 = acc[ai][bj][m][0] * sc, v1 = acc[ai][bj][m][1] * sc;
                    u32x4 w; w.x = cvt_pk_bf16(v0[0], v0[1]); w.y = cvt_pk_bf16(v0[2], v0[3]); w.z = cvt_pk_bf16(v1[0], v1[1]); w.w = cvt_pk_bf16(v1[2], v1[3]);
                    *(u32x4*)(rowp + bj * HALF) = w; } }
    }
};
struct EpiRelu2 {
    bf16_t* O;
    __device__ __forceinline__ bool zero_after(const Unit&) const { return true; }
    __device__ __forceinline__ void operator()(f32x4 (&acc)[2][2][4][2], const Unit& u, int wr, int wc, int fr, int fq) const {
        const int row0 = u.pm * BM + wr * 64 + fr, col0 = u.pn * BM + wc * 32 + 8 * fq;
#pragma unroll
        for (int ai = 0; ai < 2; ++ai)
#pragma unroll
            for (int m = 0; m < 4; ++m) { bf16_t* rowp = O + (size_t)(row0 + ai * HALF + m * 16) * DFF + col0;
#pragma unroll
                for (int bj = 0; bj < 2; ++bj) { f32x4 v0 = acc[ai][bj][m][0], v1 = acc[ai][bj][m][1];
#pragma unroll
                    for (int j = 0; j < 4; ++j) { float a = fmaxf(v0[j], 0.f), b = fmaxf(v1[j], 0.f); v0[j] = a * a; v1[j] = b * b; }
                    u32x4 w; w.x = cvt_pk_bf16(v0[0], v0[1]); w.y = cvt_pk_bf16(v0[2], v0[3]); w.z = cvt_pk_bf16(v1[0], v1[1]); w.w = cvt_pk_bf16(v1[2], v1[3]);
                    *(u32x4*)(rowp + bj * HALF) = w; } }
    }
};
struct EpiRes {
    const float* base; float* out; const float* gate;
    __device__ __forceinline__ bool zero_after(const Unit&) const { return true; }
    __device__ __forceinline__ void operator()(f32x4 (&acc)[2][2][4][2], const Unit& u, int wr, int wc, int fr, int fq) const {
        const int row0 = u.pm * BM + wr * 64 + fr, col0 = u.pn * BM + wc * 32 + 8 * fq;
        const float* gp = gate + (size_t)((u.pm * BM) >> 11) * (NMOD * D) + col0;
#pragma unroll
        for (int bj = 0; bj < 2; ++bj) {
            const f32x4 g0 = *(const f32x4*)(gp + bj * HALF), g1 = *(const f32x4*)(gp + bj * HALF + 4);
#pragma unroll
            for (int ai = 0; ai < 2; ++ai) {
#pragma unroll
                for (int m = 0; m < 4; ++m) { const size_t off = (size_t)(row0 + ai * HALF + m * 16) * D + col0 + bj * HALF;
                    const f32x4 b0 = *(const f32x4*)(base + off), b1 = *(const f32x4*)(base + off + 4);
                    *(f32x4*)(out + off) = b0 + g0 * acc[ai][bj][m][0];
                    *(f32x4*)(out + off + 4) = b1 + g1 * acc[ai][bj][m][1];
                    if (m & 1) asm volatile("" ::: "memory"); }
            }
        }
    }
};
struct EpiMerge {
    const bf16_t* proj; bf16_t* O;
    __device__ __forceinline__ bool zero_after(const Unit& u) const { return u.seg == 2; }
    __device__ __forceinline__ void operator()(f32x4 (&acc)[2][2][4][2], const Unit& u, int wr, int wc, int fr, int fq) const {
        const int row0 = u.pm * BM + wr * 64 + fr, col0 = u.pn * BM + wc * 32 + 8 * fq;
        const int seg = u.seg;
#pragma unroll
        for (int ai = 0; ai < 2; ++ai)
#pragma unroll
            for (int m = 0; m < 4; ++m) { const size_t row = (size_t)(row0 + ai * HALF + m * 16); const bf16_t* gp = proj + row * LDP + GATE + col0;
#pragma unroll
                for (int bj = 0; bj < 2; ++bj) {
                    if (seg < 2) {
                        const u32x4 ga = *(const u32x4*)(gp + seg * D + bj * HALF), gb = *(const u32x4*)(gp + (seg + 1) * D + bj * HALF);
                        float r[8];
#pragma unroll
                        for (int j = 0; j < 4; ++j) {
                            const float a0 = fminf(fmaxf(bflo(ga[j]), -40.f), 40.f), a1 = fminf(fmaxf(bfhi(ga[j]), -40.f), 40.f);
                            const float b0 = fminf(fmaxf(bflo(gb[j]), -40.f), 40.f), b1 = fminf(fmaxf(bfhi(gb[j]), -40.f), 40.f);
                            r[2 * j] = (1.f + __expf(-b0)) * __builtin_amdgcn_rcpf(1.f + __expf(-a0));
                            r[2 * j + 1] = (1.f + __expf(-b1)) * __builtin_amdgcn_rcpf(1.f + __expf(-a1)); }
                        acc[ai][bj][m][0] = acc[ai][bj][m][0] * (f32x4){r[0], r[1], r[2], r[3]};
                        acc[ai][bj][m][1] = acc[ai][bj][m][1] * (f32x4){r[4], r[5], r[6], r[7]};
                    } else {
                        const u32x4 gc = *(const u32x4*)(gp + 2 * D + bj * HALF);
                        float r[8];
#pragma unroll
                        for (int j = 0; j < 4; ++j) {
                            const float c0 = fminf(fmaxf(bflo(gc[j]), -40.f), 40.f), c1 = fminf(fmaxf(bfhi(gc[j]), -40.f), 40.f);
                            r[2 * j] = __builtin_amdgcn_rcpf(1.f + __expf(-c0)); r[2 * j + 1] = __builtin_amdgcn_rcpf(1.f + __expf(-c1)); }
                        const f32x4 v0 = acc[ai][bj][m][0] * (f32x4){r[0], r[1], r[2], r[3]}, v1 = acc[ai][bj][m][1] * (f32x4){r[4], r[5], r[6], r[7]};
                        u32x4 w; w.x = cvt_pk_bf16(v0[0], v0[1]); w.y = cvt_pk_bf16(v0[2], v0[3]); w.z = cvt_pk_bf16(v1[0], v1[1]); w.w = cvt_pk_bf16(v1[2], v1[3]);
                        *(u32x4*)(O + row * D + col0 + bj * HALF) = w;
                    } } }
    }
};

template <class Epi, bool ALIGN_EPI = true>
__device__ __forceinline__ void gemm_phase(LAS uchar* lds, const Gemm g, const Order& S, const Epi& E) {
    const int tid = tid_fresh(), wid = __builtin_amdgcn_readfirstlane(tid >> 6), lane = tid & 63, wr = wid >> 2, wc = wid & 3, fr = lane & 15, fq = lane >> 4;
    const int K = g.K;
    unsigned voffA[2], voffB[2];
#pragma unroll
    for (int i = 0; i < 2; ++i) { int R, C; stage_rc(tid * 16 + i * 8192, R, C); const int Rb = (R & ~31) + perm32(R & 31);
        voffA[i] = (unsigned)(R * K + C) * 2u; voffB[i] = (unsigned)(Rb * K + C) * 2u; }
    const size_t kstep = (size_t)(BK * 2);
    const size_t hstep = (size_t)HALF * K * 2;
    const size_t tstep = 2 * hstep;
    const unsigned ldsw = (unsigned)wid * 1024u;
    const int aoff = lds_byte(wr * 64 + fr, fq * 8), boff = lds_byte(wc * 32 + fr, fq * 8);
#define PG8_SA(b, h) (((b) * 2 + (h)) * HTB)
#define PG8_SB(b, h) ((4 + (b) * 2 + (h)) * HTB)
#define PG8_STAGE(bufoff, gbase, voff) do { _Pragma("unroll") for (int _i = 0; _i < 2; ++_i) \
        __builtin_amdgcn_global_load_lds((const unsigned*)((const char*)(gbase) + (voff)[_i]), (LAS unsigned*)(lds + (bufoff) + ldsw + _i * 8192), 16, 0, 0); } while (0)
#define PG8_LDA(dst, b, h) do { _Pragma("unroll") for (int m = 0; m < 4; ++m) _Pragma("unroll") for (int k = 0; k < 2; ++k) dst[m][k] = *(const LAS bf16x8*)(lds + PG8_SA(b, h) + aoff + m * 2048 + k * 1024); } while (0)
#define PG8_LDB(dst, b, h) do { _Pragma("unroll") for (int n = 0; n < 2; ++n) _Pragma("unroll") for (int k = 0; k < 2; ++k) dst[n][k] = *(const LAS bf16x8*)(lds + PG8_SB(b, h) + boff + n * 2048 + k * 1024); } while (0)
#define PG8_MMA(ai, bj, At, Bt) do { __builtin_amdgcn_s_setprio(1); _Pragma("unroll") for (int m = 0; m < 4; ++m) _Pragma("unroll") for (int n = 0; n < 2; ++n) _Pragma("unroll") for (int k = 0; k < 2; ++k) \
        acc[ai][bj][m][n] = __builtin_amdgcn_mfma_f32_16x16x32_bf16(Bt[n][k], At[m][k], acc[ai][bj][m][n], 0, 0, 0); __builtin_amdgcn_s_setprio(0); } while (0)
#define PG8_WAIT_V(n) asm volatile("s_waitcnt vmcnt(" #n ")" ::: "memory")
#define PG8_WAIT_L(n) asm volatile("s_waitcnt lgkmcnt(" #n ")" ::: "memory")
#define PG8_BAR __builtin_amdgcn_s_barrier()
#define PG8_SCHED __builtin_amdgcn_sched_barrier(0)
    Unit cur, nxt; int ui = 0;
    if (!S.next(0, cur)) return;
    f32x4 acc[2][2][4][2];
#pragma unroll
    for (int a = 0; a < 2; ++a)
#pragma unroll
        for (int b = 0; b < 2; ++b)
#pragma unroll
            for (int m = 0; m < 4; ++m)
#pragma unroll
                for (int n = 0; n < 2; ++n) acc[a][b][m][n] = (f32x4){0.f, 0.f, 0.f, 0.f};
    bf16x8 At[4][2], B0[2][2], B1[2][2];
    const char* cA = (const char*)g.A + (size_t)cur.pm * tstep + (size_t)cur.koff * 2; const char* cB = (const char*)g.Bt + (size_t)cur.pn * tstep + (size_t)cur.koff * 2;
    PG8_STAGE(PG8_SB(0, 0), cB, voffB); PG8_STAGE(PG8_SB(0, 1), cB + hstep, voffB); PG8_STAGE(PG8_SA(0, 0), cA, voffA); PG8_STAGE(PG8_SA(0, 1), cA + hstep, voffA);
    if (wr == 1) PG8_BAR;
    PG8_WAIT_V(2); PG8_BAR;
    PG8_STAGE(PG8_SB(1, 0), cB + kstep, voffB); PG8_STAGE(PG8_SA(1, 0), cA + kstep, voffA); PG8_STAGE(PG8_SB(1, 1), cB + hstep + kstep, voffB);
    PG8_WAIT_V(6); PG8_BAR;
    for (;;) {
        const bool has_next = S.next(ui + 1, nxt);
        const char* nA = has_next ? (const char*)g.A + (size_t)nxt.pm * tstep + (size_t)nxt.koff * 2 : cA; const char* nB = has_next ? (const char*)g.Bt + (size_t)nxt.pn * tstep + (size_t)nxt.koff * 2 : cB;
        const int nt = cur.nt;
        for (int t = 0; t < nt; t += 2) {
            const bool last = (t == nt - 2);
            const char* a1 = cA + (size_t)(t + 1) * kstep;
            const char* a2 = last ? nA : cA + (size_t)(t + 2) * kstep; const char* b2 = last ? nB : cB + (size_t)(t + 2) * kstep;
            const char* a3 = a2 + kstep; const char* b3 = b2 + kstep;
            PG8_LDB(B0, 0, 0); PG8_LDB(B1, 0, 1); PG8_SCHED; PG8_LDA(At, 0, 0); PG8_STAGE(PG8_SA(1, 1), a1 + hstep, voffA);
            PG8_WAIT_V(8); PG8_WAIT_L(0); PG8_BAR; PG8_MMA(0, 0, At, B0); PG8_MMA(0, 1, At, B1); PG8_BAR; PG8_SCHED;
            PG8_LDA(At, 0, 1); PG8_STAGE(PG8_SB(0, 0), b2, voffB); PG8_STAGE(PG8_SB(0, 1), b2 + hstep, voffB); PG8_STAGE(PG8_SA(0, 0), a2, voffA);
            PG8_WAIT_V(8); PG8_WAIT_L(0); PG8_BAR; PG8_MMA(1, 0, At, B0); PG8_MMA(1, 1, At, B1); PG8_BAR; PG8_SCHED;
            PG8_LDB(B0, 1, 0); PG8_LDB(B1, 1, 1); PG8_SCHED; PG8_LDA(At, 1, 0); PG8_STAGE(PG8_SA(0, 1), a2 + hstep, voffA);
            PG8_WAIT_V(8); PG8_WAIT_L(0); PG8_BAR; PG8_MMA(0, 0, At, B0); PG8_MMA(0, 1, At, B1); PG8_BAR; PG8_SCHED;
            PG8_LDA(At, 1, 1); PG8_STAGE(PG8_SB(1, 0), b3, voffB); PG8_STAGE(PG8_SB(1, 1), b3 + hstep, voffB); PG8_STAGE(PG8_SA(1, 0), a3, voffA);
            PG8_WAIT_V(8); PG8_WAIT_L(0); PG8_BAR; PG8_MMA(1, 0, At, B0); PG8_MMA(1, 1, At, B1); PG8_BAR; PG8_SCHED;
        }
        if constexpr (ALIGN_EPI) { if (wr == 0) PG8_BAR; }
        E(acc, cur, wr, wc, fr, fq);
        if (!has_next) break;
        if (E.zero_after(cur)) {
#pragma unroll
            for (int a = 0; a < 2; ++a)
#pragma unroll
                for (int b = 0; b < 2; ++b)
#pragma unroll
                    for (int m = 0; m < 4; ++m)
#pragma unroll
                        for (int n = 0; n < 2; ++n) acc[a][b][m][n] = (f32x4){0.f, 0.f, 0.f, 0.f};
        }
        cur = nxt; cA = nA; cB = nB; ++ui;
        if constexpr (ALIGN_EPI) { if (wr == 1) PG8_BAR; }
    }
    PG8_WAIT_V(0);
    if constexpr (!ALIGN_EPI) { if (wr == 0) PG8_BAR; }
    PG8_BAR;
#undef PG8_SA
#undef PG8_SB
#undef PG8_STAGE
#undef PG8_LDA
#undef PG8_LDB
#undef PG8_MMA
#undef PG8_WAIT_V
#undef PG8_WAIT_L
#undef PG8_BAR
#undef PG8_SCHED
}
}

__device__ __forceinline__ int crow(int r, int hi) { return (r & 3) + 8 * (r >> 2) + 4 * hi; }
__device__ __forceinline__ s16x4 vtr(const LAS uchar* p) { return __builtin_bit_cast(s16x4, __builtin_amdgcn_ds_read_tr16_b64_v4i16((LAS s16x4*)p)); }
__device__ __forceinline__ float xhalf_max(float m) { auto rr = __builtin_amdgcn_permlane32_swap(__builtin_bit_cast(unsigned, m), __builtin_bit_cast(unsigned, m), false, false); return fmaxf(__builtin_bit_cast(float, rr[0]), __builtin_bit_cast(float, rr[1])); }
__device__ __forceinline__ float xhalf_sum(float m) { auto rr = __builtin_amdgcn_permlane32_swap(__builtin_bit_cast(unsigned, m), __builtin_bit_cast(unsigned, m), false, false); return __builtin_bit_cast(float, rr[0]) + __builtin_bit_cast(float, rr[1]); }

__device__ __forceinline__ void glds16(const void* gsrc, unsigned lds_dst) { unsigned keep;
    asm volatile("s_mov_b32 %0, m0\n\ts_mov_b32 m0, %2\n\ts_nop 0\n\tglobal_load_lds_dwordx4 %1, off\n\ts_mov_b32 m0, %0" : "=&s"(keep) : "v"(gsrc), "s"(lds_dst) : "memory"); }
constexpr int ATT_SLOT = 32768, ATT_WSF = 98304;
__device__ __forceinline__ void attn_unit(LAS uchar* lds, const bf16_t* proj, bf16_t* ocat, int bl, int h, int qb, float lam, float laminit, const float* sg) {
    const int tid = tid_fresh(), lane = tid & 63, r32 = lane & 31, hi = lane >> 5;
    const int wave = __builtin_amdgcn_readfirstlane(tid >> 6), mi = wave >> 2, rb = wave & 3;
    const size_t rowbase = (size_t)bl * SEQ;
    const int q0 = qb * 128 + rb * 32;
    const float m2 = exp2f(-2.f * (float)(h + 1)) * LOG2E;
    bf16x8 qf[4];
    { const bf16_t* qp = proj + (rowbase + q0 + r32) * LDP + CQ + h * 128 + mi * 64 + hi * 8;
#pragma unroll
      for (int d0 = 0; d0 < 4; ++d0) qf[d0] = *(const bf16x8*)(qp + d0 * 16); }
    const bf16_t* ksrc0 = proj + (rowbase + lane) * LDP + CK + h * 128 + wave * 8;
    const bf16_t* ksrc1 = ksrc0 + 64;
    const bf16_t* vsrc0 = proj + (rowbase + 16 * (wave & 3) + (lane >> 2)) * LDP + CV + h * 128 + (wave >> 2) * 32 + (lane & 3) * 8;
    const bf16_t* vsrc1 = vsrc0 + 64;
    const unsigned lds0 = (unsigned)(uintptr_t)lds + (unsigned)wave * 1024u;
#define ATT_ISSUE(t, sb) do { const size_t go_ = (size_t)(t) * 64 * LDP; const unsigned d_ = (unsigned)__builtin_amdgcn_readfirstlane((int)(lds0 + (unsigned)(sb))); \
        glds16(ksrc0 + go_, d_); glds16(ksrc1 + go_, d_ + 8192u); glds16(vsrc0 + go_, d_ + 16384u); glds16(vsrc1 + go_, d_ + 24576u); } while (0)
    LAS float* wsf = (LAS float*)(lds + ATT_WSF) + wave * 64;
    f32x16 o[4];
#pragma unroll
    for (int d = 0; d < 4; ++d)
#pragma unroll
        for (int r = 0; r < 16; ++r) o[d][r] = 0.f;
    float mhat = 0.f;
    f32x16 ol;
#pragma unroll
    for (int r = 0; r < 16; ++r) ol[r] = 0.f;
    const bf16x8 ones = (bf16x8){0x3F80, 0x3F80, 0x3F80, 0x3F80, 0x3F80, 0x3F80, 0x3F80, 0x3F80};
    const int kfo = (mi * 8 + hi) * 1024 + r32 * 16;
    const int vfo = 16384 + ((lane >> 4) & 1) * 32 + (lane & 3) * 8 + (4 * hi + ((lane & 15) >> 2)) * 64;
    ATT_ISSUE(0, 0); ATT_ISSUE(1, ATT_SLOT);
    int slot_c = 0, slot_n = 2 * ATT_SLOT;
    for (int t = 0; t < SEQ / 64; ++t) {
        if (t + 1 < SEQ / 64) asm volatile("s_waitcnt vmcnt(4) lgkmcnt(0)" ::: "memory"); else asm volatile("s_waitcnt vmcnt(0) lgkmcnt(0)" ::: "memory");
        __builtin_amdgcn_s_barrier();
        asm volatile("" ::: "memory");
        if (t + 2 < SEQ / 64) ATT_ISSUE(t + 2, slot_n);
        const LAS uchar* sl = lds + slot_c;
        { const int nx = slot_c + ATT_SLOT; slot_n = slot_c; slot_c = (nx == 3 * ATT_SLOT) ? 0 : nx; }
        const float dq = (float)(q0 + r32 - 64 * t - 4 * hi);
        f32x16 p0, p1;
#pragma unroll
        for (int r = 0; r < 16; ++r) { const float kc = (float)((r & 3) + 8 * (r >> 2));
            p0[r] = __builtin_fmaf(-m2, __builtin_fabsf(dq - kc), -mhat); p1[r] = __builtin_fmaf(-m2, __builtin_fabsf(dq - kc - 32.f), -mhat); }
#pragma unroll
        for (int d0 = 0; d0 < 4; ++d0) {
            const bf16x8 a0 = *(const LAS bf16x8*)(sl + kfo + d0 * 2048), a1 = *(const LAS bf16x8*)(sl + kfo + d0 * 2048 + 512);
            p0 = __builtin_amdgcn_mfma_f32_32x32x16_bf16(a0, qf[d0], p0, 0, 0, 0);
            p1 = __builtin_amdgcn_mfma_f32_32x32x16_bf16(a1, qf[d0], p1, 0, 0, 0); }
        float rm = fmaxf(p0[0], p1[0]);
#pragma unroll
        for (int r = 1; r < 16; ++r) rm = fmaxf(rm, fmaxf(p0[r], p1[r]));
        rm = xhalf_max(rm);
        const bool first = (t == 0);
        if (first || __any(rm > 8.f)) {
            const float dl = first ? rm : fmaxf(rm, 0.f);
            mhat += dl;
#pragma unroll
            for (int r = 0; r < 16; ++r) { p0[r] -= dl; p1[r] -= dl; }
            if (!first) {
                const float f = __builtin_amdgcn_exp2f(-dl);
                if (hi == 0) wsf[r32] = f;
                float fr_[16];
#pragma unroll
                for (int r = 0; r < 16; ++r) fr_[r] = wsf[crow(r, hi)];
#pragma unroll
                for (int d = 0; d < 4; ++d)
#pragma unroll
                    for (int r = 0; r < 16; ++r) o[d][r] *= fr_[r];
#pragma unroll
                for (int r = 0; r < 16; ++r) ol[r] *= fr_[r];
            }
        }
#pragma unroll
        for (int r = 0; r < 16; ++r) { p0[r] = __builtin_amdgcn_exp2f(p0[r]); p1[r] = __builtin_amdgcn_exp2f(p1[r]); }
        u32x4 pw[4];
#pragma unroll
        for (int j = 0; j < 4; ++j) { pw[0][j] = cvt_pk_bf16(p0[2 * j], p0[2 * j + 1]); pw[1][j] = cvt_pk_bf16(p0[8 + 2 * j], p0[8 + 2 * j + 1]);
                                      pw[2][j] = cvt_pk_bf16(p1[2 * j], p1[2 * j + 1]); pw[3][j] = cvt_pk_bf16(p1[8 + 2 * j], p1[8 + 2 * j + 1]); }
#pragma unroll
        for (int d = 0; d < 4; ++d)
#pragma unroll
            for (int ks = 0; ks < 4; ++ks) {
                const s16x4 lo = vtr(sl + vfo + d * 4096 + ks * 1024), hh = vtr(sl + vfo + d * 4096 + ks * 1024 + 512);
                const bf16x8 vf = (bf16x8){lo[0], lo[1], lo[2], lo[3], hh[0], hh[1], hh[2], hh[3]};
                o[d] = __builtin_amdgcn_mfma_f32_32x32x16_bf16(__builtin_bit_cast(bf16x8, pw[ks]), vf, o[d], 0, 0, 0); }
#pragma unroll
        for (int ks = 0; ks < 4; ++ks) ol = __builtin_amdgcn_mfma_f32_32x32x16_bf16(__builtin_bit_cast(bf16x8, pw[ks]), ones, ol, 0, 0, 0);
    }
#undef ATT_ISSUE
    float fr_[16];
#pragma unroll
    for (int r = 0; r < 16; ++r) fr_[r] = (mi == 0 ? 1.f : lam) / ol[r];
    __syncthreads();
    LAS float* X = (LAS float*)lds + rb * 4096;
    if (mi == 1) {
#pragma unroll
        for (int d = 0; d < 4; ++d)
#pragma unroll
            for (int r = 0; r < 16; ++r) X[(d * 16 + r) * 64 + lane] = o[d][r] * fr_[r];
    }
    __syncthreads();
    if (mi == 0) {
        float ss[16];
#pragma unroll
        for (int r = 0; r < 16; ++r) ss[r] = 0.f;
#pragma unroll
        for (int d = 0; d < 4; ++d)
#pragma unroll
            for (int r = 0; r < 16; ++r) { const float v = o[d][r] * fr_[r] - X[(d * 16 + r) * 64 + lane]; o[d][r] = v; ss[r] += v * v; }
#pragma unroll
        for (int r = 0; r < 16; ++r) {
#pragma unroll
            for (int s = 1; s < 32; s <<= 1) ss[r] += __shfl_xor(ss[r], s);
            ss[r] = rsqrtf(ss[r] * (1.f / 128.f) + EPS) * (1.f - laminit); }
        float gv[4];
#pragma unroll
        for (int d = 0; d < 4; ++d) gv[d] = sg[d * 32 + r32];
#pragma unroll
        for (int r = 0; r < 16; ++r) { bf16_t* op = ocat + (rowbase + q0 + crow(r, hi)) * D + h * 128 + r32;
#pragma unroll
            for (int d = 0; d < 4; ++d) op[d * 32] = (bf16_t)f2bf(o[d][r] * ss[r] * gv[d]); }
    }
    __syncthreads();
}

template <int DK, bool HG>
__device__ __forceinline__ void scan_item(LAS uchar* lds, const bf16_t* proj, float* oraw0, float* oraw1, bf16_t* ocat, unsigned* done, int bl, int h, int dir, const float* lb  ,
                                          const float* normg  , const float* w2  , const float* gbias  ) {
    constexpr int KPW = DK / 8, TB = 32, NS = TB / 16, NR = TB / 8, GS = 4;
    LAS float* sA = (LAS float*)lds;
    LAS float* sK = sA + TB * DK;
    LAS float* sQ = sK + TB * DK;
    LAS float* sV = sQ + TB * DK;
    LAS float* sP = sV + TB * 64;
    const int tid = tid_fresh(), lane = tid & 63, wave = __builtin_amdgcn_readfirstlane(tid >> 6);
    const int ps = tid >> 5, pi = tid & 31;
    const size_t rowbase = (size_t)bl * SEQ;
    float* oraw = dir == 0 ? oraw0 : oraw1;
    __syncthreads();
    {
        float lb0 = 0.f, lb1 = 0.f, w2c[16], bias = 0.f;
        if (HG) { lb0 = lb[dir * 256 + h * 64 + pi]; lb1 = lb[dir * 256 + h * 64 + pi + 32]; }
        else {
#pragma unroll
            for (int r = 0; r < 16; ++r) w2c[r] = w2[(dir * 16 + r) * 128 + h * 32 + pi];
            bias = gbias[dir * 128 + h * 32 + pi]; }
        f32x2 S[KPW / 2];
#pragma unroll
        for (int j = 0; j < KPW / 2; ++j) S[j] = (f32x2){0.f, 0.f};
        bf16_t rz0[NS], rz1[NS], rq0[NS], rq1[NS], rv0[NS], rv1[NS], rk0[NS]; u32x4 rl0[NS], rl1[NS];
#pragma unroll
        for (int i = 0; i < NS; ++i) { rz0[i] = rz1[i] = rq0[i] = rq1[i] = rv0[i] = rv1[i] = rk0[i] = 0; rl0[i] = rl1[i] = (u32x4){0, 0, 0, 0}; }
#define SCAN_LOAD(blk) do { _Pragma("unroll") for (int i_ = 0; i_ < NS; ++i_) { const int st_ = (blk) * TB + ps + 16 * i_; const int tok_ = dir == 0 ? st_ : 2047 - st_; const bf16_t* pr_ = proj + (rowbase + tok_) * LDP; \
        if (HG) { const int zc_ = (dir == 0 ? BFF : BFB) + h * 64 + pi; rz0[i_] = pr_[zc_]; rz1[i_] = pr_[zc_ + 32]; rq0[i_] = pr_[BQ + h * 64 + pi]; rq1[i_] = pr_[BQ + h * 64 + pi + 32]; rv0[i_] = pr_[BI + h * 64 + pi]; rv1[i_] = pr_[BI + h * 64 + pi + 32]; } \
        else { const u32x4* lp_ = (const u32x4*)(pr_ + (dir == 0 ? GLF : GLB)); rl0[i_] = lp_[0]; rl1[i_] = lp_[1]; rk0[i_] = pr_[GK + h * 32 + pi]; rq0[i_] = pr_[GQ + h * 32 + pi]; rv0[i_] = pr_[GV + h * 64 + pi]; rv1[i_] = pr_[GV + h * 64 + pi + 32]; } } } while (0)
        SCAN_LOAD(0);
        for (int blk = 0; blk < SEQ / TB; ++blk) {
#pragma unroll
            for (int i = 0; i < NS; ++i) {
                const int st = ps + 16 * i;
                if (HG) {
                    const float z0 = bf2f(rz0[i]), z1 = bf2f(rz1[i]);
                    const float s0 = __builtin_amdgcn_rcpf(1.f + __expf(-z0)), s1 = __builtin_amdgcn_rcpf(1.f + __expf(-z1));
                    sA[st * 64 + pi] = s0 * (1.f + lb0 * __expf(fminf(-z0, 80.f))); sA[st * 64 + pi + 32] = s1 * (1.f + lb1 * __expf(fminf(-z1, 80.f)));
                    sK[st * 64 + pi] = (1.f - lb0) * __builtin_amdgcn_rcpf(1.f + __expf(z0)); sK[st * 64 + pi + 32] = (1.f - lb1) * __builtin_amdgcn_rcpf(1.f + __expf(z1));
                    const float q0 = bf2f(rq0[i]), q1 = bf2f(rq1[i]);
                    sQ[st * 64 + pi] = q0 * __builtin_amdgcn_rcpf(1.f + __expf(-q0)) * 0.125f; sQ[st * 64 + pi + 32] = q1 * __builtin_amdgcn_rcpf(1.f + __expf(-q1)) * 0.125f;
                } else {
                    float z = bias;
#pragma unroll
                    for (int j = 0; j < 4; ++j) { z += bflo(rl0[i][j]) * w2c[2 * j] + bfhi(rl0[i][j]) * w2c[2 * j + 1]; z += bflo(rl1[i][j]) * w2c[8 + 2 * j] + bfhi(rl1[i][j]) * w2c[8 + 2 * j + 1]; }
                    const float ls = fminf(z, 0.f) - __logf(1.f + __expf(-fabsf(z)));
                    sA[st * 32 + pi] = __expf(ls * (1.f / 16.f));
                    sK[st * 32 + pi] = bf2f(rk0[i]);
                    sQ[st * 32 + pi] = bf2f(rq0[i]) * 0.17677669529663687f;
                }
                sV[st * 64 + pi] = bf2f(rv0[i]); sV[st * 64 + pi + 32] = bf2f(rv1[i]);
            }
            __syncthreads();
            if (blk + 1 < SEQ / TB) SCAN_LOAD(blk + 1);
            for (int s0_ = 0; s0_ < TB; s0_ += GS) {
                float vv[GS]; f32x4 a4[GS][KPW / 4], k4[GS][KPW / 4], q4[GS][KPW / 4];
#pragma unroll
                for (int g = 0; g < GS; ++g) { const int s = s0_ + g; vv[g] = sV[s * 64 + lane];
#pragma unroll
                    for (int j4 = 0; j4 < KPW / 4; ++j4) { a4[g][j4] = *(const LAS f32x4*)(sA + s * DK + wave * KPW + j4 * 4); k4[g][j4] = *(const LAS f32x4*)(sK + s * DK + wave * KPW + j4 * 4); q4[g][j4] = *(const LAS f32x4*)(sQ + s * DK + wave * KPW + j4 * 4); } }
                float po[GS];
#pragma unroll
                for (int g = 0; g < GS; ++g) {
                    f32x2 op = (f32x2){0.f, 0.f};
#pragma unroll
                    for (int j4 = 0; j4 < KPW / 4; ++j4) {
                        const f32x2 kv0 = (f32x2){k4[g][j4][0], k4[g][j4][1]} * vv[g], kv1 = (f32x2){k4[g][j4][2], k4[g][j4][3]} * vv[g];
                        S[2 * j4] = __builtin_elementwise_fma((f32x2){a4[g][j4][0], a4[g][j4][1]}, S[2 * j4], kv0);
                        S[2 * j4 + 1] = __builtin_elementwise_fma((f32x2){a4[g][j4][2], a4[g][j4][3]}, S[2 * j4 + 1], kv1);
                        op = __builtin_elementwise_fma((f32x2){q4[g][j4][0], q4[g][j4][1]}, S[2 * j4], op);
                        op = __builtin_elementwise_fma((f32x2){q4[g][j4][2], q4[g][j4][3]}, S[2 * j4 + 1], op); }
                    po[g] = op[0] + op[1]; }
#pragma unroll
                for (int g = 0; g < GS; ++g) sP[((s0_ + g) * 8 + wave) * 64 + lane] = po[g];
            }
            __syncthreads();
#pragma unroll
            for (int j2 = 0; j2 < NR; ++j2) {
                const int s = wave + 8 * j2; const int tok = dir == 0 ? blk * TB + s : 2047 - (blk * TB + s);
                float sum = 0.f;
#pragma unroll
                for (int w = 0; w < 8; ++w) sum += sP[(s * 8 + w) * 64 + lane];
                oraw[(rowbase + tok) * 512 + (HG ? 0 : 256) + h * 64 + lane] = sum;
            }
        }
#undef SCAN_LOAD
    }
    asm volatile("s_waitcnt vmcnt(0)" ::: "memory");
    __syncthreads();
    LAS unsigned* flg = (LAS unsigned*)(lds + 147456 - 128);
    if (tid == 0) { __builtin_amdgcn_fence(__ATOMIC_RELEASE, "agent"); asm volatile("s_waitcnt vmcnt(0)" ::: "memory");
        const unsigned old = __hip_atomic_fetch_add(done, 1u, __ATOMIC_RELAXED, __HIP_MEMORY_SCOPE_AGENT);
        __builtin_amdgcn_fence(__ATOMIC_ACQUIRE, "agent"); asm volatile("s_waitcnt vmcnt(0)" ::: "memory");
        flg[0] = old; }
    __syncthreads();
    if (flg[0] == 1u) {
        if (lane == 0 && tid != 0) { __builtin_amdgcn_fence(__ATOMIC_ACQUIRE, "agent"); asm volatile("s_waitcnt vmcnt(0)" ::: "memory"); }
        __syncthreads();
        const float ng = normg[lane];
        for (int t = wave; t < SEQ; t += 8) {
            const size_t o = (rowbase + t) * 512 + (HG ? 0 : 256) + h * 64 + lane;
            const float tot = __hip_atomic_load(oraw0 + o, __ATOMIC_RELAXED, __HIP_MEMORY_SCOPE_AGENT) + __hip_atomic_load(oraw1 + o, __ATOMIC_RELAXED, __HIP_MEMORY_SCOPE_AGENT);
            const float ssq = wave_sum(tot * tot);
            const float gvv = bf2f(proj[(rowbase + t) * LDP + (HG ? BG : GG) + h * 64 + lane]);
            const float outv = tot * rsqrtf(ssq * (1.f / 64.f) + EPS) * ng * (gvv * __builtin_amdgcn_rcpf(1.f + __expf(-gvv)));
            ocat[(rowbase + t) * D + (HG ? 512 : 768) + h * 64 + lane] = (bf16_t)f2bf(outv);
        }
    }
    __syncthreads();
}

__device__ __forceinline__ void norm_rows_mod(const float* src, bf16_t* dst, const float* g, const float* modl  , int grow0, int shoff, int scoff) {
    const int tid = tid_fresh(), lane = tid & 63, gw = blockIdx.x * 8 + __builtin_amdgcn_readfirstlane(tid >> 6), NGW = gridDim.x * 8;
    for (int m = gw; m < TG; m += NGW) {
        const int b = (grow0 + m) >> 11;
        const f32x4* xr = (const f32x4*)(src + (size_t)m * D) + lane;
        const f32x4* gr = (const f32x4*)g + lane; const f32x4* sh = (const f32x4*)(modl + (size_t)b * (NMOD * D) + shoff) + lane; const f32x4* sc = (const f32x4*)(modl + (size_t)b * (NMOD * D) + scoff) + lane;
        f32x4 v[4]; float s = 0.f;
#pragma unroll
        for (int j = 0; j < 4; ++j) { v[j] = xr[64 * j]; s += (v[j].x * v[j].x + v[j].y * v[j].y) + (v[j].z * v[j].z + v[j].w * v[j].w); }
        const float r = rsqrtf(wave_sum(s) * (1.f / D) + EPS);
        unsigned long long* o8 = (unsigned long long*)(dst + (size_t)m * D) + lane;
#pragma unroll
        for (int j = 0; j < 4; ++j) { const f32x4 y = v[j] * r * gr[64 * j] * (1.f + sc[64 * j]) + sh[64 * j];
            o8[64 * j] = (unsigned long long)pk2(y.x, y.y) | ((unsigned long long)pk2(y.z, y.w) << 32); }
    }
}
__device__ __forceinline__ void norm_rows_final(float* x, const float* g) {
    const int tid = tid_fresh(), lane = tid & 63, gw = blockIdx.x * 8 + __builtin_amdgcn_readfirstlane(tid >> 6), NGW = gridDim.x * 8;
    for (int m = gw; m < TG; m += NGW) {
        f32x4* xr = (f32x4*)(x + (size_t)m * D) + lane; const f32x4* gr = (const f32x4*)g + lane;
        f32x4 v[4]; float s = 0.f;
#pragma unroll
        for (int j = 0; j < 4; ++j) { v[j] = xr[64 * j]; s += (v[j].x * v[j].x + v[j].y * v[j].y) + (v[j].z * v[j].z + v[j].w * v[j].w); }
        const float r = rsqrtf(wave_sum(s) * (1.f / D) + EPS);
#pragma unroll
        for (int j = 0; j < 4; ++j) xr[64 * j] = v[j] * r * gr[64 * j];
    }
}

__device__ __forceinline__ void transpose_item(const float* W, int ldw, bf16_t* WT, int ldt, int row_off, int k_off, LAS float* scr, int kb, int nb, int lane) {
    const int k0 = 64 * kb, n0 = 32 * nb;
#pragma unroll 8
    for (int i = 0; i < 32; ++i) { const int kk = 2 * i + (lane >> 5); scr[kk * 33 + (lane & 31)] = W[(size_t)(k0 + kk) * ldw + n0 + (lane & 31)]; }
    asm volatile("s_waitcnt lgkmcnt(0)" ::: "memory");
    const int c = lane & 7;
#pragma unroll
    for (int j = 0; j < 4; ++j) { const int n = (lane >> 3) + 8 * j; const LAS float* s = scr + (8 * c) * 33 + n;
        u32x4 o; o.x = pk2(s[0 * 33], s[1 * 33]); o.y = pk2(s[2 * 33], s[3 * 33]); o.z = pk2(s[4 * 33], s[5 * 33]); o.w = pk2(s[6 * 33], s[7 * 33]);
        *(u32x4*)(WT + (size_t)(row_off + n0 + n) * ldt + k_off + k0 + 8 * c) = o; }
    asm volatile("s_waitcnt lgkmcnt(0)" ::: "memory");
}

struct Args { const void* p[24]; };
enum { P_X = 0, P_C, P_ADAW, P_ADAB, P_NMIXG, P_NMLPG, P_WIN, P_DLAM, P_DSUBG, P_HLB, P_HNG, P_GW2, P_GB, P_GNG, P_WUA, P_WUB, P_WUC, P_WOUT, P_W1, P_W2, P_FNG, P_OUT, P_WS };
typedef const unsigned long long __attribute__((address_space(4)))* kargp_t;
__device__ __forceinline__ const void* karg(int i) { kargp_t kp = (kargp_t)__builtin_amdgcn_kernarg_segment_ptr(); asm volatile("" : "+s"(kp));
    const unsigned long long v = kp[i]; const __attribute__((address_space(1))) void* g = (const __attribute__((address_space(1))) void*)v; return (const void*)g; }
#define GRID_SYNC() do { asm volatile("s_waitcnt vmcnt(0) lgkmcnt(0)" ::: "memory"); __syncthreads(); grid.sync(); \
    if (threadIdx.x < 64) { __builtin_amdgcn_fence(__ATOMIC_ACQUIRE, "agent"); asm volatile("s_waitcnt vmcnt(0)" ::: "memory"); } __syncthreads(); } while (0)
#define KF(i) ((const float*)karg(i))
#define KWS() ((uchar*)karg(P_WS))

__global__ void __launch_bounds__(512, 2) fwd_megakernel(Args a_unused) {
    extern __shared__ __attribute__((aligned(16))) uchar lds_raw[];
    LAS uchar* lds = (LAS uchar*)lds_raw;
    cg::grid_group grid = cg::this_grid();
    {
    const int tid = tid_fresh(), lane = tid & 63, wave = __builtin_amdgcn_readfirstlane(tid >> 6);

    if (blockIdx.x == 0) {
        unsigned* ctl = (unsigned*)(KWS() + WS_CTL); float* ctlf = (float*)ctl;
        for (int i = tid; i < 1024; i += 512) { ctl[i] = 0u; ctl[40960 + i] = 0u; }
        if (tid < 4) {
            const float* lp = KF(P_DLAM) + tid * 256; float s1 = 0.f, s2 = 0.f;
            for (int d = 0; d < 64; ++d) { s1 += lp[d] * lp[64 + d]; s2 += lp[128 + d] * lp[192 + d]; }
            const float li = 0.8f - 0.6f * expf(-0.3f * (float)tid);
            ctlf[1024 + tid] = expf(s1) - expf(s2) + li; ctlf[1028 + tid] = li;
        }
        {
            const float* lg = KF(P_HLB); const int j = tid;
            float v[4], mx = -1e30f;
#pragma unroll
            for (int l = 0; l < 4; ++l) { v[l] = lg[l * 512 + j]; mx = fmaxf(mx, v[l]); }
            float den = 0.f;
#pragma unroll
            for (int l = 0; l < 4; ++l) { v[l] = expf(v[l] - mx); den += v[l]; }
            float cum = 0.f; const float w0 = v[0] / den;
#pragma unroll
            for (int l = 0; l < 4; ++l) { cum += v[l] / den; ctlf[2048 + l * 512 + j] = cum - w0; }
        }
        {
            float* pv = ctlf + 8192;
            const float* s0 = KF(P_NMIXG); for (int i = tid; i < 4096; i += 512) pv[i] = s0[i];
            const float* s1 = KF(P_NMLPG); for (int i = tid; i < 4096; i += 512) pv[4096 + i] = s1[i];
            const float* s2 = KF(P_DSUBG); for (int i = tid; i < 512; i += 512) pv[8192 + i] = s2[i];
            const float* s3 = KF(P_HNG); for (int i = tid; i < 256; i += 512) pv[8704 + i] = s3[i];
            const float* s4 = KF(P_GW2); for (int i = tid; i < 16384; i += 512) pv[8960 + i] = s4[i];
            const float* s5 = KF(P_GB); for (int i = tid; i < 1024; i += 512) pv[25344 + i] = s5[i];
            const float* s6 = KF(P_GNG); for (int i = tid; i < 256; i += 512) pv[26368 + i] = s6[i];
            const float* s7 = KF(P_FNG); for (int i = tid; i < 1024; i += 512) pv[26624 + i] = s7[i];
        }
    }
#ifndef NO_MOD
    {
        LAS float* cond = (LAS float*)lds; LAS float* red = (LAS float*)(lds + 131072);
        float* mod = (float*)(KWS() + WS_MOD);
        const float* cin = KF(P_C); const float* adaw = KF(P_ADAW); const float* adab = KF(P_ADAB);
        bool loaded = false;
        for (int it = blockIdx.x; it < 4 * 96; it += gridDim.x) {
            if (!loaded) { for (int i = tid; i < 32 * 1024; i += 512) { const float cv = cin[i]; cond[i] = cv / (1.f + __expf(-cv)); } loaded = true; __syncthreads(); }
            const int l = it / 96, n0 = (it % 96) * 64;
            const float* W = adaw + (size_t)l * D * (NMOD * D) + n0 + lane;
            float acc[32];
#pragma unroll
            for (int b = 0; b < 32; ++b) acc[b] = 0.f;
            for (int k4 = 0; k4 < 32; ++k4) {
                const int k = wave * 128 + k4 * 4;
                const float w0 = W[(size_t)k * (NMOD * D)], w1 = W[(size_t)(k + 1) * (NMOD * D)], w2v = W[(size_t)(k + 2) * (NMOD * D)], w3 = W[(size_t)(k + 3) * (NMOD * D)];
#pragma unroll
                for (int b = 0; b < 32; ++b) { const f32x4 c4 = *(const LAS f32x4*)(cond + b * 1024 + k); acc[b] += c4.x * w0 + c4.y * w1 + c4.z * w2v + c4.w * w3; }
            }
#pragma unroll
            for (int rd = 0; rd < 4; ++rd) {
                __syncthreads();
#pragma unroll
                for (int bb = 0; bb < 8; ++bb) red[(wave * 8 + bb) * 64 + lane] = acc[rd * 8 + bb];
                __syncthreads();
                float s = 0.f;
#pragma unroll
                for (int w = 0; w < 8; ++w) s += red[(w * 8 + wave) * 64 + lane];
                const int b = rd * 8 + wave;
                mod[((size_t)l * 32 + b) * (NMOD * D) + n0 + lane] = s + adab[l * (NMOD * D) + n0 + lane];
            }
        }
        __syncthreads();
    }
#endif
#ifndef NO_WT
    {
        LAS float* scr = (LAS float*)(lds + wave * 8704);
        const int gw = blockIdx.x * 8 + wave, NGW = gridDim.x * 8;
        uchar* ws = KWS();
        bf16_t* win_t = (bf16_t*)(ws + WS_WIN); bf16_t* wup_t = (bf16_t*)(ws + WS_WUP); bf16_t* wout_t = (bf16_t*)(ws + WS_WOUT);
        bf16_t* w1_t = (bf16_t*)(ws + WS_W1); bf16_t* w2_t = (bf16_t*)(ws + WS_W2);
        constexpr int I_IN = 16 * 209, I_UA = 8 * 32, I_UB = 4 * 32, I_UC = 4 * 32, I_O = 16 * 32, I_1 = 16 * 128, I_2 = 64 * 32;
        constexpr int I_L = I_IN + I_UA + I_UB + I_UC + I_O + I_1 + I_2;
        for (int it = gw; it < 4 * I_L; it += NGW) {
            const int l = it / I_L; int r = it % I_L;
            if (r < I_IN) { transpose_item(KF(P_WIN) + (size_t)l * D * DIN, DIN, win_t + (size_t)l * LDP * D, D, 0, 0, scr, r / 209, r % 209, lane); continue; } r -= I_IN;
            if (r < I_UA) { transpose_item(KF(P_WUA) + (size_t)l * 512 * D, D, wup_t + (size_t)l * D * D, D, 0, 0, scr, r / 32, r % 32, lane); continue; } r -= I_UA;
            if (r < I_UB) { transpose_item(KF(P_WUB) + (size_t)l * 256 * D, D, wup_t + (size_t)l * D * D, D, 0, 512, scr, r / 32, r % 32, lane); continue; } r -= I_UB;
            if (r < I_UC) { transpose_item(KF(P_WUC) + (size_t)l * 256 * D, D, wup_t + (size_t)l * D * D, D, 0, 768, scr, r / 32, r % 32, lane); continue; } r -= I_UC;
            if (r < I_O) { transpose_item(KF(P_WOUT) + (size_t)l * D * D, D, wout_t + (size_t)l * D * D, D, 0, 0, scr, r / 32, r % 32, lane); continue; } r -= I_O;
            if (r < I_1) { transpose_item(KF(P_W1) + (size_t)l * D * DFF, DFF, w1_t + (size_t)l * DFF * D, D, 0, 0, scr, r / 128, r % 128, lane); continue; } r -= I_1;
            transpose_item(KF(P_W2) + (size_t)l * DFF * D, D, w2_t + (size_t)l * D * DFF, DFF, 0, 0, scr, r / 32, r % 32, lane);
        }
        for (int i = blockIdx.x * 512 + tid; i < 4 * 28672; i += gridDim.x * 512) { const int l = i / 28672, r = i % 28672;
            *(u32x4*)(win_t + (size_t)l * LDP * D + (size_t)DIN * D + (size_t)r * 8) = (u32x4){0u, 0u, 0u, 0u}; }
    }
#endif
    }
    GRID_SYNC();

    for (int grp = 0; grp < NGRP; ++grp) {
        for (int l = 0; l < DEPTH; ++l) {
            {
                uchar* ws = KWS(); const float* pv = (const float*)(ws + WS_CTL) + 8192;
                const float* src = (l == 0 ? KF(P_X) : (const float*)karg(P_OUT)) + (size_t)grp * TG * D;
                norm_rows_mod(src, (bf16_t*)(ws + WS_HB), pv + l * D, (const float*)(ws + WS_MOD) + (size_t)l * 32 * (NMOD * D), grp * TG, 0, D);
            }
            GRID_SYNC();
            { uchar* ws = KWS(); pg8::Gemm g{(const bf16_t*)(ws + WS_HB), (const bf16_t*)(ws + WS_WIN) + (size_t)l * LDP * D, D}; pg8::Order S; S.init(TG, LDP, D, gridDim.x, blockIdx.x, 1); pg8::EpiProj E{(bf16_t*)(ws + WS_PROJ)};
#ifndef NO_EPIPROJ
              pg8::gemm_phase<pg8::EpiProj>(lds, g, S, E);
#endif
            }
            GRID_SYNC();
            {
                uchar* ws = KWS(); const float* ctlf = (const float*)(ws + WS_CTL); const float* pv = ctlf + 8192;
                const int xq = blockIdx.x & 7; unsigned* ctr = (unsigned*)(ws + WS_CTL) + ((grp * DEPTH + l) * 8 + xq) * 4;
                const float lam = ctlf[1024 + l], laminit = ctlf[1028 + l];
                const bf16_t* PROJ = (const bf16_t*)(ws + WS_PROJ); bf16_t* OCAT = (bf16_t*)(ws + WS_OCAT); float* OFWD = (float*)(ws + WS_OFWD);
                LAS int* itm = (LAS int*)(lds + 147456 - 64);
                const int tid = tid_fresh();
                for (;;) {
                    __syncthreads();
                    if (tid == 0) itm[0] = (int)atomicAdd(ctr, 1u);
                    __syncthreads();
                    const int it = itm[0];
                    constexpr int NPQ = GB * 4 / 8;
                    if (it >= 4 * NPQ + NPQ * 16) break;
                    float* OBWD = (float*)(ws + WS_OBWD);
                    if (it < 2 * NPQ) { const int p = (it >> 1) * 8 + xq; unsigned* dn = (unsigned*)(ws + WS_CTL) + 40960 + (((grp * DEPTH + l) * GB * 4 + p) * 2);
                        scan_item<64, true>(lds, PROJ, OFWD, OBWD, OCAT, dn, p >> 2, p & 3, it & 1, ctlf + 2048 + l * 512, pv + 8704 + l * 64, nullptr, nullptr);
                    } else if (it < 4 * NPQ) { const int i2 = it - 2 * NPQ; const int p = (i2 >> 1) * 8 + xq; unsigned* dn = (unsigned*)(ws + WS_CTL) + 40960 + (((grp * DEPTH + l) * GB * 4 + p) * 2 + 1);
                        scan_item<32, false>(lds, PROJ, OFWD, OBWD, OCAT, dn, p >> 2, p & 3, i2 & 1, nullptr, pv + 26368 + l * 64, pv + 8960 + l * 4096, pv + 25344 + l * 256);
                    } else { const int u = it - 4 * NPQ, p = (u >> 4) * 8 + xq;
                        attn_unit(lds, PROJ, OCAT, p >> 2, p & 3, u & 15, lam, laminit, pv + 8192 + l * 128);
                    }
                }
            }
            GRID_SYNC();
            { uchar* ws = KWS(); pg8::Gemm g{(const bf16_t*)(ws + WS_OCAT), (const bf16_t*)(ws + WS_WUP) + (size_t)l * D * D, D}; pg8::Order S; S.init(TG, D, D, gridDim.x, blockIdx.x, 3); pg8::EpiMerge E{(const bf16_t*)(ws + WS_PROJ), (bf16_t*)(ws + WS_HB)};
#ifndef NO_EPIMERGE
              pg8::gemm_phase<pg8::EpiMerge>(lds, g, S, E);
#endif
            }
            GRID_SYNC();
            { uchar* ws = KWS(); pg8::Gemm g{(const bf16_t*)(ws + WS_HB), (const bf16_t*)(ws + WS_WOUT) + (size_t)l * D * D, D}; pg8::Order S; S.init(TG, D, D, gridDim.x, blockIdx.x, 1);
              float* xg = (float*)karg(P_OUT) + (size_t)grp * TG * D;
              pg8::EpiRes E{l == 0 ? KF(P_X) + (size_t)grp * TG * D : xg, xg, (const float*)(ws + WS_MOD) + ((size_t)l * 32 + grp * GB) * (NMOD * D) + 2 * D};
#ifndef NO_EPIRES
              pg8::gemm_phase<pg8::EpiRes>(lds, g, S, E);
#endif
            }
            GRID_SYNC();
            {
                uchar* ws = KWS(); const float* pv = (const float*)(ws + WS_CTL) + 8192;
                norm_rows_mod((const float*)karg(P_OUT) + (size_t)grp * TG * D, (bf16_t*)(ws + WS_HB), pv + 4096 + l * D, (const float*)(ws + WS_MOD) + (size_t)l * 32 * (NMOD * D), grp * TG, 3 * D, 4 * D);
            }
            GRID_SYNC();
            { uchar* ws = KWS(); pg8::Gemm g{(const bf16_t*)(ws + WS_HB), (const bf16_t*)(ws + WS_W1) + (size_t)l * DFF * D, D}; pg8::Order S; S.init(TG, DFF, D, gridDim.x, blockIdx.x, 1); pg8::EpiRelu2 E{(bf16_t*)(ws + WS_U)};
#ifndef NO_EPIRELU2
              pg8::gemm_phase<pg8::EpiRelu2>(lds, g, S, E);
#endif
            }
            GRID_SYNC();
            { uchar* ws = KWS(); pg8::Gemm g{(const bf16_t*)(ws + WS_U), (const bf16_t*)(ws + WS_W2) + (size_t)l * D * DFF, DFF}; pg8::Order S; S.init(TG, D, DFF, gridDim.x, blockIdx.x, 1);
              float* xg = (float*)karg(P_OUT) + (size_t)grp * TG * D;
              pg8::EpiRes E{xg, xg, (const float*)(ws + WS_MOD) + ((size_t)l * 32 + grp * GB) * (NMOD * D) + 5 * D};
#ifndef NO_EPIRES
              pg8::gemm_phase<pg8::EpiRes>(lds, g, S, E);
#endif
            }
            GRID_SYNC();
        }
        norm_rows_final((float*)karg(P_OUT) + (size_t)grp * TG * D, (const float*)(KWS() + WS_CTL) + 8192 + 26624);
    }
}

extern "C" void kernel_launch(void* const* d_in, const int* in_sizes, int n_in, void* d_out, int out_size, void* d_ws, size_t ws_size, hipStream_t stream) {
    static int grid = 0;
    if (grid == 0) {
        if (n_in != 21 || ws_size < WS_END) { fprintf(stderr, "kernel_launch: unexpected n_in %d / ws %zu\n", n_in, ws_size); grid = -1; return; }
        int dev = 0, cus = 0, per_cu = 0;
        if (hipGetDevice(&dev) != hipSuccess || hipDeviceGetAttribute(&cus, hipDeviceAttributeMultiprocessorCount, dev) != hipSuccess) { grid = -1; return; }
        if (hipFuncSetAttribute((const void*)fwd_megakernel, hipFuncAttributeMaxDynamicSharedMemorySize, LDS_BYTES) != hipSuccess) { fprintf(stderr, "kernel_launch: hipFuncSetAttribute failed\n"); grid = -1; return; }
        if (hipOccupancyMaxActiveBlocksPerMultiprocessor(&per_cu, (const void*)fwd_megakernel, 512, LDS_BYTES) != hipSuccess || per_cu < 1) { fprintf(stderr, "kernel_launch: occupancy query says %d\n", per_cu); per_cu = 1; }
        (void)hipGetLastError();
        grid = cus;
    }
    if (grid < 0) return;
    Args a{};
    for (int i = 0; i < 21; ++i) a.p[i] = d_in[i];
    a.p[21] = d_out; a.p[22] = d_ws; a.p[23] = nullptr;
    void* args[] = {&a};
    hipError_t e = hipLaunchCooperativeKernel((void*)fwd_megakernel, dim3(grid), dim3(512), args, LDS_BYTES, stream);
    if (e != hipSuccess) fprintf(stderr, "kernel_launch: cooperative launch failed: %s (grid %d)\n", hipGetErrorString(e), grid);
}
```

```cpp
#include <hip/hip_runtime.h>
#include <hip/hip_cooperative_groups.h>
#include <cstdio>
#include <cstdint>
namespace cg = cooperative_groups;

#define LAS __attribute__((address_space(3)))
typedef unsigned short bf16_t;
typedef short bf16x8 __attribute__((ext_vector_type(8)));
typedef float f32x4 __attribute__((ext_vector_type(4)));
typedef float f32x2 __attribute__((ext_vector_type(2)));
typedef float f32x16 __attribute__((ext_vector_type(16)));
typedef unsigned u32x4 __attribute__((ext_vector_type(4)));
typedef short s16x4 __attribute__((ext_vector_type(4)));
typedef unsigned char uchar;

constexpr int D = 1024, SEQ = 2048, BATCH = 32, DEPTH = 4, DIN = 6688, LDP = 6912, DFF = 4096, NMOD = 6;
constexpr int GB = 16, TG = GB * SEQ, NGRP = BATCH / GB;
constexpr int CQ = 0, CK = 512, CV = 1024, BQ = 1536, BFF = 1792, BFB = 2048, BI = 2304, BG = 2560;
constexpr int GQ = 2816, GK = 2944, GV = 3072, GG = 3328, GLF = 3584, GLB = 3600, GATE = 3616;
constexpr float EPS = 1e-6f, LOG2E = 1.4426950408889634f;
constexpr float QSCALE = 0.125f * LOG2E;

constexpr size_t MiB = 1u << 20;
constexpr size_t WS_CTL = 0;
constexpr size_t WS_MOD = 1 * MiB;
constexpr size_t WS_WIN = 4 * MiB;
constexpr size_t WS_WUP = 58 * MiB;
constexpr size_t WS_WOUT = 66 * MiB;
constexpr size_t WS_W1 = 74 * MiB;
constexpr size_t WS_W2 = 106 * MiB;
constexpr size_t WS_HB = 138 * MiB;
constexpr size_t WS_OCAT = 202 * MiB;
constexpr size_t WS_OFWD = 266 * MiB;
constexpr size_t WS_PROJ = 330 * MiB;
constexpr size_t WS_U = WS_PROJ;
constexpr size_t WS_OBWD = 762 * MiB;
constexpr size_t WS_END = 826 * MiB;
constexpr int LDS_BYTES = 148 * 1024;

__device__ __forceinline__ unsigned f2bf(float f) { unsigned u = __builtin_bit_cast(unsigned, f); return (u + 0x7fffu + ((u >> 16) & 1u)) >> 16; }
__device__ __forceinline__ unsigned pk2(float lo, float hi) { return f2bf(lo) | (f2bf(hi) << 16); }
__device__ __forceinline__ float bf2f(bf16_t v) { return __builtin_bit_cast(float, (unsigned)v << 16); }
__device__ __forceinline__ float bflo(unsigned u) { return __builtin_bit_cast(float, u << 16); }
__device__ __forceinline__ float bfhi(unsigned u) { return __builtin_bit_cast(float, u & 0xffff0000u); }
typedef __bf16 bf16x2_t __attribute__((ext_vector_type(2)));
__device__ __forceinline__ unsigned cvt_pk_bf16(float lo, float hi) { f32x2 v = {lo, hi}; bf16x2_t b = __builtin_convertvector(v, bf16x2_t); return __builtin_bit_cast(unsigned, b); }
__device__ __forceinline__ float wave_sum(float v) {
#pragma unroll
    for (int o = 1; o < 64; o <<= 1) v += __shfl_xor(v, o);
    return v;
}
__device__ __forceinline__ int tid_fresh() { int t = threadIdx.x; asm volatile("" : "+v"(t)); return t; }
__device__ __forceinline__ float sigmoidf_(float z) { return 1.f / (1.f + __expf(-z)); }

namespace pg8 {
constexpr int BM = 256, BK = 64, HALF = 128, HTB = HALF * BK * 2, STAGE_BYTES = 8 * HTB, NXCD = 8, WGM = 8;
__host__ __device__ __forceinline__ int lds_byte(int r, int c) { const int st = (r >> 4) * 2 + (c >> 5), rr = r & 15, cc = c & 31, ob = rr * 64 + cc * 2; return st * 1024 + (ob ^ (((ob >> 9) & 1) << 5)); }
__host__ __device__ __forceinline__ void stage_rc(int b, int& R, int& C) { const int st = b / 1024, sb = b % 1024, swz = sb ^ (((sb >> 9) & 1) << 5); R = (st >> 1) * 16 + swz / 64; C = (st & 1) * 32 + (swz % 64) / 2; }
__host__ __device__ __forceinline__ int perm32(int rho) { const int n = rho >> 4, i = rho & 15; return 8 * (i >> 2) + 4 * n + (i & 3); }

struct Unit { int pm, pn, koff, nt, seg; };
struct Gemm { const bf16_t* A; const bf16_t* Bt; int K; };

struct Order {
    int nM, nN, nwg, G, c, nseg, ntfull;
    __device__ void init(int M, int N, int K, int G_, int c_, int nseg_) { nM = M / BM; nN = N / BM; nwg = nM * nN; G = G_; c = c_; nseg = nseg_; ntfull = K / BK; }
    __device__ bool next(int i, Unit& u) const {
        int ti = i, seg = 0;
        if (nseg == 3) { ti = i / 3; seg = i - ti * 3; }
        const long L = (long)ti * G + c; if (L >= nwg) return false;
        int wgid = (int)L; { const int q = nwg / NXCD, r = nwg % NXCD, xcd = wgid % NXCD, off = wgid / NXCD; wgid = (xcd < r ? xcd * (q + 1) : r * (q + 1) + (xcd - r) * q) + off; }
        const int nig = WGM * nN, gid = wgid / nig, fm = gid * WGM, gsz = (nM - fm) < WGM ? (nM - fm) : WGM;
        u.pm = fm + ((wgid % nig) % gsz); u.pn = (wgid % nig) / gsz; u.seg = seg;
        if (nseg == 3) { u.koff = seg == 0 ? 0 : (seg == 1 ? 512 : 768); u.nt = seg == 0 ? 8 : 4; } else { u.koff = 0; u.nt = ntfull; }
        return true;
    }
};

struct EpiProj {
    bf16_t* O;
    __device__ __forceinline__ bool zero_after(const Unit&) const { return true; }
    __device__ __forceinline__ void operator()(f32x4 (&acc)[2][2][4][2], const Unit& u, int wr, int wc, int fr, int fq) const {
        const int row0 = u.pm * BM + wr * 64 + fr, col0 = u.pn * BM + wc * 32 + 8 * fq;
        const float sc = (u.pn < 2) ? QSCALE : 1.f;
#pragma unroll
        for (int ai = 0; ai < 2; ++ai)
#pragma unroll
            for (int m = 0; m < 4; ++m) { bf16_t* rowp = O + (size_t)(row0 + ai * HALF + m * 16) * LDP + col0;
#pragma unroll
                for (int bj = 0; bj < 2; ++bj) { f32x4 v0 = acc[ai][bj][m][0] * sc, v1 = acc[ai][bj][m][1] * sc;
                    u32x4 w; w.x = cvt_pk_bf16(v0[0], v0[1]); w.y = cvt_pk_bf16(v0[2], v0[3]); w.z = cvt_pk_bf16(v1[0], v1[1]); w.w = cvt_pk_bf16(v1[2], v1[3]);
                    *(u32x4*)(rowp + bj * HALF) = w; } }
    }
};
struct EpiRelu2 {
    bf16_t* O;
    __device__ __forceinline__ bool zero_after(const Unit&) const { return true; }
    __device__ __forceinline__ void operator()(f32x4 (&acc)[2][2][4][2], const Unit& u, int wr, int wc, int fr, int fq) const {
        const int row0 = u.pm * BM + wr * 64 + fr, col0 = u.pn * BM + wc * 32 + 8 * fq;
#pragma unroll
        for (int ai = 0; ai < 2; ++ai)
#pragma unroll
            for (int m = 0; m < 4; ++m) { bf16_t* rowp = O + (size_t)(row0 + ai * HALF + m * 16) * DFF + col0;
#pragma unroll
                for (int bj = 0; bj < 2; ++bj) { f32x4 v0 = acc[ai][bj][m][0], v1 = acc[ai][bj][m][1];
#pragma unroll
                    for (int j = 0; j < 4; ++j) { float a = fmaxf(v0[j], 0.f), b = fmaxf(v1[j], 0.f); v0[j] = a * a; v1[j] = b * b; }
                    u32x4 w; w.x = cvt_pk_bf16(v0[0], v0[1]); w.y = cvt_pk_bf16(v0[2], v0[3]); w.z = cvt_pk_bf16(v1[0], v1[1]); w.w = cvt_pk_bf16(v1[2], v1[3]);
                    *(u32x4*)(rowp + bj * HALF) = w; } }
    }
};
struct EpiRes {
    const float* base; float* out; const float* gate;
    __device__ __forceinline__ bool zero_after(const Unit&) const { return true; }
    __device__ __forceinline__ void operator()(f32x4 (&acc)[2][2][4][2], const Unit& u, int wr, int wc, int fr, int fq) const {
        const int row0 = u.pm * BM + wr * 64 + fr, col0 = u.pn * BM + wc * 32 + 8 * fq;
        const float* gp = gate + (size_t)((u.pm * BM) >> 11) * (NMOD * D) + col0;
#pragma unroll
        for (int bj = 0; bj < 2; ++bj) {
            const f32x4 g0 = *(const f32x4*)(gp + bj * HALF), g1 = *(const f32x4*)(gp + bj * HALF + 4);
#pragma unroll
            for (int ai = 0; ai < 2; ++ai) {
#pragma unroll
                for (int m = 0; m < 4; ++m) { const size_t off = (size_t)(row0 + ai * HALF + m * 16) * D + col0 + bj * HALF;
                    const f32x4 b0 = *(const f32x4*)(base + off), b1 = *(const f32x4*)(base + off + 4);
                    *(f32x4*)(out + off) = b0 + g0 * acc[ai][bj][m][0];
                    *(f32x4*)(out + off + 4) = b1 + g1 * acc[ai][bj][m][1];
                    if (m & 1) asm volatile("" ::: "memory"); }
            }
        }
    }
};
struct EpiMerge {
    const bf16_t* proj; bf16_t* O;
    __device__ __forceinline__ bool zero_after(const Unit& u) const { return u.seg == 2; }
    __device__ __forceinline__ void operator()(f32x4 (&acc)[2][2][4][2], const Unit& u, int wr, int wc, int fr, int fq) const {
        const int row0 = u.pm * BM + wr * 64 + fr, col0 = u.pn * BM + wc * 32 + 8 * fq;
        const int seg = u.seg;
#pragma unroll
        for (int ai = 0; ai < 2; ++ai)
#pragma unroll
            for (int m = 0; m < 4; ++m) { const size_t row = (size_t)(row0 + ai * HALF + m * 16); const bf16_t* gp = proj + row * LDP + GATE + col0;
#pragma unroll
                for (int bj = 0; bj < 2; ++bj) {
                    if (seg < 2) {
                        const u32x4 ga = *(const u32x4*)(gp + seg * D + bj * HALF), gb = *(const u32x4*)(gp + (seg + 1) * D + bj * HALF);
                        float r[8];
#pragma unroll
                        for (int j = 0; j < 4; ++j) {
                            const float a0 = fminf(fmaxf(bflo(ga[j]), -40.f), 40.f), a1 = fminf(fmaxf(bfhi(ga[j]), -40.f), 40.f);
                            const float b0 = fminf(fmaxf(bflo(gb[j]), -40.f), 40.f), b1 = fminf(fmaxf(bfhi(gb[j]), -40.f), 40.f);
                            r[2 * j] = (1.f + __expf(-b0)) * __builtin_amdgcn_rcpf(1.f + __expf(-a0));
                            r[2 * j + 1] = (1.f + __expf(-b1)) * __builtin_amdgcn_rcpf(1.f + __expf(-a1)); }
                        acc[ai][bj][m][0] = acc[ai][bj][m][0] * (f32x4){r[0], r[1], r[2], r[3]};
                        acc[ai][bj][m][1] = acc[ai][bj][m][1] * (f32x4){r[4], r[5], r[6], r[7]};
                    } else {
                        const u32x4 gc = *(const u32x4*)(gp + 2 * D + bj * HALF);
                        float r[8];
#pragma unroll
                        for (int j = 0; j < 4; ++j) {
                            const float c0 = fminf(fmaxf(bflo(gc[j]), -40.f), 40.f), c1 = fminf(fmaxf(bfhi(gc[j]), -40.f), 40.f);
                            r[2 * j] = __builtin_amdgcn_rcpf(1.f + __expf(-c0)); r[2 * j + 1] = __builtin_amdgcn_rcpf(1.f + __expf(-c1)); }
                        const f32x4 v0 = acc[ai][bj][m][0] * (f32x4){r[0], r[1], r[2], r[3]}, v1 = acc[ai][bj][m][1] * (f32x4){r[4], r[5], r[6], r[7]};
                        u32x4 w; w.x = cvt_pk_bf16(v0[0], v0[1]); w.y = cvt_pk_bf16(v0[2], v0[3]); w.z = cvt_pk_bf16(v1[0], v1[1]); w.w = cvt_pk_bf16(v1[2], v1[3]);
                        *(u32x4*)(O + row * D + col0 + bj * HALF) = w;
                    } } }
    }
};

template <class Epi, bool ALIGN_EPI = true>
__device__ __forceinline__ void gemm_phase(LAS uchar* lds, const Gemm g, const Order& S, const Epi& E) {
    const int tid = tid_fresh(), wid = __builtin_amdgcn_readfirstlane(tid >> 6), lane = tid & 63, wr = wid >> 2, wc = wid & 3, fr = lane & 15, fq = lane >> 4;
    const int K = g.K;
    unsigned voffA[2], voffB[2];
#pragma unroll
    for (int i = 0; i < 2; ++i) { int R, C; stage_rc(tid * 16 + i * 8192, R, C); const int Rb = (R & ~31) + perm32(R & 31);
        voffA[i] = (unsigned)(R * K + C) * 2u; voffB[i] = (unsigned)(Rb * K + C) * 2u; }
    const size_t kstep = (size_t)(BK * 2);
    const size_t hstep = (size_t)HALF * K * 2;
    const size_t tstep = 2 * hstep;
    const unsigned ldsw = (unsigned)wid * 1024u;
    const int aoff = lds_byte(wr * 64 + fr, fq * 8), boff = lds_byte(wc * 32 + fr, fq * 8);
#define PG8_SA(b, h) (((b) * 2 + (h)) * HTB)
#define PG8_SB(b, h) ((4 + (b) * 2 + (h)) * HTB)
#define PG8_STAGE(bufoff, gbase, voff) do { _Pragma("unroll") for (int _i = 0; _i < 2; ++_i) \
        __builtin_amdgcn_global_load_lds((const unsigned*)((const char*)(gbase) + (voff)[_i]), (LAS unsigned*)(lds + (bufoff) + ldsw + _i * 8192), 16, 0, 0); } while (0)
#define PG8_LDA(dst, b, h) do { _Pragma("unroll") for (int m = 0; m < 4; ++m) _Pragma("unroll") for (int k = 0; k < 2; ++k) dst[m][k] = *(const LAS bf16x8*)(lds + PG8_SA(b, h) + aoff + m * 2048 + k * 1024); } while (0)
#define PG8_LDB(dst, b, h) do { _Pragma("unroll") for (int n = 0; n < 2; ++n) _Pragma("unroll") for (int k = 0; k < 2; ++k) dst[n][k] = *(const LAS bf16x8*)(lds + PG8_SB(b, h) + boff + n * 2048 + k * 1024); } while (0)
#define PG8_MMA(ai, bj, At, Bt) do { __builtin_amdgcn_s_setprio(1); _Pragma("unroll") for (int m = 0; m < 4; ++m) _Pragma("unroll") for (int n = 0; n < 2; ++n) _Pragma("unroll") for (int k = 0; k < 2; ++k) \
        acc[ai][bj][m][n] = __builtin_amdgcn_mfma_f32_16x16x32_bf16(Bt[n][k], At[m][k], acc[ai][bj][m][n], 0, 0, 0); __builtin_amdgcn_s_setprio(0); } while (0)
#define PG8_WAIT_V(n) asm volatile("s_waitcnt vmcnt(" #n ")" ::: "memory")
#define PG8_WAIT_L(n) asm volatile("s_waitcnt lgkmcnt(" #n ")" ::: "memory")
#define PG8_BAR __builtin_amdgcn_s_barrier()
#define PG8_SCHED __builtin_amdgcn_sched_barrier(0)
    Unit cur, nxt; int ui = 0;
    if (!S.next(0, cur)) return;
    f32x4 acc[2][2][4][2];
#pragma unroll
    for (int a = 0; a < 2; ++a)
#pragma unroll
        for (int b = 0; b < 2; ++b)
#pragma unroll
            for (int m = 0; m < 4; ++m)
#pragma unroll
                for (int n = 0; n < 2; ++n) acc[a][b][m][n] = (f32x4){0.f, 0.f, 0.f, 0.f};
    bf16x8 At[4][2], B0[2][2], B1[2][2];
    const char* cA = (const char*)g.A + (size_t)cur.pm * tstep + (size_t)cur.koff * 2; const char* cB = (const char*)g.Bt + (size_t)cur.pn * tstep + (size_t)cur.koff * 2;
    PG8_STAGE(PG8_SB(0, 0), cB, voffB); PG8_STAGE(PG8_SB(0, 1), cB + hstep, voffB); PG8_STAGE(PG8_SA(0, 0), cA, voffA); PG8_STAGE(PG8_SA(0, 1), cA + hstep, voffA);
    if (wr == 1) PG8_BAR;
    PG8_WAIT_V(2); PG8_BAR;
    PG8_STAGE(PG8_SB(1, 0), cB + kstep, voffB); PG8_STAGE(PG8_SA(1, 0), cA + kstep, voffA); PG8_STAGE(PG8_SB(1, 1), cB + hstep + kstep, voffB);
    PG8_WAIT_V(6); PG8_BAR;
    for (;;) {
        const bool has_next = S.next(ui + 1, nxt);
        const char* nA = has_next ? (const char*)g.A + (size_t)nxt.pm * tstep + (size_t)nxt.koff * 2 : cA; const char* nB = has_next ? (const char*)g.Bt + (size_t)nxt.pn * tstep + (size_t)nxt.koff * 2 : cB;
        const int nt = cur.nt;
        for (int t = 0; t < nt; t += 2) {
            const bool last = (t == nt - 2);
            const char* a1 = cA + (size_t)(t + 1) * kstep;
            const char* a2 = last ? nA : cA + (size_t)(t + 2) * kstep; const char* b2 = last ? nB : cB + (size_t)(t + 2) * kstep;
            const char* a3 = a2 + kstep; const char* b3 = b2 + kstep;
            PG8_LDB(B0, 0, 0); PG8_LDB(B1, 0, 1); PG8_SCHED; PG8_LDA(At, 0, 0); PG8_STAGE(PG8_SA(1, 1), a1 + hstep, voffA);
            PG8_WAIT_V(8); PG8_WAIT_L(0); PG8_BAR; PG8_MMA(0, 0, At, B0); PG8_MMA(0, 1, At, B1); PG8_BAR; PG8_SCHED;
            PG8_LDA(At, 0, 1); PG8_STAGE(PG8_SB(0, 0), b2, voffB); PG8_STAGE(PG8_SB(0, 1), b2 + hstep, voffB); PG8_STAGE(PG8_SA(0, 0), a2, voffA);
            PG8_WAIT_V(8); PG8_WAIT_L(0); PG8_BAR; PG8_MMA(1, 0, At, B0); PG8_MMA(1, 1, At, B1); PG8_BAR; PG8_SCHED;
            PG8_LDB(B0, 1, 0); PG8_LDB(B1, 1, 1); PG8_SCHED; PG8_LDA(At, 1, 0); PG8_STAGE(PG8_SA(0, 1), a2 + hstep, voffA);
            PG8_WAIT_V(8); PG8_WAIT_L(0); PG8_BAR; PG8_MMA(0, 0, At, B0); PG8_MMA(0, 1, At, B1); PG8_BAR; PG8_SCHED;
            PG8_LDA(At, 1, 1); PG8_STAGE(PG8_SB(1, 0), b3, voffB); PG8_STAGE(PG8_SB(1, 1), b3 + hstep, voffB); PG8_STAGE(PG8_SA(1, 0), a3, voffA);
            PG8_WAIT_V(8); PG8_WAIT_L(0); PG8_BAR; PG8_MMA(1, 0, At, B0); PG8_MMA(1, 1, At, B1); PG8_BAR; PG8_SCHED;
        }
        if constexpr (ALIGN_EPI) { if (wr == 0) PG8_BAR; }
        E(acc, cur, wr, wc, fr, fq);
        if (!has_next) break;
        if (E.zero_after(cur)) {
#pragma unroll
            for (int a = 0; a < 2; ++a)
#pragma unroll
                for (int b = 0; b < 2; ++b)
#pragma unroll
                    for (int m = 0; m < 4; ++m)
#pragma unroll
                        for (int n = 0; n < 2; ++n) acc[a][b][m][n] = (f32x4){0.f, 0.f, 0.f, 0.f};
        }
        cur = nxt; cA = nA; cB = nB; ++ui;
        if constexpr (ALIGN_EPI) { if (wr == 1) PG8_BAR; }
    }
    PG8_WAIT_V(0);
    if constexpr (!ALIGN_EPI) { if (wr == 0) PG8_BAR; }
    PG8_BAR;
#undef PG8_SA
#undef PG8_SB
#undef PG8_STAGE
#undef PG8_LDA
#undef PG8_LDB
#undef PG8_MMA
#undef PG8_WAIT_V
#undef PG8_WAIT_L
#undef PG8_BAR
#undef PG8_SCHED
}
}

__device__ __forceinline__ int crow(int r, int hi) { return (r & 3) + 8 * (r >> 2) + 4 * hi; }
__device__ __forceinline__ s16x4 vtr(const LAS uchar* p) { return __builtin_bit_cast(s16x4, __builtin_amdgcn_ds_read_tr16_b64_v4i16((LAS s16x4*)p)); }
__device__ __forceinline__ float xhalf_max(float m) { auto rr = __builtin_amdgcn_permlane32_swap(__builtin_bit_cast(unsigned, m), __builtin_bit_cast(unsigned, m), false, false); return fmaxf(__builtin_bit_cast(float, rr[0]), __builtin_bit_cast(float, rr[1])); }
__device__ __forceinline__ float xhalf_sum(float m) { auto rr = __builtin_amdgcn_permlane32_swap(__builtin_bit_cast(unsigned, m), __builtin_bit_cast(unsigned, m), false, false); return __builtin_bit_cast(float, rr[0]) + __builtin_bit_cast(float, rr[1]); }

__device__ __forceinline__ void glds16(const void* gsrc, unsigned lds_dst) { unsigned keep;
    asm volatile("s_mov_b32 %0, m0\n\ts_mov_b32 m0, %2\n\ts_nop 0\n\tglobal_load_lds_dwordx4 %1, off\n\ts_mov_b32 m0, %0" : "=&s"(keep) : "v"(gsrc), "s"(lds_dst) : "memory"); }
constexpr int ATT_SLOT = 32768, ATT_WSF = 98304;
__device__ __forceinline__ void attn_unit(LAS uchar* lds, const bf16_t* proj, bf16_t* ocat, int bl, int h, int qb, float lam, float laminit, const float* sg) {
    const int tid = tid_fresh(), lane = tid & 63, r32 = lane & 31, hi = lane >> 5;
    const int wave = __builtin_amdgcn_readfirstlane(tid >> 6), mi = wave >> 2, rb = wave & 3;
    const size_t rowbase = (size_t)bl * SEQ;
    const int q0 = qb * 128 + rb * 32;
    const float m2 = exp2f(-2.f * (float)(h + 1)) * LOG2E;
    bf16x8 qf[4];
    { const bf16_t* qp = proj + (rowbase + q0 + r32) * LDP + CQ + h * 128 + mi * 64 + hi * 8;
#pragma unroll
      for (int d0 = 0; d0 < 4; ++d0) qf[d0] = *(const bf16x8*)(qp + d0 * 16); }
    const bf16_t* ksrc0 = proj + (rowbase + lane) * LDP + CK + h * 128 + wave * 8;
    const bf16_t* ksrc1 = ksrc0 + 64;
    const bf16_t* vsrc0 = proj + (rowbase + 16 * (wave & 3) + (lane >> 2)) * LDP + CV + h * 128 + (wave >> 2) * 32 + (lane & 3) * 8;
    const bf16_t* vsrc1 = vsrc0 + 64;
    const unsigned lds0 = (unsigned)(uintptr_t)lds + (unsigned)wave * 1024u;
#define ATT_ISSUE(t, sb) do { const size_t go_ = (size_t)(t) * 64 * LDP; const unsigned d_ = (unsigned)__builtin_amdgcn_readfirstlane((int)(lds0 + (unsigned)(sb))); \
        glds16(ksrc0 + go_, d_); glds16(ksrc1 + go_, d_ + 8192u); glds16(vsrc0 + go_, d_ + 16384u); glds16(vsrc1 + go_, d_ + 24576u); } while (0)
    LAS float* wsf = (LAS float*)(lds + ATT_WSF) + wave * 64;
    f32x16 o[4];
#pragma unroll
    for (int d = 0; d < 4; ++d)
#pragma unroll
        for (int r = 0; r < 16; ++r) o[d][r] = 0.f;
    float mhat = 0.f;
    f32x16 ol;
#pragma unroll
    for (int r = 0; r < 16; ++r) ol[r] = 0.f;
    const bf16x8 ones = (bf16x8){0x3F80, 0x3F80, 0x3F80, 0x3F80, 0x3F80, 0x3F80, 0x3F80, 0x3F80};
    const int kfo = (mi * 8 + hi) * 1024 + r32 * 16;
    const int vfo = 16384 + ((lane >> 4) & 1) * 32 + (lane & 3) * 8 + (4 * hi + ((lane & 15) >> 2)) * 64;
    ATT_ISSUE(0, 0); ATT_ISSUE(1, ATT_SLOT);
    int slot_c = 0, slot_n = 2 * ATT_SLOT;
    for (int t = 0; t < SEQ / 64; ++t) {
        if (t + 1 < SEQ / 64) asm volatile("s_waitcnt vmcnt(4) lgkmcnt(0)" ::: "memory"); else asm volatile("s_waitcnt vmcnt(0) lgkmcnt(0)" ::: "memory");
        __builtin_amdgcn_s_barrier();
        asm volatile("" ::: "memory");
        if (t + 2 < SEQ / 64) ATT_ISSUE(t + 2, slot_n);
        const LAS uchar* sl = lds + slot_c;
        { const int nx = slot_c + ATT_SLOT; slot_n = slot_c; slot_c = (nx == 3 * ATT_SLOT) ? 0 : nx; }
        const float dq = (float)(q0 + r32 - 64 * t - 4 * hi);
        f32x16 p0, p1;
#pragma unroll
        for (int r = 0; r < 16; ++r) { const float kc = (float)((r & 3) + 8 * (r >> 2));
            p0[r] = __builtin_fmaf(-m2, __builtin_fabsf(dq - kc), -mhat); p1[r] = __builtin_fmaf(-m2, __builtin_fabsf(dq - kc - 32.f), -mhat); }
#pragma unroll
        for (int d0 = 0; d0 < 4; ++d0) {
            const bf16x8 a0 = *(const LAS bf16x8*)(sl + kfo + d0 * 2048), a1 = *(const LAS bf16x8*)(sl + kfo + d0 * 2048 + 512);
            p0 = __builtin_amdgcn_mfma_f32_32x32x16_bf16(a0, qf[d0], p0, 0, 0, 0);
            p1 = __builtin_amdgcn_mfma_f32_32x32x16_bf16(a1, qf[d0], p1, 0, 0, 0); }
        float rm = fmaxf(p0[0], p1[0]);
#pragma unroll
        for (int r = 1; r < 16; ++r) rm = fmaxf(rm, fmaxf(p0[r], p1[r]));
        rm = xhalf_max(rm);
        const bool first = (t == 0);
        if (first || __any(rm > 8.f)) {
            const float dl = first ? rm : fmaxf(rm, 0.f);
            mhat += dl;
#pragma unroll
            for (int r = 0; r < 16; ++r) { p0[r] -= dl; p1[r] -= dl; }
            if (!first) {
                const float f = __builtin_amdgcn_exp2f(-dl);
                if (hi == 0) wsf[r32] = f;
                float fr_[16];
#pragma unroll
                for (int r = 0; r < 16; ++r) fr_[r] = wsf[crow(r, hi)];
#pragma unroll
                for (int d = 0; d < 4; ++d)
#pragma unroll
                    for (int r = 0; r < 16; ++r) o[d][r] *= fr_[r];
#pragma unroll
                for (int r = 0; r < 16; ++r) ol[r] *= fr_[r];
            }
        }
#pragma unroll
        for (int r = 0; r < 16; ++r) { p0[r] = __builtin_amdgcn_exp2f(p0[r]); p1[r] = __builtin_amdgcn_exp2f(p1[r]); }
        u32x4 pw[4];
#pragma unroll
        for (int j = 0; j < 4; ++j) { pw[0][j] = cvt_pk_bf16(p0[2 * j], p0[2 * j + 1]); pw[1][j] = cvt_pk_bf16(p0[8 + 2 * j], p0[8 + 2 * j + 1]);
                                      pw[2][j] = cvt_pk_bf16(p1[2 * j], p1[2 * j + 1]); pw[3][j] = cvt_pk_bf16(p1[8 + 2 * j], p1[8 + 2 * j + 1]); }
#pragma unroll
        for (int d = 0; d < 4; ++d)
#pragma unroll
            for (int ks = 0; ks < 4; ++ks) {
                const s16x4 lo = vtr(sl + vfo + d * 4096 + ks * 1024), hh = vtr(sl + vfo + d * 4096 + ks * 1024 + 512);
                const bf16x8 vf = (bf16x8){lo[0], lo[1], lo[2], lo[3], hh[0], hh[1], hh[2], hh[3]};
                o[d] = __builtin_amdgcn_mfma_f32_32x32x16_bf16(__builtin_bit_cast(bf16x8, pw[ks]), vf, o[d], 0, 0, 0); }
#pragma unroll
        for (int ks = 0; ks < 4; ++ks) ol = __builtin_amdgcn_mfma_f32_32x32x16_bf16(__builtin_bit_cast(bf16x8, pw[ks]), ones, ol, 0, 0, 0);
    }
#undef ATT_ISSUE
    float fr_[16];
#pragma unroll
    for (int r = 0; r < 16; ++r) fr_[r] = (mi == 0 ? 1.f : lam) / ol[r];
    __syncthreads();
    LAS float* X = (LAS float*)lds + rb * 4096;
    if (mi == 1) {
#pragma unroll
        for (int d = 0; d < 4; ++d)
#pragma unroll
            for (int r = 0; r < 16; ++r) X[(d * 16 + r) * 64 + lane] = o[d][r] * fr_[r];
    }
    __syncthreads();
    if (mi == 0) {
        float ss[16];
#pragma unroll
        for (int r = 0; r < 16; ++r) ss[r] = 0.f;
#pragma unroll
        for (int d = 0; d < 4; ++d)
#pragma unroll
            for (int r = 0; r < 16; ++r) { const float v = o[d][r] * fr_[r] - X[(d * 16 + r) * 64 + lane]; o[d][r] = v; ss[r] += v * v; }
#pragma unroll
        for (int r = 0; r < 16; ++r) {
#pragma unroll
            for (int s = 1; s < 32; s <<= 1) ss[r] += __shfl_xor(ss[r], s);
            ss[r] = rsqrtf(ss[r] * (1.f / 128.f) + EPS) * (1.f - laminit); }
        float gv[4];
#pragma unroll
        for (int d = 0; d < 4; ++d) gv[d] = sg[d * 32 + r32];
#pragma unroll
        for (int r = 0; r < 16; ++r) { bf16_t* op = ocat + (rowbase + q0 + crow(r, hi)) * D + h * 128 + r32;
#pragma unroll
            for (int d = 0; d < 4; ++d) op[d * 32] = (bf16_t)f2bf(o[d][r] * ss[r] * gv[d]); }
    }
    __syncthreads();
}

template <int DK, bool HG>
__device__ __forceinline__ void scan_item(LAS uchar* lds, const bf16_t* proj, float* oraw0, float* oraw1, bf16_t* ocat, unsigned* done, int bl, int h, int dir, const float* lb  ,
                                          const float* normg  , const float* w2  , const float* gbias  ) {
    constexpr int KPW = DK / 8, TB = 32, NS = TB / 16, NR = TB / 8, GS = 4;
    LAS float* sA = (LAS float*)lds;
    LAS float* sK = sA + TB * DK;
    LAS float* sQ = sK + TB * DK;
    LAS float* sV = sQ + TB * DK;
    LAS float* sP = sV + TB * 64;
    const int tid = tid_fresh(), lane = tid & 63, wave = __builtin_amdgcn_readfirstlane(tid >> 6);
    const int ps = tid >> 5, pi = tid & 31;
    const size_t rowbase = (size_t)bl * SEQ;
    float* oraw = dir == 0 ? oraw0 : oraw1;
    __syncthreads();
    {
        float lb0 = 0.f, lb1 = 0.f, w2c[16], bias = 0.f;
        if (HG) { lb0 = lb[dir * 256 + h * 64 + pi]; lb1 = lb[dir * 256 + h * 64 + pi + 32]; }
        else {
#pragma unroll
            for (int r = 0; r < 16; ++r) w2c[r] = w2[(dir * 16 + r) * 128 + h * 32 + pi];
            bias = gbias[dir * 128 + h * 32 + pi]; }
        f32x2 S[KPW / 2];
#pragma unroll
        for (int j = 0; j < KPW / 2; ++j) S[j] = (f32x2){0.f, 0.f};
        bf16_t rz0[NS], rz1[NS], rq0[NS], rq1[NS], rv0[NS], rv1[NS], rk0[NS]; u32x4 rl0[NS], rl1[NS];
#pragma unroll
        for (int i = 0; i < NS; ++i) { rz0[i] = rz1[i] = rq0[i] = rq1[i] = rv0[i] = rv1[i] = rk0[i] = 0; rl0[i] = rl1[i] = (u32x4){0, 0, 0, 0}; }
#define SCAN_LOAD(blk) do { _Pragma("unroll") for (int i_ = 0; i_ < NS; ++i_) { const int st_ = (blk) * TB + ps + 16 * i_; const int tok_ = dir == 0 ? st_ : 2047 - st_; const bf16_t* pr_ = proj + (rowbase + tok_) * LDP; \
        if (HG) { const int zc_ = (dir == 0 ? BFF : BFB) + h * 64 + pi; rz0[i_] = pr_[zc_]; rz1[i_] = pr_[zc_ + 32]; rq0[i_] = pr_[BQ + h * 64 + pi]; rq1[i_] = pr_[BQ + h * 64 + pi + 32]; rv0[i_] = pr_[BI + h * 64 + pi]; rv1[i_] = pr_[BI + h * 64 + pi + 32]; } \
        else { const u32x4* lp_ = (const u32x4*)(pr_ + (dir == 0 ? GLF : GLB)); rl0[i_] = lp_[0]; rl1[i_] = lp_[1]; rk0[i_] = pr_[GK + h * 32 + pi]; rq0[i_] = pr_[GQ + h * 32 + pi]; rv0[i_] = pr_[GV + h * 64 + pi]; rv1[i_] = pr_[GV + h * 64 + pi + 32]; } } } while (0)
        SCAN_LOAD(0);
        for (int blk = 0; blk < SEQ / TB; ++blk) {
#pragma unroll
            for (int i = 0; i < NS; ++i) {
                const int st = ps + 16 * i;
                if (HG) {
                    const float z0 = bf2f(rz0[i]), z1 = bf2f(rz1[i]);
                    const float s0 = __builtin_amdgcn_rcpf(1.f + __expf(-z0)), s1 = __builtin_amdgcn_rcpf(1.f + __expf(-z1));
                    sA[st * 64 + pi] = s0 * (1.f + lb0 * __expf(fminf(-z0, 80.f))); sA[st * 64 + pi + 32] = s1 * (1.f + lb1 * __expf(fminf(-z1, 80.f)));
                    sK[st * 64 + pi] = (1.f - lb0) * __builtin_amdgcn_rcpf(1.f + __expf(z0)); sK[st * 64 + pi + 32] = (1.f - lb1) * __builtin_amdgcn_rcpf(1.f + __expf(z1));
                    const float q0 = bf2f(rq0[i]), q1 = bf2f(rq1[i]);
                    sQ[st * 64 + pi] = q0 * __builtin_amdgcn_rcpf(1.f + __expf(-q0)) * 0.125f; sQ[st * 64 + pi + 32] = q1 * __builtin_amdgcn_rcpf(1.f + __expf(-q1)) * 0.125f;
                } else {
                    float z = bias;
#pragma unroll
                    for (int j = 0; j < 4; ++j) { z += bflo(rl0[i][j]) * w2c[2 * j] + bfhi(rl0[i][j]) * w2c[2 * j + 1]; z += bflo(rl1[i][j]) * w2c[8 + 2 * j] + bfhi(rl1[i][j]) * w2c[8 + 2 * j + 1]; }
                    const float ls = fminf(z, 0.f) - __logf(1.f + __expf(-fabsf(z)));
                    sA[st * 32 + pi] = __expf(ls * (1.f / 16.f));
                    sK[st * 32 + pi] = bf2f(rk0[i]);
                    sQ[st * 32 + pi] = bf2f(rq0[i]) * 0.17677669529663687f;
                }
                sV[st * 64 + pi] = bf2f(rv0[i]); sV[st * 64 + pi + 32] = bf2f(rv1[i]);
            }
            __syncthreads();
            if (blk + 1 < SEQ / TB) SCAN_LOAD(blk + 1);
            for (int s0_ = 0; s0_ < TB; s0_ += GS) {
                float vv[GS]; f32x4 a4[GS][KPW / 4], k4[GS][KPW / 4], q4[GS][KPW / 4];
#pragma unroll
                for (int g = 0; g < GS; ++g) { const int s = s0_ + g; vv[g] = sV[s * 64 + lane];
#pragma unroll
                    for (int j4 = 0; j4 < KPW / 4; ++j4) { a4[g][j4] = *(const LAS f32x4*)(sA + s * DK + wave * KPW + j4 * 4); k4[g][j4] = *(const LAS f32x4*)(sK + s * DK + wave * KPW + j4 * 4); q4[g][j4] = *(const LAS f32x4*)(sQ + s * DK + wave * KPW + j4 * 4); } }
                float po[GS];
#pragma unroll
                for (int g = 0; g < GS; ++g) {
                    f32x2 op = (f32x2){0.f, 0.f};
#pragma unroll
                    for (int j4 = 0; j4 < KPW / 4; ++j4) {
                        const f32x2 kv0 = (f32x2){k4[g][j4][0], k4[g][j4][1]} * vv[g], kv1 = (f32x2){k4[g][j4][2], k4[g][j4][3]} * vv[g];
                        S[2 * j4] = __builtin_elementwise_fma((f32x2){a4[g][j4][0], a4[g][j4][1]}, S[2 * j4], kv0);
                        S[2 * j4 + 1] = __builtin_elementwise_fma((f32x2){a4[g][j4][2], a4[g][j4][3]}, S[2 * j4 + 1], kv1);
                        op = __builtin_elementwise_fma((f32x2){q4[g][j4][0], q4[g][j4][1]}, S[2 * j4], op);
                        op = __builtin_elementwise_fma((f32x2){q4[g][j4][2], q4[g][j4][3]}, S[2 * j4 + 1], op); }
                    po[g] = op[0] + op[1]; }
#pragma unroll
                for (int g = 0; g < GS; ++g) sP[((s0_ + g) * 8 + wave) * 64 + lane] = po[g];
            }
            __syncthreads();
#pragma unroll
            for (int j2 = 0; j2 < NR; ++j2) {
                const int s = wave + 8 * j2; const int tok = dir == 0 ? blk * TB + s : 2047 - (blk * TB + s);
                float sum = 0.f;
#pragma unroll
                for (int w = 0; w < 8; ++w) sum += sP[(s * 8 + w) * 64 + lane];
                oraw[(rowbase + tok) * 512 + (HG ? 0 : 256) + h * 64 + lane] = sum;
            }
        }
#undef SCAN_LOAD
    }
    asm volatile("s_waitcnt vmcnt(0)" ::: "memory");
    __syncthreads();
    LAS unsigned* flg = (LAS unsigned*)(lds + 147456 - 128);
    if (tid == 0) { __builtin_amdgcn_fence(__ATOMIC_RELEASE, "agent"); asm volatile("s_waitcnt vmcnt(0)" ::: "memory");
        const unsigned old = __hip_atomic_fetch_add(done, 1u, __ATOMIC_RELAXED, __HIP_MEMORY_SCOPE_AGENT);
        __builtin_amdgcn_fence(__ATOMIC_ACQUIRE, "agent"); asm volatile("s_waitcnt vmcnt(0)" ::: "memory");
        flg[0] = old; }
    __syncthreads();
    if (flg[0] == 1u) {
        if (lane == 0 && tid != 0) { __builtin_amdgcn_fence(__ATOMIC_ACQUIRE, "agent"); asm volatile("s_waitcnt vmcnt(0)" ::: "memory"); }
        __syncthreads();
        const float ng = normg[lane];
        for (int t = wave; t < SEQ; t += 8) {
            const size_t o = (rowbase + t) * 512 + (HG ? 0 : 256) + h * 64 + lane;
            const float tot = __hip_atomic_load(oraw0 + o, __ATOMIC_RELAXED, __HIP_MEMORY_SCOPE_AGENT) + __hip_atomic_load(oraw1 + o, __ATOMIC_RELAXED, __HIP_MEMORY_SCOPE_AGENT);
            const float ssq = wave_sum(tot * tot);
            const float gvv = bf2f(proj[(rowbase + t) * LDP + (HG ? BG : GG) + h * 64 + lane]);
            const float outv = tot * rsqrtf(ssq * (1.f / 64.f) + EPS) * ng * (gvv * __builtin_amdgcn_rcpf(1.f + __expf(-gvv)));
            ocat[(rowbase + t) * D + (HG ? 512 : 768) + h * 64 + lane] = (bf16_t)f2bf(outv);
        }
    }
    __syncthreads();
}

__device__ __forceinline__ void norm_rows_mod(const float* src, bf16_t* dst, const float* g, const float* modl  , int grow0, int shoff, int scoff) {
    const int tid = tid_fresh(), lane = tid & 63, gw = blockIdx.x * 8 + __builtin_amdgcn_readfirstlane(tid >> 6), NGW = gridDim.x * 8;
    for (int m = gw; m < TG; m += NGW) {
        const int b = (grow0 + m) >> 11;
        const f32x4* xr = (const f32x4*)(src + (size_t)m * D) + lane;
        const f32x4* gr = (const f32x4*)g + lane; const f32x4* sh = (const f32x4*)(modl + (size_t)b * (NMOD * D) + shoff) + lane; const f32x4* sc = (const f32x4*)(modl + (size_t)b * (NMOD * D) + scoff) + lane;
        f32x4 v[4]; float s = 0.f;
#pragma unroll
        for (int j = 0; j < 4; ++j) { v[j] = xr[64 * j]; s += (v[j].x * v[j].x + v[j].y * v[j].y) + (v[j].z * v[j].z + v[j].w * v[j].w); }
        const float r = rsqrtf(wave_sum(s) * (1.f / D) + EPS);
        unsigned long long* o8 = (unsigned long long*)(dst + (size_t)m * D) + lane;
#pragma unroll
        for (int j = 0; j < 4; ++j) { const f32x4 y = v[j] * r * gr[64 * j] * (1.f + sc[64 * j]) + sh[64 * j];
            o8[64 * j] = (unsigned long long)pk2(y.x, y.y) | ((unsigned long long)pk2(y.z, y.w) << 32); }
    }
}
__device__ __forceinline__ void norm_rows_final(float* x, const float* g) {
    const int tid = tid_fresh(), lane = tid & 63, gw = blockIdx.x * 8 + __builtin_amdgcn_readfirstlane(tid >> 6), NGW = gridDim.x * 8;
    for (int m = gw; m < TG; m += NGW) {
        f32x4* xr = (f32x4*)(x + (size_t)m * D) + lane; const f32x4* gr = (const f32x4*)g + lane;
        f32x4 v[4]; float s = 0.f;
#pragma unroll
        for (int j = 0; j < 4; ++j) { v[j] = xr[64 * j]; s += (v[j].x * v[j].x + v[j].y * v[j].y) + (v[j].z * v[j].z + v[j].w * v[j].w); }
        const float r = rsqrtf(wave_sum(s) * (1.f / D) + EPS);
#pragma unroll
        for (int j = 0; j < 4; ++j) xr[64 * j] = v[j] * r * gr[64 * j];
    }
}

__device__ __forceinline__ void transpose_item(const float* W, int ldw, bf16_t* WT, int ldt, int row_off, int k_off, LAS float* scr, int kb, int nb, int lane) {
    const int k0 = 64 * kb, n0 = 32 * nb;
#pragma unroll 8
    for (int i = 0; i < 32; ++i) { const int kk = 2 * i + (lane >> 5); scr[kk * 33 + (lane & 31)] = W[(size_t)(k0 + kk) * ldw + n0 + (lane & 31)]; }
    asm volatile("s_waitcnt lgkmcnt(0)" ::: "memory");
    const int c = lane & 7;
#pragma unroll
    for (int j = 0; j < 4; ++j) { const int n = (lane >> 3) + 8 * j; const LAS float* s = scr + (8 * c) * 33 + n;
        u32x4 o; o.x = pk2(s[0 * 33], s[1 * 33]); o.y = pk2(s[2 * 33], s[3 * 33]); o.z = pk2(s[4 * 33], s[5 * 33]); o.w = pk2(s[6 * 33], s[7 * 33]);
        *(u32x4*)(WT + (size_t)(row_off + n0 + n) * ldt + k_off + k0 + 8 * c) = o; }
    asm volatile("s_waitcnt lgkmcnt(0)" ::: "memory");
}

#define XB_TMO      128
#define XB_XCNT(j)  (256  + 64 * (j))
#define XB_XSUB(j)  (1280 + 64 * (j))
#define XB_XGEN(j)  (2304 + 64 * (j))
#define XB_TOP      3328
#define XB_TOPGEN   3392
#define XCD_BAR_WORDS 3456
#define XB_SPIN_CAP (1u << 18)

__device__ __forceinline__ unsigned xb_ld(unsigned* p)              { return __hip_atomic_load(p, __ATOMIC_RELAXED, __HIP_MEMORY_SCOPE_AGENT); }
__device__ __forceinline__ unsigned xb_add(unsigned* p, unsigned v) { return __hip_atomic_fetch_add(p, v, __ATOMIC_RELAXED, __HIP_MEMORY_SCOPE_AGENT); }
__device__ __forceinline__ unsigned xb_xcc_id() { return (unsigned)__builtin_amdgcn_s_getreg((3 << 11) | 20) & 0xFu; }
#define XB_SPIN(cond, bar) do { unsigned _sp = 0; while (cond) { __builtin_amdgcn_s_sleep(1); \
    if ((++_sp & 255u) == 0u) { if (xb_ld(&(bar)[XB_TMO])) break; if (_sp > XB_SPIN_CAP) { atomicAdd(&(bar)[XB_TMO], 1u); break; } } } } while (0)

struct XcdBarrier {
    unsigned* bar; unsigned x;
    volatile LAS unsigned* st;
};

__device__ __forceinline__ XcdBarrier xcd_barrier_post(unsigned* bar, volatile LAS unsigned* st) {
    XcdBarrier b; b.bar = bar; b.x = xb_xcc_id(); b.st = st;
    if (threadIdx.x == 0) (void)xb_add(&bar[XB_XCNT(b.x)], 1u);
    return b;
}
__device__ __forceinline__ void xcd_barrier_complete(unsigned* bar, unsigned x, unsigned& nloc, unsigned& nx) {
    const unsigned G = gridDim.x * gridDim.y * gridDim.z;
    unsigned sum, cnt, mine, sp = 0u;
    for (;;) {
        sum = 0u; cnt = 0u; mine = 0u;
#pragma unroll
        for (unsigned j = 0; j < 16; ++j) { const unsigned c = xb_ld(&bar[XB_XCNT(j)]); sum += c; cnt += (c > 0u) ? 1u : 0u; mine = (j == x) ? c : mine; }
        if (sum == G) break;
        __builtin_amdgcn_s_sleep(1);
        if ((++sp & 255u) == 0u) { if (xb_ld(&bar[XB_TMO])) break; if (sp > XB_SPIN_CAP) { atomicAdd(&bar[XB_TMO], 1u); break; } }
    }
    nloc = mine > 0u ? mine : 1u; nx = cnt > 0u ? cnt : 1u;
}

__device__ __forceinline__ void xcd_barrier(const XcdBarrier& b) {
    asm volatile("s_waitcnt vmcnt(0)" ::: "memory");
    __syncthreads();
    if (threadIdx.x == 0) {
        unsigned* bar = b.bar;
        __builtin_amdgcn_s_waitcnt(0);
        unsigned nloc = b.st[0], nx = b.st[1];
        if (nloc == 0u) { xcd_barrier_complete(bar, b.x, nloc, nx); b.st[0] = nloc; b.st[1] = nx; }
        const unsigned old = xb_add(&bar[XB_XSUB(b.x)], 1u);
        const unsigned gen = old / nloc;
        if (old + 1u == (gen + 1u) * nloc) {
            __builtin_amdgcn_fence(__ATOMIC_RELEASE, "agent");
            asm volatile("s_waitcnt vmcnt(0)" ::: "memory");
            const unsigned og = xb_add(&bar[XB_TOP], 1u);
            const unsigned tg = og / nx;
            if (og + 1u == (tg + 1u) * nx) xb_add(&bar[XB_TOPGEN], 1u);
            else XB_SPIN(xb_ld(&bar[XB_TOPGEN]) == tg, bar);
            __builtin_amdgcn_fence(__ATOMIC_ACQUIRE, "agent");
            xb_add(&bar[XB_XGEN(b.x)], 1u);
            asm volatile("s_waitcnt vmcnt(0)" ::: "memory");
        } else {
            XB_SPIN(xb_ld(&bar[XB_XGEN(b.x)]) == gen, bar);
            __builtin_amdgcn_fence(__ATOMIC_ACQUIRE, "agent");
            asm volatile("s_waitcnt vmcnt(0)" ::: "memory");
        }
    }
    __syncthreads();
}


constexpr int CW_XBAR = 45056;
#define XSYNC() do { XcdBarrier xb_; xb_.bar = (unsigned*)(KWS() + WS_CTL) + CW_XBAR; xb_.x = xb_xcc_id(); xb_.st = (volatile LAS unsigned*)(lds + 147456 - 256); xcd_barrier(xb_); } while (0)

struct Args { const void* p[24]; };
enum { P_X = 0, P_C, P_ADAW, P_ADAB, P_NMIXG, P_NMLPG, P_WIN, P_DLAM, P_DSUBG, P_HLB, P_HNG, P_GW2, P_GB, P_GNG, P_WUA, P_WUB, P_WUC, P_WOUT, P_W1, P_W2, P_FNG, P_OUT, P_WS };
typedef const unsigned long long __attribute__((address_space(4)))* kargp_t;
__device__ __forceinline__ const void* karg(int i) { kargp_t kp = (kargp_t)__builtin_amdgcn_kernarg_segment_ptr(); asm volatile("" : "+s"(kp));
    const unsigned long long v = kp[i]; const __attribute__((address_space(1))) void* g = (const __attribute__((address_space(1))) void*)v; return (const void*)g; }
#define GRID_SYNC() do { asm volatile("s_waitcnt vmcnt(0) lgkmcnt(0)" ::: "memory"); __syncthreads(); grid.sync(); \
    if (threadIdx.x < 64) { __builtin_amdgcn_fence(__ATOMIC_ACQUIRE, "agent"); asm volatile("s_waitcnt vmcnt(0)" ::: "memory"); } __syncthreads(); } while (0)
#define KF(i) ((const float*)karg(i))
#define KWS() ((uchar*)karg(P_WS))

__global__ void __launch_bounds__(512, 2) fwd_megakernel(Args a_unused) {
    extern __shared__ __attribute__((aligned(16))) uchar lds_raw[];
    LAS uchar* lds = (LAS uchar*)lds_raw;
    cg::grid_group grid = cg::this_grid();
    {
    const int tid = tid_fresh(), lane = tid & 63, wave = __builtin_amdgcn_readfirstlane(tid >> 6);

    if (blockIdx.x == 0) {
        unsigned* ctl = (unsigned*)(KWS() + WS_CTL); float* ctlf = (float*)ctl;
        for (int i = tid; i < 1024; i += 512) { ctl[i] = 0u; ctl[40960 + i] = 0u; }
        for (int i = tid; i < XCD_BAR_WORDS; i += 512) ctl[CW_XBAR + i] = 0u;
        if (tid < 4) {
            const float* lp = KF(P_DLAM) + tid * 256; float s1 = 0.f, s2 = 0.f;
            for (int d = 0; d < 64; ++d) { s1 += lp[d] * lp[64 + d]; s2 += lp[128 + d] * lp[192 + d]; }
            const float li = 0.8f - 0.6f * expf(-0.3f * (float)tid);
            ctlf[1024 + tid] = expf(s1) - expf(s2) + li; ctlf[1028 + tid] = li;
        }
        {
            const float* lg = KF(P_HLB); const int j = tid;
            float v[4], mx = -1e30f;
#pragma unroll
            for (int l = 0; l < 4; ++l) { v[l] = lg[l * 512 + j]; mx = fmaxf(mx, v[l]); }
            float den = 0.f;
#pragma unroll
            for (int l = 0; l < 4; ++l) { v[l] = expf(v[l] - mx); den += v[l]; }
            float cum = 0.f; const float w0 = v[0] / den;
#pragma unroll
            for (int l = 0; l < 4; ++l) { cum += v[l] / den; ctlf[2048 + l * 512 + j] = cum - w0; }
        }
        {
            float* pv = ctlf + 8192;
            const float* s0 = KF(P_NMIXG); for (int i = tid; i < 4096; i += 512) pv[i] = s0[i];
            const float* s1 = KF(P_NMLPG); for (int i = tid; i < 4096; i += 512) pv[4096 + i] = s1[i];
            const float* s2 = KF(P_DSUBG); for (int i = tid; i < 512; i += 512) pv[8192 + i] = s2[i];
            const float* s3 = KF(P_HNG); for (int i = tid; i < 256; i += 512) pv[8704 + i] = s3[i];
            const float* s4 = KF(P_GW2); for (int i = tid; i < 16384; i += 512) pv[8960 + i] = s4[i];
            const float* s5 = KF(P_GB); for (int i = tid; i < 1024; i += 512) pv[25344 + i] = s5[i];
            const float* s6 = KF(P_GNG); for (int i = tid; i < 256; i += 512) pv[26368 + i] = s6[i];
            const float* s7 = KF(P_FNG); for (int i = tid; i < 1024; i += 512) pv[26624 + i] = s7[i];
        }
    }
#ifndef NO_MOD
    {
        LAS float* cond = (LAS float*)lds; LAS float* red = (LAS float*)(lds + 131072);
        float* mod = (float*)(KWS() + WS_MOD);
        const float* cin = KF(P_C); const float* adaw = KF(P_ADAW); const float* adab = KF(P_ADAB);
        bool loaded = false;
        for (int it = blockIdx.x; it < 4 * 96; it += gridDim.x) {
            if (!loaded) { for (int i = tid; i < 32 * 1024; i += 512) { const float cv = cin[i]; cond[i] = cv / (1.f + __expf(-cv)); } loaded = true; __syncthreads(); }
            const int l = it / 96, n0 = (it % 96) * 64;
            const float* W = adaw + (size_t)l * D * (NMOD * D) + n0 + lane;
            float acc[32];
#pragma unroll
            for (int b = 0; b < 32; ++b) acc[b] = 0.f;
            for (int k4 = 0; k4 < 32; ++k4) {
                const int k = wave * 128 + k4 * 4;
                const float w0 = W[(size_t)k * (NMOD * D)], w1 = W[(size_t)(k + 1) * (NMOD * D)], w2v = W[(size_t)(k + 2) * (NMOD * D)], w3 = W[(size_t)(k + 3) * (NMOD * D)];
#pragma unroll
                for (int b = 0; b < 32; ++b) { const f32x4 c4 = *(const LAS f32x4*)(cond + b * 1024 + k); acc[b] += c4.x * w0 + c4.y * w1 + c4.z * w2v + c4.w * w3; }
            }
#pragma unroll
            for (int rd = 0; rd < 4; ++rd) {
                __syncthreads();
#pragma unroll
                for (int bb = 0; bb < 8; ++bb) red[(wave * 8 + bb) * 64 + lane] = acc[rd * 8 + bb];
                __syncthreads();
                float s = 0.f;
#pragma unroll
                for (int w = 0; w < 8; ++w) s += red[(w * 8 + wave) * 64 + lane];
                const int b = rd * 8 + wave;
                mod[((size_t)l * 32 + b) * (NMOD * D) + n0 + lane] = s + adab[l * (NMOD * D) + n0 + lane];
            }
        }
        __syncthreads();
    }
#endif
#ifndef NO_WT
    {
        LAS float* scr = (LAS float*)(lds + wave * 8704);
        const int gw = blockIdx.x * 8 + wave, NGW = gridDim.x * 8;
        uchar* ws = KWS();
        bf16_t* win_t = (bf16_t*)(ws + WS_WIN); bf16_t* wup_t = (bf16_t*)(ws + WS_WUP); bf16_t* wout_t = (bf16_t*)(ws + WS_WOUT);
        bf16_t* w1_t = (bf16_t*)(ws + WS_W1); bf16_t* w2_t = (bf16_t*)(ws + WS_W2);
        constexpr int I_IN = 16 * 209, I_UA = 8 * 32, I_UB = 4 * 32, I_UC = 4 * 32, I_O = 16 * 32, I_1 = 16 * 128, I_2 = 64 * 32;
        constexpr int I_L = I_IN + I_UA + I_UB + I_UC + I_O + I_1 + I_2;
        for (int it = gw; it < 4 * I_L; it += NGW) {
            const int l = it / I_L; int r = it % I_L;
            if (r < I_IN) { transpose_item(KF(P_WIN) + (size_t)l * D * DIN, DIN, win_t + (size_t)l * LDP * D, D, 0, 0, scr, r / 209, r % 209, lane); continue; } r -= I_IN;
            if (r < I_UA) { transpose_item(KF(P_WUA) + (size_t)l * 512 * D, D, wup_t + (size_t)l * D * D, D, 0, 0, scr, r / 32, r % 32, lane); continue; } r -= I_UA;
            if (r < I_UB) { transpose_item(KF(P_WUB) + (size_t)l * 256 * D, D, wup_t + (size_t)l * D * D, D, 0, 512, scr, r / 32, r % 32, lane); continue; } r -= I_UB;
            if (r < I_UC) { transpose_item(KF(P_WUC) + (size_t)l * 256 * D, D, wup_t + (size_t)l * D * D, D, 0, 768, scr, r / 32, r % 32, lane); continue; } r -= I_UC;
            if (r < I_O) { transpose_item(KF(P_WOUT) + (size_t)l * D * D, D, wout_t + (size_t)l * D * D, D, 0, 0, scr, r / 32, r % 32, lane); continue; } r -= I_O;
            if (r < I_1) { transpose_item(KF(P_W1) + (size_t)l * D * DFF, DFF, w1_t + (size_t)l * DFF * D, D, 0, 0, scr, r / 128, r % 128, lane); continue; } r -= I_1;
            transpose_item(KF(P_W2) + (size_t)l * DFF * D, D, w2_t + (size_t)l * D * DFF, DFF, 0, 0, scr, r / 32, r % 32, lane);
        }
        for (int i = blockIdx.x * 512 + tid; i < 4 * 28672; i += gridDim.x * 512) { const int l = i / 28672, r = i % 28672;
            *(u32x4*)(win_t + (size_t)l * LDP * D + (size_t)DIN * D + (size_t)r * 8) = (u32x4){0u, 0u, 0u, 0u}; }
    }
#endif
    }
    GRID_SYNC();
    if (threadIdx.x < 2) ((LAS unsigned*)(lds + 147456 - 256))[threadIdx.x] = 0u;
    (void)xcd_barrier_post((unsigned*)(KWS() + WS_CTL) + CW_XBAR, (volatile LAS unsigned*)(lds + 147456 - 256));

    for (int grp = 0; grp < NGRP; ++grp) {
        for (int l = 0; l < DEPTH; ++l) {
            {
                uchar* ws = KWS(); const float* pv = (const float*)(ws + WS_CTL) + 8192;
                const float* src = (l == 0 ? KF(P_X) : (const float*)karg(P_OUT)) + (size_t)grp * TG * D;
                norm_rows_mod(src, (bf16_t*)(ws + WS_HB), pv + l * D, (const float*)(ws + WS_MOD) + (size_t)l * 32 * (NMOD * D), grp * TG, 0, D);
            }
            XSYNC();
            { uchar* ws = KWS(); pg8::Gemm g{(const bf16_t*)(ws + WS_HB), (const bf16_t*)(ws + WS_WIN) + (size_t)l * LDP * D, D}; pg8::Order S; S.init(TG, LDP, D, gridDim.x, blockIdx.x, 1); pg8::EpiProj E{(bf16_t*)(ws + WS_PROJ)};
#ifndef NO_EPIPROJ
              pg8::gemm_phase<pg8::EpiProj>(lds, g, S, E);
#endif
            }
            XSYNC();
            {
                uchar* ws = KWS(); const float* ctlf = (const float*)(ws + WS_CTL); const float* pv = ctlf + 8192;
                const int xq = blockIdx.x & 7; unsigned* ctr = (unsigned*)(ws + WS_CTL) + ((grp * DEPTH + l) * 8 + xq) * 4;
                const float lam = ctlf[1024 + l], laminit = ctlf[1028 + l];
                const bf16_t* PROJ = (const bf16_t*)(ws + WS_PROJ); bf16_t* OCAT = (bf16_t*)(ws + WS_OCAT); float* OFWD = (float*)(ws + WS_OFWD);
                LAS int* itm = (LAS int*)(lds + 147456 - 64);
                const int tid = tid_fresh();
                for (;;) {
                    __syncthreads();
                    if (tid == 0) itm[0] = (int)atomicAdd(ctr, 1u);
                    __syncthreads();
                    const int it = itm[0];
                    constexpr int NPQ = GB * 4 / 8;
                    if (it >= 4 * NPQ + NPQ * 16) break;
                    float* OBWD = (float*)(ws + WS_OBWD);
                    if (it < 2 * NPQ) { const int p = (it >> 1) * 8 + xq; unsigned* dn = (unsigned*)(ws + WS_CTL) + 40960 + (((grp * DEPTH + l) * GB * 4 + p) * 2);
                        scan_item<64, true>(lds, PROJ, OFWD, OBWD, OCAT, dn, p >> 2, p & 3, it & 1, ctlf + 2048 + l * 512, pv + 8704 + l * 64, nullptr, nullptr);
                    } else if (it < 4 * NPQ) { const int i2 = it - 2 * NPQ; const int p = (i2 >> 1) * 8 + xq; unsigned* dn = (unsigned*)(ws + WS_CTL) + 40960 + (((grp * DEPTH + l) * GB * 4 + p) * 2 + 1);
                        scan_item<32, false>(lds, PROJ, OFWD, OBWD, OCAT, dn, p >> 2, p & 3, i2 & 1, nullptr, pv + 26368 + l * 64, pv + 8960 + l * 4096, pv + 25344 + l * 256);
                    } else { const int u = it - 4 * NPQ, p = (u >> 4) * 8 + xq;
                        attn_unit(lds, PROJ, OCAT, p >> 2, p & 3, u & 15, lam, laminit, pv + 8192 + l * 128);
                    }
                }
            }
            XSYNC();
            { uchar* ws = KWS(); pg8::Gemm g{(const bf16_t*)(ws + WS_OCAT), (const bf16_t*)(ws + WS_WUP) + (size_t)l * D * D, D}; pg8::Order S; S.init(TG, D, D, gridDim.x, blockIdx.x, 3); pg8::EpiMerge E{(const bf16_t*)(ws + WS_PROJ), (bf16_t*)(ws + WS_HB)};
#ifndef NO_EPIMERGE
              pg8::gemm_phase<pg8::EpiMerge>(lds, g, S, E);
#endif
            }
            XSYNC();
            { uchar* ws = KWS(); pg8::Gemm g{(const bf16_t*)(ws + WS_HB), (const bf16_t*)(ws + WS_WOUT) + (size_t)l * D * D, D}; pg8::Order S; S.init(TG, D, D, gridDim.x, blockIdx.x, 1);
              float* xg = (float*)karg(P_OUT) + (size_t)grp * TG * D;
              pg8::EpiRes E{l == 0 ? KF(P_X) + (size_t)grp * TG * D : xg, xg, (const float*)(ws + WS_MOD) + ((size_t)l * 32 + grp * GB) * (NMOD * D) + 2 * D};
#ifndef NO_EPIRES
              pg8::gemm_phase<pg8::EpiRes>(lds, g, S, E);
#endif
            }
            XSYNC();
            {
                uchar* ws = KWS(); const float* pv = (const float*)(ws + WS_CTL) + 8192;
                norm_rows_mod((const float*)karg(P_OUT) + (size_t)grp * TG * D, (bf16_t*)(ws + WS_HB), pv + 4096 + l * D, (const float*)(ws + WS_MOD) + (size_t)l * 32 * (NMOD * D), grp * TG, 3 * D, 4 * D);
            }
            XSYNC();
            { uchar* ws = KWS(); pg8::Gemm g{(const bf16_t*)(ws + WS_HB), (const bf16_t*)(ws + WS_W1) + (size_t)l * DFF * D, D}; pg8::Order S; S.init(TG, DFF, D, gridDim.x, blockIdx.x, 1); pg8::EpiRelu2 E{(bf16_t*)(ws + WS_U)};
#ifndef NO_EPIRELU2
              pg8::gemm_phase<pg8::EpiRelu2>(lds, g, S, E);
#endif
            }
            XSYNC();
            { uchar* ws = KWS(); pg8::Gemm g{(const bf16_t*)(ws + WS_U), (const bf16_t*)(ws + WS_W2) + (size_t)l * D * DFF, DFF}; pg8::Order S; S.init(TG, D, DFF, gridDim.x, blockIdx.x, 1);
              float* xg = (float*)karg(P_OUT) + (size_t)grp * TG * D;
              pg8::EpiRes E{xg, xg, (const float*)(ws + WS_MOD) + ((size_t)l * 32 + grp * GB) * (NMOD * D) + 5 * D};
#ifndef NO_EPIRES
              pg8::gemm_phase<pg8::EpiRes>(lds, g, S, E);
#endif
            }
            XSYNC();
        }
        norm_rows_final((float*)karg(P_OUT) + (size_t)grp * TG * D, (const float*)(KWS() + WS_CTL) + 8192 + 26624);
    }
}

extern "C" void kernel_launch(void* const* d_in, const int* in_sizes, int n_in, void* d_out, int out_size, void* d_ws, size_t ws_size, hipStream_t stream) {
    static int grid = 0;
    if (grid == 0) {
        if (n_in != 21 || ws_size < WS_END) { fprintf(stderr, "kernel_launch: unexpected n_in %d / ws %zu\n", n_in, ws_size); grid = -1; return; }
        int dev = 0, cus = 0, per_cu = 0;
        if (hipGetDevice(&dev) != hipSuccess || hipDeviceGetAttribute(&cus, hipDeviceAttributeMultiprocessorCount, dev) != hipSuccess) { grid = -1; return; }
        if (hipFuncSetAttribute((const void*)fwd_megakernel, hipFuncAttributeMaxDynamicSharedMemorySize, LDS_BYTES) != hipSuccess) { fprintf(stderr, "kernel_launch: hipFuncSetAttribute failed\n"); grid = -1; return; }
        if (hipOccupancyMaxActiveBlocksPerMultiprocessor(&per_cu, (const void*)fwd_megakernel, 512, LDS_BYTES) != hipSuccess || per_cu < 1) { fprintf(stderr, "kernel_launch: occupancy query says %d\n", per_cu); per_cu = 1; }
        (void)hipGetLastError();
        grid = cus;
    }
    if (grid < 0) return;
    Args a{};
    for (int i = 0; i < 21; ++i) a.p[i] = d_in[i];
    a.p[21] = d_out; a.p[22] = d_ws; a.p[23] = nullptr;
    void* args[] = {&a};
    hipError_t e = hipLaunchCooperativeKernel((void*)fwd_megakernel, dim3(grid), dim3(512), args, LDS_BYTES, stream);
    if (e != hipSuccess) fprintf(stderr, "kernel_launch: cooperative launch failed: %s (grid %d)\n", hipGetErrorString(e), grid);
}
```

```cpp
#include <hip/hip_runtime.h>
#include <hip/hip_cooperative_groups.h>
#include <cstdio>
#include <cstdint>
namespace cg = cooperative_groups;

#define LAS __attribute__((address_space(3)))
typedef unsigned short bf16_t;
typedef short bf16x8 __attribute__((ext_vector_type(8)));
typedef float f32x4 __attribute__((ext_vector_type(4)));
typedef float f32x2 __attribute__((ext_vector_type(2)));
typedef float f32x16 __attribute__((ext_vector_type(16)));
typedef unsigned u32x4 __attribute__((ext_vector_type(4)));
typedef short s16x4 __attribute__((ext_vector_type(4)));
typedef unsigned char uchar;

constexpr int D = 1024, SEQ = 2048, BATCH = 32, DEPTH = 4, DIN = 6688, LDP = 6912, DFF = 4096, NMOD = 6;
constexpr int GB = 16, TG = GB * SEQ, NGRP = BATCH / GB;
constexpr int CQ = 0, CK = 512, CV = 1024, BQ = 1536, BFF = 1792, BFB = 2048, BI = 2304, BG = 2560;
constexpr int GQ = 2816, GK = 2944, GV = 3072, GG = 3328, GLF = 3584, GLB = 3600, GATE = 3616;
constexpr float EPS = 1e-6f, LOG2E = 1.4426950408889634f;
constexpr float QSCALE = 0.125f * LOG2E;

constexpr size_t MiB = 1u << 20;
constexpr size_t WS_CTL = 0;
constexpr size_t WS_MOD = 1 * MiB;
constexpr size_t WS_WIN = 4 * MiB;
constexpr size_t WS_WUP = 58 * MiB;
constexpr size_t WS_WOUT = 66 * MiB;
constexpr size_t WS_W1 = 74 * MiB;
constexpr size_t WS_W2 = 106 * MiB;
constexpr size_t WS_HB = 138 * MiB;
constexpr size_t WS_OCAT = 202 * MiB;
constexpr size_t WS_OFWD = 266 * MiB;
constexpr size_t WS_PROJ = 330 * MiB;
constexpr size_t WS_U = WS_PROJ;
constexpr size_t WS_OBWD = 762 * MiB;
constexpr size_t WS_ATT = 826 * MiB;
constexpr size_t WS_END = 922 * MiB;
constexpr int LDS_BYTES = 148 * 1024;

__device__ __forceinline__ unsigned f2bf(float f) { unsigned u = __builtin_bit_cast(unsigned, f); return (u + 0x7fffu + ((u >> 16) & 1u)) >> 16; }
__device__ __forceinline__ unsigned pk2(float lo, float hi) { return f2bf(lo) | (f2bf(hi) << 16); }
__device__ __forceinline__ float bf2f(bf16_t v) { return __builtin_bit_cast(float, (unsigned)v << 16); }
__device__ __forceinline__ float bflo(unsigned u) { return __builtin_bit_cast(float, u << 16); }
__device__ __forceinline__ float bfhi(unsigned u) { return __builtin_bit_cast(float, u & 0xffff0000u); }
typedef __bf16 bf16x2_t __attribute__((ext_vector_type(2)));
__device__ __forceinline__ unsigned cvt_pk_bf16(float lo, float hi) { f32x2 v = {lo, hi}; bf16x2_t b = __builtin_convertvector(v, bf16x2_t); return __builtin_bit_cast(unsigned, b); }
__device__ __forceinline__ float wave_sum(float v) {
#pragma unroll
    for (int o = 1; o < 64; o <<= 1) v += __shfl_xor(v, o);
    return v;
}
__device__ __forceinline__ int tid_fresh() { int t = threadIdx.x; asm volatile("" : "+v"(t)); return t; }
__device__ __forceinline__ float sigmoidf_(float z) { return 1.f / (1.f + __expf(-z)); }

namespace pg8 {
constexpr int BM = 256, BK = 64, HALF = 128, HTB = HALF * BK * 2, STAGE_BYTES = 8 * HTB, NXCD = 8, WGM = 8;
__host__ __device__ __forceinline__ int lds_byte(int r, int c) { const int st = (r >> 4) * 2 + (c >> 5), rr = r & 15, cc = c & 31, ob = rr * 64 + cc * 2; return st * 1024 + (ob ^ (((ob >> 9) & 1) << 5)); }
__host__ __device__ __forceinline__ void stage_rc(int b, int& R, int& C) { const int st = b / 1024, sb = b % 1024, swz = sb ^ (((sb >> 9) & 1) << 5); R = (st >> 1) * 16 + swz / 64; C = (st & 1) * 32 + (swz % 64) / 2; }
__host__ __device__ __forceinline__ int perm32(int rho) { const int n = rho >> 4, i = rho & 15; return 8 * (i >> 2) + 4 * n + (i & 3); }

struct Unit { int pm, pn, koff, nt, seg; };
struct Gemm { const bf16_t* A; const bf16_t* Bt; int K; };

struct Order {
    int nM, nN, nwg, G, c, nseg, ntfull;
    __device__ void init(int M, int N, int K, int G_, int c_, int nseg_) { nM = M / BM; nN = N / BM; nwg = nM * nN; G = G_; c = c_; nseg = nseg_; ntfull = K / BK; }
    __device__ bool next(int i, Unit& u) const {
        int ti = i, seg = 0;
        if (nseg == 3) { ti = i / 3; seg = i - ti * 3; }
        const long L = (long)ti * G + c; if (L >= nwg) return false;
        int wgid = (int)L; { const int q = nwg / NXCD, r = nwg % NXCD, xcd = wgid % NXCD, off = wgid / NXCD; wgid = (xcd < r ? xcd * (q + 1) : r * (q + 1) + (xcd - r) * q) + off; }
        const int nig = WGM * nN, gid = wgid / nig, fm = gid * WGM, gsz = (nM - fm) < WGM ? (nM - fm) : WGM;
        u.pm = fm + ((wgid % nig) % gsz); u.pn = (wgid % nig) / gsz; u.seg = seg;
        if (nseg == 3) { u.koff = seg == 0 ? 0 : (seg == 1 ? 512 : 768); u.nt = seg == 0 ? 8 : 4; } else { u.koff = 0; u.nt = ntfull; }
        return true;
    }
};

struct EpiProj {
    bf16_t* O; bf16_t* att;
    __device__ __forceinline__ bool zero_after(const Unit&) const { return true; }
    __device__ __forceinline__ void operator()(f32x4 (&acc)[2][2][4][2], const Unit& u, int wr, int wc, int fr, int fq) const {
        const int row0 = u.pm * BM + wr * 64 + fr, col0 = u.pn * BM + wc * 32 + 8 * fq;
        const float sc = (u.pn < 2) ? QSCALE : 1.f;
        const bool toatt = u.pn < 6;
#pragma unroll
        for (int ai = 0; ai < 2; ++ai)
#pragma unroll
            for (int m = 0; m < 4; ++m) { const int row = row0 + ai * HALF + m * 16; bf16_t* rowp = O + (size_t)row * LDP + col0;
#pragma unroll
                for (int bj = 0; bj < 2; ++bj) { f32x4 v0 = acc[ai][bj][m][0] * sc, v1 = acc[ai][bj][m][1] * sc;
                    u32x4 w; w.x = cvt_pk_bf16(v0[0], v0[1]); w.y = cvt_pk_bf16(v0[2], v0[3]); w.z = cvt_pk_bf16(v1[0], v1[1]); w.w = cvt_pk_bf16(v1[2], v1[3]);
                    if (toatt) { const int seg = u.pn * 2 + bj, typ = seg >> 2, hh = seg & 3;
                        *(u32x4*)(att + ((size_t)(((row >> 11) * 4 + hh) * SEQ + (row & 2047))) * 384 + typ * 128 + wc * 32 + 8 * fq) = w; }
                    else *(u32x4*)(rowp + bj * HALF) = w; } }
    }
};
struct EpiRelu2 {
    bf16_t* O;
    __device__ __forceinline__ bool zero_after(const Unit&) const { return true; }
    __device__ __forceinline__ void operator()(f32x4 (&acc)[2][2][4][2], const Unit& u, int wr, int wc, int fr, int fq) const {
        const int row0 = u.pm * BM + wr * 64 + fr, col0 = u.pn * BM + wc * 32 + 8 * fq;
#pragma unroll
        for (int ai = 0; ai < 2; ++ai)
#pragma unroll
            for (int m = 0; m < 4; ++m) { bf16_t* rowp = O + (size_t)(row0 + ai * HALF + m * 16) * DFF + col0;
#pragma unroll
                for (int bj = 0; bj < 2; ++bj) { f32x4 v0 = acc[ai][bj][m][0], v1 = acc[ai][bj][m][1];
#pragma unroll
                    for (int j = 0; j < 4; ++j) { float a = fmaxf(v0[j], 0.f), b = fmaxf(v1[j], 0.f); v0[j] = a * a; v1[j] = b * b; }
                    u32x4 w; w.x = cvt_pk_bf16(v0[0], v0[1]); w.y = cvt_pk_bf16(v0[2], v0[3]); w.z = cvt_pk_bf16(v1[0], v1[1]); w.w = cvt_pk_bf16(v1[2], v1[3]);
                    *(u32x4*)(rowp + bj * HALF) = w; } }
    }
};
struct EpiRes {
    const float* base; float* out; const float* gate;
    __device__ __forceinline__ bool zero_after(const Unit&) const { return true; }
    __device__ __forceinline__ void operator()(f32x4 (&acc)[2][2][4][2], const Unit& u, int wr, int wc, int fr, int fq) const {
        const int row0 = u.pm * BM + wr * 64 + fr, col0 = u.pn * BM + wc * 32 + 8 * fq;
        const float* gp = gate + (size_t)((u.pm * BM) >> 11) * (NMOD * D) + col0;
#pragma unroll
        for (int bj = 0; bj < 2; ++bj) {
            const f32x4 g0 = *(const f32x4*)(gp + bj * HALF), g1 = *(const f32x4*)(gp + bj * HALF + 4);
#pragma unroll
            for (int ai = 0; ai < 2; ++ai) {
#pragma unroll
                for (int m = 0; m < 4; ++m) { const size_t off = (size_t)(row0 + ai * HALF + m * 16) * D + col0 + bj * HALF;
                    const f32x4 b0 = *(const f32x4*)(base + off), b1 = *(const f32x4*)(base + off + 4);
                    *(f32x4*)(out + off) = b0 + g0 * acc[ai][bj][m][0];
                    *(f32x4*)(out + off + 4) = b1 + g1 * acc[ai][bj][m][1];
                    if (m & 1) asm volatile("" ::: "memory"); }
            }
        }
    }
};
struct EpiMerge {
    const bf16_t* proj; bf16_t* O;
    __device__ __forceinline__ bool zero_after(const Unit& u) const { return u.seg == 2; }
    __device__ __forceinline__ void operator()(f32x4 (&acc)[2][2][4][2], const Unit& u, int wr, int wc, int fr, int fq) const {
        const int row0 = u.pm * BM + wr * 64 + fr, col0 = u.pn * BM + wc * 32 + 8 * fq;
        const int seg = u.seg;
#pragma unroll
        for (int ai = 0; ai < 2; ++ai)
#pragma unroll
            for (int m = 0; m < 4; ++m) { const size_t row = (size_t)(row0 + ai * HALF + m * 16); const bf16_t* gp = proj + row * LDP + GATE + col0;
#pragma unroll
                for (int bj = 0; bj < 2; ++bj) {
                    if (seg < 2) {
                        const u32x4 ga = *(const u32x4*)(gp + seg * D + bj * HALF), gb = *(const u32x4*)(gp + (seg + 1) * D + bj * HALF);
                        float r[8];
#pragma unroll
                        for (int j = 0; j < 4; ++j) {
                            const float a0 = fminf(fmaxf(bflo(ga[j]), -40.f), 40.f), a1 = fminf(fmaxf(bfhi(ga[j]), -40.f), 40.f);
                            const float b0 = fminf(fmaxf(bflo(gb[j]), -40.f), 40.f), b1 = fminf(fmaxf(bfhi(gb[j]), -40.f), 40.f);
                            r[2 * j] = (1.f + __expf(-b0)) * __builtin_amdgcn_rcpf(1.f + __expf(-a0));
                            r[2 * j + 1] = (1.f + __expf(-b1)) * __builtin_amdgcn_rcpf(1.f + __expf(-a1)); }
                        acc[ai][bj][m][0] = acc[ai][bj][m][0] * (f32x4){r[0], r[1], r[2], r[3]};
                        acc[ai][bj][m][1] = acc[ai][bj][m][1] * (f32x4){r[4], r[5], r[6], r[7]};
                    } else {
                        const u32x4 gc = *(const u32x4*)(gp + 2 * D + bj * HALF);
                        float r[8];
#pragma unroll
                        for (int j = 0; j < 4; ++j) {
                            const float c0 = fminf(fmaxf(bflo(gc[j]), -40.f), 40.f), c1 = fminf(fmaxf(bfhi(gc[j]), -40.f), 40.f);
                            r[2 * j] = __builtin_amdgcn_rcpf(1.f + __expf(-c0)); r[2 * j + 1] = __builtin_amdgcn_rcpf(1.f + __expf(-c1)); }
                        const f32x4 v0 = acc[ai][bj][m][0] * (f32x4){r[0], r[1], r[2], r[3]}, v1 = acc[ai][bj][m][1] * (f32x4){r[4], r[5], r[6], r[7]};
                        u32x4 w; w.x = cvt_pk_bf16(v0[0], v0[1]); w.y = cvt_pk_bf16(v0[2], v0[3]); w.z = cvt_pk_bf16(v1[0], v1[1]); w.w = cvt_pk_bf16(v1[2], v1[3]);
                        *(u32x4*)(O + row * D + col0 + bj * HALF) = w;
                    } } }
    }
};

template <class Epi, bool ALIGN_EPI = true>
__device__ __forceinline__ void gemm_phase(LAS uchar* lds, const Gemm g, const Order& S, const Epi& E) {
    const int tid = tid_fresh(), wid = __builtin_amdgcn_readfirstlane(tid >> 6), lane = tid & 63, wr = wid >> 2, wc = wid & 3, fr = lane & 15, fq = lane >> 4;
    const int K = g.K;
    unsigned voffA[2], voffB[2];
#pragma unroll
    for (int i = 0; i < 2; ++i) { int R, C; stage_rc(tid * 16 + i * 8192, R, C); const int Rb = (R & ~31) + perm32(R & 31);
        voffA[i] = (unsigned)(R * K + C) * 2u; voffB[i] = (unsigned)(Rb * K + C) * 2u; }
    const size_t kstep = (size_t)(BK * 2);
    const size_t hstep = (size_t)HALF * K * 2;
    const size_t tstep = 2 * hstep;
    const unsigned ldsw = (unsigned)wid * 1024u;
    const int aoff = lds_byte(wr * 64 + fr, fq * 8), boff = lds_byte(wc * 32 + fr, fq * 8);
#define PG8_SA(b, h) (((b) * 2 + (h)) * HTB)
#define PG8_SB(b, h) ((4 + (b) * 2 + (h)) * HTB)
#define PG8_STAGE(bufoff, gbase, voff) do { _Pragma("unroll") for (int _i = 0; _i < 2; ++_i) \
        __builtin_amdgcn_global_load_lds((const unsigned*)((const char*)(gbase) + (voff)[_i]), (LAS unsigned*)(lds + (bufoff) + ldsw + _i * 8192), 16, 0, 0); } while (0)
#define PG8_LDA(dst, b, h) do { _Pragma("unroll") for (int m = 0; m < 4; ++m) _Pragma("unroll") for (int k = 0; k < 2; ++k) dst[m][k] = *(const LAS bf16x8*)(lds + PG8_SA(b, h) + aoff + m * 2048 + k * 1024); } while (0)
#define PG8_LDB(dst, b, h) do { _Pragma("unroll") for (int n = 0; n < 2; ++n) _Pragma("unroll") for (int k = 0; k < 2; ++k) dst[n][k] = *(const LAS bf16x8*)(lds + PG8_SB(b, h) + boff + n * 2048 + k * 1024); } while (0)
#define PG8_MMA(ai, bj, At, Bt) do { __builtin_amdgcn_s_setprio(1); _Pragma("unroll") for (int m = 0; m < 4; ++m) _Pragma("unroll") for (int n = 0; n < 2; ++n) _Pragma("unroll") for (int k = 0; k < 2; ++k) \
        acc[ai][bj][m][n] = __builtin_amdgcn_mfma_f32_16x16x32_bf16(Bt[n][k], At[m][k], acc[ai][bj][m][n], 0, 0, 0); __builtin_amdgcn_s_setprio(0); } while (0)
#define PG8_WAIT_V(n) asm volatile("s_waitcnt vmcnt(" #n ")" ::: "memory")
#define PG8_WAIT_L(n) asm volatile("s_waitcnt lgkmcnt(" #n ")" ::: "memory")
#define PG8_BAR __builtin_amdgcn_s_barrier()
#define PG8_SCHED __builtin_amdgcn_sched_barrier(0)
    Unit cur, nxt; int ui = 0;
    if (!S.next(0, cur)) return;
    f32x4 acc[2][2][4][2];
#pragma unroll
    for (int a = 0; a < 2; ++a)
#pragma unroll
        for (int b = 0; b < 2; ++b)
#pragma unroll
            for (int m = 0; m < 4; ++m)
#pragma unroll
                for (int n = 0; n < 2; ++n) acc[a][b][m][n] = (f32x4){0.f, 0.f, 0.f, 0.f};
    bf16x8 At[4][2], B0[2][2], B1[2][2];
    const char* cA = (const char*)g.A + (size_t)cur.pm * tstep + (size_t)cur.koff * 2; const char* cB = (const char*)g.Bt + (size_t)cur.pn * tstep + (size_t)cur.koff * 2;
    PG8_STAGE(PG8_SB(0, 0), cB, voffB); PG8_STAGE(PG8_SB(0, 1), cB + hstep, voffB); PG8_STAGE(PG8_SA(0, 0), cA, voffA); PG8_STAGE(PG8_SA(0, 1), cA + hstep, voffA);
    if (wr == 1) PG8_BAR;
    PG8_WAIT_V(2); PG8_BAR;
    PG8_STAGE(PG8_SB(1, 0), cB + kstep, voffB); PG8_STAGE(PG8_SA(1, 0), cA + kstep, voffA); PG8_STAGE(PG8_SB(1, 1), cB + hstep + kstep, voffB);
    PG8_WAIT_V(6); PG8_BAR;
    for (;;) {
        const bool has_next = S.next(ui + 1, nxt);
        const char* nA = has_next ? (const char*)g.A + (size_t)nxt.pm * tstep + (size_t)nxt.koff * 2 : cA; const char* nB = has_next ? (const char*)g.Bt + (size_t)nxt.pn * tstep + (size_t)nxt.koff * 2 : cB;
        const int nt = cur.nt;
        for (int t = 0; t < nt; t += 2) {
            const bool last = (t == nt - 2);
            const char* a1 = cA + (size_t)(t + 1) * kstep;
            const char* a2 = last ? nA : cA + (size_t)(t + 2) * kstep; const char* b2 = last ? nB : cB + (size_t)(t + 2) * kstep;
            const char* a3 = a2 + kstep; const char* b3 = b2 + kstep;
            PG8_LDB(B0, 0, 0); PG8_LDB(B1, 0, 1); PG8_SCHED; PG8_LDA(At, 0, 0); PG8_STAGE(PG8_SA(1, 1), a1 + hstep, voffA);
            PG8_WAIT_V(8); PG8_WAIT_L(0); PG8_BAR; PG8_MMA(0, 0, At, B0); PG8_MMA(0, 1, At, B1); PG8_BAR; PG8_SCHED;
            PG8_LDA(At, 0, 1); PG8_STAGE(PG8_SB(0, 0), b2, voffB); PG8_STAGE(PG8_SB(0, 1), b2 + hstep, voffB); PG8_STAGE(PG8_SA(0, 0), a2, voffA);
            PG8_WAIT_V(8); PG8_WAIT_L(0); PG8_BAR; PG8_MMA(1, 0, At, B0); PG8_MMA(1, 1, At, B1); PG8_BAR; PG8_SCHED;
            PG8_LDB(B0, 1, 0); PG8_LDB(B1, 1, 1); PG8_SCHED; PG8_LDA(At, 1, 0); PG8_STAGE(PG8_SA(0, 1), a2 + hstep, voffA);
            PG8_WAIT_V(8); PG8_WAIT_L(0); PG8_BAR; PG8_MMA(0, 0, At, B0); PG8_MMA(0, 1, At, B1); PG8_BAR; PG8_SCHED;
            PG8_LDA(At, 1, 1); PG8_STAGE(PG8_SB(1, 0), b3, voffB); PG8_STAGE(PG8_SB(1, 1), b3 + hstep, voffB); PG8_STAGE(PG8_SA(1, 0), a3, voffA);
            PG8_WAIT_V(8); PG8_WAIT_L(0); PG8_BAR; PG8_MMA(1, 0, At, B0); PG8_MMA(1, 1, At, B1); PG8_BAR; PG8_SCHED;
        }
        if constexpr (ALIGN_EPI) { if (wr == 0) PG8_BAR; }
        E(acc, cur, wr, wc, fr, fq);
        if (!has_next) break;
        if (E.zero_after(cur)) {
#pragma unroll
            for (int a = 0; a < 2; ++a)
#pragma unroll
                for (int b = 0; b < 2; ++b)
#pragma unroll
                    for (int m = 0; m < 4; ++m)
#pragma unroll
                        for (int n = 0; n < 2; ++n) acc[a][b][m][n] = (f32x4){0.f, 0.f, 0.f, 0.f};
        }
        cur = nxt; cA = nA; cB = nB; ++ui;
        if constexpr (ALIGN_EPI) { if (wr == 1) PG8_BAR; }
    }
    PG8_WAIT_V(0);
    if constexpr (!ALIGN_EPI) { if (wr == 0) PG8_BAR; }
    PG8_BAR;
#undef PG8_SA
#undef PG8_SB
#undef PG8_STAGE
#undef PG8_LDA
#undef PG8_LDB
#undef PG8_MMA
#undef PG8_WAIT_V
#undef PG8_WAIT_L
#undef PG8_BAR
#undef PG8_SCHED
}
}

__device__ __forceinline__ int crow(int r, int hi) { return (r & 3) + 8 * (r >> 2) + 4 * hi; }
__device__ __forceinline__ s16x4 vtr(const LAS uchar* p) { return __builtin_bit_cast(s16x4, __builtin_amdgcn_ds_read_tr16_b64_v4i16((LAS s16x4*)p)); }
__device__ __forceinline__ float xhalf_max(float m) { auto rr = __builtin_amdgcn_permlane32_swap(__builtin_bit_cast(unsigned, m), __builtin_bit_cast(unsigned, m), false, false); return fmaxf(__builtin_bit_cast(float, rr[0]), __builtin_bit_cast(float, rr[1])); }
__device__ __forceinline__ float xhalf_sum(float m) { auto rr = __builtin_amdgcn_permlane32_swap(__builtin_bit_cast(unsigned, m), __builtin_bit_cast(unsigned, m), false, false); return __builtin_bit_cast(float, rr[0]) + __builtin_bit_cast(float, rr[1]); }

__device__ __forceinline__ void glds16(const void* gsrc, unsigned lds_dst) { unsigned keep;
    asm volatile("s_mov_b32 %0, m0\n\ts_mov_b32 m0, %2\n\ts_nop 0\n\tglobal_load_lds_dwordx4 %1, off\n\ts_mov_b32 m0, %0" : "=&s"(keep) : "v"(gsrc), "s"(lds_dst) : "memory"); }
constexpr int ATT_SLOT = 32768, ATT_WSF = 98304;
__device__ __forceinline__ void attn_unit(LAS uchar* lds, const bf16_t* proj, bf16_t* ocat, int bl, int h, int qb, float lam, float laminit, const float* sg) {
    const int tid = tid_fresh(), lane = tid & 63, r32 = lane & 31, hi = lane >> 5;
    const int wave = __builtin_amdgcn_readfirstlane(tid >> 6), mi = wave >> 2, rb = wave & 3;
    const size_t rowbase = (size_t)bl * SEQ;
    const int q0 = qb * 128 + rb * 32;
    const float m2 = exp2f(-2.f * (float)(h + 1)) * LOG2E;
    bf16x8 qf[4];
    const bf16_t* att = proj;
    const size_t hb = (size_t)(bl * 4 + h) * SEQ;
    { const bf16_t* qp = att + (hb + q0 + r32) * 384 + mi * 64 + hi * 8;
#pragma unroll
      for (int d0 = 0; d0 < 4; ++d0) qf[d0] = *(const bf16x8*)(qp + d0 * 16); }
    const int kkey = 4 * wave + (lane >> 4);
    const bf16_t* ksrc0 = att + (hb + kkey) * 384 + 128 + (((lane & 15) ^ (kkey & 15)) * 8);
    const bf16_t* ksrc1 = ksrc0 + (size_t)32 * 384;
    const bf16_t* vsrc0 = att + (hb + 16 * (wave & 3) + (lane >> 2)) * 384 + 256 + (wave >> 2) * 32 + (lane & 3) * 8;
    const bf16_t* vsrc1 = vsrc0 + 64;
    const unsigned lds0 = (unsigned)(uintptr_t)lds + (unsigned)wave * 1024u;
#define ATT_ISSUE(t, sb) do { const size_t go_ = (size_t)(t) * 64 * 384; const unsigned d_ = (unsigned)__builtin_amdgcn_readfirstlane((int)(lds0 + (unsigned)(sb))); \
        glds16(ksrc0 + go_, d_); glds16(ksrc1 + go_, d_ + 8192u); glds16(vsrc0 + go_, d_ + 16384u); glds16(vsrc1 + go_, d_ + 24576u); } while (0)
    LAS float* wsf = (LAS float*)(lds + ATT_WSF) + wave * 64;
    f32x16 o[4];
#pragma unroll
    for (int d = 0; d < 4; ++d)
#pragma unroll
        for (int r = 0; r < 16; ++r) o[d][r] = 0.f;
    float mhat = 0.f;
    f32x16 ol;
#pragma unroll
    for (int r = 0; r < 16; ++r) ol[r] = 0.f;
    const bf16x8 ones = (bf16x8){0x3F80, 0x3F80, 0x3F80, 0x3F80, 0x3F80, 0x3F80, 0x3F80, 0x3F80};
    int kfo[4];
#pragma unroll
    for (int d0 = 0; d0 < 4; ++d0) kfo[d0] = r32 * 256 + (((mi * 8 + 2 * d0 + hi) ^ (r32 & 15)) * 16);
    const int vfo = 16384 + ((lane >> 4) & 1) * 32 + (lane & 3) * 8 + (4 * hi + ((lane & 15) >> 2)) * 64;
    ATT_ISSUE(0, 0); ATT_ISSUE(1, ATT_SLOT);
    int slot_c = 0, slot_n = 2 * ATT_SLOT;
    for (int t = 0; t < SEQ / 64; ++t) {
        if (t + 1 < SEQ / 64) asm volatile("s_waitcnt vmcnt(4) lgkmcnt(0)" ::: "memory"); else asm volatile("s_waitcnt vmcnt(0) lgkmcnt(0)" ::: "memory");
        __builtin_amdgcn_s_barrier();
        asm volatile("" ::: "memory");
        if (t + 2 < SEQ / 64) ATT_ISSUE(t + 2, slot_n);
        const LAS uchar* sl = lds + slot_c;
        { const int nx = slot_c + ATT_SLOT; slot_n = slot_c; slot_c = (nx == 3 * ATT_SLOT) ? 0 : nx; }
        const float dq = (float)(q0 + r32 - 64 * t - 4 * hi);
        f32x16 p0, p1;
#pragma unroll
        for (int r = 0; r < 16; ++r) { const float kc = (float)((r & 3) + 8 * (r >> 2));
            p0[r] = __builtin_fmaf(-m2, __builtin_fabsf(dq - kc), -mhat); p1[r] = __builtin_fmaf(-m2, __builtin_fabsf(dq - kc - 32.f), -mhat); }
#pragma unroll
        for (int d0 = 0; d0 < 4; ++d0) {
            const bf16x8 a0 = *(const LAS bf16x8*)(sl + kfo[d0]), a1 = *(const LAS bf16x8*)(sl + kfo[d0] + 8192);
            p0 = __builtin_amdgcn_mfma_f32_32x32x16_bf16(a0, qf[d0], p0, 0, 0, 0);
            p1 = __builtin_amdgcn_mfma_f32_32x32x16_bf16(a1, qf[d0], p1, 0, 0, 0); }
        float rm = fmaxf(p0[0], p1[0]);
#pragma unroll
        for (int r = 1; r < 16; ++r) rm = fmaxf(rm, fmaxf(p0[r], p1[r]));
        rm = xhalf_max(rm);
        const bool first = (t == 0);
        if (first || __any(rm > 8.f)) {
            const float dl = first ? rm : fmaxf(rm, 0.f);
            mhat += dl;
#pragma unroll
            for (int r = 0; r < 16; ++r) { p0[r] -= dl; p1[r] -= dl; }
            if (!first) {
                const float f = __builtin_amdgcn_exp2f(-dl);
                if (hi == 0) wsf[r32] = f;
                float fr_[16];
#pragma unroll
                for (int r = 0; r < 16; ++r) fr_[r] = wsf[crow(r, hi)];
#pragma unroll
                for (int d = 0; d < 4; ++d)
#pragma unroll
                    for (int r = 0; r < 16; ++r) o[d][r] *= fr_[r];
#pragma unroll
                for (int r = 0; r < 16; ++r) ol[r] *= fr_[r];
            }
        }
#pragma unroll
        for (int r = 0; r < 16; ++r) { p0[r] = __builtin_amdgcn_exp2f(p0[r]); p1[r] = __builtin_amdgcn_exp2f(p1[r]); }
        u32x4 pw[4];
#pragma unroll
        for (int j = 0; j < 4; ++j) { pw[0][j] = cvt_pk_bf16(p0[2 * j], p0[2 * j + 1]); pw[1][j] = cvt_pk_bf16(p0[8 + 2 * j], p0[8 + 2 * j + 1]);
                                      pw[2][j] = cvt_pk_bf16(p1[2 * j], p1[2 * j + 1]); pw[3][j] = cvt_pk_bf16(p1[8 + 2 * j], p1[8 + 2 * j + 1]); }
#pragma unroll
        for (int d = 0; d < 4; ++d)
#pragma unroll
            for (int ks = 0; ks < 4; ++ks) {
                const s16x4 lo = vtr(sl + vfo + d * 4096 + ks * 1024), hh = vtr(sl + vfo + d * 4096 + ks * 1024 + 512);
                const bf16x8 vf = (bf16x8){lo[0], lo[1], lo[2], lo[3], hh[0], hh[1], hh[2], hh[3]};
                o[d] = __builtin_amdgcn_mfma_f32_32x32x16_bf16(__builtin_bit_cast(bf16x8, pw[ks]), vf, o[d], 0, 0, 0); }
#pragma unroll
        for (int ks = 0; ks < 4; ++ks) ol = __builtin_amdgcn_mfma_f32_32x32x16_bf16(__builtin_bit_cast(bf16x8, pw[ks]), ones, ol, 0, 0, 0);
    }
#undef ATT_ISSUE
    float fr_[16];
#pragma unroll
    for (int r = 0; r < 16; ++r) fr_[r] = (mi == 0 ? 1.f : lam) / ol[r];
    __syncthreads();
    LAS float* X = (LAS float*)lds + rb * 4096;
    if (mi == 1) {
#pragma unroll
        for (int d = 0; d < 4; ++d)
#pragma unroll
            for (int r = 0; r < 16; ++r) X[(d * 16 + r) * 64 + lane] = o[d][r] * fr_[r];
    }
    __syncthreads();
    if (mi == 0) {
        float ss[16];
#pragma unroll
        for (int r = 0; r < 16; ++r) ss[r] = 0.f;
#pragma unroll
        for (int d = 0; d < 4; ++d)
#pragma unroll
            for (int r = 0; r < 16; ++r) { const float v = o[d][r] * fr_[r] - X[(d * 16 + r) * 64 + lane]; o[d][r] = v; ss[r] += v * v; }
#pragma unroll
        for (int r = 0; r < 16; ++r) {
#pragma unroll
            for (int s = 1; s < 32; s <<= 1) ss[r] += __shfl_xor(ss[r], s);
            ss[r] = rsqrtf(ss[r] * (1.f / 128.f) + EPS) * (1.f - laminit); }
        float gv[4];
#pragma unroll
        for (int d = 0; d < 4; ++d) gv[d] = sg[d * 32 + r32];
#pragma unroll
        for (int r = 0; r < 16; ++r) { bf16_t* op = ocat + (rowbase + q0 + crow(r, hi)) * D + h * 128 + r32;
#pragma unroll
            for (int d = 0; d < 4; ++d) op[d * 32] = (bf16_t)f2bf(o[d][r] * ss[r] * gv[d]); }
    }
    __syncthreads();
}

template <int DK, bool HG>
__device__ __forceinline__ void scan_item(LAS uchar* lds, const bf16_t* proj, float* oraw0, float* oraw1, bf16_t* ocat, unsigned* done, int bl, int h, int dir, const float* lb  ,
                                          const float* normg  , const float* w2  , const float* gbias  ) {
    constexpr int KPW = DK / 8, TB = 32, NS = TB / 16, NR = TB / 8, GS = 4;
    LAS float* sA = (LAS float*)lds;
    LAS float* sK = sA + TB * DK;
    LAS float* sQ = sK + TB * DK;
    LAS float* sV = sQ + TB * DK;
    LAS float* sP = sV + TB * 64;
    const int tid = tid_fresh(), lane = tid & 63, wave = __builtin_amdgcn_readfirstlane(tid >> 6);
    const int ps = tid >> 5, pi = tid & 31;
    const size_t rowbase = (size_t)bl * SEQ;
    float* oraw = dir == 0 ? oraw0 : oraw1;
    __syncthreads();
    {
        float lb0 = 0.f, lb1 = 0.f, w2c[16], bias = 0.f;
        if (HG) { lb0 = lb[dir * 256 + h * 64 + pi]; lb1 = lb[dir * 256 + h * 64 + pi + 32]; }
        else {
#pragma unroll
            for (int r = 0; r < 16; ++r) w2c[r] = w2[(dir * 16 + r) * 128 + h * 32 + pi];
            bias = gbias[dir * 128 + h * 32 + pi]; }
        f32x2 S[KPW / 2];
#pragma unroll
        for (int j = 0; j < KPW / 2; ++j) S[j] = (f32x2){0.f, 0.f};
        bf16_t rz0[2][NS], rz1[2][NS], rq0[2][NS], rq1[2][NS], rv0[2][NS], rv1[2][NS], rk0[2][NS]; u32x4 rl0[2][NS], rl1[2][NS];
#pragma unroll
        for (int i = 0; i < NS; ++i) for (int e = 0; e < 2; ++e) { rz0[e][i] = rz1[e][i] = rq0[e][i] = rq1[e][i] = rv0[e][i] = rv1[e][i] = rk0[e][i] = 0; rl0[e][i] = rl1[e][i] = (u32x4){0, 0, 0, 0}; }
#define SCAN_LOAD(blk, E_) do { _Pragma("unroll") for (int i_ = 0; i_ < NS; ++i_) { const int st_ = (blk) * TB + ps + 16 * i_; const int tok_ = dir == 0 ? st_ : 2047 - st_; const bf16_t* pr_ = proj + (rowbase + tok_) * LDP; \
        if (HG) { const int zc_ = (dir == 0 ? BFF : BFB) + h * 64 + pi; rz0[E_][i_] = pr_[zc_]; rz1[E_][i_] = pr_[zc_ + 32]; rq0[E_][i_] = pr_[BQ + h * 64 + pi]; rq1[E_][i_] = pr_[BQ + h * 64 + pi + 32]; rv0[E_][i_] = pr_[BI + h * 64 + pi]; rv1[E_][i_] = pr_[BI + h * 64 + pi + 32]; } \
        else { const u32x4* lp_ = (const u32x4*)(pr_ + (dir == 0 ? GLF : GLB)); rl0[E_][i_] = lp_[0]; rl1[E_][i_] = lp_[1]; rk0[E_][i_] = pr_[GK + h * 32 + pi]; rq0[E_][i_] = pr_[GQ + h * 32 + pi]; rv0[E_][i_] = pr_[GV + h * 64 + pi]; rv1[E_][i_] = pr_[GV + h * 64 + pi + 32]; } } } while (0)
        SCAN_LOAD(0, 0); SCAN_LOAD(1, 1);
        for (int blk2 = 0; blk2 < SEQ / TB; blk2 += 2) {
            { const int blk = blk2;
#pragma unroll
            for (int i = 0; i < NS; ++i) {
                const int st = ps + 16 * i;
                if (HG) {
                    const float z0 = bf2f(rz0[0][i]), z1 = bf2f(rz1[0][i]);
                    const float s0 = __builtin_amdgcn_rcpf(1.f + __expf(-z0)), s1 = __builtin_amdgcn_rcpf(1.f + __expf(-z1));
                    sA[st * 64 + pi] = s0 * (1.f + lb0 * __expf(fminf(-z0, 80.f))); sA[st * 64 + pi + 32] = s1 * (1.f + lb1 * __expf(fminf(-z1, 80.f)));
                    sK[st * 64 + pi] = (1.f - lb0) * __builtin_amdgcn_rcpf(1.f + __expf(z0)); sK[st * 64 + pi + 32] = (1.f - lb1) * __builtin_amdgcn_rcpf(1.f + __expf(z1));
                    const float q0 = bf2f(rq0[0][i]), q1 = bf2f(rq1[0][i]);
                    sQ[st * 64 + pi] = q0 * __builtin_amdgcn_rcpf(1.f + __expf(-q0)) * 0.125f; sQ[st * 64 + pi + 32] = q1 * __builtin_amdgcn_rcpf(1.f + __expf(-q1)) * 0.125f;
                } else {
                    float z = bias;
#pragma unroll
                    for (int j = 0; j < 4; ++j) { z += bflo(rl0[0][i][j]) * w2c[2 * j] + bfhi(rl0[0][i][j]) * w2c[2 * j + 1]; z += bflo(rl1[0][i][j]) * w2c[8 + 2 * j] + bfhi(rl1[0][i][j]) * w2c[8 + 2 * j + 1]; }
                    const float ls = fminf(z, 0.f) - __logf(1.f + __expf(-fabsf(z)));
                    sA[st * 32 + pi] = __expf(ls * (1.f / 16.f));
                    sK[st * 32 + pi] = bf2f(rk0[0][i]);
                    sQ[st * 32 + pi] = bf2f(rq0[0][i]) * 0.17677669529663687f;
                }
                sV[st * 64 + pi] = bf2f(rv0[0][i]); sV[st * 64 + pi + 32] = bf2f(rv1[0][i]);
            }
            asm volatile("s_waitcnt lgkmcnt(0)" ::: "memory"); __builtin_amdgcn_s_barrier(); asm volatile("" ::: "memory");
            if (blk + 2 < SEQ / TB) SCAN_LOAD(blk + 2, 0);
            for (int s0_ = 0; s0_ < TB; s0_ += GS) {
                float vv[GS]; f32x4 a4[GS][KPW / 4], k4[GS][KPW / 4], q4[GS][KPW / 4];
#pragma unroll
                for (int g = 0; g < GS; ++g) { const int s = s0_ + g; vv[g] = sV[s * 64 + lane];
#pragma unroll
                    for (int j4 = 0; j4 < KPW / 4; ++j4) { a4[g][j4] = *(const LAS f32x4*)(sA + s * DK + wave * KPW + j4 * 4); k4[g][j4] = *(const LAS f32x4*)(sK + s * DK + wave * KPW + j4 * 4); q4[g][j4] = *(const LAS f32x4*)(sQ + s * DK + wave * KPW + j4 * 4); } }
                float po[GS];
#pragma unroll
                for (int g = 0; g < GS; ++g) {
                    f32x2 op = (f32x2){0.f, 0.f};
#pragma unroll
                    for (int j4 = 0; j4 < KPW / 4; ++j4) {
                        const f32x2 kv0 = (f32x2){k4[g][j4][0], k4[g][j4][1]} * vv[g], kv1 = (f32x2){k4[g][j4][2], k4[g][j4][3]} * vv[g];
                        S[2 * j4] = __builtin_elementwise_fma((f32x2){a4[g][j4][0], a4[g][j4][1]}, S[2 * j4], kv0);
                        S[2 * j4 + 1] = __builtin_elementwise_fma((f32x2){a4[g][j4][2], a4[g][j4][3]}, S[2 * j4 + 1], kv1);
                        op = __builtin_elementwise_fma((f32x2){q4[g][j4][0], q4[g][j4][1]}, S[2 * j4], op);
                        op = __builtin_elementwise_fma((f32x2){q4[g][j4][2], q4[g][j4][3]}, S[2 * j4 + 1], op); }
                    po[g] = op[0] + op[1]; }
#pragma unroll
                for (int g = 0; g < GS; ++g) sP[((s0_ + g) * 8 + wave) * 64 + lane] = po[g];
            }
            asm volatile("s_waitcnt lgkmcnt(0)" ::: "memory"); __builtin_amdgcn_s_barrier(); asm volatile("" ::: "memory");
#pragma unroll
            for (int j2 = 0; j2 < NR; ++j2) {
                const int s = wave + 8 * j2; const int tok = dir == 0 ? blk * TB + s : 2047 - (blk * TB + s);
                float sum = 0.f;
#pragma unroll
                for (int w = 0; w < 8; ++w) sum += sP[(s * 8 + w) * 64 + lane];
                oraw[(rowbase + tok) * 512 + (HG ? 0 : 256) + h * 64 + lane] = sum;
            }
            }
            { const int blk = blk2 + 1;
#pragma unroll
            for (int i = 0; i < NS; ++i) {
                const int st = ps + 16 * i;
                if (HG) {
                    const float z0 = bf2f(rz0[1][i]), z1 = bf2f(rz1[1][i]);
                    const float s0 = __builtin_amdgcn_rcpf(1.f + __expf(-z0)), s1 = __builtin_amdgcn_rcpf(1.f + __expf(-z1));
                    sA[st * 64 + pi] = s0 * (1.f + lb0 * __expf(fminf(-z0, 80.f))); sA[st * 64 + pi + 32] = s1 * (1.f + lb1 * __expf(fminf(-z1, 80.f)));
                    sK[st * 64 + pi] = (1.f - lb0) * __builtin_amdgcn_rcpf(1.f + __expf(z0)); sK[st * 64 + pi + 32] = (1.f - lb1) * __builtin_amdgcn_rcpf(1.f + __expf(z1));
                    const float q0 = bf2f(rq0[1][i]), q1 = bf2f(rq1[1][i]);
                    sQ[st * 64 + pi] = q0 * __builtin_amdgcn_rcpf(1.f + __expf(-q0)) * 0.125f; sQ[st * 64 + pi + 32] = q1 * __builtin_amdgcn_rcpf(1.f + __expf(-q1)) * 0.125f;
                } else {
                    float z = bias;
#pragma unroll
                    for (int j = 0; j < 4; ++j) { z += bflo(rl0[1][i][j]) * w2c[2 * j] + bfhi(rl0[1][i][j]) * w2c[2 * j + 1]; z += bflo(rl1[1][i][j]) * w2c[8 + 2 * j] + bfhi(rl1[1][i][j]) * w2c[8 + 2 * j + 1]; }
                    const float ls = fminf(z, 0.f) - __logf(1.f + __expf(-fabsf(z)));
                    sA[st * 32 + pi] = __expf(ls * (1.f / 16.f));
                    sK[st * 32 + pi] = bf2f(rk0[1][i]);
                    sQ[st * 32 + pi] = bf2f(rq0[1][i]) * 0.17677669529663687f;
                }
                sV[st * 64 + pi] = bf2f(rv0[1][i]); sV[st * 64 + pi + 32] = bf2f(rv1[1][i]);
            }
            asm volatile("s_waitcnt lgkmcnt(0)" ::: "memory"); __builtin_amdgcn_s_barrier(); asm volatile("" ::: "memory");
            if (blk + 2 < SEQ / TB) SCAN_LOAD(blk + 2, 1);
            for (int s0_ = 0; s0_ < TB; s0_ += GS) {
                float vv[GS]; f32x4 a4[GS][KPW / 4], k4[GS][KPW / 4], q4[GS][KPW / 4];
#pragma unroll
                for (int g = 0; g < GS; ++g) { const int s = s0_ + g; vv[g] = sV[s * 64 + lane];
#pragma unroll
                    for (int j4 = 0; j4 < KPW / 4; ++j4) { a4[g][j4] = *(const LAS f32x4*)(sA + s * DK + wave * KPW + j4 * 4); k4[g][j4] = *(const LAS f32x4*)(sK + s * DK + wave * KPW + j4 * 4); q4[g][j4] = *(const LAS f32x4*)(sQ + s * DK + wave * KPW + j4 * 4); } }
                float po[GS];
#pragma unroll
                for (int g = 0; g < GS; ++g) {
                    f32x2 op = (f32x2){0.f, 0.f};
#pragma unroll
                    for (int j4 = 0; j4 < KPW / 4; ++j4) {
                        const f32x2 kv0 = (f32x2){k4[g][j4][0], k4[g][j4][1]} * vv[g], kv1 = (f32x2){k4[g][j4][2], k4[g][j4][3]} * vv[g];
                        S[2 * j4] = __builtin_elementwise_fma((f32x2){a4[g][j4][0], a4[g][j4][1]}, S[2 * j4], kv0);
                        S[2 * j4 + 1] = __builtin_elementwise_fma((f32x2){a4[g][j4][2], a4[g][j4][3]}, S[2 * j4 + 1], kv1);
                        op = __builtin_elementwise_fma((f32x2){q4[g][j4][0], q4[g][j4][1]}, S[2 * j4], op);
                        op = __builtin_elementwise_fma((f32x2){q4[g][j4][2], q4[g][j4][3]}, S[2 * j4 + 1], op); }
                    po[g] = op[0] + op[1]; }
#pragma unroll
                for (int g = 0; g < GS; ++g) sP[((s0_ + g) * 8 + wave) * 64 + lane] = po[g];
            }
            asm volatile("s_waitcnt lgkmcnt(0)" ::: "memory"); __builtin_amdgcn_s_barrier(); asm volatile("" ::: "memory");
#pragma unroll
            for (int j2 = 0; j2 < NR; ++j2) {
                const int s = wave + 8 * j2; const int tok = dir == 0 ? blk * TB + s : 2047 - (blk * TB + s);
                float sum = 0.f;
#pragma unroll
                for (int w = 0; w < 8; ++w) sum += sP[(s * 8 + w) * 64 + lane];
                oraw[(rowbase + tok) * 512 + (HG ? 0 : 256) + h * 64 + lane] = sum;
            }
            }
        }
#undef SCAN_LOAD
    }
    asm volatile("s_waitcnt vmcnt(0)" ::: "memory");
    __syncthreads();
    LAS unsigned* flg = (LAS unsigned*)(lds + 147456 - 128);
    if (tid == 0) { __builtin_amdgcn_fence(__ATOMIC_RELEASE, "agent"); asm volatile("s_waitcnt vmcnt(0)" ::: "memory");
        const unsigned old = __hip_atomic_fetch_add(done, 1u, __ATOMIC_RELAXED, __HIP_MEMORY_SCOPE_AGENT);
        __builtin_amdgcn_fence(__ATOMIC_ACQUIRE, "agent"); asm volatile("s_waitcnt vmcnt(0)" ::: "memory");
        flg[0] = old; }
    __syncthreads();
    if (flg[0] == 1u) {
        if (lane == 0 && tid != 0) { __builtin_amdgcn_fence(__ATOMIC_ACQUIRE, "agent"); asm volatile("s_waitcnt vmcnt(0)" ::: "memory"); }
        __syncthreads();
        const float ng = normg[lane];
        for (int t0 = wave * 16; t0 < SEQ; t0 += 128) {
            float fa[16], fb[16]; bf16_t gq[16];
#pragma unroll
            for (int i = 0; i < 16; ++i) { const size_t o = (rowbase + t0 + i) * 512 + (HG ? 0 : 256) + h * 64 + lane;
                fa[i] = __hip_atomic_load(oraw0 + o, __ATOMIC_RELAXED, __HIP_MEMORY_SCOPE_AGENT); fb[i] = __hip_atomic_load(oraw1 + o, __ATOMIC_RELAXED, __HIP_MEMORY_SCOPE_AGENT);
                gq[i] = proj[(rowbase + t0 + i) * LDP + (HG ? BG : GG) + h * 64 + lane]; }
#pragma unroll
            for (int i = 0; i < 16; ++i) {
                const float tot = fa[i] + fb[i];
                const float ssq = wave_sum(tot * tot);
                const float gvv = bf2f(gq[i]);
                const float outv = tot * rsqrtf(ssq * (1.f / 64.f) + EPS) * ng * (gvv * __builtin_amdgcn_rcpf(1.f + __expf(-gvv)));
                ocat[(rowbase + t0 + i) * D + (HG ? 512 : 768) + h * 64 + lane] = (bf16_t)f2bf(outv);
            }
        }
    }
    __syncthreads();
}

__device__ __forceinline__ void norm_rows_mod(const float* src, bf16_t* dst, const float* g, const float* modl  , int grow0, int shoff, int scoff) {
    const int tid = tid_fresh(), lane = tid & 63, gw = blockIdx.x * 8 + __builtin_amdgcn_readfirstlane(tid >> 6), NGW = gridDim.x * 8;
    for (int m = gw; m < TG; m += NGW) {
        const int b = (grow0 + m) >> 11;
        const f32x4* xr = (const f32x4*)(src + (size_t)m * D) + lane;
        const f32x4* gr = (const f32x4*)g + lane; const f32x4* sh = (const f32x4*)(modl + (size_t)b * (NMOD * D) + shoff) + lane; const f32x4* sc = (const f32x4*)(modl + (size_t)b * (NMOD * D) + scoff) + lane;
        f32x4 v[4]; float s = 0.f;
#pragma unroll
        for (int j = 0; j < 4; ++j) { v[j] = xr[64 * j]; s += (v[j].x * v[j].x + v[j].y * v[j].y) + (v[j].z * v[j].z + v[j].w * v[j].w); }
        const float r = rsqrtf(wave_sum(s) * (1.f / D) + EPS);
        unsigned long long* o8 = (unsigned long long*)(dst + (size_t)m * D) + lane;
#pragma unroll
        for (int j = 0; j < 4; ++j) { const f32x4 y = v[j] * r * gr[64 * j] * (1.f + sc[64 * j]) + sh[64 * j];
            o8[64 * j] = (unsigned long long)pk2(y.x, y.y) | ((unsigned long long)pk2(y.z, y.w) << 32); }
    }
}
__device__ __forceinline__ void norm_rows_final(float* x, const float* g) {
    const int tid = tid_fresh(), lane = tid & 63, gw = blockIdx.x * 8 + __builtin_amdgcn_readfirstlane(tid >> 6), NGW = gridDim.x * 8;
    for (int m = gw; m < TG; m += NGW) {
        f32x4* xr = (f32x4*)(x + (size_t)m * D) + lane; const f32x4* gr = (const f32x4*)g + lane;
        f32x4 v[4]; float s = 0.f;
#pragma unroll
        for (int j = 0; j < 4; ++j) { v[j] = xr[64 * j]; s += (v[j].x * v[j].x + v[j].y * v[j].y) + (v[j].z * v[j].z + v[j].w * v[j].w); }
        const float r = rsqrtf(wave_sum(s) * (1.f / D) + EPS);
#pragma unroll
        for (int j = 0; j < 4; ++j) xr[64 * j] = v[j] * r * gr[64 * j];
    }
}

__device__ __forceinline__ void transpose_item(const float* W, int ldw, bf16_t* WT, int ldt, int row_off, int k_off, LAS float* scr, int kb, int nb, int lane) {
    const int k0 = 64 * kb, n0 = 32 * nb;
#pragma unroll 8
    for (int i = 0; i < 32; ++i) { const int kk = 2 * i + (lane >> 5); scr[kk * 33 + (lane & 31)] = W[(size_t)(k0 + kk) * ldw + n0 + (lane & 31)]; }
    asm volatile("s_waitcnt lgkmcnt(0)" ::: "memory");
    const int c = lane & 7;
#pragma unroll
    for (int j = 0; j < 4; ++j) { const int n = (lane >> 3) + 8 * j; const LAS float* s = scr + (8 * c) * 33 + n;
        u32x4 o; o.x = pk2(s[0 * 33], s[1 * 33]); o.y = pk2(s[2 * 33], s[3 * 33]); o.z = pk2(s[4 * 33], s[5 * 33]); o.w = pk2(s[6 * 33], s[7 * 33]);
        *(u32x4*)(WT + (size_t)(row_off + n0 + n) * ldt + k_off + k0 + 8 * c) = o; }
    asm volatile("s_waitcnt lgkmcnt(0)" ::: "memory");
}

#define XB_TMO      128
#define XB_XCNT(j)  (256  + 64 * (j))
#define XB_XSUB(j)  (1280 + 64 * (j))
#define XB_XGEN(j)  (2304 + 64 * (j))
#define XB_TOP      3328
#define XB_TOPGEN   3392
#define XCD_BAR_WORDS 3456
#define XB_SPIN_CAP (1u << 18)

__device__ __forceinline__ unsigned xb_ld(unsigned* p)              { return __hip_atomic_load(p, __ATOMIC_RELAXED, __HIP_MEMORY_SCOPE_AGENT); }
__device__ __forceinline__ unsigned xb_add(unsigned* p, unsigned v) { return __hip_atomic_fetch_add(p, v, __ATOMIC_RELAXED, __HIP_MEMORY_SCOPE_AGENT); }
__device__ __forceinline__ unsigned xb_xcc_id() { return (unsigned)__builtin_amdgcn_s_getreg((3 << 11) | 20) & 0xFu; }
#define XB_SPIN(cond, bar) do { unsigned _sp = 0; while (cond) { __builtin_amdgcn_s_sleep(1); \
    if ((++_sp & 255u) == 0u) { if (xb_ld(&(bar)[XB_TMO])) break; if (_sp > XB_SPIN_CAP) { atomicAdd(&(bar)[XB_TMO], 1u); break; } } } } while (0)

struct XcdBarrier {
    unsigned* bar; unsigned x;
    volatile LAS unsigned* st;
};

__device__ __forceinline__ XcdBarrier xcd_barrier_post(unsigned* bar, volatile LAS unsigned* st) {
    XcdBarrier b; b.bar = bar; b.x = xb_xcc_id(); b.st = st;
    if (threadIdx.x == 0) (void)xb_add(&bar[XB_XCNT(b.x)], 1u);
    return b;
}
__device__ __forceinline__ void xcd_barrier_complete(unsigned* bar, unsigned x, unsigned& nloc, unsigned& nx) {
    const unsigned G = gridDim.x * gridDim.y * gridDim.z;
    unsigned sum, cnt, mine, sp = 0u;
    for (;;) {
        sum = 0u; cnt = 0u; mine = 0u;
#pragma unroll
        for (unsigned j = 0; j < 16; ++j) { const unsigned c = xb_ld(&bar[XB_XCNT(j)]); sum += c; cnt += (c > 0u) ? 1u : 0u; mine = (j == x) ? c : mine; }
        if (sum == G) break;
        __builtin_amdgcn_s_sleep(1);
        if ((++sp & 255u) == 0u) { if (xb_ld(&bar[XB_TMO])) break; if (sp > XB_SPIN_CAP) { atomicAdd(&bar[XB_TMO], 1u); break; } }
    }
    nloc = mine > 0u ? mine : 1u; nx = cnt > 0u ? cnt : 1u;
}

__device__ __forceinline__ void xcd_barrier(const XcdBarrier& b) {
    asm volatile("s_waitcnt vmcnt(0)" ::: "memory");
    __syncthreads();
    if (threadIdx.x == 0) {
        unsigned* bar = b.bar;
        __builtin_amdgcn_s_waitcnt(0);
        unsigned nloc = b.st[0], nx = b.st[1];
        if (nloc == 0u) { xcd_barrier_complete(bar, b.x, nloc, nx); b.st[0] = nloc; b.st[1] = nx; }
        const unsigned old = xb_add(&bar[XB_XSUB(b.x)], 1u);
        const unsigned gen = old / nloc;
        if (old + 1u == (gen + 1u) * nloc) {
            __builtin_amdgcn_fence(__ATOMIC_RELEASE, "agent");
            asm volatile("s_waitcnt vmcnt(0)" ::: "memory");
            const unsigned og = xb_add(&bar[XB_TOP], 1u);
            const unsigned tg = og / nx;
            if (og + 1u == (tg + 1u) * nx) xb_add(&bar[XB_TOPGEN], 1u);
            else XB_SPIN(xb_ld(&bar[XB_TOPGEN]) == tg, bar);
            __builtin_amdgcn_fence(__ATOMIC_ACQUIRE, "agent");
            xb_add(&bar[XB_XGEN(b.x)], 1u);
            asm volatile("s_waitcnt vmcnt(0)" ::: "memory");
        } else {
            XB_SPIN(xb_ld(&bar[XB_XGEN(b.x)]) == gen, bar);
            __builtin_amdgcn_fence(__ATOMIC_ACQUIRE, "agent");
            asm volatile("s_waitcnt vmcnt(0)" ::: "memory");
        }
    }
    __syncthreads();
}


constexpr int CW_XBAR = 45056;
#define XSYNC() do { XcdBarrier xb_; xb_.bar = (unsigned*)(KWS() + WS_CTL) + CW_XBAR; xb_.x = xb_xcc_id(); xb_.st = (volatile LAS unsigned*)(lds + 147456 - 256); xcd_barrier(xb_); } while (0)

struct Args { const void* p[24]; };
enum { P_X = 0, P_C, P_ADAW, P_ADAB, P_NMIXG, P_NMLPG, P_WIN, P_DLAM, P_DSUBG, P_HLB, P_HNG, P_GW2, P_GB, P_GNG, P_WUA, P_WUB, P_WUC, P_WOUT, P_W1, P_W2, P_FNG, P_OUT, P_WS };
typedef const unsigned long long __attribute__((address_space(4)))* kargp_t;
__device__ __forceinline__ const void* karg(int i) { kargp_t kp = (kargp_t)__builtin_amdgcn_kernarg_segment_ptr(); asm volatile("" : "+s"(kp));
    const unsigned long long v = kp[i]; const __attribute__((address_space(1))) void* g = (const __attribute__((address_space(1))) void*)v; return (const void*)g; }
#define GRID_SYNC() do { asm volatile("s_waitcnt vmcnt(0) lgkmcnt(0)" ::: "memory"); __syncthreads(); grid.sync(); \
    if (threadIdx.x < 64) { __builtin_amdgcn_fence(__ATOMIC_ACQUIRE, "agent"); asm volatile("s_waitcnt vmcnt(0)" ::: "memory"); } __syncthreads(); } while (0)
#define KF(i) ((const float*)karg(i))
#define KWS() ((uchar*)karg(P_WS))

__global__ void __launch_bounds__(512, 2) fwd_megakernel(Args a_unused) {
    extern __shared__ __attribute__((aligned(16))) uchar lds_raw[];
    LAS uchar* lds = (LAS uchar*)lds_raw;
    cg::grid_group grid = cg::this_grid();
    {
    const int tid = tid_fresh(), lane = tid & 63, wave = __builtin_amdgcn_readfirstlane(tid >> 6);

    if (blockIdx.x == 0) {
        unsigned* ctl = (unsigned*)(KWS() + WS_CTL); float* ctlf = (float*)ctl;
        for (int i = tid; i < 1024; i += 512) { ctl[i] = 0u; ctl[40960 + i] = 0u; }
        for (int i = tid; i < XCD_BAR_WORDS; i += 512) ctl[CW_XBAR + i] = 0u;
        if (tid < 4) {
            const float* lp = KF(P_DLAM) + tid * 256; float s1 = 0.f, s2 = 0.f;
            for (int d = 0; d < 64; ++d) { s1 += lp[d] * lp[64 + d]; s2 += lp[128 + d] * lp[192 + d]; }
            const float li = 0.8f - 0.6f * expf(-0.3f * (float)tid);
            ctlf[1024 + tid] = expf(s1) - expf(s2) + li; ctlf[1028 + tid] = li;
        }
        {
            const float* lg = KF(P_HLB); const int j = tid;
            float v[4], mx = -1e30f;
#pragma unroll
            for (int l = 0; l < 4; ++l) { v[l] = lg[l * 512 + j]; mx = fmaxf(mx, v[l]); }
            float den = 0.f;
#pragma unroll
            for (int l = 0; l < 4; ++l) { v[l] = expf(v[l] - mx); den += v[l]; }
            float cum = 0.f; const float w0 = v[0] / den;
#pragma unroll
            for (int l = 0; l < 4; ++l) { cum += v[l] / den; ctlf[2048 + l * 512 + j] = cum - w0; }
        }
        {
            float* pv = ctlf + 8192;
            const float* s0 = KF(P_NMIXG); for (int i = tid; i < 4096; i += 512) pv[i] = s0[i];
            const float* s1 = KF(P_NMLPG); for (int i = tid; i < 4096; i += 512) pv[4096 + i] = s1[i];
            const float* s2 = KF(P_DSUBG); for (int i = tid; i < 512; i += 512) pv[8192 + i] = s2[i];
            const float* s3 = KF(P_HNG); for (int i = tid; i < 256; i += 512) pv[8704 + i] = s3[i];
            const float* s4 = KF(P_GW2); for (int i = tid; i < 16384; i += 512) pv[8960 + i] = s4[i];
            const float* s5 = KF(P_GB); for (int i = tid; i < 1024; i += 512) pv[25344 + i] = s5[i];
            const float* s6 = KF(P_GNG); for (int i = tid; i < 256; i += 512) pv[26368 + i] = s6[i];
            const float* s7 = KF(P_FNG); for (int i = tid; i < 1024; i += 512) pv[26624 + i] = s7[i];
        }
    }
#ifndef NO_MOD
    {
        LAS float* cond = (LAS float*)lds; LAS float* red = (LAS float*)(lds + 131072);
        float* mod = (float*)(KWS() + WS_MOD);
        const float* cin = KF(P_C); const float* adaw = KF(P_ADAW); const float* adab = KF(P_ADAB);
        bool loaded = false;
        for (int it = blockIdx.x; it < 4 * 96; it += gridDim.x) {
            if (!loaded) { for (int i = tid; i < 32 * 1024; i += 512) { const float cv = cin[i]; cond[i] = cv / (1.f + __expf(-cv)); } loaded = true; __syncthreads(); }
            const int l = it / 96, n0 = (it % 96) * 64;
            const float* W = adaw + (size_t)l * D * (NMOD * D) + n0 + lane;
            float acc[32];
#pragma unroll
            for (int b = 0; b < 32; ++b) acc[b] = 0.f;
            for (int k4 = 0; k4 < 32; ++k4) {
                const int k = wave * 128 + k4 * 4;
                const float w0 = W[(size_t)k * (NMOD * D)], w1 = W[(size_t)(k + 1) * (NMOD * D)], w2v = W[(size_t)(k + 2) * (NMOD * D)], w3 = W[(size_t)(k + 3) * (NMOD * D)];
#pragma unroll
                for (int b = 0; b < 32; ++b) { const f32x4 c4 = *(const LAS f32x4*)(cond + b * 1024 + k); acc[b] += c4.x * w0 + c4.y * w1 + c4.z * w2v + c4.w * w3; }
            }
#pragma unroll
            for (int rd = 0; rd < 4; ++rd) {
                __syncthreads();
#pragma unroll
                for (int bb = 0; bb < 8; ++bb) red[(wave * 8 + bb) * 64 + lane] = acc[rd * 8 + bb];
                __syncthreads();
                float s = 0.f;
#pragma unroll
                for (int w = 0; w < 8; ++w) s += red[(w * 8 + wave) * 64 + lane];
                const int b = rd * 8 + wave;
                mod[((size_t)l * 32 + b) * (NMOD * D) + n0 + lane] = s + adab[l * (NMOD * D) + n0 + lane];
            }
        }
        __syncthreads();
    }
#endif
#ifndef NO_WT
    {
        LAS float* scr = (LAS float*)(lds + wave * 8704);
        const int gw = blockIdx.x * 8 + wave, NGW = gridDim.x * 8;
        uchar* ws = KWS();
        bf16_t* win_t = (bf16_t*)(ws + WS_WIN); bf16_t* wup_t = (bf16_t*)(ws + WS_WUP); bf16_t* wout_t = (bf16_t*)(ws + WS_WOUT);
        bf16_t* w1_t = (bf16_t*)(ws + WS_W1); bf16_t* w2_t = (bf16_t*)(ws + WS_W2);
        constexpr int I_IN = 16 * 209, I_UA = 8 * 32, I_UB = 4 * 32, I_UC = 4 * 32, I_O = 16 * 32, I_1 = 16 * 128, I_2 = 64 * 32;
        constexpr int I_L = I_IN + I_UA + I_UB + I_UC + I_O + I_1 + I_2;
        for (int it = gw; it < 4 * I_L; it += NGW) {
            const int l = it / I_L; int r = it % I_L;
            if (r < I_IN) { transpose_item(KF(P_WIN) + (size_t)l * D * DIN, DIN, win_t + (size_t)l * LDP * D, D, 0, 0, scr, r / 209, r % 209, lane); continue; } r -= I_IN;
            if (r < I_UA) { transpose_item(KF(P_WUA) + (size_t)l * 512 * D, D, wup_t + (size_t)l * D * D, D, 0, 0, scr, r / 32, r % 32, lane); continue; } r -= I_UA;
            if (r < I_UB) { transpose_item(KF(P_WUB) + (size_t)l * 256 * D, D, wup_t + (size_t)l * D * D, D, 0, 512, scr, r / 32, r % 32, lane); continue; } r -= I_UB;
            if (r < I_UC) { transpose_item(KF(P_WUC) + (size_t)l * 256 * D, D, wup_t + (size_t)l * D * D, D, 0, 768, scr, r / 32, r % 32, lane); continue; } r -= I_UC;
            if (r < I_O) { transpose_item(KF(P_WOUT) + (size_t)l * D * D, D, wout_t + (size_t)l * D * D, D, 0, 0, scr, r / 32, r % 32, lane); continue; } r -= I_O;
            if (r < I_1) { transpose_item(KF(P_W1) + (size_t)l * D * DFF, DFF, w1_t + (size_t)l * DFF * D, D, 0, 0, scr, r / 128, r % 128, lane); continue; } r -= I_1;
            transpose_item(KF(P_W2) + (size_t)l * DFF * D, D, w2_t + (size_t)l * D * DFF, DFF, 0, 0, scr, r / 32, r % 32, lane);
        }
        for (int i = blockIdx.x * 512 + tid; i < 4 * 28672; i += gridDim.x * 512) { const int l = i / 28672, r = i % 28672;
            *(u32x4*)(win_t + (size_t)l * LDP * D + (size_t)DIN * D + (size_t)r * 8) = (u32x4){0u, 0u, 0u, 0u}; }
    }
#endif
    }
    GRID_SYNC();
    if (threadIdx.x < 2) ((LAS unsigned*)(lds + 147456 - 256))[threadIdx.x] = 0u;
    (void)xcd_barrier_post((unsigned*)(KWS() + WS_CTL) + CW_XBAR, (volatile LAS unsigned*)(lds + 147456 - 256));

    for (int grp = 0; grp < NGRP; ++grp) {
        for (int l = 0; l < DEPTH; ++l) {
            {
                uchar* ws = KWS(); const float* pv = (const float*)(ws + WS_CTL) + 8192;
                const float* src = (l == 0 ? KF(P_X) : (const float*)karg(P_OUT)) + (size_t)grp * TG * D;
                norm_rows_mod(src, (bf16_t*)(ws + WS_HB), pv + l * D, (const float*)(ws + WS_MOD) + (size_t)l * 32 * (NMOD * D), grp * TG, 0, D);
            }
            XSYNC();
            { uchar* ws = KWS(); pg8::Gemm g{(const bf16_t*)(ws + WS_HB), (const bf16_t*)(ws + WS_WIN) + (size_t)l * LDP * D, D}; pg8::Order S; S.init(TG, LDP, D, gridDim.x, blockIdx.x, 1); pg8::EpiProj E{(bf16_t*)(ws + WS_PROJ), (bf16_t*)(ws + WS_ATT)};
#ifndef NO_EPIPROJ
              pg8::gemm_phase<pg8::EpiProj>(lds, g, S, E);
#endif
            }
            XSYNC();
            {
                uchar* ws = KWS(); const float* ctlf = (const float*)(ws + WS_CTL); const float* pv = ctlf + 8192;
                const int xq = blockIdx.x & 7; unsigned* ctr = (unsigned*)(ws + WS_CTL) + ((grp * DEPTH + l) * 8 + xq) * 4;
                const float lam = ctlf[1024 + l], laminit = ctlf[1028 + l];
                const bf16_t* PROJ = (const bf16_t*)(ws + WS_PROJ); bf16_t* OCAT = (bf16_t*)(ws + WS_OCAT); float* OFWD = (float*)(ws + WS_OFWD);
                LAS int* itm = (LAS int*)(lds + 147456 - 64);
                const int tid = tid_fresh();
                for (;;) {
                    __syncthreads();
                    if (tid == 0) itm[0] = (int)atomicAdd(ctr, 1u);
                    __syncthreads();
                    const int it = itm[0];
                    constexpr int NPQ = GB * 4 / 8;
                    if (it >= 4 * NPQ + NPQ * 16) break;
                    float* OBWD = (float*)(ws + WS_OBWD);
                    if (it < 2 * NPQ) { const int p = (it >> 1) * 8 + xq; unsigned* dn = (unsigned*)(ws + WS_CTL) + 40960 + (((grp * DEPTH + l) * GB * 4 + p) * 2);
                        scan_item<64, true>(lds, PROJ, OFWD, OBWD, OCAT, dn, p >> 2, p & 3, it & 1, ctlf + 2048 + l * 512, pv + 8704 + l * 64, nullptr, nullptr);
                    } else if (it < 4 * NPQ) { const int i2 = it - 2 * NPQ; const int p = (i2 >> 1) * 8 + xq; unsigned* dn = (unsigned*)(ws + WS_CTL) + 40960 + (((grp * DEPTH + l) * GB * 4 + p) * 2 + 1);
                        scan_item<32, false>(lds, PROJ, OFWD, OBWD, OCAT, dn, p >> 2, p & 3, i2 & 1, nullptr, pv + 26368 + l * 64, pv + 8960 + l * 4096, pv + 25344 + l * 256);
                    } else { const int u = it - 4 * NPQ, p = (u >> 4) * 8 + xq;
                        attn_unit(lds, (const bf16_t*)(ws + WS_ATT), OCAT, p >> 2, p & 3, u & 15, lam, laminit, pv + 8192 + l * 128);
                    }
                }
            }
            XSYNC();
            { uchar* ws = KWS(); pg8::Gemm g{(const bf16_t*)(ws + WS_OCAT), (const bf16_t*)(ws + WS_WUP) + (size_t)l * D * D, D}; pg8::Order S; S.init(TG, D, D, gridDim.x, blockIdx.x, 3); pg8::EpiMerge E{(const bf16_t*)(ws + WS_PROJ), (bf16_t*)(ws + WS_HB)};
#ifndef NO_EPIMERGE
              pg8::gemm_phase<pg8::EpiMerge>(lds, g, S, E);
#endif
            }
            XSYNC();
            { uchar* ws = KWS(); pg8::Gemm g{(const bf16_t*)(ws + WS_HB), (const bf16_t*)(ws + WS_WOUT) + (size_t)l * D * D, D}; pg8::Order S; S.init(TG, D, D, gridDim.x, blockIdx.x, 1);
              float* xg = (float*)karg(P_OUT) + (size_t)grp * TG * D;
              pg8::EpiRes E{l == 0 ? KF(P_X) + (size_t)grp * TG * D : xg, xg, (const float*)(ws + WS_MOD) + ((size_t)l * 32 + grp * GB) * (NMOD * D) + 2 * D};
#ifndef NO_EPIRES
              pg8::gemm_phase<pg8::EpiRes>(lds, g, S, E);
#endif
            }
            XSYNC();
            {
                uchar* ws = KWS(); const float* pv = (const float*)(ws + WS_CTL) + 8192;
                norm_rows_mod((const float*)karg(P_OUT) + (size_t)grp * TG * D, (bf16_t*)(ws + WS_HB), pv + 4096 + l * D, (const float*)(ws + WS_MOD) + (size_t)l * 32 * (NMOD * D), grp * TG, 3 * D, 4 * D);
            }
            XSYNC();
            { uchar* ws = KWS(); pg8::Gemm g{(const bf16_t*)(ws + WS_HB), (const bf16_t*)(ws + WS_W1) + (size_t)l * DFF * D, D}; pg8::Order S; S.init(TG, DFF, D, gridDim.x, blockIdx.x, 1); pg8::EpiRelu2 E{(bf16_t*)(ws + WS_U)};
#ifndef NO_EPIRELU2
              pg8::gemm_phase<pg8::EpiRelu2>(lds, g, S, E);
#endif
            }
            XSYNC();
            { uchar* ws = KWS(); pg8::Gemm g{(const bf16_t*)(ws + WS_U), (const bf16_t*)(ws + WS_W2) + (size_t)l * D * DFF, DFF}; pg8::Order S; S.init(TG, D, DFF, gridDim.x, blockIdx.x, 1);
              float* xg = (float*)karg(P_OUT) + (size_t)grp * TG * D;
              pg8::EpiRes E{xg, xg, (const float*)(ws + WS_MOD) + ((size_t)l * 32 + grp * GB) * (NMOD * D) + 5 * D};
#ifndef NO_EPIRES
              pg8::gemm_phase<pg8::EpiRes>(lds, g, S, E);
#endif
            }
            XSYNC();
        }
        norm_rows_final((float*)karg(P_OUT) + (size_t)grp * TG * D, (const float*)(KWS() + WS_CTL) + 8192 + 26624);
    }
}

extern "C" void kernel_launch(void* const* d_in, const int* in_sizes, int n_in, void* d_out, int out_size, void* d_ws, size_t ws_size, hipStream_t stream) {
    static int grid = 0;
    if (grid == 0) {
        if (n_in != 21 || ws_size < WS_END) { fprintf(stderr, "kernel_launch: unexpected n_in %d / ws %zu\n", n_in, ws_size); grid = -1; return; }
        int dev = 0, cus = 0, per_cu = 0;
        if (hipGetDevice(&dev) != hipSuccess || hipDeviceGetAttribute(&cus, hipDeviceAttributeMultiprocessorCount, dev) != hipSuccess) { grid = -1; return; }
        if (hipFuncSetAttribute((const void*)fwd_megakernel, hipFuncAttributeMaxDynamicSharedMemorySize, LDS_BYTES) != hipSuccess) { fprintf(stderr, "kernel_launch: hipFuncSetAttribute failed\n"); grid = -1; return; }
        if (hipOccupancyMaxActiveBlocksPerMultiprocessor(&per_cu, (const void*)fwd_megakernel, 512, LDS_BYTES) != hipSuccess || per_cu < 1) { fprintf(stderr, "kernel_launch: occupancy query says %d\n", per_cu); per_cu = 1; }
        (void)hipGetLastError();
        grid = cus;
    }
    if (grid < 0) return;
    Args a{};
    for (int i = 0; i < 21; ++i) a.p[i] = d_in[i];
    a.p[21] = d_out; a.p[22] = d_ws; a.p[23] = nullptr;
    void* args[] = {&a};
    hipError_t e = hipLaunchCooperativeKernel((void*)fwd_megakernel, dim3(grid), dim3(512), args, LDS_BYTES, stream);
    if (e != hipSuccess) fprintf(stderr, "kernel_launch: cooperative launch failed: %s (grid %d)\n", hipGetErrorString(e), grid);
}
```

```cpp
#include <hip/hip_runtime.h>
#include <hip/hip_cooperative_groups.h>
#include <cstdio>
#include <cstdint>
namespace cg = cooperative_groups;

#define LAS __attribute__((address_space(3)))
typedef unsigned short bf16_t;
typedef short bf16x8 __attribute__((ext_vector_type(8)));
typedef float f32x4 __attribute__((ext_vector_type(4)));
typedef float f32x2 __attribute__((ext_vector_type(2)));
typedef float f32x16 __attribute__((ext_vector_type(16)));
typedef unsigned u32x4 __attribute__((ext_vector_type(4)));
typedef short s16x4 __attribute__((ext_vector_type(4)));
typedef unsigned char uchar;

constexpr int D = 1024, SEQ = 2048, BATCH = 32, DEPTH = 4, DIN = 6688, LDP = 6912, DFF = 4096, NMOD = 6;
constexpr int GB = 16, TG = GB * SEQ, NGRP = BATCH / GB;
constexpr int CQ = 0, CK = 512, CV = 1024, BQ = 1536, BFF = 1792, BFB = 2048, BI = 2304, BG = 2560;
constexpr int GQ = 2816, GK = 2944, GV = 3072, GG = 3328, GLF = 3584, GLB = 3600, GATE = 3616;
constexpr float EPS = 1e-6f, LOG2E = 1.4426950408889634f;
constexpr float QSCALE = 0.125f * LOG2E;

constexpr size_t MiB = 1u << 20;
constexpr size_t WS_CTL = 0;
constexpr size_t WS_MOD = 1 * MiB;
constexpr size_t WS_WIN = 4 * MiB;
constexpr size_t WS_WUP = 58 * MiB;
constexpr size_t WS_WOUT = 66 * MiB;
constexpr size_t WS_W1 = 74 * MiB;
constexpr size_t WS_W2 = 106 * MiB;
constexpr size_t WS_HB = 138 * MiB;
constexpr size_t WS_OCAT = 202 * MiB;
constexpr size_t WS_OFWD = 266 * MiB;
constexpr size_t WS_PROJ = 330 * MiB;
constexpr size_t WS_U = WS_PROJ;
constexpr size_t WS_OBWD = 762 * MiB;
constexpr size_t WS_ATT = 826 * MiB;
constexpr size_t WS_END = 922 * MiB;
constexpr int LDS_BYTES = 148 * 1024;

__device__ __forceinline__ unsigned f2bf(float f) { unsigned u = __builtin_bit_cast(unsigned, f); return (u + 0x7fffu + ((u >> 16) & 1u)) >> 16; }
__device__ __forceinline__ unsigned pk2(float lo, float hi) { return f2bf(lo) | (f2bf(hi) << 16); }
__device__ __forceinline__ float bf2f(bf16_t v) { return __builtin_bit_cast(float, (unsigned)v << 16); }
__device__ __forceinline__ float bflo(unsigned u) { return __builtin_bit_cast(float, u << 16); }
__device__ __forceinline__ float bfhi(unsigned u) { return __builtin_bit_cast(float, u & 0xffff0000u); }
typedef __bf16 bf16x2_t __attribute__((ext_vector_type(2)));
__device__ __forceinline__ unsigned cvt_pk_bf16(float lo, float hi) { f32x2 v = {lo, hi}; bf16x2_t b = __builtin_convertvector(v, bf16x2_t); return __builtin_bit_cast(unsigned, b); }
__device__ __forceinline__ float wave_sum(float v) {
#pragma unroll
    for (int o = 1; o < 64; o <<= 1) v += __shfl_xor(v, o);
    return v;
}
__device__ __forceinline__ int tid_fresh() { int t = threadIdx.x; asm volatile("" : "+v"(t)); return t; }
__device__ __forceinline__ float sigmoidf_(float z) { return 1.f / (1.f + __expf(-z)); }

namespace pg8 {
constexpr int BM = 256, BK = 64, HALF = 128, HTB = HALF * BK * 2, STAGE_BYTES = 8 * HTB, NXCD = 8, WGM = 8;
__host__ __device__ __forceinline__ int lds_byte(int r, int c) { const int st = (r >> 4) * 2 + (c >> 5), rr = r & 15, cc = c & 31, ob = rr * 64 + cc * 2; return st * 1024 + (ob ^ (((ob >> 9) & 1) << 5)); }
__host__ __device__ __forceinline__ void stage_rc(int b, int& R, int& C) { const int st = b / 1024, sb = b % 1024, swz = sb ^ (((sb >> 9) & 1) << 5); R = (st >> 1) * 16 + swz / 64; C = (st & 1) * 32 + (swz % 64) / 2; }
__host__ __device__ __forceinline__ int perm32(int rho) { const int n = rho >> 4, i = rho & 15; return 8 * (i >> 2) + 4 * n + (i & 3); }

struct Unit { int pm, pn, koff, nt, seg; };
struct Gemm { const bf16_t* A; const bf16_t* Bt; int K; };

struct Order {
    int nM, nN, nwg, G, c, nseg, ntfull;
    __device__ void init(int M, int N, int K, int G_, int c_, int nseg_) { nM = M / BM; nN = N / BM; nwg = nM * nN; G = G_; c = c_; nseg = nseg_; ntfull = K / BK; }
    __device__ bool next(int i, Unit& u) const {
        int ti = i, seg = 0;
        if (nseg == 3) { ti = i / 3; seg = i - ti * 3; }
        const long L = (long)ti * G + c; if (L >= nwg) return false;
        int wgid = (int)L; { const int q = nwg / NXCD, r = nwg % NXCD, xcd = wgid % NXCD, off = wgid / NXCD; wgid = (xcd < r ? xcd * (q + 1) : r * (q + 1) + (xcd - r) * q) + off; }
        const int nig = WGM * nN, gid = wgid / nig, fm = gid * WGM, gsz = (nM - fm) < WGM ? (nM - fm) : WGM;
        u.pm = fm + ((wgid % nig) % gsz); u.pn = (wgid % nig) / gsz; u.seg = seg;
        if (nseg == 3) { u.koff = seg == 0 ? 0 : (seg == 1 ? 512 : 768); u.nt = seg == 0 ? 8 : 4; } else { u.koff = 0; u.nt = ntfull; }
        return true;
    }
};

struct EpiProj {
    bf16_t* O; bf16_t* att;
    __device__ __forceinline__ bool zero_after(const Unit&) const { return true; }
    __device__ __forceinline__ void operator()(f32x4 (&acc)[2][2][4][2], const Unit& u, int wr, int wc, int fr, int fq) const {
        const int row0 = u.pm * BM + wr * 64 + fr, col0 = u.pn * BM + wc * 32 + 8 * fq;
        const float sc = (u.pn < 2) ? QSCALE : 1.f;
        const bool toatt = u.pn < 6;
#pragma unroll
        for (int ai = 0; ai < 2; ++ai)
#pragma unroll
            for (int m = 0; m < 4; ++m) { const int row = row0 + ai * HALF + m * 16; bf16_t* rowp = O + (size_t)row * LDP + col0;
#pragma unroll
                for (int bj = 0; bj < 2; ++bj) { f32x4 v0 = acc[ai][bj][m][0] * sc, v1 = acc[ai][bj][m][1] * sc;
                    u32x4 w; w.x = cvt_pk_bf16(v0[0], v0[1]); w.y = cvt_pk_bf16(v0[2], v0[3]); w.z = cvt_pk_bf16(v1[0], v1[1]); w.w = cvt_pk_bf16(v1[2], v1[3]);
                    if (toatt) { const int seg = u.pn * 2 + bj, typ = seg >> 2, hh = seg & 3;
                        *(u32x4*)(att + ((size_t)(((row >> 11) * 4 + hh) * SEQ + (row & 2047))) * 384 + typ * 128 + wc * 32 + 8 * fq) = w; }
                    else *(u32x4*)(rowp + bj * HALF) = w; } }
    }
};
struct EpiRelu2 {
    bf16_t* O;
    __device__ __forceinline__ bool zero_after(const Unit&) const { return true; }
    __device__ __forceinline__ void operator()(f32x4 (&acc)[2][2][4][2], const Unit& u, int wr, int wc, int fr, int fq) const {
        const int row0 = u.pm * BM + wr * 64 + fr, col0 = u.pn * BM + wc * 32 + 8 * fq;
#pragma unroll
        for (int ai = 0; ai < 2; ++ai)
#pragma unroll
            for (int m = 0; m < 4; ++m) { bf16_t* rowp = O + (size_t)(row0 + ai * HALF + m * 16) * DFF + col0;
#pragma unroll
                for (int bj = 0; bj < 2; ++bj) { f32x4 v0 = acc[ai][bj][m][0], v1 = acc[ai][bj][m][1];
#pragma unroll
                    for (int j = 0; j < 4; ++j) { float a = fmaxf(v0[j], 0.f), b = fmaxf(v1[j], 0.f); v0[j] = a * a; v1[j] = b * b; }
                    u32x4 w; w.x = cvt_pk_bf16(v0[0], v0[1]); w.y = cvt_pk_bf16(v0[2], v0[3]); w.z = cvt_pk_bf16(v1[0], v1[1]); w.w = cvt_pk_bf16(v1[2], v1[3]);
                    *(u32x4*)(rowp + bj * HALF) = w; } }
    }
};
struct EpiRes {
    const float* base; float* out; const float* gate;
    __device__ __forceinline__ bool zero_after(const Unit&) const { return true; }
    __device__ __forceinline__ void operator()(f32x4 (&acc)[2][2][4][2], const Unit& u, int wr, int wc, int fr, int fq) const {
        const int row0 = u.pm * BM + wr * 64 + fr, col0 = u.pn * BM + wc * 32 + 8 * fq;
        const float* gp = gate + (size_t)((u.pm * BM) >> 11) * (NMOD * D) + col0;
#pragma unroll
        for (int bj = 0; bj < 2; ++bj) {
            const f32x4 g0 = *(const f32x4*)(gp + bj * HALF), g1 = *(const f32x4*)(gp + bj * HALF + 4);
#pragma unroll
            for (int ai = 0; ai < 2; ++ai) {
#pragma unroll
                for (int m = 0; m < 4; ++m) { const size_t off = (size_t)(row0 + ai * HALF + m * 16) * D + col0 + bj * HALF;
                    const f32x4 b0 = *(const f32x4*)(base + off), b1 = *(const f32x4*)(base + off + 4);
                    *(f32x4*)(out + off) = b0 + g0 * acc[ai][bj][m][0];
                    *(f32x4*)(out + off + 4) = b1 + g1 * acc[ai][bj][m][1];
                    if (m & 1) asm volatile("" ::: "memory"); }
            }
        }
    }
};
struct EpiMerge {
    const bf16_t* proj; bf16_t* O;
    __device__ __forceinline__ bool zero_after(const Unit& u) const { return u.seg == 2; }
    __device__ __forceinline__ void operator()(f32x4 (&acc)[2][2][4][2], const Unit& u, int wr, int wc, int fr, int fq) const {
        const int row0 = u.pm * BM + wr * 64 + fr, col0 = u.pn * BM + wc * 32 + 8 * fq;
        const int seg = u.seg;
#pragma unroll
        for (int ai = 0; ai < 2; ++ai)
#pragma unroll
            for (int m = 0; m < 4; ++m) { const size_t row = (size_t)(row0 + ai * HALF + m * 16); const bf16_t* gp = proj + row * LDP + GATE + col0;
#pragma unroll
                for (int bj = 0; bj < 2; ++bj) {
                    if (seg < 2) {
                        const u32x4 ga = *(const u32x4*)(gp + seg * D + bj * HALF), gb = *(const u32x4*)(gp + (seg + 1) * D + bj * HALF);
                        float r[8];
#pragma unroll
                        for (int j = 0; j < 4; ++j) {
                            const float a0 = fminf(fmaxf(bflo(ga[j]), -40.f), 40.f), a1 = fminf(fmaxf(bfhi(ga[j]), -40.f), 40.f);
                            const float b0 = fminf(fmaxf(bflo(gb[j]), -40.f), 40.f), b1 = fminf(fmaxf(bfhi(gb[j]), -40.f), 40.f);
                            r[2 * j] = (1.f + __expf(-b0)) * __builtin_amdgcn_rcpf(1.f + __expf(-a0));
                            r[2 * j + 1] = (1.f + __expf(-b1)) * __builtin_amdgcn_rcpf(1.f + __expf(-a1)); }
                        acc[ai][bj][m][0] = acc[ai][bj][m][0] * (f32x4){r[0], r[1], r[2], r[3]};
                        acc[ai][bj][m][1] = acc[ai][bj][m][1] * (f32x4){r[4], r[5], r[6], r[7]};
                    } else {
                        const u32x4 gc = *(const u32x4*)(gp + 2 * D + bj * HALF);
                        float r[8];
#pragma unroll
                        for (int j = 0; j < 4; ++j) {
                            const float c0 = fminf(fmaxf(bflo(gc[j]), -40.f), 40.f), c1 = fminf(fmaxf(bfhi(gc[j]), -40.f), 40.f);
                            r[2 * j] = __builtin_amdgcn_rcpf(1.f + __expf(-c0)); r[2 * j + 1] = __builtin_amdgcn_rcpf(1.f + __expf(-c1)); }
                        const f32x4 v0 = acc[ai][bj][m][0] * (f32x4){r[0], r[1], r[2], r[3]}, v1 = acc[ai][bj][m][1] * (f32x4){r[4], r[5], r[6], r[7]};
                        u32x4 w; w.x = cvt_pk_bf16(v0[0], v0[1]); w.y = cvt_pk_bf16(v0[2], v0[3]); w.z = cvt_pk_bf16(v1[0], v1[1]); w.w = cvt_pk_bf16(v1[2], v1[3]);
                        *(u32x4*)(O + row * D + col0 + bj * HALF) = w;
                    } } }
    }
};

template <class Epi, bool ALIGN_EPI = true>
__device__ __forceinline__ void gemm_phase(LAS uchar* lds, const Gemm g, const Order& S, const Epi& E) {
    const int tid = tid_fresh(), wid = __builtin_amdgcn_readfirstlane(tid >> 6), lane = tid & 63, wr = wid >> 2, wc = wid & 3, fr = lane & 15, fq = lane >> 4;
    const int K = g.K;
    unsigned voffA[2], voffB[2];
#pragma unroll
    for (int i = 0; i < 2; ++i) { int R, C; stage_rc(tid * 16 + i * 8192, R, C); const int Rb = (R & ~31) + perm32(R & 31);
        voffA[i] = (unsigned)(R * K + C) * 2u; voffB[i] = (unsigned)(Rb * K + C) * 2u; }
    const size_t kstep = (size_t)(BK * 2);
    const size_t hstep = (size_t)HALF * K * 2;
    const size_t tstep = 2 * hstep;
    const unsigned ldsw = (unsigned)wid * 1024u;
    const int aoff = lds_byte(wr * 64 + fr, fq * 8), boff = lds_byte(wc * 32 + fr, fq * 8);
#define PG8_SA(b, h) (((b) * 2 + (h)) * HTB)
#define PG8_SB(b, h) ((4 + (b) * 2 + (h)) * HTB)
#define PG8_STAGE(bufoff, gbase, voff) do { _Pragma("unroll") for (int _i = 0; _i < 2; ++_i) \
        __builtin_amdgcn_global_load_lds((const unsigned*)((const char*)(gbase) + (voff)[_i]), (LAS unsigned*)(lds + (bufoff) + ldsw + _i * 8192), 16, 0, 0); } while (0)
#define PG8_LDA(dst, b, h) do { _Pragma("unroll") for (int m = 0; m < 4; ++m) _Pragma("unroll") for (int k = 0; k < 2; ++k) dst[m][k] = *(const LAS bf16x8*)(lds + PG8_SA(b, h) + aoff + m * 2048 + k * 1024); } while (0)
#define PG8_LDB(dst, b, h) do { _Pragma("unroll") for (int n = 0; n < 2; ++n) _Pragma("unroll") for (int k = 0; k < 2; ++k) dst[n][k] = *(const LAS bf16x8*)(lds + PG8_SB(b, h) + boff + n * 2048 + k * 1024); } while (0)
#define PG8_MMA(ai, bj, At, Bt) do { __builtin_amdgcn_s_setprio(1); _Pragma("unroll") for (int m = 0; m < 4; ++m) _Pragma("unroll") for (int n = 0; n < 2; ++n) _Pragma("unroll") for (int k = 0; k < 2; ++k) \
        acc[ai][bj][m][n] = __builtin_amdgcn_mfma_f32_16x16x32_bf16(Bt[n][k], At[m][k], acc[ai][bj][m][n], 0, 0, 0); __builtin_amdgcn_s_setprio(0); } while (0)
#define PG8_WAIT_V(n) asm volatile("s_waitcnt vmcnt(" #n ")" ::: "memory")
#define PG8_WAIT_L(n) asm volatile("s_waitcnt lgkmcnt(" #n ")" ::: "memory")
#define PG8_BAR __builtin_amdgcn_s_barrier()
#define PG8_SCHED __builtin_amdgcn_sched_barrier(0)
    Unit cur, nxt; int ui = 0;
    if (!S.next(0, cur)) return;
    f32x4 acc[2][2][4][2];
#pragma unroll
    for (int a = 0; a < 2; ++a)
#pragma unroll
        for (int b = 0; b < 2; ++b)
#pragma unroll
            for (int m = 0; m < 4; ++m)
#pragma unroll
                for (int n = 0; n < 2; ++n) acc[a][b][m][n] = (f32x4){0.f, 0.f, 0.f, 0.f};
    bf16x8 At[4][2], B0[2][2], B1[2][2];
    const char* cA = (const char*)g.A + (size_t)cur.pm * tstep + (size_t)cur.koff * 2; const char* cB = (const char*)g.Bt + (size_t)cur.pn * tstep + (size_t)cur.koff * 2;
    PG8_STAGE(PG8_SB(0, 0), cB, voffB); PG8_STAGE(PG8_SB(0, 1), cB + hstep, voffB); PG8_STAGE(PG8_SA(0, 0), cA, voffA); PG8_STAGE(PG8_SA(0, 1), cA + hstep, voffA);
    if (wr == 1) PG8_BAR;
    PG8_WAIT_V(2); PG8_BAR;
    PG8_STAGE(PG8_SB(1, 0), cB + kstep, voffB); PG8_STAGE(PG8_SA(1, 0), cA + kstep, voffA); PG8_STAGE(PG8_SB(1, 1), cB + hstep + kstep, voffB);
    PG8_WAIT_V(6); PG8_BAR;
    for (;;) {
        const bool has_next = S.next(ui + 1, nxt);
        const char* nA = has_next ? (const char*)g.A + (size_t)nxt.pm * tstep + (size_t)nxt.koff * 2 : cA; const char* nB = has_next ? (const char*)g.Bt + (size_t)nxt.pn * tstep + (size_t)nxt.koff * 2 : cB;
        const int nt = cur.nt;
        for (int t = 0; t < nt; t += 2) {
            const bool last = (t == nt - 2);
            const char* a1 = cA + (size_t)(t + 1) * kstep;
            const char* a2 = last ? nA : cA + (size_t)(t + 2) * kstep; const char* b2 = last ? nB : cB + (size_t)(t + 2) * kstep;
            const char* a3 = a2 + kstep; const char* b3 = b2 + kstep;
            PG8_LDB(B0, 0, 0); PG8_LDB(B1, 0, 1); PG8_SCHED; PG8_LDA(At, 0, 0); PG8_STAGE(PG8_SA(1, 1), a1 + hstep, voffA);
            PG8_WAIT_V(8); PG8_WAIT_L(0); PG8_BAR; PG8_MMA(0, 0, At, B0); PG8_MMA(0, 1, At, B1); PG8_BAR; PG8_SCHED;
            PG8_LDA(At, 0, 1); PG8_STAGE(PG8_SB(0, 0), b2, voffB); PG8_STAGE(PG8_SB(0, 1), b2 + hstep, voffB); PG8_STAGE(PG8_SA(0, 0), a2, voffA);
            PG8_WAIT_V(8); PG8_WAIT_L(0); PG8_BAR; PG8_MMA(1, 0, At, B0); PG8_MMA(1, 1, At, B1); PG8_BAR; PG8_SCHED;
            PG8_LDB(B0, 1, 0); PG8_LDB(B1, 1, 1); PG8_SCHED; PG8_LDA(At, 1, 0); PG8_STAGE(PG8_SA(0, 1), a2 + hstep, voffA);
            PG8_WAIT_V(8); PG8_WAIT_L(0); PG8_BAR; PG8_MMA(0, 0, At, B0); PG8_MMA(0, 1, At, B1); PG8_BAR; PG8_SCHED;
            PG8_LDA(At, 1, 1); PG8_STAGE(PG8_SB(1, 0), b3, voffB); PG8_STAGE(PG8_SB(1, 1), b3 + hstep, voffB); PG8_STAGE(PG8_SA(1, 0), a3, voffA);
            PG8_WAIT_V(8); PG8_WAIT_L(0); PG8_BAR; PG8_MMA(1, 0, At, B0); PG8_MMA(1, 1, At, B1); PG8_BAR; PG8_SCHED;
        }
        if constexpr (ALIGN_EPI) { if (wr == 0) PG8_BAR; }
        E(acc, cur, wr, wc, fr, fq);
        if (!has_next) break;
        if (E.zero_after(cur)) {
#pragma unroll
            for (int a = 0; a < 2; ++a)
#pragma unroll
                for (int b = 0; b < 2; ++b)
#pragma unroll
                    for (int m = 0; m < 4; ++m)
#pragma unroll
                        for (int n = 0; n < 2; ++n) acc[a][b][m][n] = (f32x4){0.f, 0.f, 0.f, 0.f};
        }
        cur = nxt; cA = nA; cB = nB; ++ui;
        if constexpr (ALIGN_EPI) { if (wr == 1) PG8_BAR; }
    }
    PG8_WAIT_V(0);
    if constexpr (!ALIGN_EPI) { if (wr == 0) PG8_BAR; }
    PG8_BAR;
#undef PG8_SA
#undef PG8_SB
#undef PG8_STAGE
#undef PG8_LDA
#undef PG8_LDB
#undef PG8_MMA
#undef PG8_WAIT_V
#undef PG8_WAIT_L
#undef PG8_BAR
#undef PG8_SCHED
}
}

__device__ __forceinline__ int crow(int r, int hi) { return (r & 3) + 8 * (r >> 2) + 4 * hi; }
__device__ __forceinline__ s16x4 vtr(const LAS uchar* p) { return __builtin_bit_cast(s16x4, __builtin_amdgcn_ds_read_tr16_b64_v4i16((LAS s16x4*)p)); }
__device__ __forceinline__ float xhalf_max(float m) { auto rr = __builtin_amdgcn_permlane32_swap(__builtin_bit_cast(unsigned, m), __builtin_bit_cast(unsigned, m), false, false); return fmaxf(__builtin_bit_cast(float, rr[0]), __builtin_bit_cast(float, rr[1])); }
__device__ __forceinline__ float xhalf_sum(float m) { auto rr = __builtin_amdgcn_permlane32_swap(__builtin_bit_cast(unsigned, m), __builtin_bit_cast(unsigned, m), false, false); return __builtin_bit_cast(float, rr[0]) + __builtin_bit_cast(float, rr[1]); }

__device__ __forceinline__ void glds16(const void* gsrc, unsigned lds_dst) { unsigned keep;
    asm volatile("s_mov_b32 %0, m0\n\ts_mov_b32 m0, %2\n\ts_nop 0\n\tglobal_load_lds_dwordx4 %1, off\n\ts_mov_b32 m0, %0" : "=&s"(keep) : "v"(gsrc), "s"(lds_dst) : "memory"); }
constexpr int ATT_SLOT = 32768, ATT_WSF = 98304;
__device__ __forceinline__ void attn_unit(LAS uchar* lds, const bf16_t* proj, bf16_t* ocat, int bl, int h, int qb, float lam, float laminit, const float* sg) {
    const int tid = tid_fresh(), lane = tid & 63, r32 = lane & 31, hi = lane >> 5;
    const int wave = __builtin_amdgcn_readfirstlane(tid >> 6), mi = wave >> 2, rb = wave & 3;
    const size_t rowbase = (size_t)bl * SEQ;
    const int q0 = qb * 128 + rb * 32;
    const float m2 = exp2f(-2.f * (float)(h + 1)) * LOG2E;
    bf16x8 qf[4];
    const bf16_t* att = proj;
    const size_t hb = (size_t)(bl * 4 + h) * SEQ;
    { const bf16_t* qp = att + (hb + q0 + r32) * 384 + mi * 64 + hi * 8;
#pragma unroll
      for (int d0 = 0; d0 < 4; ++d0) qf[d0] = *(const bf16x8*)(qp + d0 * 16); }
    const int kkey = 4 * wave + (lane >> 4);
    const bf16_t* ksrc0 = att + (hb + kkey) * 384 + 128 + (((lane & 15) ^ (kkey & 15)) * 8);
    const bf16_t* ksrc1 = ksrc0 + (size_t)32 * 384;
    const bf16_t* vsrc0 = att + (hb + 16 * (wave & 3) + (lane >> 2)) * 384 + 256 + (wave >> 2) * 32 + (lane & 3) * 8;
    const bf16_t* vsrc1 = vsrc0 + 64;
    const unsigned lds0 = (unsigned)(uintptr_t)lds + (unsigned)wave * 1024u;
#define ATT_ISSUE(t, sb) do { const size_t go_ = (size_t)(t) * 64 * 384; const unsigned d_ = (unsigned)__builtin_amdgcn_readfirstlane((int)(lds0 + (unsigned)(sb))); \
        glds16(ksrc0 + go_, d_); glds16(ksrc1 + go_, d_ + 8192u); glds16(vsrc0 + go_, d_ + 16384u); glds16(vsrc1 + go_, d_ + 24576u); } while (0)
    LAS float* wsf = (LAS float*)(lds + ATT_WSF) + wave * 64;
    f32x16 o[4];
#pragma unroll
    for (int d = 0; d < 4; ++d)
#pragma unroll
        for (int r = 0; r < 16; ++r) o[d][r] = 0.f;
    float mhat = 0.f;
    f32x16 ol;
#pragma unroll
    for (int r = 0; r < 16; ++r) ol[r] = 0.f;
    const bf16x8 ones = (bf16x8){0x3F80, 0x3F80, 0x3F80, 0x3F80, 0x3F80, 0x3F80, 0x3F80, 0x3F80};
    int kfo[4];
#pragma unroll
    for (int d0 = 0; d0 < 4; ++d0) kfo[d0] = r32 * 256 + (((mi * 8 + 2 * d0 + hi) ^ (r32 & 15)) * 16);
    const int vfo = 16384 + ((lane >> 4) & 1) * 32 + (lane & 3) * 8 + (4 * hi + ((lane & 15) >> 2)) * 64;
    ATT_ISSUE(0, 0); ATT_ISSUE(1, ATT_SLOT);
    int slot_c = 0, slot_n = 2 * ATT_SLOT;
    for (int t = 0; t < SEQ / 64; ++t) {
        if (t + 1 < SEQ / 64) asm volatile("s_waitcnt vmcnt(4) lgkmcnt(0)" ::: "memory"); else asm volatile("s_waitcnt vmcnt(0) lgkmcnt(0)" ::: "memory");
        __builtin_amdgcn_s_barrier();
        asm volatile("" ::: "memory");
        if (t + 2 < SEQ / 64) ATT_ISSUE(t + 2, slot_n);
        const LAS uchar* sl = lds + slot_c;
        { const int nx = slot_c + ATT_SLOT; slot_n = slot_c; slot_c = (nx == 3 * ATT_SLOT) ? 0 : nx; }
        const float dq = (float)(q0 + r32 - 64 * t - 4 * hi);
        f32x16 p0, p1;
#pragma unroll
        for (int r = 0; r < 16; ++r) { const float kc = (float)((r & 3) + 8 * (r >> 2));
            p0[r] = __builtin_fmaf(-m2, __builtin_fabsf(dq - kc), -mhat); p1[r] = __builtin_fmaf(-m2, __builtin_fabsf(dq - kc - 32.f), -mhat); }
#pragma unroll
        for (int d0 = 0; d0 < 4; ++d0) {
            const bf16x8 a0 = *(const LAS bf16x8*)(sl + kfo[d0]), a1 = *(const LAS bf16x8*)(sl + kfo[d0] + 8192);
            p0 = __builtin_amdgcn_mfma_f32_32x32x16_bf16(a0, qf[d0], p0, 0, 0, 0);
            p1 = __builtin_amdgcn_mfma_f32_32x32x16_bf16(a1, qf[d0], p1, 0, 0, 0); }
        float rm = fmaxf(p0[0], p1[0]);
#pragma unroll
        for (int r = 1; r < 16; ++r) rm = fmaxf(rm, fmaxf(p0[r], p1[r]));
        rm = xhalf_max(rm);
        const bool first = (t == 0);
        if (first || __any(rm > 8.f)) {
            const float dl = first ? rm : fmaxf(rm, 0.f);
            mhat += dl;
#pragma unroll
            for (int r = 0; r < 16; ++r) { p0[r] -= dl; p1[r] -= dl; }
            if (!first) {
                const float f = __builtin_amdgcn_exp2f(-dl);
                if (hi == 0) wsf[r32] = f;
                float fr_[16];
#pragma unroll
                for (int r = 0; r < 16; ++r) fr_[r] = wsf[crow(r, hi)];
#pragma unroll
                for (int d = 0; d < 4; ++d)
#pragma unroll
                    for (int r = 0; r < 16; ++r) o[d][r] *= fr_[r];
#pragma unroll
                for (int r = 0; r < 16; ++r) ol[r] *= fr_[r];
            }
        }
#pragma unroll
        for (int r = 0; r < 16; ++r) { p0[r] = __builtin_amdgcn_exp2f(p0[r]); p1[r] = __builtin_amdgcn_exp2f(p1[r]); }
        u32x4 pw[4];
#pragma unroll
        for (int j = 0; j < 4; ++j) { pw[0][j] = cvt_pk_bf16(p0[2 * j], p0[2 * j + 1]); pw[1][j] = cvt_pk_bf16(p0[8 + 2 * j], p0[8 + 2 * j + 1]);
                                      pw[2][j] = cvt_pk_bf16(p1[2 * j], p1[2 * j + 1]); pw[3][j] = cvt_pk_bf16(p1[8 + 2 * j], p1[8 + 2 * j + 1]); }
#pragma unroll
        for (int d = 0; d < 4; ++d)
#pragma unroll
            for (int ks = 0; ks < 4; ++ks) {
                const s16x4 lo = vtr(sl + vfo + d * 4096 + ks * 1024), hh = vtr(sl + vfo + d * 4096 + ks * 1024 + 512);
                const bf16x8 vf = (bf16x8){lo[0], lo[1], lo[2], lo[3], hh[0], hh[1], hh[2], hh[3]};
                o[d] = __builtin_amdgcn_mfma_f32_32x32x16_bf16(__builtin_bit_cast(bf16x8, pw[ks]), vf, o[d], 0, 0, 0); }
#pragma unroll
        for (int ks = 0; ks < 4; ++ks) ol = __builtin_amdgcn_mfma_f32_32x32x16_bf16(__builtin_bit_cast(bf16x8, pw[ks]), ones, ol, 0, 0, 0);
    }
#undef ATT_ISSUE
    float fr_[16];
#pragma unroll
    for (int r = 0; r < 16; ++r) fr_[r] = (mi == 0 ? 1.f : lam) / ol[r];
    __syncthreads();
    LAS float* X = (LAS float*)lds + rb * 4096;
    if (mi == 1) {
#pragma unroll
        for (int d = 0; d < 4; ++d)
#pragma unroll
            for (int r = 0; r < 16; ++r) X[(d * 16 + r) * 64 + lane] = o[d][r] * fr_[r];
    }
    __syncthreads();
    if (mi == 0) {
        float ss[16];
#pragma unroll
        for (int r = 0; r < 16; ++r) ss[r] = 0.f;
#pragma unroll
        for (int d = 0; d < 4; ++d)
#pragma unroll
            for (int r = 0; r < 16; ++r) { const float v = o[d][r] * fr_[r] - X[(d * 16 + r) * 64 + lane]; o[d][r] = v; ss[r] += v * v; }
#pragma unroll
        for (int r = 0; r < 16; ++r) {
#pragma unroll
            for (int s = 1; s < 32; s <<= 1) ss[r] += __shfl_xor(ss[r], s);
            ss[r] = rsqrtf(ss[r] * (1.f / 128.f) + EPS) * (1.f - laminit); }
        float gv[4];
#pragma unroll
        for (int d = 0; d < 4; ++d) gv[d] = sg[d * 32 + r32];
#pragma unroll
        for (int r = 0; r < 16; ++r) { bf16_t* op = ocat + (rowbase + q0 + crow(r, hi)) * D + h * 128 + r32;
#pragma unroll
            for (int d = 0; d < 4; ++d) op[d * 32] = (bf16_t)f2bf(o[d][r] * ss[r] * gv[d]); }
    }
    __syncthreads();
}

template <int DK, bool HG>
__device__ __forceinline__ void scan_item(LAS uchar* lds, const bf16_t* proj, float* oraw0, float* oraw1, bf16_t* ocat, unsigned* done, int bl, int h, int dir, const float* lb  ,
                                          const float* normg  , const float* w2  , const float* gbias  ) {
    constexpr int KPW = DK / 8, TB = 32, NS = TB / 16, NR = TB / 8, GS = 4;
    LAS float* sA = (LAS float*)lds;
    LAS float* sK = sA + TB * DK;
    LAS float* sQ = sK + TB * DK;
    LAS float* sV = sQ + TB * DK;
    LAS float* sP = sV + TB * 64;
    const int tid = tid_fresh(), lane = tid & 63, wave = __builtin_amdgcn_readfirstlane(tid >> 6);
    const int ps = tid >> 5, pi = tid & 31;
    const size_t rowbase = (size_t)bl * SEQ;
    float* oraw = dir == 0 ? oraw0 : oraw1;
    __syncthreads();
    {
        float lb0 = 0.f, lb1 = 0.f, w2c[16], bias = 0.f;
        if (HG) { lb0 = lb[dir * 256 + h * 64 + pi]; lb1 = lb[dir * 256 + h * 64 + pi + 32]; }
        else {
#pragma unroll
            for (int r = 0; r < 16; ++r) w2c[r] = w2[(dir * 16 + r) * 128 + h * 32 + pi];
            bias = gbias[dir * 128 + h * 32 + pi]; }
        f32x2 S[KPW / 2];
#pragma unroll
        for (int j = 0; j < KPW / 2; ++j) S[j] = (f32x2){0.f, 0.f};
        bf16_t rz0[2][NS], rz1[2][NS], rq0[2][NS], rq1[2][NS], rv0[2][NS], rv1[2][NS], rk0[2][NS]; u32x4 rl0[2][NS], rl1[2][NS];
#pragma unroll
        for (int i = 0; i < NS; ++i) for (int e = 0; e < 2; ++e) { rz0[e][i] = rz1[e][i] = rq0[e][i] = rq1[e][i] = rv0[e][i] = rv1[e][i] = rk0[e][i] = 0; rl0[e][i] = rl1[e][i] = (u32x4){0, 0, 0, 0}; }
#define SCAN_LOAD(blk, E_) do { _Pragma("unroll") for (int i_ = 0; i_ < NS; ++i_) { const int st_ = (blk) * TB + ps + 16 * i_; const int tok_ = dir == 0 ? st_ : 2047 - st_; const bf16_t* pr_ = proj + (rowbase + tok_) * LDP; \
        if (HG) { const int zc_ = (dir == 0 ? BFF : BFB) + h * 64 + pi; rz0[E_][i_] = pr_[zc_]; rz1[E_][i_] = pr_[zc_ + 32]; rq0[E_][i_] = pr_[BQ + h * 64 + pi]; rq1[E_][i_] = pr_[BQ + h * 64 + pi + 32]; rv0[E_][i_] = pr_[BI + h * 64 + pi]; rv1[E_][i_] = pr_[BI + h * 64 + pi + 32]; } \
        else { const u32x4* lp_ = (const u32x4*)(pr_ + (dir == 0 ? GLF : GLB)); rl0[E_][i_] = lp_[0]; rl1[E_][i_] = lp_[1]; rk0[E_][i_] = pr_[GK + h * 32 + pi]; rq0[E_][i_] = pr_[GQ + h * 32 + pi]; rv0[E_][i_] = pr_[GV + h * 64 + pi]; rv1[E_][i_] = pr_[GV + h * 64 + pi + 32]; } } } while (0)
        SCAN_LOAD(0, 0); SCAN_LOAD(1, 1);
        for (int blk2 = 0; blk2 < SEQ / TB; blk2 += 2) {
            { const int blk = blk2;
#pragma unroll
            for (int i = 0; i < NS; ++i) {
                const int st = ps + 16 * i;
                if (HG) {
                    const float z0 = bf2f(rz0[0][i]), z1 = bf2f(rz1[0][i]);
                    const float s0 = __builtin_amdgcn_rcpf(1.f + __expf(-z0)), s1 = __builtin_amdgcn_rcpf(1.f + __expf(-z1));
                    sA[st * 64 + pi] = s0 * (1.f + lb0 * __expf(fminf(-z0, 80.f))); sA[st * 64 + pi + 32] = s1 * (1.f + lb1 * __expf(fminf(-z1, 80.f)));
                    sK[st * 64 + pi] = (1.f - lb0) * __builtin_amdgcn_rcpf(1.f + __expf(z0)); sK[st * 64 + pi + 32] = (1.f - lb1) * __builtin_amdgcn_rcpf(1.f + __expf(z1));
                    const float q0 = bf2f(rq0[0][i]), q1 = bf2f(rq1[0][i]);
                    sQ[st * 64 + pi] = q0 * __builtin_amdgcn_rcpf(1.f + __expf(-q0)) * 0.125f; sQ[st * 64 + pi + 32] = q1 * __builtin_amdgcn_rcpf(1.f + __expf(-q1)) * 0.125f;
                } else {
                    float z = bias;
#pragma unroll
                    for (int j = 0; j < 4; ++j) { z += bflo(rl0[0][i][j]) * w2c[2 * j] + bfhi(rl0[0][i][j]) * w2c[2 * j + 1]; z += bflo(rl1[0][i][j]) * w2c[8 + 2 * j] + bfhi(rl1[0][i][j]) * w2c[8 + 2 * j + 1]; }
                    const float ls = fminf(z, 0.f) - __logf(1.f + __expf(-fabsf(z)));
                    sA[st * 32 + pi] = __expf(ls * (1.f / 16.f));
                    sK[st * 32 + pi] = bf2f(rk0[0][i]);
                    sQ[st * 32 + pi] = bf2f(rq0[0][i]) * 0.17677669529663687f;
                }
                sV[st * 64 + pi] = bf2f(rv0[0][i]); sV[st * 64 + pi + 32] = bf2f(rv1[0][i]);
            }
            asm volatile("s_waitcnt lgkmcnt(0)" ::: "memory"); __builtin_amdgcn_s_barrier(); asm volatile("" ::: "memory");
            if (blk + 2 < SEQ / TB) SCAN_LOAD(blk + 2, 0);
            for (int s0_ = 0; s0_ < TB; s0_ += GS) {
                float vv[GS]; f32x4 a4[GS][KPW / 4], k4[GS][KPW / 4], q4[GS][KPW / 4];
#pragma unroll
                for (int g = 0; g < GS; ++g) { const int s = s0_ + g; vv[g] = sV[s * 64 + lane];
#pragma unroll
                    for (int j4 = 0; j4 < KPW / 4; ++j4) { a4[g][j4] = *(const LAS f32x4*)(sA + s * DK + wave * KPW + j4 * 4); k4[g][j4] = *(const LAS f32x4*)(sK + s * DK + wave * KPW + j4 * 4); q4[g][j4] = *(const LAS f32x4*)(sQ + s * DK + wave * KPW + j4 * 4); } }
                float po[GS];
#pragma unroll
                for (int g = 0; g < GS; ++g) {
                    f32x2 op = (f32x2){0.f, 0.f};
#pragma unroll
                    for (int j4 = 0; j4 < KPW / 4; ++j4) {
                        const f32x2 kv0 = (f32x2){k4[g][j4][0], k4[g][j4][1]} * vv[g], kv1 = (f32x2){k4[g][j4][2], k4[g][j4][3]} * vv[g];
                        S[2 * j4] = __builtin_elementwise_fma((f32x2){a4[g][j4][0], a4[g][j4][1]}, S[2 * j4], kv0);
                        S[2 * j4 + 1] = __builtin_elementwise_fma((f32x2){a4[g][j4][2], a4[g][j4][3]}, S[2 * j4 + 1], kv1);
                        op = __builtin_elementwise_fma((f32x2){q4[g][j4][0], q4[g][j4][1]}, S[2 * j4], op);
                        op = __builtin_elementwise_fma((f32x2){q4[g][j4][2], q4[g][j4][3]}, S[2 * j4 + 1], op); }
                    po[g] = op[0] + op[1]; }
#pragma unroll
                for (int g = 0; g < GS; ++g) sP[((s0_ + g) * 8 + wave) * 64 + lane] = po[g];
            }
            asm volatile("s_waitcnt lgkmcnt(0)" ::: "memory"); __builtin_amdgcn_s_barrier(); asm volatile("" ::: "memory");
#pragma unroll
            for (int j2 = 0; j2 < NR; ++j2) {
                const int s = wave + 8 * j2; const int tok = dir == 0 ? blk * TB + s : 2047 - (blk * TB + s);
                float sum = 0.f;
#pragma unroll
                for (int w = 0; w < 8; ++w) sum += sP[(s * 8 + w) * 64 + lane];
                oraw[(rowbase + tok) * 512 + (HG ? 0 : 256) + h * 64 + lane] = sum;
            }
            }
            { const int blk = blk2 + 1;
#pragma unroll
            for (int i = 0; i < NS; ++i) {
                const int st = ps + 16 * i;
                if (HG) {
                    const float z0 = bf2f(rz0[1][i]), z1 = bf2f(rz1[1][i]);
                    const float s0 = __builtin_amdgcn_rcpf(1.f + __expf(-z0)), s1 = __builtin_amdgcn_rcpf(1.f + __expf(-z1));
                    sA[st * 64 + pi] = s0 * (1.f + lb0 * __expf(fminf(-z0, 80.f))); sA[st * 64 + pi + 32] = s1 * (1.f + lb1 * __expf(fminf(-z1, 80.f)));
                    sK[st * 64 + pi] = (1.f - lb0) * __builtin_amdgcn_rcpf(1.f + __expf(z0)); sK[st * 64 + pi + 32] = (1.f - lb1) * __builtin_amdgcn_rcpf(1.f + __expf(z1));
                    const float q0 = bf2f(rq0[1][i]), q1 = bf2f(rq1[1][i]);
                    sQ[st * 64 + pi] = q0 * __builtin_amdgcn_rcpf(1.f + __expf(-q0)) * 0.125f; sQ[st * 64 + pi + 32] = q1 * __builtin_amdgcn_rcpf(1.f + __expf(-q1)) * 0.125f;
                } else {
                    float z = bias;
#pragma unroll
                    for (int j = 0; j < 4; ++j) { z += bflo(rl0[1][i][j]) * w2c[2 * j] + bfhi(rl0[1][i][j]) * w2c[2 * j + 1]; z += bflo(rl1[1][i][j]) * w2c[8 + 2 * j] + bfhi(rl1[1][i][j]) * w2c[8 + 2 * j + 1]; }
                    const float ls = fminf(z, 0.f) - __logf(1.f + __expf(-fabsf(z)));
                    sA[st * 32 + pi] = __expf(ls * (1.f / 16.f));
                    sK[st * 32 + pi] = bf2f(rk0[1][i]);
                    sQ[st * 32 + pi] = bf2f(rq0[1][i]) * 0.17677669529663687f;
                }
                sV[st * 64 + pi] = bf2f(rv0[1][i]); sV[st * 64 + pi + 32] = bf2f(rv1[1][i]);
            }
            asm volatile("s_waitcnt lgkmcnt(0)" ::: "memory"); __builtin_amdgcn_s_barrier(); asm volatile("" ::: "memory");
            if (blk + 2 < SEQ / TB) SCAN_LOAD(blk + 2, 1);
            for (int s0_ = 0; s0_ < TB; s0_ += GS) {
                float vv[GS]; f32x4 a4[GS][KPW / 4], k4[GS][KPW / 4], q4[GS][KPW / 4];
#pragma unroll
                for (int g = 0; g < GS; ++g) { const int s = s0_ + g; vv[g] = sV[s * 64 + lane];
#pragma unroll
                    for (int j4 = 0; j4 < KPW / 4; ++j4) { a4[g][j4] = *(const LAS f32x4*)(sA + s * DK + wave * KPW + j4 * 4); k4[g][j4] = *(const LAS f32x4*)(sK + s * DK + wave * KPW + j4 * 4); q4[g][j4] = *(const LAS f32x4*)(sQ + s * DK + wave * KPW + j4 * 4); } }
                float po[GS];
#pragma unroll
                for (int g = 0; g < GS; ++g) {
                    f32x2 op = (f32x2){0.f, 0.f};
#pragma unroll
                    for (int j4 = 0; j4 < KPW / 4; ++j4) {
                        const f32x2 kv0 = (f32x2){k4[g][j4][0], k4[g][j4][1]} * vv[g], kv1 = (f32x2){k4[g][j4][2], k4[g][j4][3]} * vv[g];
                        S[2 * j4] = __builtin_elementwise_fma((f32x2){a4[g][j4][0], a4[g][j4][1]}, S[2 * j4], kv0);
                        S[2 * j4 + 1] = __builtin_elementwise_fma((f32x2){a4[g][j4][2], a4[g][j4][3]}, S[2 * j4 + 1], kv1);
                        op = __builtin_elementwise_fma((f32x2){q4[g][j4][0], q4[g][j4][1]}, S[2 * j4], op);
                        op = __builtin_elementwise_fma((f32x2){q4[g][j4][2], q4[g][j4][3]}, S[2 * j4 + 1], op); }
                    po[g] = op[0] + op[1]; }
#pragma unroll
                for (int g = 0; g < GS; ++g) sP[((s0_ + g) * 8 + wave) * 64 + lane] = po[g];
            }
            asm volatile("s_waitcnt lgkmcnt(0)" ::: "memory"); __builtin_amdgcn_s_barrier(); asm volatile("" ::: "memory");
#pragma unroll
            for (int j2 = 0; j2 < NR; ++j2) {
                const int s = wave + 8 * j2; const int tok = dir == 0 ? blk * TB + s : 2047 - (blk * TB + s);
                float sum = 0.f;
#pragma unroll
                for (int w = 0; w < 8; ++w) sum += sP[(s * 8 + w) * 64 + lane];
                oraw[(rowbase + tok) * 512 + (HG ? 0 : 256) + h * 64 + lane] = sum;
            }
            }
        }
#undef SCAN_LOAD
    }
    asm volatile("s_waitcnt vmcnt(0)" ::: "memory");
    __syncthreads();
    LAS unsigned* flg = (LAS unsigned*)(lds + 147456 - 128);
    if (tid == 0) { __builtin_amdgcn_fence(__ATOMIC_RELEASE, "agent"); asm volatile("s_waitcnt vmcnt(0)" ::: "memory");
        const unsigned old = __hip_atomic_fetch_add(done, 1u, __ATOMIC_RELAXED, __HIP_MEMORY_SCOPE_AGENT);
        __builtin_amdgcn_fence(__ATOMIC_ACQUIRE, "agent"); asm volatile("s_waitcnt vmcnt(0)" ::: "memory");
        flg[0] = old; }
    __syncthreads();
    if (flg[0] == 1u) {
        if (lane == 0 && tid != 0) { __builtin_amdgcn_fence(__ATOMIC_ACQUIRE, "agent"); asm volatile("s_waitcnt vmcnt(0)" ::: "memory"); }
        __syncthreads();
        const float ng = normg[lane];
        for (int t0 = wave * 16; t0 < SEQ; t0 += 128) {
            float fa[16], fb[16]; bf16_t gq[16];
#pragma unroll
            for (int i = 0; i < 16; ++i) { const size_t o = (rowbase + t0 + i) * 512 + (HG ? 0 : 256) + h * 64 + lane;
                fa[i] = __hip_atomic_load(oraw0 + o, __ATOMIC_RELAXED, __HIP_MEMORY_SCOPE_AGENT); fb[i] = __hip_atomic_load(oraw1 + o, __ATOMIC_RELAXED, __HIP_MEMORY_SCOPE_AGENT);
                gq[i] = proj[(rowbase + t0 + i) * LDP + (HG ? BG : GG) + h * 64 + lane]; }
#pragma unroll
            for (int i = 0; i < 16; ++i) {
                const float tot = fa[i] + fb[i];
                const float ssq = wave_sum(tot * tot);
                const float gvv = bf2f(gq[i]);
                const float outv = tot * rsqrtf(ssq * (1.f / 64.f) + EPS) * ng * (gvv * __builtin_amdgcn_rcpf(1.f + __expf(-gvv)));
                ocat[(rowbase + t0 + i) * D + (HG ? 512 : 768) + h * 64 + lane] = (bf16_t)f2bf(outv);
            }
        }
    }
    __syncthreads();
}

__device__ __forceinline__ void norm_rows_mod(const float* src, bf16_t* dst, const float* g, const float* modl  , int grow0, int shoff, int scoff) {
    const int tid = tid_fresh(), lane = tid & 63, gw = blockIdx.x * 8 + __builtin_amdgcn_readfirstlane(tid >> 6), NGW = gridDim.x * 8;
    const f32x4* gr = (const f32x4*)g + lane;
    f32x4 gg[4];
#pragma unroll
    for (int j = 0; j < 4; ++j) gg[j] = gr[64 * j];
    for (int m0 = gw; m0 < TG; m0 += 2 * NGW) {
        f32x4 v[2][4]; float s[2];
#pragma unroll
        for (int e = 0; e < 2; ++e) { const int m = m0 + e * NGW; const f32x4* xr = (const f32x4*)(src + (size_t)m * D) + lane;
#pragma unroll
            for (int j = 0; j < 4; ++j) v[e][j] = xr[64 * j]; }
#pragma unroll
        for (int e = 0; e < 2; ++e) { s[e] = 0.f;
#pragma unroll
            for (int j = 0; j < 4; ++j) s[e] += (v[e][j].x * v[e][j].x + v[e][j].y * v[e][j].y) + (v[e][j].z * v[e][j].z + v[e][j].w * v[e][j].w); }
#pragma unroll
        for (int e = 0; e < 2; ++e) { const int m = m0 + e * NGW; const int b = (grow0 + m) >> 11;
            const f32x4* sh = (const f32x4*)(modl + (size_t)b * (NMOD * D) + shoff) + lane; const f32x4* sc = (const f32x4*)(modl + (size_t)b * (NMOD * D) + scoff) + lane;
            const float r = rsqrtf(wave_sum(s[e]) * (1.f / D) + EPS);
            unsigned long long* o8 = (unsigned long long*)(dst + (size_t)m * D) + lane;
#pragma unroll
            for (int j = 0; j < 4; ++j) { const f32x4 y = v[e][j] * r * gg[j] * (1.f + sc[64 * j]) + sh[64 * j];
                o8[64 * j] = (unsigned long long)pk2(y.x, y.y) | ((unsigned long long)pk2(y.z, y.w) << 32); } }
    }
}
__device__ __forceinline__ void norm_rows_final(float* x, const float* g) {
    const int tid = tid_fresh(), lane = tid & 63, gw = blockIdx.x * 8 + __builtin_amdgcn_readfirstlane(tid >> 6), NGW = gridDim.x * 8;
    for (int m = gw; m < TG; m += NGW) {
        f32x4* xr = (f32x4*)(x + (size_t)m * D) + lane; const f32x4* gr = (const f32x4*)g + lane;
        f32x4 v[4]; float s = 0.f;
#pragma unroll
        for (int j = 0; j < 4; ++j) { v[j] = xr[64 * j]; s += (v[j].x * v[j].x + v[j].y * v[j].y) + (v[j].z * v[j].z + v[j].w * v[j].w); }
        const float r = rsqrtf(wave_sum(s) * (1.f / D) + EPS);
#pragma unroll
        for (int j = 0; j < 4; ++j) xr[64 * j] = v[j] * r * gr[64 * j];
    }
}

__device__ __forceinline__ void transpose_item(const float* W, int ldw, bf16_t* WT, int ldt, int row_off, int k_off, LAS float* scr, int kb, int nb, int lane) {
    const int k0 = 64 * kb, n0 = 32 * nb;
#pragma unroll 8
    for (int i = 0; i < 32; ++i) { const int kk = 2 * i + (lane >> 5); scr[kk * 33 + (lane & 31)] = W[(size_t)(k0 + kk) * ldw + n0 + (lane & 31)]; }
    asm volatile("s_waitcnt lgkmcnt(0)" ::: "memory");
    const int c = lane & 7;
#pragma unroll
    for (int j = 0; j < 4; ++j) { const int n = (lane >> 3) + 8 * j; const LAS float* s = scr + (8 * c) * 33 + n;
        u32x4 o; o.x = pk2(s[0 * 33], s[1 * 33]); o.y = pk2(s[2 * 33], s[3 * 33]); o.z = pk2(s[4 * 33], s[5 * 33]); o.w = pk2(s[6 * 33], s[7 * 33]);
        *(u32x4*)(WT + (size_t)(row_off + n0 + n) * ldt + k_off + k0 + 8 * c) = o; }
    asm volatile("s_waitcnt lgkmcnt(0)" ::: "memory");
}

#define XB_TMO      128
#define XB_XCNT(j)  (256  + 64 * (j))
#define XB_XSUB(j)  (1280 + 64 * (j))
#define XB_XGEN(j)  (2304 + 64 * (j))
#define XB_TOP      3328
#define XB_TOPGEN   3392
#define XCD_BAR_WORDS 3456
#define XB_SPIN_CAP (1u << 18)

__device__ __forceinline__ unsigned xb_ld(unsigned* p)              { return __hip_atomic_load(p, __ATOMIC_RELAXED, __HIP_MEMORY_SCOPE_AGENT); }
__device__ __forceinline__ unsigned xb_add(unsigned* p, unsigned v) { return __hip_atomic_fetch_add(p, v, __ATOMIC_RELAXED, __HIP_MEMORY_SCOPE_AGENT); }
__device__ __forceinline__ unsigned xb_xcc_id() { return (unsigned)__builtin_amdgcn_s_getreg((3 << 11) | 20) & 0xFu; }
#define XB_SPIN(cond, bar) do { unsigned _sp = 0; while (cond) { __builtin_amdgcn_s_sleep(1); \
    if ((++_sp & 255u) == 0u) { if (xb_ld(&(bar)[XB_TMO])) break; if (_sp > XB_SPIN_CAP) { atomicAdd(&(bar)[XB_TMO], 1u); break; } } } } while (0)

struct XcdBarrier {
    unsigned* bar; unsigned x;
    volatile LAS unsigned* st;
};

__device__ __forceinline__ XcdBarrier xcd_barrier_post(unsigned* bar, volatile LAS unsigned* st) {
    XcdBarrier b; b.bar = bar; b.x = xb_xcc_id(); b.st = st;
    if (threadIdx.x == 0) (void)xb_add(&bar[XB_XCNT(b.x)], 1u);
    return b;
}
__device__ __forceinline__ void xcd_barrier_complete(unsigned* bar, unsigned x, unsigned& nloc, unsigned& nx) {
    const unsigned G = gridDim.x * gridDim.y * gridDim.z;
    unsigned sum, cnt, mine, sp = 0u;
    for (;;) {
        sum = 0u; cnt = 0u; mine = 0u;
#pragma unroll
        for (unsigned j = 0; j < 16; ++j) { const unsigned c = xb_ld(&bar[XB_XCNT(j)]); sum += c; cnt += (c > 0u) ? 1u : 0u; mine = (j == x) ? c : mine; }
        if (sum == G) break;
        __builtin_amdgcn_s_sleep(1);
        if ((++sp & 255u) == 0u) { if (xb_ld(&bar[XB_TMO])) break; if (sp > XB_SPIN_CAP) { atomicAdd(&bar[XB_TMO], 1u); break; } }
    }
    nloc = mine > 0u ? mine : 1u; nx = cnt > 0u ? cnt : 1u;
}

__device__ __forceinline__ void xcd_barrier(const XcdBarrier& b) {
    asm volatile("s_waitcnt vmcnt(0)" ::: "memory");
    __syncthreads();
    if (threadIdx.x == 0) {
        unsigned* bar = b.bar;
        __builtin_amdgcn_s_waitcnt(0);
        unsigned nloc = b.st[0], nx = b.st[1];
        if (nloc == 0u) { xcd_barrier_complete(bar, b.x, nloc, nx); b.st[0] = nloc; b.st[1] = nx; }
        const unsigned old = xb_add(&bar[XB_XSUB(b.x)], 1u);
        const unsigned gen = old / nloc;
        if (old + 1u == (gen + 1u) * nloc) {
            __builtin_amdgcn_fence(__ATOMIC_RELEASE, "agent");
            asm volatile("s_waitcnt vmcnt(0)" ::: "memory");
            const unsigned og = xb_add(&bar[XB_TOP], 1u);
            const unsigned tg = og / nx;
            if (og + 1u == (tg + 1u) * nx) xb_add(&bar[XB_TOPGEN], 1u);
            else XB_SPIN(xb_ld(&bar[XB_TOPGEN]) == tg, bar);
            __builtin_amdgcn_fence(__ATOMIC_ACQUIRE, "agent");
            xb_add(&bar[XB_XGEN(b.x)], 1u);
            asm volatile("s_waitcnt vmcnt(0)" ::: "memory");
        } else {
            XB_SPIN(xb_ld(&bar[XB_XGEN(b.x)]) == gen, bar);
            __builtin_amdgcn_fence(__ATOMIC_ACQUIRE, "agent");
            asm volatile("s_waitcnt vmcnt(0)" ::: "memory");
        }
    }
    __syncthreads();
}


constexpr int CW_XBAR = 45056;
#define XSYNC() do { XcdBarrier xb_; xb_.bar = (unsigned*)(KWS() + WS_CTL) + CW_XBAR; xb_.x = xb_xcc_id(); xb_.st = (volatile LAS unsigned*)(lds + 147456 - 256); xcd_barrier(xb_); } while (0)

struct Args { const void* p[24]; };
enum { P_X = 0, P_C, P_ADAW, P_ADAB, P_NMIXG, P_NMLPG, P_WIN, P_DLAM, P_DSUBG, P_HLB, P_HNG, P_GW2, P_GB, P_GNG, P_WUA, P_WUB, P_WUC, P_WOUT, P_W1, P_W2, P_FNG, P_OUT, P_WS };
typedef const unsigned long long __attribute__((address_space(4)))* kargp_t;
__device__ __forceinline__ const void* karg(int i) { kargp_t kp = (kargp_t)__builtin_amdgcn_kernarg_segment_ptr(); asm volatile("" : "+s"(kp));
    const unsigned long long v = kp[i]; const __attribute__((address_space(1))) void* g = (const __attribute__((address_space(1))) void*)v; return (const void*)g; }
#define GRID_SYNC() do { asm volatile("s_waitcnt vmcnt(0) lgkmcnt(0)" ::: "memory"); __syncthreads(); grid.sync(); \
    if (threadIdx.x < 64) { __builtin_amdgcn_fence(__ATOMIC_ACQUIRE, "agent"); asm volatile("s_waitcnt vmcnt(0)" ::: "memory"); } __syncthreads(); } while (0)
#define KF(i) ((const float*)karg(i))
#define KWS() ((uchar*)karg(P_WS))

__global__ void __launch_bounds__(512, 2) fwd_megakernel(Args a_unused) {
    extern __shared__ __attribute__((aligned(16))) uchar lds_raw[];
    LAS uchar* lds = (LAS uchar*)lds_raw;
    cg::grid_group grid = cg::this_grid();
    {
    const int tid = tid_fresh(), lane = tid & 63, wave = __builtin_amdgcn_readfirstlane(tid >> 6);

    if (blockIdx.x == 0) {
        unsigned* ctl = (unsigned*)(KWS() + WS_CTL); float* ctlf = (float*)ctl;
        for (int i = tid; i < 1024; i += 512) { ctl[i] = 0u; ctl[40960 + i] = 0u; }
        for (int i = tid; i < XCD_BAR_WORDS; i += 512) ctl[CW_XBAR + i] = 0u;
        if (tid < 4) {
            const float* lp = KF(P_DLAM) + tid * 256; float s1 = 0.f, s2 = 0.f;
            for (int d = 0; d < 64; ++d) { s1 += lp[d] * lp[64 + d]; s2 += lp[128 + d] * lp[192 + d]; }
            const float li = 0.8f - 0.6f * expf(-0.3f * (float)tid);
            ctlf[1024 + tid] = expf(s1) - expf(s2) + li; ctlf[1028 + tid] = li;
        }
        {
            const float* lg = KF(P_HLB); const int j = tid;
            float v[4], mx = -1e30f;
#pragma unroll
            for (int l = 0; l < 4; ++l) { v[l] = lg[l * 512 + j]; mx = fmaxf(mx, v[l]); }
            float den = 0.f;
#pragma unroll
            for (int l = 0; l < 4; ++l) { v[l] = expf(v[l] - mx); den += v[l]; }
            float cum = 0.f; const float w0 = v[0] / den;
#pragma unroll
            for (int l = 0; l < 4; ++l) { cum += v[l] / den; ctlf[2048 + l * 512 + j] = cum - w0; }
        }
        {
            float* pv = ctlf + 8192;
            const float* s0 = KF(P_NMIXG); for (int i = tid; i < 4096; i += 512) pv[i] = s0[i];
            const float* s1 = KF(P_NMLPG); for (int i = tid; i < 4096; i += 512) pv[4096 + i] = s1[i];
            const float* s2 = KF(P_DSUBG); for (int i = tid; i < 512; i += 512) pv[8192 + i] = s2[i];
            const float* s3 = KF(P_HNG); for (int i = tid; i < 256; i += 512) pv[8704 + i] = s3[i];
            const float* s4 = KF(P_GW2); for (int i = tid; i < 16384; i += 512) pv[8960 + i] = s4[i];
            const float* s5 = KF(P_GB); for (int i = tid; i < 1024; i += 512) pv[25344 + i] = s5[i];
            const float* s6 = KF(P_GNG); for (int i = tid; i < 256; i += 512) pv[26368 + i] = s6[i];
            const float* s7 = KF(P_FNG); for (int i = tid; i < 1024; i += 512) pv[26624 + i] = s7[i];
        }
    }
#ifndef NO_MOD
    {
        LAS float* cond = (LAS float*)lds; LAS float* red = (LAS float*)(lds + 131072);
        float* mod = (float*)(KWS() + WS_MOD);
        const float* cin = KF(P_C); const float* adaw = KF(P_ADAW); const float* adab = KF(P_ADAB);
        bool loaded = false;
        for (int it = blockIdx.x; it < 4 * 96; it += gridDim.x) {
            if (!loaded) { for (int i = tid; i < 32 * 1024; i += 512) { const float cv = cin[i]; cond[i] = cv / (1.f + __expf(-cv)); } loaded = true; __syncthreads(); }
            const int l = it / 96, n0 = (it % 96) * 64;
            const float* W = adaw + (size_t)l * D * (NMOD * D) + n0 + lane;
            float acc[32];
#pragma unroll
            for (int b = 0; b < 32; ++b) acc[b] = 0.f;
            for (int k4 = 0; k4 < 32; ++k4) {
                const int k = wave * 128 + k4 * 4;
                const float w0 = W[(size_t)k * (NMOD * D)], w1 = W[(size_t)(k + 1) * (NMOD * D)], w2v = W[(size_t)(k + 2) * (NMOD * D)], w3 = W[(size_t)(k + 3) * (NMOD * D)];
#pragma unroll
                for (int b = 0; b < 32; ++b) { const f32x4 c4 = *(const LAS f32x4*)(cond + b * 1024 + k); acc[b] += c4.x * w0 + c4.y * w1 + c4.z * w2v + c4.w * w3; }
            }
#pragma unroll
            for (int rd = 0; rd < 4; ++rd) {
                __syncthreads();
#pragma unroll
                for (int bb = 0; bb < 8; ++bb) red[(wave * 8 + bb) * 64 + lane] = acc[rd * 8 + bb];
                __syncthreads();
                float s = 0.f;
#pragma unroll
                for (int w = 0; w < 8; ++w) s += red[(w * 8 + wave) * 64 + lane];
                const int b = rd * 8 + wave;
                mod[((size_t)l * 32 + b) * (NMOD * D) + n0 + lane] = s + adab[l * (NMOD * D) + n0 + lane];
            }
        }
        __syncthreads();
    }
#endif
#ifndef NO_WT
    {
        LAS float* scr = (LAS float*)(lds + wave * 8704);
        const int gw = blockIdx.x * 8 + wave, NGW = gridDim.x * 8;
        uchar* ws = KWS();
        bf16_t* win_t = (bf16_t*)(ws + WS_WIN); bf16_t* wup_t = (bf16_t*)(ws + WS_WUP); bf16_t* wout_t = (bf16_t*)(ws + WS_WOUT);
        bf16_t* w1_t = (bf16_t*)(ws + WS_W1); bf16_t* w2_t = (bf16_t*)(ws + WS_W2);
        constexpr int I_IN = 16 * 209, I_UA = 8 * 32, I_UB = 4 * 32, I_UC = 4 * 32, I_O = 16 * 32, I_1 = 16 * 128, I_2 = 64 * 32;
        constexpr int I_L = I_IN + I_UA + I_UB + I_UC + I_O + I_1 + I_2;
        for (int it = gw; it < 4 * I_L; it += NGW) {
            const int l = it / I_L; int r = it % I_L;
            if (r < I_IN) { transpose_item(KF(P_WIN) + (size_t)l * D * DIN, DIN, win_t + (size_t)l * LDP * D, D, 0, 0, scr, r / 209, r % 209, lane); continue; } r -= I_IN;
            if (r < I_UA) { transpose_item(KF(P_WUA) + (size_t)l * 512 * D, D, wup_t + (size_t)l * D * D, D, 0, 0, scr, r / 32, r % 32, lane); continue; } r -= I_UA;
            if (r < I_UB) { transpose_item(KF(P_WUB) + (size_t)l * 256 * D, D, wup_t + (size_t)l * D * D, D, 0, 512, scr, r / 32, r % 32, lane); continue; } r -= I_UB;
            if (r < I_UC) { transpose_item(KF(P_WUC) + (size_t)l * 256 * D, D, wup_t + (size_t)l * D * D, D, 0, 768, scr, r / 32, r % 32, lane); continue; } r -= I_UC;
            if (r < I_O) { transpose_item(KF(P_WOUT) + (size_t)l * D * D, D, wout_t + (size_t)l * D * D, D, 0, 0, scr, r / 32, r % 32, lane); continue; } r -= I_O;
            if (r < I_1) { transpose_item(KF(P_W1) + (size_t)l * D * DFF, DFF, w1_t + (size_t)l * DFF * D, D, 0, 0, scr, r / 128, r % 128, lane); continue; } r -= I_1;
            transpose_item(KF(P_W2) + (size_t)l * DFF * D, D, w2_t + (size_t)l * D * DFF, DFF, 0, 0, scr, r / 32, r % 32, lane);
        }
        for (int i = blockIdx.x * 512 + tid; i < 4 * 28672; i += gridDim.x * 512) { const int l = i / 28672, r = i % 28672;
            *(u32x4*)(win_t + (size_t)l * LDP * D + (size_t)DIN * D + (size_t)r * 8) = (u32x4){0u, 0u, 0u, 0u}; }
    }
#endif
    }
    GRID_SYNC();
    if (threadIdx.x < 2) ((LAS unsigned*)(lds + 147456 - 256))[threadIdx.x] = 0u;
    (void)xcd_barrier_post((unsigned*)(KWS() + WS_CTL) + CW_XBAR, (volatile LAS unsigned*)(lds + 147456 - 256));

    for (int grp = 0; grp < NGRP; ++grp) {
        for (int l = 0; l < DEPTH; ++l) {
            {
                uchar* ws = KWS(); const float* pv = (const float*)(ws + WS_CTL) + 8192;
                const float* src = (l == 0 ? KF(P_X) : (const float*)karg(P_OUT)) + (size_t)grp * TG * D;
                norm_rows_mod(src, (bf16_t*)(ws + WS_HB), pv + l * D, (const float*)(ws + WS_MOD) + (size_t)l * 32 * (NMOD * D), grp * TG, 0, D);
            }
            XSYNC();
            { uchar* ws = KWS(); pg8::Gemm g{(const bf16_t*)(ws + WS_HB), (const bf16_t*)(ws + WS_WIN) + (size_t)l * LDP * D, D}; pg8::Order S; S.init(TG, LDP, D, gridDim.x, blockIdx.x, 1); pg8::EpiProj E{(bf16_t*)(ws + WS_PROJ), (bf16_t*)(ws + WS_ATT)};
#ifndef NO_EPIPROJ
              pg8::gemm_phase<pg8::EpiProj>(lds, g, S, E);
#endif
            }
            XSYNC();
            {
                uchar* ws = KWS(); const float* ctlf = (const float*)(ws + WS_CTL); const float* pv = ctlf + 8192;
                const int xq = blockIdx.x & 7; unsigned* ctr = (unsigned*)(ws + WS_CTL) + ((grp * DEPTH + l) * 8 + xq) * 4;
                const float lam = ctlf[1024 + l], laminit = ctlf[1028 + l];
                const bf16_t* PROJ = (const bf16_t*)(ws + WS_PROJ); bf16_t* OCAT = (bf16_t*)(ws + WS_OCAT); float* OFWD = (float*)(ws + WS_OFWD);
                LAS int* itm = (LAS int*)(lds + 147456 - 64);
                const int tid = tid_fresh();
                for (;;) {
                    __syncthreads();
                    if (tid == 0) itm[0] = (int)atomicAdd(ctr, 1u);
                    __syncthreads();
                    const int it = itm[0];
                    constexpr int NPQ = GB * 4 / 8;
                    if (it >= 4 * NPQ + NPQ * 16) break;
                    float* OBWD = (float*)(ws + WS_OBWD);
                    if (it < 2 * NPQ) { const int p = (it >> 1) * 8 + xq; unsigned* dn = (unsigned*)(ws + WS_CTL) + 40960 + (((grp * DEPTH + l) * GB * 4 + p) * 2);
                        scan_item<64, true>(lds, PROJ, OFWD, OBWD, OCAT, dn, p >> 2, p & 3, it & 1, ctlf + 2048 + l * 512, pv + 8704 + l * 64, nullptr, nullptr);
                    } else if (it < 4 * NPQ) { const int i2 = it - 2 * NPQ; const int p = (i2 >> 1) * 8 + xq; unsigned* dn = (unsigned*)(ws + WS_CTL) + 40960 + (((grp * DEPTH + l) * GB * 4 + p) * 2 + 1);
                        scan_item<32, false>(lds, PROJ, OFWD, OBWD, OCAT, dn, p >> 2, p & 3, i2 & 1, nullptr, pv + 26368 + l * 64, pv + 8960 + l * 4096, pv + 25344 + l * 256);
                    } else { const int u = it - 4 * NPQ, p = (u >> 4) * 8 + xq;
                        attn_unit(lds, (const bf16_t*)(ws + WS_ATT), OCAT, p >> 2, p & 3, u & 15, lam, laminit, pv + 8192 + l * 128);
                    }
                }
            }
            XSYNC();
            { uchar* ws = KWS(); pg8::Gemm g{(const bf16_t*)(ws + WS_OCAT), (const bf16_t*)(ws + WS_WUP) + (size_t)l * D * D, D}; pg8::Order S; S.init(TG, D, D, gridDim.x, blockIdx.x, 3); pg8::EpiMerge E{(const bf16_t*)(ws + WS_PROJ), (bf16_t*)(ws + WS_HB)};
#ifndef NO_EPIMERGE
              pg8::gemm_phase<pg8::EpiMerge>(lds, g, S, E);
#endif
            }
            XSYNC();
            { uchar* ws = KWS(); pg8::Gemm g{(const bf16_t*)(ws + WS_HB), (const bf16_t*)(ws + WS_WOUT) + (size_t)l * D * D, D}; pg8::Order S; S.init(TG, D, D, gridDim.x, blockIdx.x, 1);
              float* xg = (float*)karg(P_OUT) + (size_t)grp * TG * D;
              pg8::EpiRes E{l == 0 ? KF(P_X) + (size_t)grp * TG * D : xg, xg, (const float*)(ws + WS_MOD) + ((size_t)l * 32 + grp * GB) * (NMOD * D) + 2 * D};
#ifndef NO_EPIRES
              pg8::gemm_phase<pg8::EpiRes>(lds, g, S, E);
#endif
            }
            XSYNC();
            {
                uchar* ws = KWS(); const float* pv = (const float*)(ws + WS_CTL) + 8192;
                norm_rows_mod((const float*)karg(P_OUT) + (size_t)grp * TG * D, (bf16_t*)(ws + WS_HB), pv + 4096 + l * D, (const float*)(ws + WS_MOD) + (size_t)l * 32 * (NMOD * D), grp * TG, 3 * D, 4 * D);
            }
            XSYNC();
            { uchar* ws = KWS(); pg8::Gemm g{(const bf16_t*)(ws + WS_HB), (const bf16_t*)(ws + WS_W1) + (size_t)l * DFF * D, D}; pg8::Order S; S.init(TG, DFF, D, gridDim.x, blockIdx.x, 1); pg8::EpiRelu2 E{(bf16_t*)(ws + WS_U)};
#ifndef NO_EPIRELU2
              pg8::gemm_phase<pg8::EpiRelu2>(lds, g, S, E);
#endif
            }
            XSYNC();
            { uchar* ws = KWS(); pg8::Gemm g{(const bf16_t*)(ws + WS_U), (const bf16_t*)(ws + WS_W2) + (size_t)l * D * DFF, DFF}; pg8::Order S; S.init(TG, D, DFF, gridDim.x, blockIdx.x, 1);
              float* xg = (float*)karg(P_OUT) + (size_t)grp * TG * D;
              pg8::EpiRes E{xg, xg, (const float*)(ws + WS_MOD) + ((size_t)l * 32 + grp * GB) * (NMOD * D) + 5 * D};
#ifndef NO_EPIRES
              pg8::gemm_phase<pg8::EpiRes>(lds, g, S, E);
#endif
            }
            XSYNC();
        }
        norm_rows_final((float*)karg(P_OUT) + (size_t)grp * TG * D, (const float*)(KWS() + WS_CTL) + 8192 + 26624);
    }
}

extern "C" void kernel_launch(void* const* d_in, const int* in_sizes, int n_in, void* d_out, int out_size, void* d_ws, size_t ws_size, hipStream_t stream) {
    static int grid = 0;
    if (grid == 0) {
        if (n_in != 21 || ws_size < WS_END) { fprintf(stderr, "kernel_launch: unexpected n_in %d / ws %zu\n", n_in, ws_size); grid = -1; return; }
        int dev = 0, cus = 0, per_cu = 0;
        if (hipGetDevice(&dev) != hipSuccess || hipDeviceGetAttribute(&cus, hipDeviceAttributeMultiprocessorCount, dev) != hipSuccess) { grid = -1; return; }
        if (hipFuncSetAttribute((const void*)fwd_megakernel, hipFuncAttributeMaxDynamicSharedMemorySize, LDS_BYTES) != hipSuccess) { fprintf(stderr, "kernel_launch: hipFuncSetAttribute failed\n"); grid = -1; return; }
        if (hipOccupancyMaxActiveBlocksPerMultiprocessor(&per_cu, (const void*)fwd_megakernel, 512, LDS_BYTES) != hipSuccess || per_cu < 1) { fprintf(stderr, "kernel_launch: occupancy query says %d\n", per_cu); per_cu = 1; }
        (void)hipGetLastError();
        grid = cus;
    }
    if (grid < 0) return;
    Args a{};
    for (int i = 0; i < 21; ++i) a.p[i] = d_in[i];
    a.p[21] = d_out; a.p[22] = d_ws; a.p[23] = nullptr;
    void* args[] = {&a};
    hipError_t e = hipLaunchCooperativeKernel((void*)fwd_megakernel, dim3(grid), dim3(512), args, LDS_BYTES, stream);
    if (e != hipSuccess) fprintf(stderr, "kernel_launch: cooperative launch failed: %s (grid %d)\n", hipGetErrorString(e), grid);
}
```

```cpp
#include <hip/hip_runtime.h>
#include <hip/hip_cooperative_groups.h>
#include <cstdio>
#include <cstdint>
namespace cg = cooperative_groups;

#define LAS __attribute__((address_space(3)))
typedef unsigned short bf16_t;
typedef short bf16x8 __attribute__((ext_vector_type(8)));
typedef float f32x4 __attribute__((ext_vector_type(4)));
typedef float f32x2 __attribute__((ext_vector_type(2)));
typedef float f32x16 __attribute__((ext_vector_type(16)));
typedef unsigned u32x4 __attribute__((ext_vector_type(4)));
typedef short s16x4 __attribute__((ext_vector_type(4)));
typedef unsigned char uchar;

constexpr int D = 1024, SEQ = 2048, BATCH = 32, DEPTH = 4, DIN = 6688, LDP = 6912, DFF = 4096, NMOD = 6;
constexpr int GB = 16, TG = GB * SEQ, NGRP = BATCH / GB;
constexpr int CQ = 0, CK = 512, CV = 1024, BQ = 1536, BFF = 1792, BFB = 2048, BI = 2304, BG = 2560;
constexpr int GQ = 2816, GK = 2944, GV = 3072, GG = 3328, GLF = 3584, GLB = 3600, GATE = 3616;
constexpr float EPS = 1e-6f, LOG2E = 1.4426950408889634f;
constexpr float QSCALE = 0.125f * LOG2E;

constexpr size_t MiB = 1u << 20;
constexpr size_t WS_CTL = 0;
constexpr size_t WS_MOD = 1 * MiB;
constexpr size_t WS_WIN = 4 * MiB;
constexpr size_t WS_WUP = 58 * MiB;
constexpr size_t WS_WOUT = 66 * MiB;
constexpr size_t WS_W1 = 74 * MiB;
constexpr size_t WS_W2 = 106 * MiB;
constexpr size_t WS_HB = 138 * MiB;
constexpr size_t WS_OCAT = 202 * MiB;
constexpr size_t WS_OFWD = 266 * MiB;
constexpr size_t WS_PROJ = 330 * MiB;
constexpr size_t WS_U = WS_PROJ;
constexpr size_t WS_OBWD = 762 * MiB;
constexpr size_t WS_ATT = 826 * MiB;
constexpr size_t WS_END = 922 * MiB;
constexpr int LDS_BYTES = 148 * 1024;

__device__ __forceinline__ unsigned f2bf(float f) { unsigned u = __builtin_bit_cast(unsigned, f); return (u + 0x7fffu + ((u >> 16) & 1u)) >> 16; }
__device__ __forceinline__ unsigned pk2(float lo, float hi) { return f2bf(lo) | (f2bf(hi) << 16); }
__device__ __forceinline__ float bf2f(bf16_t v) { return __builtin_bit_cast(float, (unsigned)v << 16); }
__device__ __forceinline__ float bflo(unsigned u) { return __builtin_bit_cast(float, u << 16); }
__device__ __forceinline__ float bfhi(unsigned u) { return __builtin_bit_cast(float, u & 0xffff0000u); }
typedef __bf16 bf16x2_t __attribute__((ext_vector_type(2)));
__device__ __forceinline__ unsigned cvt_pk_bf16(float lo, float hi) { f32x2 v = {lo, hi}; bf16x2_t b = __builtin_convertvector(v, bf16x2_t); return __builtin_bit_cast(unsigned, b); }
__device__ __forceinline__ float wave_sum(float v) {
#pragma unroll
    for (int o = 1; o < 64; o <<= 1) v += __shfl_xor(v, o);
    return v;
}
__device__ __forceinline__ int tid_fresh() { int t = threadIdx.x; asm volatile("" : "+v"(t)); return t; }
__device__ __forceinline__ float sigmoidf_(float z) { return 1.f / (1.f + __expf(-z)); }

namespace pg8 {
constexpr int BM = 256, BK = 64, HALF = 128, HTB = HALF * BK * 2, STAGE_BYTES = 8 * HTB, NXCD = 8, WGM = 8;
__host__ __device__ __forceinline__ int lds_byte(int r, int c) { const int st = (r >> 4) * 2 + (c >> 5), rr = r & 15, cc = c & 31, ob = rr * 64 + cc * 2; return st * 1024 + (ob ^ (((ob >> 9) & 1) << 5)); }
__host__ __device__ __forceinline__ void stage_rc(int b, int& R, int& C) { const int st = b / 1024, sb = b % 1024, swz = sb ^ (((sb >> 9) & 1) << 5); R = (st >> 1) * 16 + swz / 64; C = (st & 1) * 32 + (swz % 64) / 2; }
__host__ __device__ __forceinline__ int perm32(int rho) { const int n = rho >> 4, i = rho & 15; return 8 * (i >> 2) + 4 * n + (i & 3); }

struct Unit { int pm, pn, koff, nt, seg; };
struct Gemm { const bf16_t* A; const bf16_t* Bt; int K; };

struct Order {
    int nM, nN, nwg, G, c, nseg, ntfull;
    __device__ void init(int M, int N, int K, int G_, int c_, int nseg_) { nM = M / BM; nN = N / BM; nwg = nM * nN; G = G_; c = c_; nseg = nseg_; ntfull = K / BK; }
    __device__ bool next(int i, Unit& u) const {
        int ti = i, seg = 0;
        if (nseg == 3) { ti = i / 3; seg = i - ti * 3; }
        const long L = (long)ti * G + c; if (L >= nwg) return false;
        int wgid = (int)L; { const int q = nwg / NXCD, r = nwg % NXCD, xcd = wgid % NXCD, off = wgid / NXCD; wgid = (xcd < r ? xcd * (q + 1) : r * (q + 1) + (xcd - r) * q) + off; }
        const int nig = WGM * nN, gid = wgid / nig, fm = gid * WGM, gsz = (nM - fm) < WGM ? (nM - fm) : WGM;
        u.pm = fm + ((wgid % nig) % gsz); u.pn = (wgid % nig) / gsz; u.seg = seg;
        if (nseg == 3) { u.koff = seg == 0 ? 0 : (seg == 1 ? 512 : 768); u.nt = seg == 0 ? 8 : 4; } else { u.koff = 0; u.nt = ntfull; }
        return true;
    }
};

struct EpiProj {
    bf16_t* O; bf16_t* att;
    __device__ __forceinline__ bool zero_after(const Unit&) const { return true; }
    __device__ __forceinline__ void operator()(f32x4 (&acc)[2][2][4][2], const Unit& u, int wr, int wc, int fr, int fq) const {
        const int row0 = u.pm * BM + wr * 64 + fr, col0 = u.pn * BM + wc * 32 + 8 * fq;
        const float sc = (u.pn < 2) ? QSCALE : 1.f;
        const bool toatt = u.pn < 6;
#pragma unroll
        for (int ai = 0; ai < 2; ++ai)
#pragma unroll
            for (int m = 0; m < 4; ++m) { const int row = row0 + ai * HALF + m * 16; bf16_t* rowp = O + (size_t)row * LDP + col0;
#pragma unroll
                for (int bj = 0; bj < 2; ++bj) { f32x4 v0 = acc[ai][bj][m][0] * sc, v1 = acc[ai][bj][m][1] * sc;
                    u32x4 w; w.x = cvt_pk_bf16(v0[0], v0[1]); w.y = cvt_pk_bf16(v0[2], v0[3]); w.z = cvt_pk_bf16(v1[0], v1[1]); w.w = cvt_pk_bf16(v1[2], v1[3]);
                    if (toatt) { const int seg = u.pn * 2 + bj, typ = seg >> 2, hh = seg & 3;
                        *(u32x4*)(att + ((size_t)(((row >> 11) * 4 + hh) * SEQ + (row & 2047))) * 384 + typ * 128 + wc * 32 + 8 * fq) = w; }
                    else *(u32x4*)(rowp + bj * HALF) = w; } }
    }
};
struct EpiRelu2 {
    bf16_t* O;
    __device__ __forceinline__ bool zero_after(const Unit&) const { return true; }
    __device__ __forceinline__ void operator()(f32x4 (&acc)[2][2][4][2], const Unit& u, int wr, int wc, int fr, int fq) const {
        const int row0 = u.pm * BM + wr * 64 + fr, col0 = u.pn * BM + wc * 32 + 8 * fq;
#pragma unroll
        for (int ai = 0; ai < 2; ++ai)
#pragma unroll
            for (int m = 0; m < 4; ++m) { bf16_t* rowp = O + (size_t)(row0 + ai * HALF + m * 16) * DFF + col0;
#pragma unroll
                for (int bj = 0; bj < 2; ++bj) { f32x4 v0 = acc[ai][bj][m][0], v1 = acc[ai][bj][m][1];
#pragma unroll
                    for (int j = 0; j < 4; ++j) { float a = fmaxf(v0[j], 0.f), b = fmaxf(v1[j], 0.f); v0[j] = a * a; v1[j] = b * b; }
                    u32x4 w; w.x = cvt_pk_bf16(v0[0], v0[1]); w.y = cvt_pk_bf16(v0[2], v0[3]); w.z = cvt_pk_bf16(v1[0], v1[1]); w.w = cvt_pk_bf16(v1[2], v1[3]);
                    *(u32x4*)(rowp + bj * HALF) = w; } }
    }
};
struct EpiRes {
    const float* base; float* out; const float* gate;
    __device__ __forceinline__ bool zero_after(const Unit&) const { return true; }
    __device__ __forceinline__ void operator()(f32x4 (&acc)[2][2][4][2], const Unit& u, int wr, int wc, int fr, int fq) const {
        const int row0 = u.pm * BM + wr * 64 + fr, col0 = u.pn * BM + wc * 32 + 8 * fq;
        const float* gp = gate + (size_t)((u.pm * BM) >> 11) * (NMOD * D) + col0;
#pragma unroll
        for (int bj = 0; bj < 2; ++bj) {
            const f32x4 g0 = *(const f32x4*)(gp + bj * HALF), g1 = *(const f32x4*)(gp + bj * HALF + 4);
#pragma unroll
            for (int ai = 0; ai < 2; ++ai) {
#pragma unroll
                for (int m = 0; m < 4; ++m) { const size_t off = (size_t)(row0 + ai * HALF + m * 16) * D + col0 + bj * HALF;
                    const f32x4 b0 = *(const f32x4*)(base + off), b1 = *(const f32x4*)(base + off + 4);
                    *(f32x4*)(out + off) = b0 + g0 * acc[ai][bj][m][0];
                    *(f32x4*)(out + off + 4) = b1 + g1 * acc[ai][bj][m][1];
                    if (m & 1) asm volatile("" ::: "memory"); }
            }
        }
    }
};
struct EpiMerge {
    const bf16_t* proj; bf16_t* O;
    __device__ __forceinline__ bool zero_after(const Unit& u) const { return u.seg == 2; }
    __device__ __forceinline__ void operator()(f32x4 (&acc)[2][2][4][2], const Unit& u, int wr, int wc, int fr, int fq) const {
        const int row0 = u.pm * BM + wr * 64 + fr, col0 = u.pn * BM + wc * 32 + 8 * fq;
        const int seg = u.seg;
#pragma unroll
        for (int ai = 0; ai < 2; ++ai)
#pragma unroll
            for (int m = 0; m < 4; ++m) { const size_t row = (size_t)(row0 + ai * HALF + m * 16); const bf16_t* gp = proj + row * LDP + GATE + col0;
#pragma unroll
                for (int bj = 0; bj < 2; ++bj) {
                    if (seg < 2) {
                        const u32x4 ga = *(const u32x4*)(gp + seg * D + bj * HALF), gb = *(const u32x4*)(gp + (seg + 1) * D + bj * HALF);
                        float r[8];
#pragma unroll
                        for (int j = 0; j < 4; ++j) {
                            const float a0 = fminf(fmaxf(bflo(ga[j]), -40.f), 40.f), a1 = fminf(fmaxf(bfhi(ga[j]), -40.f), 40.f);
                            const float b0 = fminf(fmaxf(bflo(gb[j]), -40.f), 40.f), b1 = fminf(fmaxf(bfhi(gb[j]), -40.f), 40.f);
                            r[2 * j] = (1.f + __expf(-b0)) * __builtin_amdgcn_rcpf(1.f + __expf(-a0));
                            r[2 * j + 1] = (1.f + __expf(-b1)) * __builtin_amdgcn_rcpf(1.f + __expf(-a1)); }
                        acc[ai][bj][m][0] = acc[ai][bj][m][0] * (f32x4){r[0], r[1], r[2], r[3]};
                        acc[ai][bj][m][1] = acc[ai][bj][m][1] * (f32x4){r[4], r[5], r[6], r[7]};
                    } else {
                        const u32x4 gc = *(const u32x4*)(gp + 2 * D + bj * HALF);
                        float r[8];
#pragma unroll
                        for (int j = 0; j < 4; ++j) {
                            const float c0 = fminf(fmaxf(bflo(gc[j]), -40.f), 40.f), c1 = fminf(fmaxf(bfhi(gc[j]), -40.f), 40.f);
                            r[2 * j] = __builtin_amdgcn_rcpf(1.f + __expf(-c0)); r[2 * j + 1] = __builtin_amdgcn_rcpf(1.f + __expf(-c1)); }
                        const f32x4 v0 = acc[ai][bj][m][0] * (f32x4){r[0], r[1], r[2], r[3]}, v1 = acc[ai][bj][m][1] * (f32x4){r[4], r[5], r[6], r[7]};
                        u32x4 w; w.x = cvt_pk_bf16(v0[0], v0[1]); w.y = cvt_pk_bf16(v0[2], v0[3]); w.z = cvt_pk_bf16(v1[0], v1[1]); w.w = cvt_pk_bf16(v1[2], v1[3]);
                        *(u32x4*)(O + row * D + col0 + bj * HALF) = w;
                    } } }
    }
};

template <class Epi, bool ALIGN_EPI = true>
__device__ __forceinline__ void gemm_phase(LAS uchar* lds, const Gemm g, const Order& S, const Epi& E) {
    const int tid = tid_fresh(), wid = __builtin_amdgcn_readfirstlane(tid >> 6), lane = tid & 63, wr = wid >> 2, wc = wid & 3, fr = lane & 15, fq = lane >> 4;
    const int K = g.K;
    unsigned voffA[2], voffB[2];
#pragma unroll
    for (int i = 0; i < 2; ++i) { int R, C; stage_rc(tid * 16 + i * 8192, R, C); const int Rb = (R & ~31) + perm32(R & 31);
        voffA[i] = (unsigned)(R * K + C) * 2u; voffB[i] = (unsigned)(Rb * K + C) * 2u; }
    const size_t kstep = (size_t)(BK * 2);
    const size_t hstep = (size_t)HALF * K * 2;
    const size_t tstep = 2 * hstep;
    const unsigned ldsw = (unsigned)wid * 1024u;
    const int aoff = lds_byte(wr * 64 + fr, fq * 8), boff = lds_byte(wc * 32 + fr, fq * 8);
#define PG8_SA(b, h) (((b) * 2 + (h)) * HTB)
#define PG8_SB(b, h) ((4 + (b) * 2 + (h)) * HTB)
#define PG8_STAGE(bufoff, gbase, voff) do { _Pragma("unroll") for (int _i = 0; _i < 2; ++_i) \
        __builtin_amdgcn_global_load_lds((const unsigned*)((const char*)(gbase) + (voff)[_i]), (LAS unsigned*)(lds + (bufoff) + ldsw + _i * 8192), 16, 0, 0); } while (0)
#define PG8_LDA(dst, b, h) do { _Pragma("unroll") for (int m = 0; m < 4; ++m) _Pragma("unroll") for (int k = 0; k < 2; ++k) dst[m][k] = *(const LAS bf16x8*)(lds + PG8_SA(b, h) + aoff + m * 2048 + k * 1024); } while (0)
#define PG8_LDB(dst, b, h) do { _Pragma("unroll") for (int n = 0; n < 2; ++n) _Pragma("unroll") for (int k = 0; k < 2; ++k) dst[n][k] = *(const LAS bf16x8*)(lds + PG8_SB(b, h) + boff + n * 2048 + k * 1024); } while (0)
#define PG8_MMA(ai, bj, At, Bt) do { __builtin_amdgcn_s_setprio(1); _Pragma("unroll") for (int m = 0; m < 4; ++m) _Pragma("unroll") for (int n = 0; n < 2; ++n) _Pragma("unroll") for (int k = 0; k < 2; ++k) \
        acc[ai][bj][m][n] = __builtin_amdgcn_mfma_f32_16x16x32_bf16(Bt[n][k], At[m][k], acc[ai][bj][m][n], 0, 0, 0); __builtin_amdgcn_s_setprio(0); } while (0)
#define PG8_WAIT_V(n) asm volatile("s_waitcnt vmcnt(" #n ")" ::: "memory")
#define PG8_WAIT_L(n) asm volatile("s_waitcnt lgkmcnt(" #n ")" ::: "memory")
#define PG8_BAR __builtin_amdgcn_s_barrier()
#define PG8_SCHED __builtin_amdgcn_sched_barrier(0)
    Unit cur, nxt; int ui = 0;
    if (!S.next(0, cur)) return;
    f32x4 acc[2][2][4][2];
#pragma unroll
    for (int a = 0; a < 2; ++a)
#pragma unroll
        for (int b = 0; b < 2; ++b)
#pragma unroll
            for (int m = 0; m < 4; ++m)
#pragma unroll
                for (int n = 0; n < 2; ++n) acc[a][b][m][n] = (f32x4){0.f, 0.f, 0.f, 0.f};
    bf16x8 At[4][2], B0[2][2], B1[2][2];
    const char* cA = (const char*)g.A + (size_t)cur.pm * tstep + (size_t)cur.koff * 2; const char* cB = (const char*)g.Bt + (size_t)cur.pn * tstep + (size_t)cur.koff * 2;
    PG8_STAGE(PG8_SB(0, 0), cB, voffB); PG8_STAGE(PG8_SB(0, 1), cB + hstep, voffB); PG8_STAGE(PG8_SA(0, 0), cA, voffA); PG8_STAGE(PG8_SA(0, 1), cA + hstep, voffA);
    if (wr == 1) PG8_BAR;
    PG8_WAIT_V(2); PG8_BAR;
    PG8_STAGE(PG8_SB(1, 0), cB + kstep, voffB); PG8_STAGE(PG8_SA(1, 0), cA + kstep, voffA); PG8_STAGE(PG8_SB(1, 1), cB + hstep + kstep, voffB);
    PG8_WAIT_V(6); PG8_BAR;
    for (;;) {
        const bool has_next = S.next(ui + 1, nxt);
        const char* nA = has_next ? (const char*)g.A + (size_t)nxt.pm * tstep + (size_t)nxt.koff * 2 : cA; const char* nB = has_next ? (const char*)g.Bt + (size_t)nxt.pn * tstep + (size_t)nxt.koff * 2 : cB;
        const int nt = cur.nt;
        for (int t = 0; t < nt; t += 2) {
            const bool last = (t == nt - 2);
            const char* a1 = cA + (size_t)(t + 1) * kstep;
            const char* a2 = last ? nA : cA + (size_t)(t + 2) * kstep; const char* b2 = last ? nB : cB + (size_t)(t + 2) * kstep;
            const char* a3 = a2 + kstep; const char* b3 = b2 + kstep;
            PG8_LDB(B0, 0, 0); PG8_LDB(B1, 0, 1); PG8_SCHED; PG8_LDA(At, 0, 0); PG8_STAGE(PG8_SA(1, 1), a1 + hstep, voffA);
            PG8_WAIT_V(8); PG8_WAIT_L(0); PG8_BAR; PG8_MMA(0, 0, At, B0); PG8_MMA(0, 1, At, B1); PG8_BAR; PG8_SCHED;
            PG8_LDA(At, 0, 1); PG8_STAGE(PG8_SB(0, 0), b2, voffB); PG8_STAGE(PG8_SB(0, 1), b2 + hstep, voffB); PG8_STAGE(PG8_SA(0, 0), a2, voffA);
            PG8_WAIT_V(8); PG8_WAIT_L(0); PG8_BAR; PG8_MMA(1, 0, At, B0); PG8_MMA(1, 1, At, B1); PG8_BAR; PG8_SCHED;
            PG8_LDB(B0, 1, 0); PG8_LDB(B1, 1, 1); PG8_SCHED; PG8_LDA(At, 1, 0); PG8_STAGE(PG8_SA(0, 1), a2 + hstep, voffA);
            PG8_WAIT_V(8); PG8_WAIT_L(0); PG8_BAR; PG8_MMA(0, 0, At, B0); PG8_MMA(0, 1, At, B1); PG8_BAR; PG8_SCHED;
            PG8_LDA(At, 1, 1); PG8_STAGE(PG8_SB(1, 0), b3, voffB); PG8_STAGE(PG8_SB(1, 1), b3 + hstep, voffB); PG8_STAGE(PG8_SA(1, 0), a3, voffA);
            PG8_WAIT_V(8); PG8_WAIT_L(0); PG8_BAR; PG8_MMA(1, 0, At, B0); PG8_MMA(1, 1, At, B1); PG8_BAR; PG8_SCHED;
        }
        if constexpr (ALIGN_EPI) { if (wr == 0) PG8_BAR; }
        E(acc, cur, wr, wc, fr, fq);
        if (!has_next) break;
        if (E.zero_after(cur)) {
#pragma unroll
            for (int a = 0; a < 2; ++a)
#pragma unroll
                for (int b = 0; b < 2; ++b)
#pragma unroll
                    for (int m = 0; m < 4; ++m)
#pragma unroll
                        for (int n = 0; n < 2; ++n) acc[a][b][m][n] = (f32x4){0.f, 0.f, 0.f, 0.f};
        }
        cur = nxt; cA = nA; cB = nB; ++ui;
        if constexpr (ALIGN_EPI) { if (wr == 1) PG8_BAR; }
    }
    PG8_WAIT_V(0);
    if constexpr (!ALIGN_EPI) { if (wr == 0) PG8_BAR; }
    PG8_BAR;
#undef PG8_SA
#undef PG8_SB
#undef PG8_STAGE
#undef PG8_LDA
#undef PG8_LDB
#undef PG8_MMA
#undef PG8_WAIT_V
#undef PG8_WAIT_L
#undef PG8_BAR
#undef PG8_SCHED
}
}

__device__ __forceinline__ int crow(int r, int hi) { return (r & 3) + 8 * (r >> 2) + 4 * hi; }
__device__ __forceinline__ s16x4 vtr(const LAS uchar* p) { return __builtin_bit_cast(s16x4, __builtin_amdgcn_ds_read_tr16_b64_v4i16((LAS s16x4*)p)); }
__device__ __forceinline__ float xhalf_max(float m) { auto rr = __builtin_amdgcn_permlane32_swap(__builtin_bit_cast(unsigned, m), __builtin_bit_cast(unsigned, m), false, false); return fmaxf(__builtin_bit_cast(float, rr[0]), __builtin_bit_cast(float, rr[1])); }
__device__ __forceinline__ float xhalf_sum(float m) { auto rr = __builtin_amdgcn_permlane32_swap(__builtin_bit_cast(unsigned, m), __builtin_bit_cast(unsigned, m), false, false); return __builtin_bit_cast(float, rr[0]) + __builtin_bit_cast(float, rr[1]); }

__device__ __forceinline__ void glds16(const void* gsrc, unsigned lds_dst) { unsigned keep;
    asm volatile("s_mov_b32 %0, m0\n\ts_mov_b32 m0, %2\n\ts_nop 0\n\tglobal_load_lds_dwordx4 %1, off\n\ts_mov_b32 m0, %0" : "=&s"(keep) : "v"(gsrc), "s"(lds_dst) : "memory"); }
constexpr int ATT_SLOT = 32768, ATT_WSF = 98304;
__device__ __forceinline__ void attn_unit(LAS uchar* lds, const bf16_t* proj, bf16_t* ocat, int bl, int h, int qb, float lam, float laminit, const float* sg) {
    const int tid = tid_fresh(), lane = tid & 63, r32 = lane & 31, hi = lane >> 5;
    const int wave = __builtin_amdgcn_readfirstlane(tid >> 6), mi = wave >> 2, rb = wave & 3;
    const size_t rowbase = (size_t)bl * SEQ;
    const int q0 = qb * 128 + rb * 32;
    const float m2 = exp2f(-2.f * (float)(h + 1)) * LOG2E;
    bf16x8 qf[4];
    const bf16_t* att = proj;
    const size_t hb = (size_t)(bl * 4 + h) * SEQ;
    { const bf16_t* qp = att + (hb + q0 + r32) * 384 + mi * 64 + hi * 8;
#pragma unroll
      for (int d0 = 0; d0 < 4; ++d0) qf[d0] = *(const bf16x8*)(qp + d0 * 16); }
    const int kkey = 4 * wave + (lane >> 4);
    const bf16_t* ksrc0 = att + (hb + kkey) * 384 + 128 + (((lane & 15) ^ (kkey & 15)) * 8);
    const bf16_t* ksrc1 = ksrc0 + (size_t)32 * 384;
    const bf16_t* vsrc0 = att + (hb + 16 * (wave & 3) + (lane >> 2)) * 384 + 256 + (wave >> 2) * 32 + (lane & 3) * 8;
    const bf16_t* vsrc1 = vsrc0 + 64;
    const unsigned lds0 = (unsigned)(uintptr_t)lds + (unsigned)wave * 1024u;
#define ATT_ISSUE(t, sb) do { const size_t go_ = (size_t)(t) * 64 * 384; const unsigned d_ = (unsigned)__builtin_amdgcn_readfirstlane((int)(lds0 + (unsigned)(sb))); \
        glds16(ksrc0 + go_, d_); glds16(ksrc1 + go_, d_ + 8192u); glds16(vsrc0 + go_, d_ + 16384u); glds16(vsrc1 + go_, d_ + 24576u); } while (0)
    LAS float* wsf = (LAS float*)(lds + ATT_WSF) + wave * 64;
    f32x16 o[4];
#pragma unroll
    for (int d = 0; d < 4; ++d)
#pragma unroll
        for (int r = 0; r < 16; ++r) o[d][r] = 0.f;
    float mhat = 0.f;
    f32x16 ol;
#pragma unroll
    for (int r = 0; r < 16; ++r) ol[r] = 0.f;
    const bf16x8 ones = (bf16x8){0x3F80, 0x3F80, 0x3F80, 0x3F80, 0x3F80, 0x3F80, 0x3F80, 0x3F80};
    int kfo[4];
#pragma unroll
    for (int d0 = 0; d0 < 4; ++d0) kfo[d0] = r32 * 256 + (((mi * 8 + 2 * d0 + hi) ^ (r32 & 15)) * 16);
    const int vfo = 16384 + ((lane >> 4) & 1) * 32 + (lane & 3) * 8 + (4 * hi + ((lane & 15) >> 2)) * 64;
    ATT_ISSUE(0, 0); ATT_ISSUE(1, ATT_SLOT);
    int slot_c = 0, slot_n = 2 * ATT_SLOT;
    for (int t = 0; t < SEQ / 64; ++t) {
        if (t + 1 < SEQ / 64) asm volatile("s_waitcnt vmcnt(4) lgkmcnt(0)" ::: "memory"); else asm volatile("s_waitcnt vmcnt(0) lgkmcnt(0)" ::: "memory");
        __builtin_amdgcn_s_barrier();
        asm volatile("" ::: "memory");
        if (t + 2 < SEQ / 64) ATT_ISSUE(t + 2, slot_n);
        const LAS uchar* sl = lds + slot_c;
        { const int nx = slot_c + ATT_SLOT; slot_n = slot_c; slot_c = (nx == 3 * ATT_SLOT) ? 0 : nx; }
        const float dq = (float)(q0 + r32 - 64 * t - 4 * hi);
        f32x16 p0, p1;
        const int side = (64 * t + 63 < q0) ? 1 : ((64 * t > q0 + 31) ? -1 : 0);
        if (side != 0) {
            const float sm = side > 0 ? m2 : -m2; const float base = __builtin_fmaf(-sm, dq, -mhat);
#pragma unroll
            for (int r = 0; r < 16; ++r) { const float kc = (float)((r & 3) + 8 * (r >> 2));
                p0[r] = __builtin_fmaf(sm, kc, base); p1[r] = __builtin_fmaf(sm, kc + 32.f, base); }
        } else {
#pragma unroll
            for (int r = 0; r < 16; ++r) { const float kc = (float)((r & 3) + 8 * (r >> 2));
                p0[r] = __builtin_fmaf(-m2, __builtin_fabsf(dq - kc), -mhat); p1[r] = __builtin_fmaf(-m2, __builtin_fabsf(dq - kc - 32.f), -mhat); }
        }
        __builtin_amdgcn_s_setprio(1);
#pragma unroll
        for (int d0 = 0; d0 < 4; ++d0) {
            const bf16x8 a0 = *(const LAS bf16x8*)(sl + kfo[d0]), a1 = *(const LAS bf16x8*)(sl + kfo[d0] + 8192);
            p0 = __builtin_amdgcn_mfma_f32_32x32x16_bf16(a0, qf[d0], p0, 0, 0, 0);
            p1 = __builtin_amdgcn_mfma_f32_32x32x16_bf16(a1, qf[d0], p1, 0, 0, 0); }
        __builtin_amdgcn_s_setprio(0);
        float rm = fmaxf(p0[0], p1[0]);
#pragma unroll
        for (int r = 1; r < 16; ++r) rm = fmaxf(rm, fmaxf(p0[r], p1[r]));
        rm = xhalf_max(rm);
        const bool first = (t == 0);
        if (first || __any(rm > 8.f)) {
            const float dl = first ? rm : fmaxf(rm, 0.f);
            mhat += dl;
#pragma unroll
            for (int r = 0; r < 16; ++r) { p0[r] -= dl; p1[r] -= dl; }
            if (!first) {
                const float f = __builtin_amdgcn_exp2f(-dl);
                if (hi == 0) wsf[r32] = f;
                float fr_[16];
#pragma unroll
                for (int r = 0; r < 16; ++r) fr_[r] = wsf[crow(r, hi)];
#pragma unroll
                for (int d = 0; d < 4; ++d)
#pragma unroll
                    for (int r = 0; r < 16; ++r) o[d][r] *= fr_[r];
#pragma unroll
                for (int r = 0; r < 16; ++r) ol[r] *= fr_[r];
            }
        }
#pragma unroll
        for (int r = 0; r < 16; ++r) { p0[r] = __builtin_amdgcn_exp2f(p0[r]); p1[r] = __builtin_amdgcn_exp2f(p1[r]); }
        u32x4 pw[4];
#pragma unroll
        for (int j = 0; j < 4; ++j) { pw[0][j] = cvt_pk_bf16(p0[2 * j], p0[2 * j + 1]); pw[1][j] = cvt_pk_bf16(p0[8 + 2 * j], p0[8 + 2 * j + 1]);
                                      pw[2][j] = cvt_pk_bf16(p1[2 * j], p1[2 * j + 1]); pw[3][j] = cvt_pk_bf16(p1[8 + 2 * j], p1[8 + 2 * j + 1]); }
        __builtin_amdgcn_s_setprio(1);
#pragma unroll
        for (int d = 0; d < 4; ++d)
#pragma unroll
            for (int ks = 0; ks < 4; ++ks) {
                const s16x4 lo = vtr(sl + vfo + d * 4096 + ks * 1024), hh = vtr(sl + vfo + d * 4096 + ks * 1024 + 512);
                const bf16x8 vf = (bf16x8){lo[0], lo[1], lo[2], lo[3], hh[0], hh[1], hh[2], hh[3]};
                o[d] = __builtin_amdgcn_mfma_f32_32x32x16_bf16(__builtin_bit_cast(bf16x8, pw[ks]), vf, o[d], 0, 0, 0); }
#pragma unroll
        for (int ks = 0; ks < 4; ++ks) ol = __builtin_amdgcn_mfma_f32_32x32x16_bf16(__builtin_bit_cast(bf16x8, pw[ks]), ones, ol, 0, 0, 0);
        __builtin_amdgcn_s_setprio(0);
    }
#undef ATT_ISSUE
    float fr_[16];
#pragma unroll
    for (int r = 0; r < 16; ++r) fr_[r] = (mi == 0 ? 1.f : lam) / ol[r];
    __syncthreads();
    LAS float* X = (LAS float*)lds + rb * 4096;
    if (mi == 1) {
#pragma unroll
        for (int d = 0; d < 4; ++d)
#pragma unroll
            for (int r = 0; r < 16; ++r) X[(d * 16 + r) * 64 + lane] = o[d][r] * fr_[r];
    }
    __syncthreads();
    if (mi == 0) {
        float ss[16];
#pragma unroll
        for (int r = 0; r < 16; ++r) ss[r] = 0.f;
#pragma unroll
        for (int d = 0; d < 4; ++d)
#pragma unroll
            for (int r = 0; r < 16; ++r) { const float v = o[d][r] * fr_[r] - X[(d * 16 + r) * 64 + lane]; o[d][r] = v; ss[r] += v * v; }
#pragma unroll
        for (int r = 0; r < 16; ++r) {
#pragma unroll
            for (int s = 1; s < 32; s <<= 1) ss[r] += __shfl_xor(ss[r], s);
            ss[r] = rsqrtf(ss[r] * (1.f / 128.f) + EPS) * (1.f - laminit); }
        float gv[4];
#pragma unroll
        for (int d = 0; d < 4; ++d) gv[d] = sg[d * 32 + r32];
#pragma unroll
        for (int r = 0; r < 16; ++r) { bf16_t* op = ocat + (rowbase + q0 + crow(r, hi)) * D + h * 128 + r32;
#pragma unroll
            for (int d = 0; d < 4; ++d) op[d * 32] = (bf16_t)f2bf(o[d][r] * ss[r] * gv[d]); }
    }
    __syncthreads();
}

template <int DK, bool HG>
__device__ __forceinline__ void scan_item(LAS uchar* lds, const bf16_t* proj, float* oraw0, float* oraw1, bf16_t* ocat, unsigned* done, int bl, int h, int dir, const float* lb  ,
                                          const float* normg  , const float* w2  , const float* gbias  ) {
    constexpr int KPW = DK / 8, TB = 32, NS = TB / 16, NR = TB / 8, GS = 4;
    LAS float* sA = (LAS float*)lds;
    LAS float* sK = sA + TB * DK;
    LAS float* sQ = sK + TB * DK;
    LAS float* sV = sQ + TB * DK;
    LAS float* sP = sV + TB * 64;
    const int tid = tid_fresh(), lane = tid & 63, wave = __builtin_amdgcn_readfirstlane(tid >> 6);
    const int ps = tid >> 5, pi = tid & 31;
    const size_t rowbase = (size_t)bl * SEQ;
    float* oraw = dir == 0 ? oraw0 : oraw1;
    __syncthreads();
    {
        float lb0 = 0.f, lb1 = 0.f, w2c[16], bias = 0.f;
        if (HG) { lb0 = lb[dir * 256 + h * 64 + pi]; lb1 = lb[dir * 256 + h * 64 + pi + 32]; }
        else {
#pragma unroll
            for (int r = 0; r < 16; ++r) w2c[r] = w2[(dir * 16 + r) * 128 + h * 32 + pi];
            bias = gbias[dir * 128 + h * 32 + pi]; }
        f32x2 S[KPW / 2];
#pragma unroll
        for (int j = 0; j < KPW / 2; ++j) S[j] = (f32x2){0.f, 0.f};
        bf16_t rz0[2][NS], rz1[2][NS], rq0[2][NS], rq1[2][NS], rv0[2][NS], rv1[2][NS], rk0[2][NS]; u32x4 rl0[2][NS], rl1[2][NS];
#pragma unroll
        for (int i = 0; i < NS; ++i) for (int e = 0; e < 2; ++e) { rz0[e][i] = rz1[e][i] = rq0[e][i] = rq1[e][i] = rv0[e][i] = rv1[e][i] = rk0[e][i] = 0; rl0[e][i] = rl1[e][i] = (u32x4){0, 0, 0, 0}; }
#define SCAN_LOAD(blk, E_) do { _Pragma("unroll") for (int i_ = 0; i_ < NS; ++i_) { const int st_ = (blk) * TB + ps + 16 * i_; const int tok_ = dir == 0 ? st_ : 2047 - st_; const bf16_t* pr_ = proj + (rowbase + tok_) * LDP; \
        if (HG) { const int zc_ = (dir == 0 ? BFF : BFB) + h * 64 + pi; rz0[E_][i_] = pr_[zc_]; rz1[E_][i_] = pr_[zc_ + 32]; rq0[E_][i_] = pr_[BQ + h * 64 + pi]; rq1[E_][i_] = pr_[BQ + h * 64 + pi + 32]; rv0[E_][i_] = pr_[BI + h * 64 + pi]; rv1[E_][i_] = pr_[BI + h * 64 + pi + 32]; } \
        else { const u32x4* lp_ = (const u32x4*)(pr_ + (dir == 0 ? GLF : GLB)); rl0[E_][i_] = lp_[0]; rl1[E_][i_] = lp_[1]; rk0[E_][i_] = pr_[GK + h * 32 + pi]; rq0[E_][i_] = pr_[GQ + h * 32 + pi]; rv0[E_][i_] = pr_[GV + h * 64 + pi]; rv1[E_][i_] = pr_[GV + h * 64 + pi + 32]; } } } while (0)
        SCAN_LOAD(0, 0); SCAN_LOAD(1, 1);
        for (int blk2 = 0; blk2 < SEQ / TB; blk2 += 2) {
            { const int blk = blk2;
#pragma unroll
            for (int i = 0; i < NS; ++i) {
                const int st = ps + 16 * i;
                if (HG) {
                    const float z0 = bf2f(rz0[0][i]), z1 = bf2f(rz1[0][i]);
                    const float s0 = __builtin_amdgcn_rcpf(1.f + __expf(-z0)), s1 = __builtin_amdgcn_rcpf(1.f + __expf(-z1));
                    sA[st * 64 + pi] = s0 * (1.f + lb0 * __expf(fminf(-z0, 80.f))); sA[st * 64 + pi + 32] = s1 * (1.f + lb1 * __expf(fminf(-z1, 80.f)));
                    sK[st * 64 + pi] = (1.f - lb0) * __builtin_amdgcn_rcpf(1.f + __expf(z0)); sK[st * 64 + pi + 32] = (1.f - lb1) * __builtin_amdgcn_rcpf(1.f + __expf(z1));
                    const float q0 = bf2f(rq0[0][i]), q1 = bf2f(rq1[0][i]);
                    sQ[st * 64 + pi] = q0 * __builtin_amdgcn_rcpf(1.f + __expf(-q0)) * 0.125f; sQ[st * 64 + pi + 32] = q1 * __builtin_amdgcn_rcpf(1.f + __expf(-q1)) * 0.125f;
                } else {
                    float z = bias;
#pragma unroll
                    for (int j = 0; j < 4; ++j) { z += bflo(rl0[0][i][j]) * w2c[2 * j] + bfhi(rl0[0][i][j]) * w2c[2 * j + 1]; z += bflo(rl1[0][i][j]) * w2c[8 + 2 * j] + bfhi(rl1[0][i][j]) * w2c[8 + 2 * j + 1]; }
                    const float ls = fminf(z, 0.f) - __logf(1.f + __expf(-fabsf(z)));
                    sA[st * 32 + pi] = __expf(ls * (1.f / 16.f));
                    sK[st * 32 + pi] = bf2f(rk0[0][i]);
                    sQ[st * 32 + pi] = bf2f(rq0[0][i]) * 0.17677669529663687f;
                }
                sV[st * 64 + pi] = bf2f(rv0[0][i]); sV[st * 64 + pi + 32] = bf2f(rv1[0][i]);
            }
            asm volatile("s_waitcnt lgkmcnt(0)" ::: "memory"); __builtin_amdgcn_s_barrier(); asm volatile("" ::: "memory");
            if (blk + 2 < SEQ / TB) SCAN_LOAD(blk + 2, 0);
            for (int s0_ = 0; s0_ < TB; s0_ += GS) {
                float vv[GS]; f32x4 a4[GS][KPW / 4], k4[GS][KPW / 4], q4[GS][KPW / 4];
#pragma unroll
                for (int g = 0; g < GS; ++g) { const int s = s0_ + g; vv[g] = sV[s * 64 + lane];
#pragma unroll
                    for (int j4 = 0; j4 < KPW / 4; ++j4) { a4[g][j4] = *(const LAS f32x4*)(sA + s * DK + wave * KPW + j4 * 4); k4[g][j4] = *(const LAS f32x4*)(sK + s * DK + wave * KPW + j4 * 4); q4[g][j4] = *(const LAS f32x4*)(sQ + s * DK + wave * KPW + j4 * 4); } }
                float po[GS];
#pragma unroll
                for (int g = 0; g < GS; ++g) {
                    f32x2 op = (f32x2){0.f, 0.f};
#pragma unroll
                    for (int j4 = 0; j4 < KPW / 4; ++j4) {
                        const f32x2 kv0 = (f32x2){k4[g][j4][0], k4[g][j4][1]} * vv[g], kv1 = (f32x2){k4[g][j4][2], k4[g][j4][3]} * vv[g];
                        S[2 * j4] = __builtin_elementwise_fma((f32x2){a4[g][j4][0], a4[g][j4][1]}, S[2 * j4], kv0);
                        S[2 * j4 + 1] = __builtin_elementwise_fma((f32x2){a4[g][j4][2], a4[g][j4][3]}, S[2 * j4 + 1], kv1);
                        op = __builtin_elementwise_fma((f32x2){q4[g][j4][0], q4[g][j4][1]}, S[2 * j4], op);
                        op = __builtin_elementwise_fma((f32x2){q4[g][j4][2], q4[g][j4][3]}, S[2 * j4 + 1], op); }
                    po[g] = op[0] + op[1]; }
#pragma unroll
                for (int g = 0; g < GS; ++g) sP[((s0_ + g) * 8 + wave) * 64 + lane] = po[g];
            }
            asm volatile("s_waitcnt lgkmcnt(0)" ::: "memory"); __builtin_amdgcn_s_barrier(); asm volatile("" ::: "memory");
#pragma unroll
            for (int j2 = 0; j2 < NR; ++j2) {
                const int s = wave + 8 * j2; const int tok = dir == 0 ? blk * TB + s : 2047 - (blk * TB + s);
                float sum = 0.f;
#pragma unroll
                for (int w = 0; w < 8; ++w) sum += sP[(s * 8 + w) * 64 + lane];
                oraw[(rowbase + tok) * 512 + (HG ? 0 : 256) + h * 64 + lane] = sum;
            }
            }
            { const int blk = blk2 + 1;
#pragma unroll
            for (int i = 0; i < NS; ++i) {
                const int st = ps + 16 * i;
                if (HG) {
                    const float z0 = bf2f(rz0[1][i]), z1 = bf2f(rz1[1][i]);
                    const float s0 = __builtin_amdgcn_rcpf(1.f + __expf(-z0)), s1 = __builtin_amdgcn_rcpf(1.f + __expf(-z1));
                    sA[st * 64 + pi] = s0 * (1.f + lb0 * __expf(fminf(-z0, 80.f))); sA[st * 64 + pi + 32] = s1 * (1.f + lb1 * __expf(fminf(-z1, 80.f)));
                    sK[st * 64 + pi] = (1.f - lb0) * __builtin_amdgcn_rcpf(1.f + __expf(z0)); sK[st * 64 + pi + 32] = (1.f - lb1) * __builtin_amdgcn_rcpf(1.f + __expf(z1));
                    const float q0 = bf2f(rq0[1][i]), q1 = bf2f(rq1[1][i]);
                    sQ[st * 64 + pi] = q0 * __builtin_amdgcn_rcpf(1.f + __expf(-q0)) * 0.125f; sQ[st * 64 + pi + 32] = q1 * __builtin_amdgcn_rcpf(1.f + __expf(-q1)) * 0.125f;
                } else {
                    float z = bias;
#pragma unroll
                    for (int j = 0; j < 4; ++j) { z += bflo(rl0[1][i][j]) * w2c[2 * j] + bfhi(rl0[1][i][j]) * w2c[2 * j + 1]; z += bflo(rl1[1][i][j]) * w2c[8 + 2 * j] + bfhi(rl1[1][i][j]) * w2c[8 + 2 * j + 1]; }
                    const float ls = fminf(z, 0.f) - __logf(1.f + __expf(-fabsf(z)));
                    sA[st * 32 + pi] = __expf(ls * (1.f / 16.f));
                    sK[st * 32 + pi] = bf2f(rk0[1][i]);
                    sQ[st * 32 + pi] = bf2f(rq0[1][i]) * 0.17677669529663687f;
                }
                sV[st * 64 + pi] = bf2f(rv0[1][i]); sV[st * 64 + pi + 32] = bf2f(rv1[1][i]);
            }
            asm volatile("s_waitcnt lgkmcnt(0)" ::: "memory"); __builtin_amdgcn_s_barrier(); asm volatile("" ::: "memory");
            if (blk + 2 < SEQ / TB) SCAN_LOAD(blk + 2, 1);
            for (int s0_ = 0; s0_ < TB; s0_ += GS) {
                float vv[GS]; f32x4 a4[GS][KPW / 4], k4[GS][KPW / 4], q4[GS][KPW / 4];
#pragma unroll
                for (int g = 0; g < GS; ++g) { const int s = s0_ + g; vv[g] = sV[s * 64 + lane];
#pragma unroll
                    for (int j4 = 0; j4 < KPW / 4; ++j4) { a4[g][j4] = *(const LAS f32x4*)(sA + s * DK + wave * KPW + j4 * 4); k4[g][j4] = *(const LAS f32x4*)(sK + s * DK + wave * KPW + j4 * 4); q4[g][j4] = *(const LAS f32x4*)(sQ + s * DK + wave * KPW + j4 * 4); } }
                float po[GS];
#pragma unroll
                for (int g = 0; g < GS; ++g) {
                    f32x2 op = (f32x2){0.f, 0.f};
#pragma unroll
                    for (int j4 = 0; j4 < KPW / 4; ++j4) {
                        const f32x2 kv0 = (f32x2){k4[g][j4][0], k4[g][j4][1]} * vv[g], kv1 = (f32x2){k4[g][j4][2], k4[g][j4][3]} * vv[g];
                        S[2 * j4] = __builtin_elementwise_fma((f32x2){a4[g][j4][0], a4[g][j4][1]}, S[2 * j4], kv0);
                        S[2 * j4 + 1] = __builtin_elementwise_fma((f32x2){a4[g][j4][2], a4[g][j4][3]}, S[2 * j4 + 1], kv1);
                        op = __builtin_elementwise_fma((f32x2){q4[g][j4][0], q4[g][j4][1]}, S[2 * j4], op);
                        op = __builtin_elementwise_fma((f32x2){q4[g][j4][2], q4[g][j4][3]}, S[2 * j4 + 1], op); }
                    po[g] = op[0] + op[1]; }
#pragma unroll
                for (int g = 0; g < GS; ++g) sP[((s0_ + g) * 8 + wave) * 64 + lane] = po[g];
            }
            asm volatile("s_waitcnt lgkmcnt(0)" ::: "memory"); __builtin_amdgcn_s_barrier(); asm volatile("" ::: "memory");
#pragma unroll
            for (int j2 = 0; j2 < NR; ++j2) {
                const int s = wave + 8 * j2; const int tok = dir == 0 ? blk * TB + s : 2047 - (blk * TB + s);
                float sum = 0.f;
#pragma unroll
                for (int w = 0; w < 8; ++w) sum += sP[(s * 8 + w) * 64 + lane];
                oraw[(rowbase + tok) * 512 + (HG ? 0 : 256) + h * 64 + lane] = sum;
            }
            }
        }
#undef SCAN_LOAD
    }
    asm volatile("s_waitcnt vmcnt(0)" ::: "memory");
    __syncthreads();
    LAS unsigned* flg = (LAS unsigned*)(lds + 147456 - 128);
    if (tid == 0) { __builtin_amdgcn_fence(__ATOMIC_RELEASE, "agent"); asm volatile("s_waitcnt vmcnt(0)" ::: "memory");
        const unsigned old = __hip_atomic_fetch_add(done, 1u, __ATOMIC_RELAXED, __HIP_MEMORY_SCOPE_AGENT);
        __builtin_amdgcn_fence(__ATOMIC_ACQUIRE, "agent"); asm volatile("s_waitcnt vmcnt(0)" ::: "memory");
        flg[0] = old; }
    __syncthreads();
    if (flg[0] == 1u) {
        if (lane == 0 && tid != 0) { __builtin_amdgcn_fence(__ATOMIC_ACQUIRE, "agent"); asm volatile("s_waitcnt vmcnt(0)" ::: "memory"); }
        __syncthreads();
        const float ng = normg[lane];
        for (int t0 = wave * 16; t0 < SEQ; t0 += 128) {
            float fa[16], fb[16]; bf16_t gq[16];
#pragma unroll
            for (int i = 0; i < 16; ++i) { const size_t o = (rowbase + t0 + i) * 512 + (HG ? 0 : 256) + h * 64 + lane;
                fa[i] = __hip_atomic_load(oraw0 + o, __ATOMIC_RELAXED, __HIP_MEMORY_SCOPE_AGENT); fb[i] = __hip_atomic_load(oraw1 + o, __ATOMIC_RELAXED, __HIP_MEMORY_SCOPE_AGENT);
                gq[i] = proj[(rowbase + t0 + i) * LDP + (HG ? BG : GG) + h * 64 + lane]; }
#pragma unroll
            for (int i = 0; i < 16; ++i) {
                const float tot = fa[i] + fb[i];
                const float ssq = wave_sum(tot * tot);
                const float gvv = bf2f(gq[i]);
                const float outv = tot * rsqrtf(ssq * (1.f / 64.f) + EPS) * ng * (gvv * __builtin_amdgcn_rcpf(1.f + __expf(-gvv)));
                ocat[(rowbase + t0 + i) * D + (HG ? 512 : 768) + h * 64 + lane] = (bf16_t)f2bf(outv);
            }
        }
    }
    __syncthreads();
}

__device__ __forceinline__ void norm_rows_mod(const float* src, bf16_t* dst, const float* g, const float* modl  , int grow0, int shoff, int scoff) {
    const int tid = tid_fresh(), lane = tid & 63, gw = blockIdx.x * 8 + __builtin_amdgcn_readfirstlane(tid >> 6), NGW = gridDim.x * 8;
    const f32x4* gr = (const f32x4*)g + lane;
    f32x4 gg[4];
#pragma unroll
    for (int j = 0; j < 4; ++j) gg[j] = gr[64 * j];
    for (int m0 = gw; m0 < TG; m0 += 2 * NGW) {
        f32x4 v[2][4]; float s[2];
#pragma unroll
        for (int e = 0; e < 2; ++e) { const int m = m0 + e * NGW; const f32x4* xr = (const f32x4*)(src + (size_t)m * D) + lane;
#pragma unroll
            for (int j = 0; j < 4; ++j) v[e][j] = xr[64 * j]; }
#pragma unroll
        for (int e = 0; e < 2; ++e) { s[e] = 0.f;
#pragma unroll
            for (int j = 0; j < 4; ++j) s[e] += (v[e][j].x * v[e][j].x + v[e][j].y * v[e][j].y) + (v[e][j].z * v[e][j].z + v[e][j].w * v[e][j].w); }
#pragma unroll
        for (int e = 0; e < 2; ++e) { const int m = m0 + e * NGW; const int b = (grow0 + m) >> 11;
            const f32x4* sh = (const f32x4*)(modl + (size_t)b * (NMOD * D) + shoff) + lane; const f32x4* sc = (const f32x4*)(modl + (size_t)b * (NMOD * D) + scoff) + lane;
            const float r = rsqrtf(wave_sum(s[e]) * (1.f / D) + EPS);
            unsigned long long* o8 = (unsigned long long*)(dst + (size_t)m * D) + lane;
#pragma unroll
            for (int j = 0; j < 4; ++j) { const f32x4 y = v[e][j] * r * gg[j] * (1.f + sc[64 * j]) + sh[64 * j];
                o8[64 * j] = (unsigned long long)pk2(y.x, y.y) | ((unsigned long long)pk2(y.z, y.w) << 32); } }
    }
}
__device__ __forceinline__ void norm_rows_final(float* x, const float* g) {
    const int tid = tid_fresh(), lane = tid & 63, gw = blockIdx.x * 8 + __builtin_amdgcn_readfirstlane(tid >> 6), NGW = gridDim.x * 8;
    for (int m = gw; m < TG; m += NGW) {
        f32x4* xr = (f32x4*)(x + (size_t)m * D) + lane; const f32x4* gr = (const f32x4*)g + lane;
        f32x4 v[4]; float s = 0.f;
#pragma unroll
        for (int j = 0; j < 4; ++j) { v[j] = xr[64 * j]; s += (v[j].x * v[j].x + v[j].y * v[j].y) + (v[j].z * v[j].z + v[j].w * v[j].w); }
        const float r = rsqrtf(wave_sum(s) * (1.f / D) + EPS);
#pragma unroll
        for (int j = 0; j < 4; ++j) xr[64 * j] = v[j] * r * gr[64 * j];
    }
}

__device__ __forceinline__ void transpose_item(const float* W, int ldw, bf16_t* WT, int ldt, int row_off, int k_off, LAS float* scr, int kb, int nb, int lane) {
    const int k0 = 64 * kb, n0 = 32 * nb;
#pragma unroll 8
    for (int i = 0; i < 32; ++i) { const int kk = 2 * i + (lane >> 5); scr[kk * 33 + (lane & 31)] = W[(size_t)(k0 + kk) * ldw + n0 + (lane & 31)]; }
    asm volatile("s_waitcnt lgkmcnt(0)" ::: "memory");
    const int c = lane & 7;
#pragma unroll
    for (int j = 0; j < 4; ++j) { const int n = (lane >> 3) + 8 * j; const LAS float* s = scr + (8 * c) * 33 + n;
        u32x4 o; o.x = pk2(s[0 * 33], s[1 * 33]); o.y = pk2(s[2 * 33], s[3 * 33]); o.z = pk2(s[4 * 33], s[5 * 33]); o.w = pk2(s[6 * 33], s[7 * 33]);
        *(u32x4*)(WT + (size_t)(row_off + n0 + n) * ldt + k_off + k0 + 8 * c) = o; }
    asm volatile("s_waitcnt lgkmcnt(0)" ::: "memory");
}

#define XB_TMO      128
#define XB_XCNT(j)  (256  + 64 * (j))
#define XB_XSUB(j)  (1280 + 64 * (j))
#define XB_XGEN(j)  (2304 + 64 * (j))
#define XB_TOP      3328
#define XB_TOPGEN   3392
#define XCD_BAR_WORDS 3456
#define XB_SPIN_CAP (1u << 18)

__device__ __forceinline__ unsigned xb_ld(unsigned* p)              { return __hip_atomic_load(p, __ATOMIC_RELAXED, __HIP_MEMORY_SCOPE_AGENT); }
__device__ __forceinline__ unsigned xb_add(unsigned* p, unsigned v) { return __hip_atomic_fetch_add(p, v, __ATOMIC_RELAXED, __HIP_MEMORY_SCOPE_AGENT); }
__device__ __forceinline__ unsigned xb_xcc_id() { return (unsigned)__builtin_amdgcn_s_getreg((3 << 11) | 20) & 0xFu; }
#define XB_SPIN(cond, bar) do { unsigned _sp = 0; while (cond) { __builtin_amdgcn_s_sleep(1); \
    if ((++_sp & 255u) == 0u) { if (xb_ld(&(bar)[XB_TMO])) break; if (_sp > XB_SPIN_CAP) { atomicAdd(&(bar)[XB_TMO], 1u); break; } } } } while (0)

struct XcdBarrier {
    unsigned* bar; unsigned x;
    volatile LAS unsigned* st;
};

__device__ __forceinline__ XcdBarrier xcd_barrier_post(unsigned* bar, volatile LAS unsigned* st) {
    XcdBarrier b; b.bar = bar; b.x = xb_xcc_id(); b.st = st;
    if (threadIdx.x == 0) (void)xb_add(&bar[XB_XCNT(b.x)], 1u);
    return b;
}
__device__ __forceinline__ void xcd_barrier_complete(unsigned* bar, unsigned x, unsigned& nloc, unsigned& nx) {
    const unsigned G = gridDim.x * gridDim.y * gridDim.z;
    unsigned sum, cnt, mine, sp = 0u;
    for (;;) {
        sum = 0u; cnt = 0u; mine = 0u;
#pragma unroll
        for (unsigned j = 0; j < 16; ++j) { const unsigned c = xb_ld(&bar[XB_XCNT(j)]); sum += c; cnt += (c > 0u) ? 1u : 0u; mine = (j == x) ? c : mine; }
        if (sum == G) break;
        __builtin_amdgcn_s_sleep(1);
        if ((++sp & 255u) == 0u) { if (xb_ld(&bar[XB_TMO])) break; if (sp > XB_SPIN_CAP) { atomicAdd(&bar[XB_TMO], 1u); break; } }
    }
    nloc = mine > 0u ? mine : 1u; nx = cnt > 0u ? cnt : 1u;
}

__device__ __forceinline__ void xcd_barrier(const XcdBarrier& b) {
    asm volatile("s_waitcnt vmcnt(0)" ::: "memory");
    __syncthreads();
    if (threadIdx.x == 0) {
        unsigned* bar = b.bar;
        __builtin_amdgcn_s_waitcnt(0);
        unsigned nloc = b.st[0], nx = b.st[1];
        if (nloc == 0u) { xcd_barrier_complete(bar, b.x, nloc, nx); b.st[0] = nloc; b.st[1] = nx; }
        const unsigned old = xb_add(&bar[XB_XSUB(b.x)], 1u);
        const unsigned gen = old / nloc;
        if (old + 1u == (gen + 1u) * nloc) {
            __builtin_amdgcn_fence(__ATOMIC_RELEASE, "agent");
            asm volatile("s_waitcnt vmcnt(0)" ::: "memory");
            const unsigned og = xb_add(&bar[XB_TOP], 1u);
            const unsigned tg = og / nx;
            if (og + 1u == (tg + 1u) * nx) xb_add(&bar[XB_TOPGEN], 1u);
            else XB_SPIN(xb_ld(&bar[XB_TOPGEN]) == tg, bar);
            __builtin_amdgcn_fence(__ATOMIC_ACQUIRE, "agent");
            xb_add(&bar[XB_XGEN(b.x)], 1u);
            asm volatile("s_waitcnt vmcnt(0)" ::: "memory");
        } else {
            XB_SPIN(xb_ld(&bar[XB_XGEN(b.x)]) == gen, bar);
            __builtin_amdgcn_fence(__ATOMIC_ACQUIRE, "agent");
            asm volatile("s_waitcnt vmcnt(0)" ::: "memory");
        }
    }
    __syncthreads();
}


constexpr int CW_XBAR = 45056;
#define XSYNC() do { XcdBarrier xb_; xb_.bar = (unsigned*)(KWS() + WS_CTL) + CW_XBAR; xb_.x = xb_xcc_id(); xb_.st = (volatile LAS unsigned*)(lds + 147456 - 256); xcd_barrier(xb_); } while (0)

struct Args { const void* p[24]; };
enum { P_X = 0, P_C, P_ADAW, P_ADAB, P_NMIXG, P_NMLPG, P_WIN, P_DLAM, P_DSUBG, P_HLB, P_HNG, P_GW2, P_GB, P_GNG, P_WUA, P_WUB, P_WUC, P_WOUT, P_W1, P_W2, P_FNG, P_OUT, P_WS };
typedef const unsigned long long __attribute__((address_space(4)))* kargp_t;
__device__ __forceinline__ const void* karg(int i) { kargp_t kp = (kargp_t)__builtin_amdgcn_kernarg_segment_ptr(); asm volatile("" : "+s"(kp));
    const unsigned long long v = kp[i]; const __attribute__((address_space(1))) void* g = (const __attribute__((address_space(1))) void*)v; return (const void*)g; }
#define GRID_SYNC() do { asm volatile("s_waitcnt vmcnt(0) lgkmcnt(0)" ::: "memory"); __syncthreads(); grid.sync(); \
    if (threadIdx.x < 64) { __builtin_amdgcn_fence(__ATOMIC_ACQUIRE, "agent"); asm volatile("s_waitcnt vmcnt(0)" ::: "memory"); } __syncthreads(); } while (0)
#define KF(i) ((const float*)karg(i))
#define KWS() ((uchar*)karg(P_WS))

__global__ void __launch_bounds__(512, 2) fwd_megakernel(Args a_unused) {
    extern __shared__ __attribute__((aligned(16))) uchar lds_raw[];
    LAS uchar* lds = (LAS uchar*)lds_raw;
    cg::grid_group grid = cg::this_grid();
    {
    const int tid = tid_fresh(), lane = tid & 63, wave = __builtin_amdgcn_readfirstlane(tid >> 6);

    if (blockIdx.x == 0) {
        unsigned* ctl = (unsigned*)(KWS() + WS_CTL); float* ctlf = (float*)ctl;
        for (int i = tid; i < 1024; i += 512) { ctl[i] = 0u; ctl[40960 + i] = 0u; }
        for (int i = tid; i < XCD_BAR_WORDS; i += 512) ctl[CW_XBAR + i] = 0u;
        if (tid < 4) {
            const float* lp = KF(P_DLAM) + tid * 256; float s1 = 0.f, s2 = 0.f;
            for (int d = 0; d < 64; ++d) { s1 += lp[d] * lp[64 + d]; s2 += lp[128 + d] * lp[192 + d]; }
            const float li = 0.8f - 0.6f * expf(-0.3f * (float)tid);
            ctlf[1024 + tid] = expf(s1) - expf(s2) + li; ctlf[1028 + tid] = li;
        }
        {
            const float* lg = KF(P_HLB); const int j = tid;
            float v[4], mx = -1e30f;
#pragma unroll
            for (int l = 0; l < 4; ++l) { v[l] = lg[l * 512 + j]; mx = fmaxf(mx, v[l]); }
            float den = 0.f;
#pragma unroll
            for (int l = 0; l < 4; ++l) { v[l] = expf(v[l] - mx); den += v[l]; }
            float cum = 0.f; const float w0 = v[0] / den;
#pragma unroll
            for (int l = 0; l < 4; ++l) { cum += v[l] / den; ctlf[2048 + l * 512 + j] = cum - w0; }
        }
        {
            float* pv = ctlf + 8192;
            const float* s0 = KF(P_NMIXG); for (int i = tid; i < 4096; i += 512) pv[i] = s0[i];
            const float* s1 = KF(P_NMLPG); for (int i = tid; i < 4096; i += 512) pv[4096 + i] = s1[i];
            const float* s2 = KF(P_DSUBG); for (int i = tid; i < 512; i += 512) pv[8192 + i] = s2[i];
            const float* s3 = KF(P_HNG); for (int i = tid; i < 256; i += 512) pv[8704 + i] = s3[i];
            const float* s4 = KF(P_GW2); for (int i = tid; i < 16384; i += 512) pv[8960 + i] = s4[i];
            const float* s5 = KF(P_GB); for (int i = tid; i < 1024; i += 512) pv[25344 + i] = s5[i];
            const float* s6 = KF(P_GNG); for (int i = tid; i < 256; i += 512) pv[26368 + i] = s6[i];
            const float* s7 = KF(P_FNG); for (int i = tid; i < 1024; i += 512) pv[26624 + i] = s7[i];
        }
    }
#ifndef NO_MOD
    {
        LAS float* cond = (LAS float*)lds; LAS float* red = (LAS float*)(lds + 131072);
        float* mod = (float*)(KWS() + WS_MOD);
        const float* cin = KF(P_C); const float* adaw = KF(P_ADAW); const float* adab = KF(P_ADAB);
        bool loaded = false;
        for (int it = blockIdx.x; it < 4 * 96; it += gridDim.x) {
            if (!loaded) { for (int i = tid; i < 32 * 1024; i += 512) { const float cv = cin[i]; cond[i] = cv / (1.f + __expf(-cv)); } loaded = true; __syncthreads(); }
            const int l = it / 96, n0 = (it % 96) * 64;
            const float* W = adaw + (size_t)l * D * (NMOD * D) + n0 + lane;
            float acc[32];
#pragma unroll
            for (int b = 0; b < 32; ++b) acc[b] = 0.f;
            for (int k4 = 0; k4 < 32; ++k4) {
                const int k = wave * 128 + k4 * 4;
                const float w0 = W[(size_t)k * (NMOD * D)], w1 = W[(size_t)(k + 1) * (NMOD * D)], w2v = W[(size_t)(k + 2) * (NMOD * D)], w3 = W[(size_t)(k + 3) * (NMOD * D)];
#pragma unroll
                for (int b = 0; b < 32; ++b) { const f32x4 c4 = *(const LAS f32x4*)(cond + b * 1024 + k); acc[b] += c4.x * w0 + c4.y * w1 + c4.z * w2v + c4.w * w3; }
            }
#pragma unroll
            for (int rd = 0; rd < 4; ++rd) {
                __syncthreads();
#pragma unroll
                for (int bb = 0; bb < 8; ++bb) red[(wave * 8 + bb) * 64 + lane] = acc[rd * 8 + bb];
                __syncthreads();
                float s = 0.f;
#pragma unroll
                for (int w = 0; w < 8; ++w) s += red[(w * 8 + wave) * 64 + lane];
                const int b = rd * 8 + wave;
                mod[((size_t)l * 32 + b) * (NMOD * D) + n0 + lane] = s + adab[l * (NMOD * D) + n0 + lane];
            }
        }
        __syncthreads();
    }
#endif
#ifndef NO_WT
    {
        LAS float* scr = (LAS float*)(lds + wave * 8704);
        const int gw = blockIdx.x * 8 + wave, NGW = gridDim.x * 8;
        uchar* ws = KWS();
        bf16_t* win_t = (bf16_t*)(ws + WS_WIN); bf16_t* wup_t = (bf16_t*)(ws + WS_WUP); bf16_t* wout_t = (bf16_t*)(ws + WS_WOUT);
        bf16_t* w1_t = (bf16_t*)(ws + WS_W1); bf16_t* w2_t = (bf16_t*)(ws + WS_W2);
        constexpr int I_IN = 16 * 209, I_UA = 8 * 32, I_UB = 4 * 32, I_UC = 4 * 32, I_O = 16 * 32, I_1 = 16 * 128, I_2 = 64 * 32;
        constexpr int I_L = I_IN + I_UA + I_UB + I_UC + I_O + I_1 + I_2;
        for (int it = gw; it < 4 * I_L; it += NGW) {
            const int l = it / I_L; int r = it % I_L;
            if (r < I_IN) { transpose_item(KF(P_WIN) + (size_t)l * D * DIN, DIN, win_t + (size_t)l * LDP * D, D, 0, 0, scr, r / 209, r % 209, lane); continue; } r -= I_IN;
            if (r < I_UA) { transpose_item(KF(P_WUA) + (size_t)l * 512 * D, D, wup_t + (size_t)l * D * D, D, 0, 0, scr, r / 32, r % 32, lane); continue; } r -= I_UA;
            if (r < I_UB) { transpose_item(KF(P_WUB) + (size_t)l * 256 * D, D, wup_t + (size_t)l * D * D, D, 0, 512, scr, r / 32, r % 32, lane); continue; } r -= I_UB;
            if (r < I_UC) { transpose_item(KF(P_WUC) + (size_t)l * 256 * D, D, wup_t + (size_t)l * D * D, D, 0, 768, scr, r / 32, r % 32, lane); continue; } r -= I_UC;
            if (r < I_O) { transpose_item(KF(P_WOUT) + (size_t)l * D * D, D, wout_t + (size_t)l * D * D, D, 0, 0, scr, r / 32, r % 32, lane); continue; } r -= I_O;
            if (r < I_1) { transpose_item(KF(P_W1) + (size_t)l * D * DFF, DFF, w1_t + (size_t)l * DFF * D, D, 0, 0, scr, r / 128, r % 128, lane); continue; } r -= I_1;
            transpose_item(KF(P_W2) + (size_t)l * DFF * D, D, w2_t + (size_t)l * D * DFF, DFF, 0, 0, scr, r / 32, r % 32, lane);
        }
        for (int i = blockIdx.x * 512 + tid; i < 4 * 28672; i += gridDim.x * 512) { const int l = i / 28672, r = i % 28672;
            *(u32x4*)(win_t + (size_t)l * LDP * D + (size_t)DIN * D + (size_t)r * 8) = (u32x4){0u, 0u, 0u, 0u}; }
    }
#endif
    }
    GRID_SYNC();
    if (threadIdx.x < 2) ((LAS unsigned*)(lds + 147456 - 256))[threadIdx.x] = 0u;
    (void)xcd_barrier_post((unsigned*)(KWS() + WS_CTL) + CW_XBAR, (volatile LAS unsigned*)(lds + 147456 - 256));

    for (int grp = 0; grp < NGRP; ++grp) {
        for (int l = 0; l < DEPTH; ++l) {
            {
                uchar* ws = KWS(); const float* pv = (const float*)(ws + WS_CTL) + 8192;
                const float* src = (l == 0 ? KF(P_X) : (const float*)karg(P_OUT)) + (size_t)grp * TG * D;
                norm_rows_mod(src, (bf16_t*)(ws + WS_HB), pv + l * D, (const float*)(ws + WS_MOD) + (size_t)l * 32 * (NMOD * D), grp * TG, 0, D);
            }
            XSYNC();
            { uchar* ws = KWS(); pg8::Gemm g{(const bf16_t*)(ws + WS_HB), (const bf16_t*)(ws + WS_WIN) + (size_t)l * LDP * D, D}; pg8::Order S; S.init(TG, LDP, D, gridDim.x, blockIdx.x, 1); pg8::EpiProj E{(bf16_t*)(ws + WS_PROJ), (bf16_t*)(ws + WS_ATT)};
#ifndef NO_EPIPROJ
              pg8::gemm_phase<pg8::EpiProj>(lds, g, S, E);
#endif
            }
            XSYNC();
            {
                uchar* ws = KWS(); const float* ctlf = (const float*)(ws + WS_CTL); const float* pv = ctlf + 8192;
                const int xq = blockIdx.x & 7; unsigned* ctr = (unsigned*)(ws + WS_CTL) + ((grp * DEPTH + l) * 8 + xq) * 4;
                const float lam = ctlf[1024 + l], laminit = ctlf[1028 + l];
                const bf16_t* PROJ = (const bf16_t*)(ws + WS_PROJ); bf16_t* OCAT = (bf16_t*)(ws + WS_OCAT); float* OFWD = (float*)(ws + WS_OFWD);
                LAS int* itm = (LAS int*)(lds + 147456 - 64);
                const int tid = tid_fresh();
                for (;;) {
                    __syncthreads();
                    if (tid == 0) itm[0] = (int)atomicAdd(ctr, 1u);
                    __syncthreads();
                    const int it = itm[0];
                    constexpr int NPQ = GB * 4 / 8;
                    if (it >= 4 * NPQ + NPQ * 16) break;
                    float* OBWD = (float*)(ws + WS_OBWD);
                    if (it < 2 * NPQ) { const int p = (it >> 1) * 8 + xq; unsigned* dn = (unsigned*)(ws + WS_CTL) + 40960 + (((grp * DEPTH + l) * GB * 4 + p) * 2);
                        scan_item<64, true>(lds, PROJ, OFWD, OBWD, OCAT, dn, p >> 2, p & 3, it & 1, ctlf + 2048 + l * 512, pv + 8704 + l * 64, nullptr, nullptr);
                    } else if (it < 4 * NPQ) { const int i2 = it - 2 * NPQ; const int p = (i2 >> 1) * 8 + xq; unsigned* dn = (unsigned*)(ws + WS_CTL) + 40960 + (((grp * DEPTH + l) * GB * 4 + p) * 2 + 1);
                        scan_item<32, false>(lds, PROJ, OFWD, OBWD, OCAT, dn, p >> 2, p & 3, i2 & 1, nullptr, pv + 26368 + l * 64, pv + 8960 + l * 4096, pv + 25344 + l * 256);
                    } else { const int u = it - 4 * NPQ, p = (u >> 4) * 8 + xq;
                        attn_unit(lds, (const bf16_t*)(ws + WS_ATT), OCAT, p >> 2, p & 3, u & 15, lam, laminit, pv + 8192 + l * 128);
                    }
                }
            }
            XSYNC();
            { uchar* ws = KWS(); pg8::Gemm g{(const bf16_t*)(ws + WS_OCAT), (const bf16_t*)(ws + WS_WUP) + (size_t)l * D * D, D}; pg8::Order S; S.init(TG, D, D, gridDim.x, blockIdx.x, 3); pg8::EpiMerge E{(const bf16_t*)(ws + WS_PROJ), (bf16_t*)(ws + WS_HB)};
#ifndef NO_EPIMERGE
              pg8::gemm_phase<pg8::EpiMerge>(lds, g, S, E);
#endif
            }
            XSYNC();
            { uchar* ws = KWS(); pg8::Gemm g{(const bf16_t*)(ws + WS_HB), (const bf16_t*)(ws + WS_WOUT) + (size_t)l * D * D, D}; pg8::Order S; S.init(TG, D, D, gridDim.x, blockIdx.x, 1);
              float* xg = (float*)karg(P_OUT) + (size_t)grp * TG * D;
              pg8::EpiRes E{l == 0 ? KF(P_X) + (size_t)grp * TG * D : xg, xg, (const float*)(ws + WS_MOD) + ((size_t)l * 32 + grp * GB) * (NMOD * D) + 2 * D};
#ifndef NO_EPIRES
              pg8::gemm_phase<pg8::EpiRes>(lds, g, S, E);
#endif
            }
            XSYNC();
            {
                uchar* ws = KWS(); const float* pv = (const float*)(ws + WS_CTL) + 8192;
                norm_rows_mod((const float*)karg(P_OUT) + (size_t)grp * TG * D, (bf16_t*)(ws + WS_HB), pv + 4096 + l * D, (const float*)(ws + WS_MOD) + (size_t)l * 32 * (NMOD * D), grp * TG, 3 * D, 4 * D);
            }
            XSYNC();
            { uchar* ws = KWS(); pg8::Gemm g{(const bf16_t*)(ws + WS_HB), (const bf16_t*)(ws + WS_W1) + (size_t)l * DFF * D, D}; pg8::Order S; S.init(TG, DFF, D, gridDim.x, blockIdx.x, 1); pg8::EpiRelu2 E{(bf16_t*)(ws + WS_U)};
#ifndef NO_EPIRELU2
              pg8::gemm_phase<pg8::EpiRelu2>(lds, g, S, E);
#endif
            }
            XSYNC();
            { uchar* ws = KWS(); pg8::Gemm g{(const bf16_t*)(ws + WS_U), (const bf16_t*)(ws + WS_W2) + (size_t)l * D * DFF, DFF}; pg8::Order S; S.init(TG, D, DFF, gridDim.x, blockIdx.x, 1);
              float* xg = (float*)karg(P_OUT) + (size_t)grp * TG * D;
              pg8::EpiRes E{xg, xg, (const float*)(ws + WS_MOD) + ((size_t)l * 32 + grp * GB) * (NMOD * D) + 5 * D};
#ifndef NO_EPIRES
              pg8::gemm_phase<pg8::EpiRes>(lds, g, S, E);
#endif
            }
            XSYNC();
        }
        norm_rows_final((float*)karg(P_OUT) + (size_t)grp * TG * D, (const float*)(KWS() + WS_CTL) + 8192 + 26624);
    }
}

extern "C" void kernel_launch(void* const* d_in, const int* in_sizes, int n_in, void* d_out, int out_size, void* d_ws, size_t ws_size, hipStream_t stream) {
    static int grid = 0;
    if (grid == 0) {
        if (n_in != 21 || ws_size < WS_END) { fprintf(stderr, "kernel_launch: unexpected n_in %d / ws %zu\n", n_in, ws_size); grid = -1; return; }
        int dev = 0, cus = 0, per_cu = 0;
        if (hipGetDevice(&dev) != hipSuccess || hipDeviceGetAttribute(&cus, hipDeviceAttributeMultiprocessorCount, dev) != hipSuccess) { grid = -1; return; }
        if (hipFuncSetAttribute((const void*)fwd_megakernel, hipFuncAttributeMaxDynamicSharedMemorySize, LDS_BYTES) != hipSuccess) { fprintf(stderr, "kernel_launch: hipFuncSetAttribute failed\n"); grid = -1; return; }
        if (hipOccupancyMaxActiveBlocksPerMultiprocessor(&per_cu, (const void*)fwd_megakernel, 512, LDS_BYTES) != hipSuccess || per_cu < 1) { fprintf(stderr, "kernel_launch: occupancy query says %d\n", per_cu); per_cu = 1; }
        (void)hipGetLastError();
        grid = cus;
    }
    if (grid < 0) return;
    Args a{};
    for (int i = 0; i < 21; ++i) a.p[i] = d_in[i];
    a.p[21] = d_out; a.p[22] = d_ws; a.p[23] = nullptr;
    void* args[] = {&a};
    hipError_t e = hipLaunchCooperativeKernel((void*)fwd_megakernel, dim3(grid), dim3(512), args, LDS_BYTES, stream);
    if (e != hipSuccess) fprintf(stderr, "kernel_launch: cooperative launch failed: %s (grid %d)\n", hipGetErrorString(e), grid);
}
```

```cpp
#include <hip/hip_runtime.h>
#include <hip/hip_cooperative_groups.h>
#include <cstdio>
#include <cstdint>
namespace cg = cooperative_groups;

#define LAS __attribute__((address_space(3)))
typedef unsigned short bf16_t;
typedef short bf16x8 __attribute__((ext_vector_type(8)));
typedef float f32x4 __attribute__((ext_vector_type(4)));
typedef float f32x2 __attribute__((ext_vector_type(2)));
typedef float f32x16 __attribute__((ext_vector_type(16)));
typedef unsigned u32x4 __attribute__((ext_vector_type(4)));
typedef short s16x4 __attribute__((ext_vector_type(4)));
typedef unsigned char uchar;

constexpr int D = 1024, SEQ = 2048, BATCH = 32, DEPTH = 4, DIN = 6688, LDP = 6912, DFF = 4096, NMOD = 6;
constexpr int GB = 16, TG = GB * SEQ, NGRP = BATCH / GB;
constexpr int CQ = 0, CK = 512, CV = 1024, BQ = 1536, BFF = 1792, BFB = 2048, BI = 2304, BG = 2560;
constexpr int GQ = 2816, GK = 2944, GV = 3072, GG = 3328, GLF = 3584, GLB = 3600, GATE = 3616;
constexpr float EPS = 1e-6f, LOG2E = 1.4426950408889634f;
constexpr float QSCALE = 0.125f * LOG2E;

constexpr size_t MiB = 1u << 20;
constexpr size_t WS_CTL = 0;
constexpr size_t WS_MOD = 1 * MiB;
constexpr size_t WS_WIN = 4 * MiB;
constexpr size_t WS_WUP = 58 * MiB;
constexpr size_t WS_WOUT = 66 * MiB;
constexpr size_t WS_W1 = 74 * MiB;
constexpr size_t WS_W2 = 106 * MiB;
constexpr size_t WS_HB = 138 * MiB;
constexpr size_t WS_OCAT = 202 * MiB;
constexpr size_t WS_OFWD = 266 * MiB;
constexpr size_t WS_PROJ = 330 * MiB;
constexpr size_t WS_U = WS_PROJ;
constexpr size_t WS_OBWD = 762 * MiB;
constexpr size_t WS_ATT = 826 * MiB;
constexpr size_t WS_END = 922 * MiB;
constexpr int LDS_BYTES = 148 * 1024;

__device__ __forceinline__ unsigned f2bf(float f) { unsigned u = __builtin_bit_cast(unsigned, f); return (u + 0x7fffu + ((u >> 16) & 1u)) >> 16; }
__device__ __forceinline__ unsigned pk2(float lo, float hi) { return f2bf(lo) | (f2bf(hi) << 16); }
__device__ __forceinline__ float bf2f(bf16_t v) { return __builtin_bit_cast(float, (unsigned)v << 16); }
__device__ __forceinline__ float bflo(unsigned u) { return __builtin_bit_cast(float, u << 16); }
__device__ __forceinline__ float bfhi(unsigned u) { return __builtin_bit_cast(float, u & 0xffff0000u); }
typedef __bf16 bf16x2_t __attribute__((ext_vector_type(2)));
__device__ __forceinline__ unsigned cvt_pk_bf16(float lo, float hi) { f32x2 v = {lo, hi}; bf16x2_t b = __builtin_convertvector(v, bf16x2_t); return __builtin_bit_cast(unsigned, b); }
__device__ __forceinline__ float wave_sum(float v) {
#pragma unroll
    for (int o = 1; o < 64; o <<= 1) v += __shfl_xor(v, o);
    return v;
}
__device__ __forceinline__ int tid_fresh() { int t = threadIdx.x; asm volatile("" : "+v"(t)); return t; }
__device__ __forceinline__ float sigmoidf_(float z) { return 1.f / (1.f + __expf(-z)); }

namespace pg8 {
constexpr int BM = 256, BK = 64, HALF = 128, HTB = HALF * BK * 2, STAGE_BYTES = 8 * HTB, NXCD = 8, WGM = 8;
__host__ __device__ __forceinline__ int lds_byte(int r, int c) { const int st = (r >> 4) * 2 + (c >> 5), rr = r & 15, cc = c & 31, ob = rr * 64 + cc * 2; return st * 1024 + (ob ^ (((ob >> 9) & 1) << 5)); }
__host__ __device__ __forceinline__ void stage_rc(int b, int& R, int& C) { const int st = b / 1024, sb = b % 1024, swz = sb ^ (((sb >> 9) & 1) << 5); R = (st >> 1) * 16 + swz / 64; C = (st & 1) * 32 + (swz % 64) / 2; }
__host__ __device__ __forceinline__ int perm32(int rho) { const int n = rho >> 4, i = rho & 15; return 8 * (i >> 2) + 4 * n + (i & 3); }

struct Unit { int pm, pn, koff, nt, seg; };
struct Gemm { const bf16_t* A; const bf16_t* Bt; int K; };

struct Order {
    int nM, nN, nwg, G, c, nseg, ntfull;
    __device__ void init(int M, int N, int K, int G_, int c_, int nseg_) { nM = M / BM; nN = N / BM; nwg = nM * nN; G = G_; c = c_; nseg = nseg_; ntfull = K / BK; }
    __device__ bool next(int i, Unit& u) const {
        int ti = i, seg = 0;
        if (nseg == 3) { ti = i / 3; seg = i - ti * 3; }
        const long L = (long)ti * G + c; if (L >= nwg) return false;
        int wgid = (int)L; { const int q = nwg / NXCD, r = nwg % NXCD, xcd = wgid % NXCD, off = wgid / NXCD; wgid = (xcd < r ? xcd * (q + 1) : r * (q + 1) + (xcd - r) * q) + off; }
        const int nig = WGM * nN, gid = wgid / nig, fm = gid * WGM, gsz = (nM - fm) < WGM ? (nM - fm) : WGM;
        u.pm = fm + ((wgid % nig) % gsz); u.pn = (wgid % nig) / gsz; u.seg = seg;
        if (nseg == 3) { u.koff = seg == 0 ? 0 : (seg == 1 ? 512 : 768); u.nt = seg == 0 ? 8 : 4; } else { u.koff = 0; u.nt = ntfull; }
        return true;
    }
};

struct EpiProj {
    bf16_t* O; bf16_t* att;
    __device__ __forceinline__ bool zero_after(const Unit&) const { return true; }
    __device__ __forceinline__ void operator()(f32x4 (&acc)[2][2][4][2], const Unit& u, int wr, int wc, int fr, int fq) const {
        const int row0 = u.pm * BM + wr * 64 + fr, col0 = u.pn * BM + wc * 32 + 8 * fq;
        const float sc = (u.pn < 2) ? QSCALE : 1.f;
        const bool toatt = u.pn < 6;
#pragma unroll
        for (int ai = 0; ai < 2; ++ai)
#pragma unroll
            for (int m = 0; m < 4; ++m) { const int row = row0 + ai * HALF + m * 16; bf16_t* rowp = O + (size_t)row * LDP + col0;
#pragma unroll
                for (int bj = 0; bj < 2; ++bj) { f32x4 v0 = acc[ai][bj][m][0] * sc, v1 = acc[ai][bj][m][1] * sc;
                    u32x4 w; w.x = cvt_pk_bf16(v0[0], v0[1]); w.y = cvt_pk_bf16(v0[2], v0[3]); w.z = cvt_pk_bf16(v1[0], v1[1]); w.w = cvt_pk_bf16(v1[2], v1[3]);
                    if (toatt) { const int seg = u.pn * 2 + bj, typ = seg >> 2, hh = seg & 3;
                        *(u32x4*)(att + ((size_t)(((row >> 11) * 4 + hh) * SEQ + (row & 2047))) * 384 + typ * 128 + wc * 32 + 8 * fq) = w; }
                    else *(u32x4*)(rowp + bj * HALF) = w; } }
    }
};
struct EpiRelu2 {
    bf16_t* O;
    __device__ __forceinline__ bool zero_after(const Unit&) const { return true; }
    __device__ __forceinline__ void operator()(f32x4 (&acc)[2][2][4][2], const Unit& u, int wr, int wc, int fr, int fq) const {
        const int row0 = u.pm * BM + wr * 64 + fr, col0 = u.pn * BM + wc * 32 + 8 * fq;
#pragma unroll
        for (int ai = 0; ai < 2; ++ai)
#pragma unroll
            for (int m = 0; m < 4; ++m) { bf16_t* rowp = O + (size_t)(row0 + ai * HALF + m * 16) * DFF + col0;
#pragma unroll
                for (int bj = 0; bj < 2; ++bj) { f32x4 v0 = acc[ai][bj][m][0], v1 = acc[ai][bj][m][1];
#pragma unroll
                    for (int j = 0; j < 4; ++j) { float a = fmaxf(v0[j], 0.f), b = fmaxf(v1[j], 0.f); v0[j] = a * a; v1[j] = b * b; }
                    u32x4 w; w.x = cvt_pk_bf16(v0[0], v0[1]); w.y = cvt_pk_bf16(v0[2], v0[3]); w.z = cvt_pk_bf16(v1[0], v1[1]); w.w = cvt_pk_bf16(v1[2], v1[3]);
                    *(u32x4*)(rowp + bj * HALF) = w; } }
    }
};
struct EpiRes {
    const float* base; float* out; const float* gate;
    __device__ __forceinline__ bool zero_after(const Unit&) const { return true; }
    __device__ __forceinline__ void operator()(f32x4 (&acc)[2][2][4][2], const Unit& u, int wr, int wc, int fr, int fq) const {
        const int row0 = u.pm * BM + wr * 64 + fr, col0 = u.pn * BM + wc * 32 + 8 * fq;
        const float* gp = gate + (size_t)((u.pm * BM) >> 11) * (NMOD * D) + col0;
#pragma unroll
        for (int bj = 0; bj < 2; ++bj) {
            const f32x4 g0 = *(const f32x4*)(gp + bj * HALF), g1 = *(const f32x4*)(gp + bj * HALF + 4);
#pragma unroll
            for (int ai = 0; ai < 2; ++ai) {
#pragma unroll
                for (int m = 0; m < 4; ++m) { const size_t off = (size_t)(row0 + ai * HALF + m * 16) * D + col0 + bj * HALF;
                    const f32x4 b0 = *(const f32x4*)(base + off), b1 = *(const f32x4*)(base + off + 4);
                    *(f32x4*)(out + off) = b0 + g0 * acc[ai][bj][m][0];
                    *(f32x4*)(out + off + 4) = b1 + g1 * acc[ai][bj][m][1];
                    if (m & 1) asm volatile("" ::: "memory"); }
            }
        }
    }
};
struct EpiMerge {
    const bf16_t* proj; bf16_t* O;
    __device__ __forceinline__ bool zero_after(const Unit& u) const { return u.seg == 2; }
    __device__ __forceinline__ void operator()(f32x4 (&acc)[2][2][4][2], const Unit& u, int wr, int wc, int fr, int fq) const {
        const int row0 = u.pm * BM + wr * 64 + fr, col0 = u.pn * BM + wc * 32 + 8 * fq;
        const int seg = u.seg;
#pragma unroll
        for (int ai = 0; ai < 2; ++ai)
#pragma unroll
            for (int m = 0; m < 4; ++m) { const size_t row = (size_t)(row0 + ai * HALF + m * 16); const bf16_t* gp = proj + row * LDP + GATE + col0;
#pragma unroll
                for (int bj = 0; bj < 2; ++bj) {
                    if (seg < 2) {
                        const u32x4 ga = *(const u32x4*)(gp + seg * D + bj * HALF), gb = *(const u32x4*)(gp + (seg + 1) * D + bj * HALF);
                        float r[8];
#pragma unroll
                        for (int j = 0; j < 4; ++j) {
                            const float a0 = fminf(fmaxf(bflo(ga[j]), -40.f), 40.f), a1 = fminf(fmaxf(bfhi(ga[j]), -40.f), 40.f);
                            const float b0 = fminf(fmaxf(bflo(gb[j]), -40.f), 40.f), b1 = fminf(fmaxf(bfhi(gb[j]), -40.f), 40.f);
                            r[2 * j] = (1.f + __expf(-b0)) * __builtin_amdgcn_rcpf(1.f + __expf(-a0));
                            r[2 * j + 1] = (1.f + __expf(-b1)) * __builtin_amdgcn_rcpf(1.f + __expf(-a1)); }
                        acc[ai][bj][m][0] = acc[ai][bj][m][0] * (f32x4){r[0], r[1], r[2], r[3]};
                        acc[ai][bj][m][1] = acc[ai][bj][m][1] * (f32x4){r[4], r[5], r[6], r[7]};
                    } else {
                        const u32x4 gc = *(const u32x4*)(gp + 2 * D + bj * HALF);
                        float r[8];
#pragma unroll
                        for (int j = 0; j < 4; ++j) {
                            const float c0 = fminf(fmaxf(bflo(gc[j]), -40.f), 40.f), c1 = fminf(fmaxf(bfhi(gc[j]), -40.f), 40.f);
                            r[2 * j] = __builtin_amdgcn_rcpf(1.f + __expf(-c0)); r[2 * j + 1] = __builtin_amdgcn_rcpf(1.f + __expf(-c1)); }
                        const f32x4 v0 = acc[ai][bj][m][0] * (f32x4){r[0], r[1], r[2], r[3]}, v1 = acc[ai][bj][m][1] * (f32x4){r[4], r[5], r[6], r[7]};
                        u32x4 w; w.x = cvt_pk_bf16(v0[0], v0[1]); w.y = cvt_pk_bf16(v0[2], v0[3]); w.z = cvt_pk_bf16(v1[0], v1[1]); w.w = cvt_pk_bf16(v1[2], v1[3]);
                        *(u32x4*)(O + row * D + col0 + bj * HALF) = w;
                    } } }
    }
};

template <class Epi, bool ALIGN_EPI = true>
__device__ __forceinline__ void gemm_phase(LAS uchar* lds, const Gemm g, const Order& S, const Epi& E) {
    const int tid = tid_fresh(), wid = __builtin_amdgcn_readfirstlane(tid >> 6), lane = tid & 63, wr = wid >> 2, wc = wid & 3, fr = lane & 15, fq = lane >> 4;
    const int K = g.K;
    unsigned voffA[2], voffB[2];
#pragma unroll
    for (int i = 0; i < 2; ++i) { int R, C; stage_rc(tid * 16 + i * 8192, R, C); const int Rb = (R & ~31) + perm32(R & 31);
        voffA[i] = (unsigned)(R * K + C) * 2u; voffB[i] = (unsigned)(Rb * K + C) * 2u; }
    const size_t kstep = (size_t)(BK * 2);
    const size_t hstep = (size_t)HALF * K * 2;
    const size_t tstep = 2 * hstep;
    const unsigned ldsw = (unsigned)wid * 1024u;
    const int aoff = lds_byte(wr * 64 + fr, fq * 8), boff = lds_byte(wc * 32 + fr, fq * 8);
#define PG8_SA(b, h) (((b) * 2 + (h)) * HTB)
#define PG8_SB(b, h) ((4 + (b) * 2 + (h)) * HTB)
#define PG8_STAGE(bufoff, gbase, voff) do { _Pragma("unroll") for (int _i = 0; _i < 2; ++_i) \
        __builtin_amdgcn_global_load_lds((const unsigned*)((const char*)(gbase) + (voff)[_i]), (LAS unsigned*)(lds + (bufoff) + ldsw + _i * 8192), 16, 0, 0); } while (0)
#define PG8_LDA(dst, b, h) do { _Pragma("unroll") for (int m = 0; m < 4; ++m) _Pragma("unroll") for (int k = 0; k < 2; ++k) dst[m][k] = *(const LAS bf16x8*)(lds + PG8_SA(b, h) + aoff + m * 2048 + k * 1024); } while (0)
#define PG8_LDB(dst, b, h) do { _Pragma("unroll") for (int n = 0; n < 2; ++n) _Pragma("unroll") for (int k = 0; k < 2; ++k) dst[n][k] = *(const LAS bf16x8*)(lds + PG8_SB(b, h) + boff + n * 2048 + k * 1024); } while (0)
#define PG8_MMA(ai, bj, At, Bt) do { __builtin_amdgcn_s_setprio(1); _Pragma("unroll") for (int m = 0; m < 4; ++m) _Pragma("unroll") for (int n = 0; n < 2; ++n) _Pragma("unroll") for (int k = 0; k < 2; ++k) \
        acc[ai][bj][m][n] = __builtin_amdgcn_mfma_f32_16x16x32_bf16(Bt[n][k], At[m][k], acc[ai][bj][m][n], 0, 0, 0); __builtin_amdgcn_s_setprio(0); } while (0)
#define PG8_WAIT_V(n) asm volatile("s_waitcnt vmcnt(" #n ")" ::: "memory")
#define PG8_WAIT_L(n) asm volatile("s_waitcnt lgkmcnt(" #n ")" ::: "memory")
#define PG8_BAR __builtin_amdgcn_s_barrier()
#define PG8_SCHED __builtin_amdgcn_sched_barrier(0)
    Unit cur, nxt; int ui = 0;
    if (!S.next(0, cur)) return;
    f32x4 acc[2][2][4][2];
#pragma unroll
    for (int a = 0; a < 2; ++a)
#pragma unroll
        for (int b = 0; b < 2; ++b)
#pragma unroll
            for (int m = 0; m < 4; ++m)
#pragma unroll
                for (int n = 0; n < 2; ++n) acc[a][b][m][n] = (f32x4){0.f, 0.f, 0.f, 0.f};
    bf16x8 At[4][2], B0[2][2], B1[2][2];
    const char* cA = (const char*)g.A + (size_t)cur.pm * tstep + (size_t)cur.koff * 2; const char* cB = (const char*)g.Bt + (size_t)cur.pn * tstep + (size_t)cur.koff * 2;
    PG8_STAGE(PG8_SB(0, 0), cB, voffB); PG8_STAGE(PG8_SB(0, 1), cB + hstep, voffB); PG8_STAGE(PG8_SA(0, 0), cA, voffA); PG8_STAGE(PG8_SA(0, 1), cA + hstep, voffA);
    if (wr == 1) PG8_BAR;
    PG8_WAIT_V(2); PG8_BAR;
    PG8_STAGE(PG8_SB(1, 0), cB + kstep, voffB); PG8_STAGE(PG8_SA(1, 0), cA + kstep, voffA); PG8_STAGE(PG8_SB(1, 1), cB + hstep + kstep, voffB);
    PG8_WAIT_V(6); PG8_BAR;
    for (;;) {
        const bool has_next = S.next(ui + 1, nxt);
        const char* nA = has_next ? (const char*)g.A + (size_t)nxt.pm * tstep + (size_t)nxt.koff * 2 : cA; const char* nB = has_next ? (const char*)g.Bt + (size_t)nxt.pn * tstep + (size_t)nxt.koff * 2 : cB;
        const int nt = cur.nt;
        for (int t = 0; t < nt; t += 2) {
            const bool last = (t == nt - 2);
            const char* a1 = cA + (size_t)(t + 1) * kstep;
            const char* a2 = last ? nA : cA + (size_t)(t + 2) * kstep; const char* b2 = last ? nB : cB + (size_t)(t + 2) * kstep;
            const char* a3 = a2 + kstep; const char* b3 = b2 + kstep;
            PG8_LDB(B0, 0, 0); PG8_LDB(B1, 0, 1); PG8_SCHED; PG8_LDA(At, 0, 0); PG8_STAGE(PG8_SA(1, 1), a1 + hstep, voffA);
            PG8_WAIT_V(8); PG8_WAIT_L(0); PG8_BAR; PG8_MMA(0, 0, At, B0); PG8_MMA(0, 1, At, B1); PG8_BAR; PG8_SCHED;
            PG8_LDA(At, 0, 1); PG8_STAGE(PG8_SB(0, 0), b2, voffB); PG8_STAGE(PG8_SB(0, 1), b2 + hstep, voffB); PG8_STAGE(PG8_SA(0, 0), a2, voffA);
            PG8_WAIT_V(8); PG8_WAIT_L(0); PG8_BAR; PG8_MMA(1, 0, At, B0); PG8_MMA(1, 1, At, B1); PG8_BAR; PG8_SCHED;
            PG8_LDB(B0, 1, 0); PG8_LDB(B1, 1, 1); PG8_SCHED; PG8_LDA(At, 1, 0); PG8_STAGE(PG8_SA(0, 1), a2 + hstep, voffA);
            PG8_WAIT_V(8); PG8_WAIT_L(0); PG8_BAR; PG8_MMA(0, 0, At, B0); PG8_MMA(0, 1, At, B1); PG8_BAR; PG8_SCHED;
            PG8_LDA(At, 1, 1); PG8_STAGE(PG8_SB(1, 0), b3, voffB); PG8_STAGE(PG8_SB(1, 1), b3 + hstep, voffB); PG8_STAGE(PG8_SA(1, 0), a3, voffA);
            PG8_WAIT_V(8); PG8_WAIT_L(0); PG8_BAR; PG8_MMA(1, 0, At, B0); PG8_MMA(1, 1, At, B1); PG8_BAR; PG8_SCHED;
        }
        if constexpr (ALIGN_EPI) { if (wr == 0) PG8_BAR; }
        E(acc, cur, wr, wc, fr, fq);
        if (!has_next) break;
        if (E.zero_after(cur)) {
#pragma unroll
            for (int a = 0; a < 2; ++a)
#pragma unroll
                for (int b = 0; b < 2; ++b)
#pragma unroll
                    for (int m = 0; m < 4; ++m)
#pragma unroll
                        for (int n = 0; n < 2; ++n) acc[a][b][m][n] = (f32x4){0.f, 0.f, 0.f, 0.f};
        }
        cur = nxt; cA = nA; cB = nB; ++ui;
        if constexpr (ALIGN_EPI) { if (wr == 1) PG8_BAR; }
    }
    PG8_WAIT_V(0);
    if constexpr (!ALIGN_EPI) { if (wr == 0) PG8_BAR; }
    PG8_BAR;
#undef PG8_SA
#undef PG8_SB
#undef PG8_STAGE
#undef PG8_LDA
#undef PG8_LDB
#undef PG8_MMA
#undef PG8_WAIT_V
#undef PG8_WAIT_L
#undef PG8_BAR
#undef PG8_SCHED
}
}

__device__ __forceinline__ int crow(int r, int hi) { return (r & 3) + 8 * (r >> 2) + 4 * hi; }
__device__ __forceinline__ s16x4 vtr(const LAS uchar* p) { return __builtin_bit_cast(s16x4, __builtin_amdgcn_ds_read_tr16_b64_v4i16((LAS s16x4*)p)); }
__device__ __forceinline__ float xhalf_max(float m) { auto rr = __builtin_amdgcn_permlane32_swap(__builtin_bit_cast(unsigned, m), __builtin_bit_cast(unsigned, m), false, false); return fmaxf(__builtin_bit_cast(float, rr[0]), __builtin_bit_cast(float, rr[1])); }
__device__ __forceinline__ float xhalf_sum(float m) { auto rr = __builtin_amdgcn_permlane32_swap(__builtin_bit_cast(unsigned, m), __builtin_bit_cast(unsigned, m), false, false); return __builtin_bit_cast(float, rr[0]) + __builtin_bit_cast(float, rr[1]); }

__device__ __forceinline__ void glds16(const void* gsrc, unsigned lds_dst) { unsigned keep;
    asm volatile("s_mov_b32 %0, m0\n\ts_mov_b32 m0, %2\n\ts_nop 0\n\tglobal_load_lds_dwordx4 %1, off\n\ts_mov_b32 m0, %0" : "=&s"(keep) : "v"(gsrc), "s"(lds_dst) : "memory"); }
constexpr int ATT_SLOT = 32768, ATT_WSF = 131072;
__device__ __forceinline__ void attn_unit(LAS uchar* lds, const bf16_t* proj, bf16_t* ocat, int bl, int h, int qb, float lam, float laminit, const float* sg) {
    const int tid = tid_fresh(), lane = tid & 63, r32 = lane & 31, hi = lane >> 5;
    const int wave = __builtin_amdgcn_readfirstlane(tid >> 6), mi = wave >> 2, rb = wave & 3;
    const size_t rowbase = (size_t)bl * SEQ;
    const int q0 = qb * 128 + rb * 32;
    const float m2 = exp2f(-2.f * (float)(h + 1)) * LOG2E;
    bf16x8 qf[4];
    const bf16_t* att = proj;
    const size_t hb = (size_t)(bl * 4 + h) * SEQ;
    { const bf16_t* qp = att + (hb + q0 + r32) * 384 + mi * 64 + hi * 8;
#pragma unroll
      for (int d0 = 0; d0 < 4; ++d0) qf[d0] = *(const bf16x8*)(qp + d0 * 16); }
    const int kkey = 4 * wave + (lane >> 4);
    const bf16_t* ksrc0 = att + (hb + kkey) * 384 + 128 + (((lane & 15) ^ (kkey & 15)) * 8);
    const bf16_t* ksrc1 = ksrc0 + (size_t)32 * 384;
    const bf16_t* vsrc0 = att + (hb + 16 * (wave & 3) + (lane >> 2)) * 384 + 256 + (wave >> 2) * 32 + (lane & 3) * 8;
    const bf16_t* vsrc1 = vsrc0 + 64;
    const unsigned lds0 = (unsigned)(uintptr_t)lds + (unsigned)wave * 1024u;
#define ATT_ISSUE(t, sb) do { const size_t go_ = (size_t)(t) * 64 * 384; const unsigned d_ = (unsigned)__builtin_amdgcn_readfirstlane((int)(lds0 + (unsigned)(sb))); \
        glds16(ksrc0 + go_, d_); glds16(ksrc1 + go_, d_ + 8192u); glds16(vsrc0 + go_, d_ + 16384u); glds16(vsrc1 + go_, d_ + 24576u); } while (0)
    LAS float* wsf = (LAS float*)(lds + ATT_WSF) + wave * 64;
    f32x16 o[4];
#pragma unroll
    for (int d = 0; d < 4; ++d)
#pragma unroll
        for (int r = 0; r < 16; ++r) o[d][r] = 0.f;
    float mhat = 0.f;
    f32x16 ol;
#pragma unroll
    for (int r = 0; r < 16; ++r) ol[r] = 0.f;
    const bf16x8 ones = (bf16x8){0x3F80, 0x3F80, 0x3F80, 0x3F80, 0x3F80, 0x3F80, 0x3F80, 0x3F80};
    int kfo[4];
#pragma unroll
    for (int d0 = 0; d0 < 4; ++d0) kfo[d0] = r32 * 256 + (((mi * 8 + 2 * d0 + hi) ^ (r32 & 15)) * 16);
    const int vfo = 16384 + ((lane >> 4) & 1) * 32 + (lane & 3) * 8 + (4 * hi + ((lane & 15) >> 2)) * 64;
    ATT_ISSUE(0, 0); ATT_ISSUE(1, ATT_SLOT);
    u32x4 pw[4];
#pragma unroll
    for (int k = 0; k < 4; ++k) pw[k] = (u32x4){0u, 0u, 0u, 0u};
#define ATT_PV(SLP) do { const LAS uchar* sv_ = (SLP); __builtin_amdgcn_s_setprio(1); \
        _Pragma("unroll") for (int d = 0; d < 4; ++d) _Pragma("unroll") for (int ks = 0; ks < 4; ++ks) { \
            const s16x4 lo = vtr(sv_ + vfo + d * 4096 + ks * 1024), hh = vtr(sv_ + vfo + d * 4096 + ks * 1024 + 512); \
            const bf16x8 vf = (bf16x8){lo[0], lo[1], lo[2], lo[3], hh[0], hh[1], hh[2], hh[3]}; \
            o[d] = __builtin_amdgcn_mfma_f32_32x32x16_bf16(__builtin_bit_cast(bf16x8, pw[ks]), vf, o[d], 0, 0, 0); } \
        _Pragma("unroll") for (int ks = 0; ks < 4; ++ks) ol = __builtin_amdgcn_mfma_f32_32x32x16_bf16(__builtin_bit_cast(bf16x8, pw[ks]), ones, ol, 0, 0, 0); \
        __builtin_amdgcn_s_setprio(0); } while (0)
    for (int t = 0; t <= SEQ / 64; ++t) {
        if (t < SEQ / 64) {
            if (t + 1 < SEQ / 64) asm volatile("s_waitcnt vmcnt(4) lgkmcnt(0)" ::: "memory"); else asm volatile("s_waitcnt vmcnt(0) lgkmcnt(0)" ::: "memory");
            __builtin_amdgcn_s_barrier();
            asm volatile("" ::: "memory");
            if (t + 2 < SEQ / 64) ATT_ISSUE(t + 2, ((t + 2) & 3) * ATT_SLOT);
        }
        if (mi == 1 && t > 0) ATT_PV(lds + ((t - 1) & 3) * ATT_SLOT);
        if (t < SEQ / 64) {
            const LAS uchar* sl = lds + (t & 3) * ATT_SLOT;
        const float dq = (float)(q0 + r32 - 64 * t - 4 * hi);
        f32x16 p0, p1;
        const int side = (64 * t + 63 < q0) ? 1 : ((64 * t > q0 + 31) ? -1 : 0);
        if (side != 0) {
            const float sm = side > 0 ? m2 : -m2; const float base = __builtin_fmaf(-sm, dq, -mhat);
#pragma unroll
            for (int r = 0; r < 16; ++r) { const float kc = (float)((r & 3) + 8 * (r >> 2));
                p0[r] = __builtin_fmaf(sm, kc, base); p1[r] = __builtin_fmaf(sm, kc + 32.f, base); }
        } else {
#pragma unroll
            for (int r = 0; r < 16; ++r) { const float kc = (float)((r & 3) + 8 * (r >> 2));
                p0[r] = __builtin_fmaf(-m2, __builtin_fabsf(dq - kc), -mhat); p1[r] = __builtin_fmaf(-m2, __builtin_fabsf(dq - kc - 32.f), -mhat); }
        }
        __builtin_amdgcn_s_setprio(1);
#pragma unroll
        for (int d0 = 0; d0 < 4; ++d0) {
            const bf16x8 a0 = *(const LAS bf16x8*)(sl + kfo[d0]), a1 = *(const LAS bf16x8*)(sl + kfo[d0] + 8192);
            p0 = __builtin_amdgcn_mfma_f32_32x32x16_bf16(a0, qf[d0], p0, 0, 0, 0);
            p1 = __builtin_amdgcn_mfma_f32_32x32x16_bf16(a1, qf[d0], p1, 0, 0, 0); }
        __builtin_amdgcn_s_setprio(0);
        float rm = fmaxf(p0[0], p1[0]);
#pragma unroll
        for (int r = 1; r < 16; ++r) rm = fmaxf(rm, fmaxf(p0[r], p1[r]));
        rm = xhalf_max(rm);
        const bool first = (t == 0);
        if (first || __any(rm > 8.f)) {
            const float dl = first ? rm : fmaxf(rm, 0.f);
            mhat += dl;
#pragma unroll
            for (int r = 0; r < 16; ++r) { p0[r] -= dl; p1[r] -= dl; }
            if (!first) {
                const float f = __builtin_amdgcn_exp2f(-dl);
                if (hi == 0) wsf[r32] = f;
                float fr_[16];
#pragma unroll
                for (int r = 0; r < 16; ++r) fr_[r] = wsf[crow(r, hi)];
#pragma unroll
                for (int d = 0; d < 4; ++d)
#pragma unroll
                    for (int r = 0; r < 16; ++r) o[d][r] *= fr_[r];
#pragma unroll
                for (int r = 0; r < 16; ++r) ol[r] *= fr_[r];
            }
        }
#pragma unroll
        for (int r = 0; r < 16; ++r) { p0[r] = __builtin_amdgcn_exp2f(p0[r]); p1[r] = __builtin_amdgcn_exp2f(p1[r]); }
#pragma unroll
        for (int j = 0; j < 4; ++j) { pw[0][j] = cvt_pk_bf16(p0[2 * j], p0[2 * j + 1]); pw[1][j] = cvt_pk_bf16(p0[8 + 2 * j], p0[8 + 2 * j + 1]);
                                      pw[2][j] = cvt_pk_bf16(p1[2 * j], p1[2 * j + 1]); pw[3][j] = cvt_pk_bf16(p1[8 + 2 * j], p1[8 + 2 * j + 1]); }
            if (mi == 0) ATT_PV(sl);
        }
    }
#undef ATT_PV
#undef ATT_ISSUE
    float fr_[16];
#pragma unroll
    for (int r = 0; r < 16; ++r) fr_[r] = (mi == 0 ? 1.f : lam) / ol[r];
    __syncthreads();
    LAS float* X = (LAS float*)lds + rb * 4096;
    if (mi == 1) {
#pragma unroll
        for (int d = 0; d < 4; ++d)
#pragma unroll
            for (int r = 0; r < 16; ++r) X[(d * 16 + r) * 64 + lane] = o[d][r] * fr_[r];
    }
    __syncthreads();
    if (mi == 0) {
        float ss[16];
#pragma unroll
        for (int r = 0; r < 16; ++r) ss[r] = 0.f;
#pragma unroll
        for (int d = 0; d < 4; ++d)
#pragma unroll
            for (int r = 0; r < 16; ++r) { const float v = o[d][r] * fr_[r] - X[(d * 16 + r) * 64 + lane]; o[d][r] = v; ss[r] += v * v; }
#pragma unroll
        for (int r = 0; r < 16; ++r) {
#pragma unroll
            for (int s = 1; s < 32; s <<= 1) ss[r] += __shfl_xor(ss[r], s);
            ss[r] = rsqrtf(ss[r] * (1.f / 128.f) + EPS) * (1.f - laminit); }
        float gv[4];
#pragma unroll
        for (int d = 0; d < 4; ++d) gv[d] = sg[d * 32 + r32];
#pragma unroll
        for (int r = 0; r < 16; ++r) { bf16_t* op = ocat + (rowbase + q0 + crow(r, hi)) * D + h * 128 + r32;
#pragma unroll
            for (int d = 0; d < 4; ++d) op[d * 32] = (bf16_t)f2bf(o[d][r] * ss[r] * gv[d]); }
    }
    __syncthreads();
}

template <int DK, bool HG>
__device__ __forceinline__ void scan_item(LAS uchar* lds, const bf16_t* proj, float* oraw0, float* oraw1, bf16_t* ocat, unsigned* done, int bl, int h, int dir, const float* lb  ,
                                          const float* normg  , const float* w2  , const float* gbias  ) {
    constexpr int KPW = DK / 8, TB = 32, NS = TB / 16, NR = TB / 8, GS = 4;
    LAS float* sA = (LAS float*)lds;
    LAS float* sK = sA + TB * DK;
    LAS float* sQ = sK + TB * DK;
    LAS float* sV = sQ + TB * DK;
    LAS float* sP = sV + TB * 64;
    const int tid = tid_fresh(), lane = tid & 63, wave = __builtin_amdgcn_readfirstlane(tid >> 6);
    const int ps = tid >> 5, pi = tid & 31;
    const size_t rowbase = (size_t)bl * SEQ;
    float* oraw = dir == 0 ? oraw0 : oraw1;
    __syncthreads();
    {
        float lb0 = 0.f, lb1 = 0.f, w2c[16], bias = 0.f;
        if (HG) { lb0 = lb[dir * 256 + h * 64 + pi]; lb1 = lb[dir * 256 + h * 64 + pi + 32]; }
        else {
#pragma unroll
            for (int r = 0; r < 16; ++r) w2c[r] = w2[(dir * 16 + r) * 128 + h * 32 + pi];
            bias = gbias[dir * 128 + h * 32 + pi]; }
        f32x2 S[KPW / 2];
#pragma unroll
        for (int j = 0; j < KPW / 2; ++j) S[j] = (f32x2){0.f, 0.f};
        bf16_t rz0[2][NS], rz1[2][NS], rq0[2][NS], rq1[2][NS], rv0[2][NS], rv1[2][NS], rk0[2][NS]; u32x4 rl0[2][NS], rl1[2][NS];
#pragma unroll
        for (int i = 0; i < NS; ++i) for (int e = 0; e < 2; ++e) { rz0[e][i] = rz1[e][i] = rq0[e][i] = rq1[e][i] = rv0[e][i] = rv1[e][i] = rk0[e][i] = 0; rl0[e][i] = rl1[e][i] = (u32x4){0, 0, 0, 0}; }
#define SCAN_LOAD(blk, E_) do { _Pragma("unroll") for (int i_ = 0; i_ < NS; ++i_) { const int st_ = (blk) * TB + ps + 16 * i_; const int tok_ = dir == 0 ? st_ : 2047 - st_; const bf16_t* pr_ = proj + (rowbase + tok_) * LDP; \
        if (HG) { const int zc_ = (dir == 0 ? BFF : BFB) + h * 64 + pi; rz0[E_][i_] = pr_[zc_]; rz1[E_][i_] = pr_[zc_ + 32]; rq0[E_][i_] = pr_[BQ + h * 64 + pi]; rq1[E_][i_] = pr_[BQ + h * 64 + pi + 32]; rv0[E_][i_] = pr_[BI + h * 64 + pi]; rv1[E_][i_] = pr_[BI + h * 64 + pi + 32]; } \
        else { const u32x4* lp_ = (const u32x4*)(pr_ + (dir == 0 ? GLF : GLB)); rl0[E_][i_] = lp_[0]; rl1[E_][i_] = lp_[1]; rk0[E_][i_] = pr_[GK + h * 32 + pi]; rq0[E_][i_] = pr_[GQ + h * 32 + pi]; rv0[E_][i_] = pr_[GV + h * 64 + pi]; rv1[E_][i_] = pr_[GV + h * 64 + pi + 32]; } } } while (0)
        SCAN_LOAD(0, 0); SCAN_LOAD(1, 1);
        for (int blk2 = 0; blk2 < SEQ / TB; blk2 += 2) {
            { const int blk = blk2;
#pragma unroll
            for (int i = 0; i < NS; ++i) {
                const int st = ps + 16 * i;
                if (HG) {
                    const float z0 = bf2f(rz0[0][i]), z1 = bf2f(rz1[0][i]);
                    const float s0 = __builtin_amdgcn_rcpf(1.f + __expf(-z0)), s1 = __builtin_amdgcn_rcpf(1.f + __expf(-z1));
                    sA[st * 64 + pi] = s0 * (1.f + lb0 * __expf(fminf(-z0, 80.f))); sA[st * 64 + pi + 32] = s1 * (1.f + lb1 * __expf(fminf(-z1, 80.f)));
                    sK[st * 64 + pi] = (1.f - lb0) * __builtin_amdgcn_rcpf(1.f + __expf(z0)); sK[st * 64 + pi + 32] = (1.f - lb1) * __builtin_amdgcn_rcpf(1.f + __expf(z1));
                    const float q0 = bf2f(rq0[0][i]), q1 = bf2f(rq1[0][i]);
                    sQ[st * 64 + pi] = q0 * __builtin_amdgcn_rcpf(1.f + __expf(-q0)) * 0.125f; sQ[st * 64 + pi + 32] = q1 * __builtin_amdgcn_rcpf(1.f + __expf(-q1)) * 0.125f;
                } else {
                    float z = bias;
#pragma unroll
                    for (int j = 0; j < 4; ++j) { z += bflo(rl0[0][i][j]) * w2c[2 * j] + bfhi(rl0[0][i][j]) * w2c[2 * j + 1]; z += bflo(rl1[0][i][j]) * w2c[8 + 2 * j] + bfhi(rl1[0][i][j]) * w2c[8 + 2 * j + 1]; }
                    const float ls = fminf(z, 0.f) - __logf(1.f + __expf(-fabsf(z)));
                    sA[st * 32 + pi] = __expf(ls * (1.f / 16.f));
                    sK[st * 32 + pi] = bf2f(rk0[0][i]);
                    sQ[st * 32 + pi] = bf2f(rq0[0][i]) * 0.17677669529663687f;
                }
                sV[st * 64 + pi] = bf2f(rv0[0][i]); sV[st * 64 + pi + 32] = bf2f(rv1[0][i]);
            }
            asm volatile("s_waitcnt lgkmcnt(0)" ::: "memory"); __builtin_amdgcn_s_barrier(); asm volatile("" ::: "memory");
            if (blk + 2 < SEQ / TB) SCAN_LOAD(blk + 2, 0);
            for (int s0_ = 0; s0_ < TB; s0_ += GS) {
                float vv[GS]; f32x4 a4[GS][KPW / 4], k4[GS][KPW / 4], q4[GS][KPW / 4];
#pragma unroll
                for (int g = 0; g < GS; ++g) { const int s = s0_ + g; vv[g] = sV[s * 64 + lane];
#pragma unroll
                    for (int j4 = 0; j4 < KPW / 4; ++j4) { a4[g][j4] = *(const LAS f32x4*)(sA + s * DK + wave * KPW + j4 * 4); k4[g][j4] = *(const LAS f32x4*)(sK + s * DK + wave * KPW + j4 * 4); q4[g][j4] = *(const LAS f32x4*)(sQ + s * DK + wave * KPW + j4 * 4); } }
                float po[GS];
#pragma unroll
                for (int g = 0; g < GS; ++g) {
                    f32x2 op = (f32x2){0.f, 0.f};
#pragma unroll
                    for (int j4 = 0; j4 < KPW / 4; ++j4) {
                        const f32x2 kv0 = (f32x2){k4[g][j4][0], k4[g][j4][1]} * vv[g], kv1 = (f32x2){k4[g][j4][2], k4[g][j4][3]} * vv[g];
                        S[2 * j4] = __builtin_elementwise_fma((f32x2){a4[g][j4][0], a4[g][j4][1]}, S[2 * j4], kv0);
                        S[2 * j4 + 1] = __builtin_elementwise_fma((f32x2){a4[g][j4][2], a4[g][j4][3]}, S[2 * j4 + 1], kv1);
                        op = __builtin_elementwise_fma((f32x2){q4[g][j4][0], q4[g][j4][1]}, S[2 * j4], op);
                        op = __builtin_elementwise_fma((f32x2){q4[g][j4][2], q4[g][j4][3]}, S[2 * j4 + 1], op); }
                    po[g] = op[0] + op[1]; }
#pragma unroll
                for (int g = 0; g < GS; ++g) sP[((s0_ + g) * 8 + wave) * 64 + lane] = po[g];
            }
            asm volatile("s_waitcnt lgkmcnt(0)" ::: "memory"); __builtin_amdgcn_s_barrier(); asm volatile("" ::: "memory");
#pragma unroll
            for (int j2 = 0; j2 < NR; ++j2) {
                const int s = wave + 8 * j2; const int tok = dir == 0 ? blk * TB + s : 2047 - (blk * TB + s);
                float sum = 0.f;
#pragma unroll
                for (int w = 0; w < 8; ++w) sum += sP[(s * 8 + w) * 64 + lane];
                oraw[(rowbase + tok) * 512 + (HG ? 0 : 256) + h * 64 + lane] = sum;
            }
            }
            { const int blk = blk2 + 1;
#pragma unroll
            for (int i = 0; i < NS; ++i) {
                const int st = ps + 16 * i;
                if (HG) {
                    const float z0 = bf2f(rz0[1][i]), z1 = bf2f(rz1[1][i]);
                    const float s0 = __builtin_amdgcn_rcpf(1.f + __expf(-z0)), s1 = __builtin_amdgcn_rcpf(1.f + __expf(-z1));
                    sA[st * 64 + pi] = s0 * (1.f + lb0 * __expf(fminf(-z0, 80.f))); sA[st * 64 + pi + 32] = s1 * (1.f + lb1 * __expf(fminf(-z1, 80.f)));
                    sK[st * 64 + pi] = (1.f - lb0) * __builtin_amdgcn_rcpf(1.f + __expf(z0)); sK[st * 64 + pi + 32] = (1.f - lb1) * __builtin_amdgcn_rcpf(1.f + __expf(z1));
                    const float q0 = bf2f(rq0[1][i]), q1 = bf2f(rq1[1][i]);
                    sQ[st * 64 + pi] = q0 * __builtin_amdgcn_rcpf(1.f + __expf(-q0)) * 0.125f; sQ[st * 64 + pi + 32] = q1 * __builtin_amdgcn_rcpf(1.f + __expf(-q1)) * 0.125f;
                } else {
                    float z = bias;
#pragma unroll
                    for (int j = 0; j < 4; ++j) { z += bflo(rl0[1][i][j]) * w2c[2 * j] + bfhi(rl0[1][i][j]) * w2c[2 * j + 1]; z += bflo(rl1[1][i][j]) * w2c[8 + 2 * j] + bfhi(rl1[1][i][j]) * w2c[8 + 2 * j + 1]; }
                    const float ls = fminf(z, 0.f) - __logf(1.f + __expf(-fabsf(z)));
                    sA[st * 32 + pi] = __expf(ls * (1.f / 16.f));
                    sK[st * 32 + pi] = bf2f(rk0[1][i]);
                    sQ[st * 32 + pi] = bf2f(rq0[1][i]) * 0.17677669529663687f;
                }
                sV[st * 64 + pi] = bf2f(rv0[1][i]); sV[st * 64 + pi + 32] = bf2f(rv1[1][i]);
            }
            asm volatile("s_waitcnt lgkmcnt(0)" ::: "memory"); __builtin_amdgcn_s_barrier(); asm volatile("" ::: "memory");
            if (blk + 2 < SEQ / TB) SCAN_LOAD(blk + 2, 1);
            for (int s0_ = 0; s0_ < TB; s0_ += GS) {
                float vv[GS]; f32x4 a4[GS][KPW / 4], k4[GS][KPW / 4], q4[GS][KPW / 4];
#pragma unroll
                for (int g = 0; g < GS; ++g) { const int s = s0_ + g; vv[g] = sV[s * 64 + lane];
#pragma unroll
                    for (int j4 = 0; j4 < KPW / 4; ++j4) { a4[g][j4] = *(const LAS f32x4*)(sA + s * DK + wave * KPW + j4 * 4); k4[g][j4] = *(const LAS f32x4*)(sK + s * DK + wave * KPW + j4 * 4); q4[g][j4] = *(const LAS f32x4*)(sQ + s * DK + wave * KPW + j4 * 4); } }
                float po[GS];
#pragma unroll
                for (int g = 0; g < GS; ++g) {
                    f32x2 op = (f32x2){0.f, 0.f};
#pragma unroll
                    for (int j4 = 0; j4 < KPW / 4; ++j4) {
                        const f32x2 kv0 = (f32x2){k4[g][j4][0], k4[g][j4][1]} * vv[g], kv1 = (f32x2){k4[g][j4][2], k4[g][j4][3]} * vv[g];
                        S[2 * j4] = __builtin_elementwise_fma((f32x2){a4[g][j4][0], a4[g][j4][1]}, S[2 * j4], kv0);
                        S[2 * j4 + 1] = __builtin_elementwise_fma((f32x2){a4[g][j4][2], a4[g][j4][3]}, S[2 * j4 + 1], kv1);
                        op = __builtin_elementwise_fma((f32x2){q4[g][j4][0], q4[g][j4][1]}, S[2 * j4], op);
                        op = __builtin_elementwise_fma((f32x2){q4[g][j4][2], q4[g][j4][3]}, S[2 * j4 + 1], op); }
                    po[g] = op[0] + op[1]; }
#pragma unroll
                for (int g = 0; g < GS; ++g) sP[((s0_ + g) * 8 + wave) * 64 + lane] = po[g];
            }
            asm volatile("s_waitcnt lgkmcnt(0)" ::: "memory"); __builtin_amdgcn_s_barrier(); asm volatile("" ::: "memory");
#pragma unroll
            for (int j2 = 0; j2 < NR; ++j2) {
                const int s = wave + 8 * j2; const int tok = dir == 0 ? blk * TB + s : 2047 - (blk * TB + s);
                float sum = 0.f;
#pragma unroll
                for (int w = 0; w < 8; ++w) sum += sP[(s * 8 + w) * 64 + lane];
                oraw[(rowbase + tok) * 512 + (HG ? 0 : 256) + h * 64 + lane] = sum;
            }
            }
        }
#undef SCAN_LOAD
    }
    asm volatile("s_waitcnt vmcnt(0)" ::: "memory");
    __syncthreads();
    LAS unsigned* flg = (LAS unsigned*)(lds + 147456 - 128);
    if (tid == 0) { __builtin_amdgcn_fence(__ATOMIC_RELEASE, "agent"); asm volatile("s_waitcnt vmcnt(0)" ::: "memory");
        const unsigned old = __hip_atomic_fetch_add(done, 1u, __ATOMIC_RELAXED, __HIP_MEMORY_SCOPE_AGENT);
        __builtin_amdgcn_fence(__ATOMIC_ACQUIRE, "agent"); asm volatile("s_waitcnt vmcnt(0)" ::: "memory");
        flg[0] = old; }
    __syncthreads();
    if (flg[0] == 1u) {
        if (lane == 0 && tid != 0) { __builtin_amdgcn_fence(__ATOMIC_ACQUIRE, "agent"); asm volatile("s_waitcnt vmcnt(0)" ::: "memory"); }
        __syncthreads();
        const float ng = normg[lane];
        for (int t0 = wave * 16; t0 < SEQ; t0 += 128) {
            float fa[16], fb[16]; bf16_t gq[16];
#pragma unroll
            for (int i = 0; i < 16; ++i) { const size_t o = (rowbase + t0 + i) * 512 + (HG ? 0 : 256) + h * 64 + lane;
                fa[i] = __hip_atomic_load(oraw0 + o, __ATOMIC_RELAXED, __HIP_MEMORY_SCOPE_AGENT); fb[i] = __hip_atomic_load(oraw1 + o, __ATOMIC_RELAXED, __HIP_MEMORY_SCOPE_AGENT);
                gq[i] = proj[(rowbase + t0 + i) * LDP + (HG ? BG : GG) + h * 64 + lane]; }
#pragma unroll
            for (int i = 0; i < 16; ++i) {
                const float tot = fa[i] + fb[i];
                const float ssq = wave_sum(tot * tot);
                const float gvv = bf2f(gq[i]);
                const float outv = tot * rsqrtf(ssq * (1.f / 64.f) + EPS) * ng * (gvv * __builtin_amdgcn_rcpf(1.f + __expf(-gvv)));
                ocat[(rowbase + t0 + i) * D + (HG ? 512 : 768) + h * 64 + lane] = (bf16_t)f2bf(outv);
            }
        }
    }
    __syncthreads();
}

__device__ __forceinline__ void norm_rows_mod(const float* src, bf16_t* dst, const float* g, const float* modl  , int grow0, int shoff, int scoff) {
    const int tid = tid_fresh(), lane = tid & 63, gw = blockIdx.x * 8 + __builtin_amdgcn_readfirstlane(tid >> 6), NGW = gridDim.x * 8;
    const f32x4* gr = (const f32x4*)g + lane;
    f32x4 gg[4];
#pragma unroll
    for (int j = 0; j < 4; ++j) gg[j] = gr[64 * j];
    for (int m0 = gw; m0 < TG; m0 += 2 * NGW) {
        f32x4 v[2][4]; float s[2];
#pragma unroll
        for (int e = 0; e < 2; ++e) { const int m = m0 + e * NGW; const f32x4* xr = (const f32x4*)(src + (size_t)m * D) + lane;
#pragma unroll
            for (int j = 0; j < 4; ++j) v[e][j] = xr[64 * j]; }
#pragma unroll
        for (int e = 0; e < 2; ++e) { s[e] = 0.f;
#pragma unroll
            for (int j = 0; j < 4; ++j) s[e] += (v[e][j].x * v[e][j].x + v[e][j].y * v[e][j].y) + (v[e][j].z * v[e][j].z + v[e][j].w * v[e][j].w); }
#pragma unroll
        for (int e = 0; e < 2; ++e) { const int m = m0 + e * NGW; const int b = (grow0 + m) >> 11;
            const f32x4* sh = (const f32x4*)(modl + (size_t)b * (NMOD * D) + shoff) + lane; const f32x4* sc = (const f32x4*)(modl + (size_t)b * (NMOD * D) + scoff) + lane;
            const float r = rsqrtf(wave_sum(s[e]) * (1.f / D) + EPS);
            unsigned long long* o8 = (unsigned long long*)(dst + (size_t)m * D) + lane;
#pragma unroll
            for (int j = 0; j < 4; ++j) { const f32x4 y = v[e][j] * r * gg[j] * (1.f + sc[64 * j]) + sh[64 * j];
                o8[64 * j] = (unsigned long long)pk2(y.x, y.y) | ((unsigned long long)pk2(y.z, y.w) << 32); } }
    }
}
__device__ __forceinline__ void norm_rows_final(float* x, const float* g) {
    const int tid = tid_fresh(), lane = tid & 63, gw = blockIdx.x * 8 + __builtin_amdgcn_readfirstlane(tid >> 6), NGW = gridDim.x * 8;
    for (int m = gw; m < TG; m += NGW) {
        f32x4* xr = (f32x4*)(x + (size_t)m * D) + lane; const f32x4* gr = (const f32x4*)g + lane;
        f32x4 v[4]; float s = 0.f;
#pragma unroll
        for (int j = 0; j < 4; ++j) { v[j] = xr[64 * j]; s += (v[j].x * v[j].x + v[j].y * v[j].y) + (v[j].z * v[j].z + v[j].w * v[j].w); }
        const float r = rsqrtf(wave_sum(s) * (1.f / D) + EPS);
#pragma unroll
        for (int j = 0; j < 4; ++j) xr[64 * j] = v[j] * r * gr[64 * j];
    }
}

__device__ __forceinline__ void transpose_item(const float* W, int ldw, bf16_t* WT, int ldt, int row_off, int k_off, LAS float* scr, int kb, int nb, int lane) {
    const int k0 = 64 * kb, n0 = 32 * nb;
#pragma unroll 8
    for (int i = 0; i < 32; ++i) { const int kk = 2 * i + (lane >> 5); scr[kk * 33 + (lane & 31)] = W[(size_t)(k0 + kk) * ldw + n0 + (lane & 31)]; }
    asm volatile("s_waitcnt lgkmcnt(0)" ::: "memory");
    const int c = lane & 7;
#pragma unroll
    for (int j = 0; j < 4; ++j) { const int n = (lane >> 3) + 8 * j; const LAS float* s = scr + (8 * c) * 33 + n;
        u32x4 o; o.x = pk2(s[0 * 33], s[1 * 33]); o.y = pk2(s[2 * 33], s[3 * 33]); o.z = pk2(s[4 * 33], s[5 * 33]); o.w = pk2(s[6 * 33], s[7 * 33]);
        *(u32x4*)(WT + (size_t)(row_off + n0 + n) * ldt + k_off + k0 + 8 * c) = o; }
    asm volatile("s_waitcnt lgkmcnt(0)" ::: "memory");
}

#define XB_TMO      128
#define XB_XCNT(j)  (256  + 64 * (j))
#define XB_XSUB(j)  (1280 + 64 * (j))
#define XB_XGEN(j)  (2304 + 64 * (j))
#define XB_TOP      3328
#define XB_TOPGEN   3392
#define XCD_BAR_WORDS 3456
#define XB_SPIN_CAP (1u << 18)

__device__ __forceinline__ unsigned xb_ld(unsigned* p)              { return __hip_atomic_load(p, __ATOMIC_RELAXED, __HIP_MEMORY_SCOPE_AGENT); }
__device__ __forceinline__ unsigned xb_add(unsigned* p, unsigned v) { return __hip_atomic_fetch_add(p, v, __ATOMIC_RELAXED, __HIP_MEMORY_SCOPE_AGENT); }
__device__ __forceinline__ unsigned xb_xcc_id() { return (unsigned)__builtin_amdgcn_s_getreg((3 << 11) | 20) & 0xFu; }
#define XB_SPIN(cond, bar) do { unsigned _sp = 0; while (cond) { __builtin_amdgcn_s_sleep(1); \
    if ((++_sp & 255u) == 0u) { if (xb_ld(&(bar)[XB_TMO])) break; if (_sp > XB_SPIN_CAP) { atomicAdd(&(bar)[XB_TMO], 1u); break; } } } } while (0)

struct XcdBarrier {
    unsigned* bar; unsigned x;
    volatile LAS unsigned* st;
};

__device__ __forceinline__ XcdBarrier xcd_barrier_post(unsigned* bar, volatile LAS unsigned* st) {
    XcdBarrier b; b.bar = bar; b.x = xb_xcc_id(); b.st = st;
    if (threadIdx.x == 0) (void)xb_add(&bar[XB_XCNT(b.x)], 1u);
    return b;
}
__device__ __forceinline__ void xcd_barrier_complete(unsigned* bar, unsigned x, unsigned& nloc, unsigned& nx) {
    const unsigned G = gridDim.x * gridDim.y * gridDim.z;
    unsigned sum, cnt, mine, sp = 0u;
    for (;;) {
        sum = 0u; cnt = 0u; mine = 0u;
#pragma unroll
        for (unsigned j = 0; j < 16; ++j) { const unsigned c = xb_ld(&bar[XB_XCNT(j)]); sum += c; cnt += (c > 0u) ? 1u : 0u; mine = (j == x) ? c : mine; }
        if (sum == G) break;
        __builtin_amdgcn_s_sleep(1);
        if ((++sp & 255u) == 0u) { if (xb_ld(&bar[XB_TMO])) break; if (sp > XB_SPIN_CAP) { atomicAdd(&bar[XB_TMO], 1u); break; } }
    }
    nloc = mine > 0u ? mine : 1u; nx = cnt > 0u ? cnt : 1u;
}

__device__ __forceinline__ void xcd_barrier(const XcdBarrier& b) {
    asm volatile("s_waitcnt vmcnt(0)" ::: "memory");
    __syncthreads();
    if (threadIdx.x == 0) {
        unsigned* bar = b.bar;
        __builtin_amdgcn_s_waitcnt(0);
        unsigned nloc = b.st[0], nx = b.st[1];
        if (nloc == 0u) { xcd_barrier_complete(bar, b.x, nloc, nx); b.st[0] = nloc; b.st[1] = nx; }
        const unsigned old = xb_add(&bar[XB_XSUB(b.x)], 1u);
        const unsigned gen = old / nloc;
        if (old + 1u == (gen + 1u) * nloc) {
            __builtin_amdgcn_fence(__ATOMIC_RELEASE, "agent");
            asm volatile("s_waitcnt vmcnt(0)" ::: "memory");
            const unsigned og = xb_add(&bar[XB_TOP], 1u);
            const unsigned tg = og / nx;
            if (og + 1u == (tg + 1u) * nx) xb_add(&bar[XB_TOPGEN], 1u);
            else XB_SPIN(xb_ld(&bar[XB_TOPGEN]) == tg, bar);
            __builtin_amdgcn_fence(__ATOMIC_ACQUIRE, "agent");
            xb_add(&bar[XB_XGEN(b.x)], 1u);
            asm volatile("s_waitcnt vmcnt(0)" ::: "memory");
        } else {
            XB_SPIN(xb_ld(&bar[XB_XGEN(b.x)]) == gen, bar);
            __builtin_amdgcn_fence(__ATOMIC_ACQUIRE, "agent");
            asm volatile("s_waitcnt vmcnt(0)" ::: "memory");
        }
    }
    __syncthreads();
}


constexpr int CW_XBAR = 45056;
#define XSYNC() do { XcdBarrier xb_; xb_.bar = (unsigned*)(KWS() + WS_CTL) + CW_XBAR; xb_.x = xb_xcc_id(); xb_.st = (volatile LAS unsigned*)(lds + 147456 - 256); xcd_barrier(xb_); } while (0)

struct Args { const void* p[24]; };
enum { P_X = 0, P_C, P_ADAW, P_ADAB, P_NMIXG, P_NMLPG, P_WIN, P_DLAM, P_DSUBG, P_HLB, P_HNG, P_GW2, P_GB, P_GNG, P_WUA, P_WUB, P_WUC, P_WOUT, P_W1, P_W2, P_FNG, P_OUT, P_WS };
typedef const unsigned long long __attribute__((address_space(4)))* kargp_t;
__device__ __forceinline__ const void* karg(int i) { kargp_t kp = (kargp_t)__builtin_amdgcn_kernarg_segment_ptr(); asm volatile("" : "+s"(kp));
    const unsigned long long v = kp[i]; const __attribute__((address_space(1))) void* g = (const __attribute__((address_space(1))) void*)v; return (const void*)g; }
#define GRID_SYNC() do { asm volatile("s_waitcnt vmcnt(0) lgkmcnt(0)" ::: "memory"); __syncthreads(); grid.sync(); \
    if (threadIdx.x < 64) { __builtin_amdgcn_fence(__ATOMIC_ACQUIRE, "agent"); asm volatile("s_waitcnt vmcnt(0)" ::: "memory"); } __syncthreads(); } while (0)
#define KF(i) ((const float*)karg(i))
#define KWS() ((uchar*)karg(P_WS))

__global__ void __launch_bounds__(512, 2) fwd_megakernel(Args a_unused) {
    extern __shared__ __attribute__((aligned(16))) uchar lds_raw[];
    LAS uchar* lds = (LAS uchar*)lds_raw;
    cg::grid_group grid = cg::this_grid();
    {
    const int tid = tid_fresh(), lane = tid & 63, wave = __builtin_amdgcn_readfirstlane(tid >> 6);

    if (blockIdx.x == 0) {
        unsigned* ctl = (unsigned*)(KWS() + WS_CTL); float* ctlf = (float*)ctl;
        for (int i = tid; i < 1024; i += 512) { ctl[i] = 0u; ctl[40960 + i] = 0u; }
        for (int i = tid; i < XCD_BAR_WORDS; i += 512) ctl[CW_XBAR + i] = 0u;
        if (tid < 4) {
            const float* lp = KF(P_DLAM) + tid * 256; float s1 = 0.f, s2 = 0.f;
            for (int d = 0; d < 64; ++d) { s1 += lp[d] * lp[64 + d]; s2 += lp[128 + d] * lp[192 + d]; }
            const float li = 0.8f - 0.6f * expf(-0.3f * (float)tid);
            ctlf[1024 + tid] = expf(s1) - expf(s2) + li; ctlf[1028 + tid] = li;
        }
        {
            const float* lg = KF(P_HLB); const int j = tid;
            float v[4], mx = -1e30f;
#pragma unroll
            for (int l = 0; l < 4; ++l) { v[l] = lg[l * 512 + j]; mx = fmaxf(mx, v[l]); }
            float den = 0.f;
#pragma unroll
            for (int l = 0; l < 4; ++l) { v[l] = expf(v[l] - mx); den += v[l]; }
            float cum = 0.f; const float w0 = v[0] / den;
#pragma unroll
            for (int l = 0; l < 4; ++l) { cum += v[l] / den; ctlf[2048 + l * 512 + j] = cum - w0; }
        }
        {
            float* pv = ctlf + 8192;
            const float* s0 = KF(P_NMIXG); for (int i = tid; i < 4096; i += 512) pv[i] = s0[i];
            const float* s1 = KF(P_NMLPG); for (int i = tid; i < 4096; i += 512) pv[4096 + i] = s1[i];
            const float* s2 = KF(P_DSUBG); for (int i = tid; i < 512; i += 512) pv[8192 + i] = s2[i];
            const float* s3 = KF(P_HNG); for (int i = tid; i < 256; i += 512) pv[8704 + i] = s3[i];
            const float* s4 = KF(P_GW2); for (int i = tid; i < 16384; i += 512) pv[8960 + i] = s4[i];
            const float* s5 = KF(P_GB); for (int i = tid; i < 1024; i += 512) pv[25344 + i] = s5[i];
            const float* s6 = KF(P_GNG); for (int i = tid; i < 256; i += 512) pv[26368 + i] = s6[i];
            const float* s7 = KF(P_FNG); for (int i = tid; i < 1024; i += 512) pv[26624 + i] = s7[i];
        }
    }
#ifndef NO_MOD
    {
        LAS float* cond = (LAS float*)lds; LAS float* red = (LAS float*)(lds + 131072);
        float* mod = (float*)(KWS() + WS_MOD);
        const float* cin = KF(P_C); const float* adaw = KF(P_ADAW); const float* adab = KF(P_ADAB);
        bool loaded = false;
        for (int it = blockIdx.x; it < 4 * 96; it += gridDim.x) {
            if (!loaded) { for (int i = tid; i < 32 * 1024; i += 512) { const float cv = cin[i]; cond[i] = cv / (1.f + __expf(-cv)); } loaded = true; __syncthreads(); }
            const int l = it / 96, n0 = (it % 96) * 64;
            const float* W = adaw + (size_t)l * D * (NMOD * D) + n0 + lane;
            float acc[32];
#pragma unroll
            for (int b = 0; b < 32; ++b) acc[b] = 0.f;
            for (int k4 = 0; k4 < 32; ++k4) {
                const int k = wave * 128 + k4 * 4;
                const float w0 = W[(size_t)k * (NMOD * D)], w1 = W[(size_t)(k + 1) * (NMOD * D)], w2v = W[(size_t)(k + 2) * (NMOD * D)], w3 = W[(size_t)(k + 3) * (NMOD * D)];
#pragma unroll
                for (int b = 0; b < 32; ++b) { const f32x4 c4 = *(const LAS f32x4*)(cond + b * 1024 + k); acc[b] += c4.x * w0 + c4.y * w1 + c4.z * w2v + c4.w * w3; }
            }
#pragma unroll
            for (int rd = 0; rd < 4; ++rd) {
                __syncthreads();
#pragma unroll
                for (int bb = 0; bb < 8; ++bb) red[(wave * 8 + bb) * 64 + lane] = acc[rd * 8 + bb];
                __syncthreads();
                float s = 0.f;
#pragma unroll
                for (int w = 0; w < 8; ++w) s += red[(w * 8 + wave) * 64 + lane];
                const int b = rd * 8 + wave;
                mod[((size_t)l * 32 + b) * (NMOD * D) + n0 + lane] = s + adab[l * (NMOD * D) + n0 + lane];
            }
        }
        __syncthreads();
    }
#endif
#ifndef NO_WT
    {
        LAS float* scr = (LAS float*)(lds + wave * 8704);
        const int gw = blockIdx.x * 8 + wave, NGW = gridDim.x * 8;
        uchar* ws = KWS();
        bf16_t* win_t = (bf16_t*)(ws + WS_WIN); bf16_t* wup_t = (bf16_t*)(ws + WS_WUP); bf16_t* wout_t = (bf16_t*)(ws + WS_WOUT);
        bf16_t* w1_t = (bf16_t*)(ws + WS_W1); bf16_t* w2_t = (bf16_t*)(ws + WS_W2);
        constexpr int I_IN = 16 * 209, I_UA = 8 * 32, I_UB = 4 * 32, I_UC = 4 * 32, I_O = 16 * 32, I_1 = 16 * 128, I_2 = 64 * 32;
        constexpr int I_L = I_IN + I_UA + I_UB + I_UC + I_O + I_1 + I_2;
        for (int it = gw; it < 4 * I_L; it += NGW) {
            const int l = it / I_L; int r = it % I_L;
            if (r < I_IN) { transpose_item(KF(P_WIN) + (size_t)l * D * DIN, DIN, win_t + (size_t)l * LDP * D, D, 0, 0, scr, r / 209, r % 209, lane); continue; } r -= I_IN;
            if (r < I_UA) { transpose_item(KF(P_WUA) + (size_t)l * 512 * D, D, wup_t + (size_t)l * D * D, D, 0, 0, scr, r / 32, r % 32, lane); continue; } r -= I_UA;
            if (r < I_UB) { transpose_item(KF(P_WUB) + (size_t)l * 256 * D, D, wup_t + (size_t)l * D * D, D, 0, 512, scr, r / 32, r % 32, lane); continue; } r -= I_UB;
            if (r < I_UC) { transpose_item(KF(P_WUC) + (size_t)l * 256 * D, D, wup_t + (size_t)l * D * D, D, 0, 768, scr, r / 32, r % 32, lane); continue; } r -= I_UC;
            if (r < I_O) { transpose_item(KF(P_WOUT) + (size_t)l * D * D, D, wout_t + (size_t)l * D * D, D, 0, 0, scr, r / 32, r % 32, lane); continue; } r -= I_O;
            if (r < I_1) { transpose_item(KF(P_W1) + (size_t)l * D * DFF, DFF, w1_t + (size_t)l * DFF * D, D, 0, 0, scr, r / 128, r % 128, lane); continue; } r -= I_1;
            transpose_item(KF(P_W2) + (size_t)l * DFF * D, D, w2_t + (size_t)l * D * DFF, DFF, 0, 0, scr, r / 32, r % 32, lane);
        }
        for (int i = blockIdx.x * 512 + tid; i < 4 * 28672; i += gridDim.x * 512) { const int l = i / 28672, r = i % 28672;
            *(u32x4*)(win_t + (size_t)l * LDP * D + (size_t)DIN * D + (size_t)r * 8) = (u32x4){0u, 0u, 0u, 0u}; }
    }
#endif
    }
    GRID_SYNC();
    if (threadIdx.x < 2) ((LAS unsigned*)(lds + 147456 - 256))[threadIdx.x] = 0u;
    (void)xcd_barrier_post((unsigned*)(KWS() + WS_CTL) + CW_XBAR, (volatile LAS unsigned*)(lds + 147456 - 256));

    for (int grp = 0; grp < NGRP; ++grp) {
        for (int l = 0; l < DEPTH; ++l) {
            {
                uchar* ws = KWS(); const float* pv = (const float*)(ws + WS_CTL) + 8192;
                const float* src = (l == 0 ? KF(P_X) : (const float*)karg(P_OUT)) + (size_t)grp * TG * D;
                norm_rows_mod(src, (bf16_t*)(ws + WS_HB), pv + l * D, (const float*)(ws + WS_MOD) + (size_t)l * 32 * (NMOD * D), grp * TG, 0, D);
            }
            XSYNC();
            { uchar* ws = KWS(); pg8::Gemm g{(const bf16_t*)(ws + WS_HB), (const bf16_t*)(ws + WS_WIN) + (size_t)l * LDP * D, D}; pg8::Order S; S.init(TG, LDP, D, gridDim.x, blockIdx.x, 1); pg8::EpiProj E{(bf16_t*)(ws + WS_PROJ), (bf16_t*)(ws + WS_ATT)};
#ifndef NO_EPIPROJ
              pg8::gemm_phase<pg8::EpiProj>(lds, g, S, E);
#endif
            }
            XSYNC();
            {
                uchar* ws = KWS(); const float* ctlf = (const float*)(ws + WS_CTL); const float* pv = ctlf + 8192;
                const int xq = blockIdx.x & 7; unsigned* ctr = (unsigned*)(ws + WS_CTL) + ((grp * DEPTH + l) * 8 + xq) * 4;
                const float lam = ctlf[1024 + l], laminit = ctlf[1028 + l];
                const bf16_t* PROJ = (const bf16_t*)(ws + WS_PROJ); bf16_t* OCAT = (bf16_t*)(ws + WS_OCAT); float* OFWD = (float*)(ws + WS_OFWD);
                LAS int* itm = (LAS int*)(lds + 147456 - 64);
                const int tid = tid_fresh();
                for (;;) {
                    __syncthreads();
                    if (tid == 0) itm[0] = (int)atomicAdd(ctr, 1u);
                    __syncthreads();
                    const int it = itm[0];
                    constexpr int NPQ = GB * 4 / 8;
                    if (it >= 4 * NPQ + NPQ * 16) break;
                    float* OBWD = (float*)(ws + WS_OBWD);
                    if (it < 2 * NPQ) { const int p = (it >> 1) * 8 + xq; unsigned* dn = (unsigned*)(ws + WS_CTL) + 40960 + (((grp * DEPTH + l) * GB * 4 + p) * 2);
                        scan_item<64, true>(lds, PROJ, OFWD, OBWD, OCAT, dn, p >> 2, p & 3, it & 1, ctlf + 2048 + l * 512, pv + 8704 + l * 64, nullptr, nullptr);
                    } else if (it < 4 * NPQ) { const int i2 = it - 2 * NPQ; const int p = (i2 >> 1) * 8 + xq; unsigned* dn = (unsigned*)(ws + WS_CTL) + 40960 + (((grp * DEPTH + l) * GB * 4 + p) * 2 + 1);
                        scan_item<32, false>(lds, PROJ, OFWD, OBWD, OCAT, dn, p >> 2, p & 3, i2 & 1, nullptr, pv + 26368 + l * 64, pv + 8960 + l * 4096, pv + 25344 + l * 256);
                    } else { const int u = it - 4 * NPQ, p = (u >> 4) * 8 + xq;
                        attn_unit(lds, (const bf16_t*)(ws + WS_ATT), OCAT, p >> 2, p & 3, u & 15, lam, laminit, pv + 8192 + l * 128);
                    }
                }
            }
            XSYNC();
            { uchar* ws = KWS(); pg8::Gemm g{(const bf16_t*)(ws + WS_OCAT), (const bf16_t*)(ws + WS_WUP) + (size_t)l * D * D, D}; pg8::Order S; S.init(TG, D, D, gridDim.x, blockIdx.x, 3); pg8::EpiMerge E{(const bf16_t*)(ws + WS_PROJ), (bf16_t*)(ws + WS_HB)};
#ifndef NO_EPIMERGE
              pg8::gemm_phase<pg8::EpiMerge>(lds, g, S, E);
#endif
            }
            XSYNC();
            { uchar* ws = KWS(); pg8::Gemm g{(const bf16_t*)(ws + WS_HB), (const bf16_t*)(ws + WS_WOUT) + (size_t)l * D * D, D}; pg8::Order S; S.init(TG, D, D, gridDim.x, blockIdx.x, 1);
              float* xg = (float*)karg(P_OUT) + (size_t)grp * TG * D;
              pg8::EpiRes E{l == 0 ? KF(P_X) + (size_t)grp * TG * D : xg, xg, (const float*)(ws + WS_MOD) + ((size_t)l * 32 + grp * GB) * (NMOD * D) + 2 * D};
#ifndef NO_EPIRES
              pg8::gemm_phase<pg8::EpiRes>(lds, g, S, E);
#endif
            }
            XSYNC();
            {
                uchar* ws = KWS(); const float* pv = (const float*)(ws + WS_CTL) + 8192;
                norm_rows_mod((const float*)karg(P_OUT) + (size_t)grp * TG * D, (bf16_t*)(ws + WS_HB), pv + 4096 + l * D, (const float*)(ws + WS_MOD) + (size_t)l * 32 * (NMOD * D), grp * TG, 3 * D, 4 * D);
            }
            XSYNC();
            { uchar* ws = KWS(); pg8::Gemm g{(const bf16_t*)(ws + WS_HB), (const bf16_t*)(ws + WS_W1) + (size_t)l * DFF * D, D}; pg8::Order S; S.init(TG, DFF, D, gridDim.x, blockIdx.x, 1); pg8::EpiRelu2 E{(bf16_t*)(ws + WS_U)};
#ifndef NO_EPIRELU2
              pg8::gemm_phase<pg8::EpiRelu2>(lds, g, S, E);
#endif
            }
            XSYNC();
            { uchar* ws = KWS(); pg8::Gemm g{(const bf16_t*)(ws + WS_U), (const bf16_t*)(ws + WS_W2) + (size_t)l * D * DFF, DFF}; pg8::Order S; S.init(TG, D, DFF, gridDim.x, blockIdx.x, 1);
              float* xg = (float*)karg(P_OUT) + (size_t)grp * TG * D;
              pg8::EpiRes E{xg, xg, (const float*)(ws + WS_MOD) + ((size_t)l * 32 + grp * GB) * (NMOD * D) + 5 * D};
#ifndef NO_EPIRES
              pg8::gemm_phase<pg8::EpiRes>(lds, g, S, E);
#endif
            }
            XSYNC();
        }
        norm_rows_final((float*)karg(P_OUT) + (size_t)grp * TG * D, (const float*)(KWS() + WS_CTL) + 8192 + 26624);
    }
}

extern "C" void kernel_launch(void* const* d_in, const int* in_sizes, int n_in, void* d_out, int out_size, void* d_ws, size_t ws_size, hipStream_t stream) {
    static int grid = 0;
    if (grid == 0) {
        if (n_in != 21 || ws_size < WS_END) { fprintf(stderr, "kernel_launch: unexpected n_in %d / ws %zu\n", n_in, ws_size); grid = -1; return; }
        int dev = 0, cus = 0, per_cu = 0;
        if (hipGetDevice(&dev) != hipSuccess || hipDeviceGetAttribute(&cus, hipDeviceAttributeMultiprocessorCount, dev) != hipSuccess) { grid = -1; return; }
        if (hipFuncSetAttribute((const void*)fwd_megakernel, hipFuncAttributeMaxDynamicSharedMemorySize, LDS_BYTES) != hipSuccess) { fprintf(stderr, "kernel_launch: hipFuncSetAttribute failed\n"); grid = -1; return; }
        if (hipOccupancyMaxActiveBlocksPerMultiprocessor(&per_cu, (const void*)fwd_megakernel, 512, LDS_BYTES) != hipSuccess || per_cu < 1) { fprintf(stderr, "kernel_launch: occupancy query says %d\n", per_cu); per_cu = 1; }
        (void)hipGetLastError();
        grid = cus;
    }
    if (grid < 0) return;
    Args a{};
    for (int i = 0; i < 21; ++i) a.p[i] = d_in[i];
    a.p[21] = d_out; a.p[22] = d_ws; a.p[23] = nullptr;
    void* args[] = {&a};
    hipError_t e = hipLaunchCooperativeKernel((void*)fwd_megakernel, dim3(grid), dim3(512), args, LDS_BYTES, stream);
    if (e != hipSuccess) fprintf(stderr, "kernel_launch: cooperative launch failed: %s (grid %d)\n", hipGetErrorString(e), grid);
}
```

```cpp
#include <hip/hip_runtime.h>
#include <hip/hip_cooperative_groups.h>
#include <cstdio>
#include <cstdint>
namespace cg = cooperative_groups;

#define LAS __attribute__((address_space(3)))
typedef unsigned short bf16_t;
typedef short bf16x8 __attribute__((ext_vector_type(8)));
typedef float f32x4 __attribute__((ext_vector_type(4)));
typedef float f32x2 __attribute__((ext_vector_type(2)));
typedef float f32x16 __attribute__((ext_vector_type(16)));
typedef unsigned u32x4 __attribute__((ext_vector_type(4)));
typedef short s16x4 __attribute__((ext_vector_type(4)));
typedef unsigned char uchar;

constexpr int D = 1024, SEQ = 2048, BATCH = 32, DEPTH = 4, DIN = 6688, LDP = 6912, DFF = 4096, NMOD = 6;
constexpr int GB = 16, TG = GB * SEQ, NGRP = BATCH / GB;
constexpr int CQ = 0, CK = 512, CV = 1024, BQ = 1536, BFF = 1792, BFB = 2048, BI = 2304, BG = 2560;
constexpr int GQ = 2816, GK = 2944, GV = 3072, GG = 3328, GLF = 3584, GLB = 3600, GATE = 3616;
constexpr float EPS = 1e-6f, LOG2E = 1.4426950408889634f;
constexpr float QSCALE = 0.125f * LOG2E;

constexpr size_t MiB = 1u << 20;
constexpr size_t WS_CTL = 0;
constexpr size_t WS_MOD = 1 * MiB;
constexpr size_t WS_WIN = 4 * MiB;
constexpr size_t WS_WUP = 58 * MiB;
constexpr size_t WS_WOUT = 66 * MiB;
constexpr size_t WS_W1 = 74 * MiB;
constexpr size_t WS_W2 = 106 * MiB;
constexpr size_t WS_HB = 138 * MiB;
constexpr size_t WS_OCAT = 202 * MiB;
constexpr size_t WS_OFWD = 266 * MiB;
constexpr size_t WS_PROJ = 330 * MiB;
constexpr size_t WS_U = WS_PROJ;
constexpr size_t WS_OBWD = 762 * MiB;
constexpr size_t WS_ATT = 826 * MiB;
constexpr size_t WS_END = 922 * MiB;
constexpr int LDS_BYTES = 148 * 1024;

__device__ __forceinline__ unsigned f2bf(float f) { unsigned u = __builtin_bit_cast(unsigned, f); return (u + 0x7fffu + ((u >> 16) & 1u)) >> 16; }
__device__ __forceinline__ unsigned pk2(float lo, float hi) { return f2bf(lo) | (f2bf(hi) << 16); }
__device__ __forceinline__ float bf2f(bf16_t v) { return __builtin_bit_cast(float, (unsigned)v << 16); }
__device__ __forceinline__ float bflo(unsigned u) { return __builtin_bit_cast(float, u << 16); }
__device__ __forceinline__ float bfhi(unsigned u) { return __builtin_bit_cast(float, u & 0xffff0000u); }
typedef __bf16 bf16x2_t __attribute__((ext_vector_type(2)));
__device__ __forceinline__ unsigned cvt_pk_bf16(float lo, float hi) { f32x2 v = {lo, hi}; bf16x2_t b = __builtin_convertvector(v, bf16x2_t); return __builtin_bit_cast(unsigned, b); }
__device__ __forceinline__ float wave_sum(float v) {
#pragma unroll
    for (int o = 1; o < 64; o <<= 1) v += __shfl_xor(v, o);
    return v;
}
__device__ __forceinline__ int tid_fresh() { int t = threadIdx.x; asm volatile("" : "+v"(t)); return t; }
__device__ __forceinline__ float sigmoidf_(float z) { return 1.f / (1.f + __expf(-z)); }

namespace pg8 {
constexpr int BM = 256, BK = 64, HALF = 128, HTB = HALF * BK * 2, STAGE_BYTES = 8 * HTB, NXCD = 8, WGM = 8;
__host__ __device__ __forceinline__ int lds_byte(int r, int c) { const int st = (r >> 4) * 2 + (c >> 5), rr = r & 15, cc = c & 31, ob = rr * 64 + cc * 2; return st * 1024 + (ob ^ (((ob >> 9) & 1) << 5)); }
__host__ __device__ __forceinline__ void stage_rc(int b, int& R, int& C) { const int st = b / 1024, sb = b % 1024, swz = sb ^ (((sb >> 9) & 1) << 5); R = (st >> 1) * 16 + swz / 64; C = (st & 1) * 32 + (swz % 64) / 2; }
__host__ __device__ __forceinline__ int perm32(int rho) { const int n = rho >> 4, i = rho & 15; return 8 * (i >> 2) + 4 * n + (i & 3); }

struct Unit { int pm, pn, koff, nt, seg; };
struct Gemm { const bf16_t* A; const bf16_t* Bt; int K; };

struct Order {
    int nM, nN, nwg, G, c, nseg, ntfull;
    __device__ void init(int M, int N, int K, int G_, int c_, int nseg_) { nM = M / BM; nN = N / BM; nwg = nM * nN; G = G_; c = c_; nseg = nseg_; ntfull = K / BK; }
    __device__ bool next(int i, Unit& u) const {
        int ti = i, seg = 0;
        if (nseg == 3) { ti = i / 3; seg = i - ti * 3; }
        const long L = (long)ti * G + c; if (L >= nwg) return false;
        int wgid = (int)L; { const int q = nwg / NXCD, r = nwg % NXCD, xcd = wgid % NXCD, off = wgid / NXCD; wgid = (xcd < r ? xcd * (q + 1) : r * (q + 1) + (xcd - r) * q) + off; }
        const int nig = WGM * nN, gid = wgid / nig, fm = gid * WGM, gsz = (nM - fm) < WGM ? (nM - fm) : WGM;
        u.pm = fm + ((wgid % nig) % gsz); u.pn = (wgid % nig) / gsz; u.seg = seg;
        if (nseg == 3) { u.koff = seg == 0 ? 0 : (seg == 1 ? 512 : 768); u.nt = seg == 0 ? 8 : 4; } else { u.koff = 0; u.nt = ntfull; }
        return true;
    }
};

struct EpiProj {
    bf16_t* O; bf16_t* att;
    __device__ __forceinline__ bool zero_after(const Unit&) const { return true; }
    __device__ __forceinline__ void operator()(f32x4 (&acc)[2][2][4][2], const Unit& u, int wr, int wc, int fr, int fq) const {
        const int row0 = u.pm * BM + wr * 64 + fr, col0 = u.pn * BM + wc * 32 + 8 * fq;
        const float sc = (u.pn < 2) ? QSCALE : 1.f;
        const bool toatt = u.pn < 6;
#pragma unroll
        for (int ai = 0; ai < 2; ++ai)
#pragma unroll
            for (int m = 0; m < 4; ++m) { const int row = row0 + ai * HALF + m * 16; bf16_t* rowp = O + (size_t)row * LDP + col0;
#pragma unroll
                for (int bj = 0; bj < 2; ++bj) { f32x4 v0 = acc[ai][bj][m][0] * sc, v1 = acc[ai][bj][m][1] * sc;
                    u32x4 w; w.x = cvt_pk_bf16(v0[0], v0[1]); w.y = cvt_pk_bf16(v0[2], v0[3]); w.z = cvt_pk_bf16(v1[0], v1[1]); w.w = cvt_pk_bf16(v1[2], v1[3]);
                    if (toatt) { const int seg = u.pn * 2 + bj, typ = seg >> 2, hh = seg & 3;
                        *(u32x4*)(att + ((size_t)(((row >> 11) * 4 + hh) * SEQ + (row & 2047))) * 384 + typ * 128 + wc * 32 + 8 * fq) = w; }
                    else *(u32x4*)(rowp + bj * HALF) = w; } }
    }
};
struct EpiRelu2 {
    bf16_t* O;
    __device__ __forceinline__ bool zero_after(const Unit&) const { return true; }
    __device__ __forceinline__ void operator()(f32x4 (&acc)[2][2][4][2], const Unit& u, int wr, int wc, int fr, int fq) const {
        const int row0 = u.pm * BM + wr * 64 + fr, col0 = u.pn * BM + wc * 32 + 8 * fq;
#pragma unroll
        for (int ai = 0; ai < 2; ++ai)
#pragma unroll
            for (int m = 0; m < 4; ++m) { bf16_t* rowp = O + (size_t)(row0 + ai * HALF + m * 16) * DFF + col0;
#pragma unroll
                for (int bj = 0; bj < 2; ++bj) { f32x4 v0 = acc[ai][bj][m][0], v1 = acc[ai][bj][m][1];
#pragma unroll
                    for (int j = 0; j < 4; ++j) { float a = fmaxf(v0[j], 0.f), b = fmaxf(v1[j], 0.f); v0[j] = a * a; v1[j] = b * b; }
                    u32x4 w; w.x = cvt_pk_bf16(v0[0], v0[1]); w.y = cvt_pk_bf16(v0[2], v0[3]); w.z = cvt_pk_bf16(v1[0], v1[1]); w.w = cvt_pk_bf16(v1[2], v1[3]);
                    *(u32x4*)(rowp + bj * HALF) = w; } }
    }
};
struct EpiRes {
    const float* base; float* out; const float* gate;
    __device__ __forceinline__ bool zero_after(const Unit&) const { return true; }
    __device__ __forceinline__ void operator()(f32x4 (&acc)[2][2][4][2], const Unit& u, int wr, int wc, int fr, int fq) const {
        const int row0 = u.pm * BM + wr * 64 + fr, col0 = u.pn * BM + wc * 32 + 8 * fq;
        const float* gp = gate + (size_t)((u.pm * BM) >> 11) * (NMOD * D) + col0;
#pragma unroll
        for (int bj = 0; bj < 2; ++bj) {
            const f32x4 g0 = *(const f32x4*)(gp + bj * HALF), g1 = *(const f32x4*)(gp + bj * HALF + 4);
#pragma unroll
            for (int ai = 0; ai < 2; ++ai) {
#pragma unroll
                for (int m = 0; m < 4; ++m) { const size_t off = (size_t)(row0 + ai * HALF + m * 16) * D + col0 + bj * HALF;
                    const f32x4 b0 = *(const f32x4*)(base + off), b1 = *(const f32x4*)(base + off + 4);
                    *(f32x4*)(out + off) = b0 + g0 * acc[ai][bj][m][0];
                    *(f32x4*)(out + off + 4) = b1 + g1 * acc[ai][bj][m][1];
                    if (m & 1) asm volatile("" ::: "memory"); }
            }
        }
    }
};
struct EpiMerge {
    const bf16_t* proj; bf16_t* O;
    __device__ __forceinline__ bool zero_after(const Unit& u) const { return u.seg == 2; }
    __device__ __forceinline__ void operator()(f32x4 (&acc)[2][2][4][2], const Unit& u, int wr, int wc, int fr, int fq) const {
        const int row0 = u.pm * BM + wr * 64 + fr, col0 = u.pn * BM + wc * 32 + 8 * fq;
        const int seg = u.seg;
#pragma unroll
        for (int ai = 0; ai < 2; ++ai)
#pragma unroll
            for (int m = 0; m < 4; ++m) { const size_t row = (size_t)(row0 + ai * HALF + m * 16); const bf16_t* gp = proj + row * LDP + GATE + col0;
#pragma unroll
                for (int bj = 0; bj < 2; ++bj) {
                    if (seg < 2) {
                        const u32x4 ga = *(const u32x4*)(gp + seg * D + bj * HALF), gb = *(const u32x4*)(gp + (seg + 1) * D + bj * HALF);
                        float r[8];
#pragma unroll
                        for (int j = 0; j < 4; ++j) {
                            const float a0 = fminf(fmaxf(bflo(ga[j]), -40.f), 40.f), a1 = fminf(fmaxf(bfhi(ga[j]), -40.f), 40.f);
                            const float b0 = fminf(fmaxf(bflo(gb[j]), -40.f), 40.f), b1 = fminf(fmaxf(bfhi(gb[j]), -40.f), 40.f);
                            r[2 * j] = (1.f + __expf(-b0)) * __builtin_amdgcn_rcpf(1.f + __expf(-a0));
                            r[2 * j + 1] = (1.f + __expf(-b1)) * __builtin_amdgcn_rcpf(1.f + __expf(-a1)); }
                        acc[ai][bj][m][0] = acc[ai][bj][m][0] * (f32x4){r[0], r[1], r[2], r[3]};
                        acc[ai][bj][m][1] = acc[ai][bj][m][1] * (f32x4){r[4], r[5], r[6], r[7]};
                    } else {
                        const u32x4 gc = *(const u32x4*)(gp + 2 * D + bj * HALF);
                        float r[8];
#pragma unroll
                        for (int j = 0; j < 4; ++j) {
                            const float c0 = fminf(fmaxf(bflo(gc[j]), -40.f), 40.f), c1 = fminf(fmaxf(bfhi(gc[j]), -40.f), 40.f);
                            r[2 * j] = __builtin_amdgcn_rcpf(1.f + __expf(-c0)); r[2 * j + 1] = __builtin_amdgcn_rcpf(1.f + __expf(-c1)); }
                        const f32x4 v0 = acc[ai][bj][m][0] * (f32x4){r[0], r[1], r[2], r[3]}, v1 = acc[ai][bj][m][1] * (f32x4){r[4], r[5], r[6], r[7]};
                        u32x4 w; w.x = cvt_pk_bf16(v0[0], v0[1]); w.y = cvt_pk_bf16(v0[2], v0[3]); w.z = cvt_pk_bf16(v1[0], v1[1]); w.w = cvt_pk_bf16(v1[2], v1[3]);
                        *(u32x4*)(O + row * D + col0 + bj * HALF) = w;
                    } } }
    }
};

template <class Epi, bool ALIGN_EPI = true>
__device__ __forceinline__ void gemm_phase(LAS uchar* lds, const Gemm g, const Order& S, const Epi& E) {
    const int tid = tid_fresh(), wid = __builtin_amdgcn_readfirstlane(tid >> 6), lane = tid & 63, wr = wid >> 2, wc = wid & 3, fr = lane & 15, fq = lane >> 4;
    const int K = g.K;
    unsigned voffA[2], voffB[2];
#pragma unroll
    for (int i = 0; i < 2; ++i) { int R, C; stage_rc(tid * 16 + i * 8192, R, C); const int Rb = (R & ~31) + perm32(R & 31);
        voffA[i] = (unsigned)(R * K + C) * 2u; voffB[i] = (unsigned)(Rb * K + C) * 2u; }
    const size_t kstep = (size_t)(BK * 2);
    const size_t hstep = (size_t)HALF * K * 2;
    const size_t tstep = 2 * hstep;
    const unsigned ldsw = (unsigned)wid * 1024u;
    const int aoff = lds_byte(wr * 64 + fr, fq * 8), boff = lds_byte(wc * 32 + fr, fq * 8);
#define PG8_SA(b, h) (((b) * 2 + (h)) * HTB)
#define PG8_SB(b, h) ((4 + (b) * 2 + (h)) * HTB)
#define PG8_STAGE(bufoff, gbase, voff) do { _Pragma("unroll") for (int _i = 0; _i < 2; ++_i) \
        __builtin_amdgcn_global_load_lds((const unsigned*)((const char*)(gbase) + (voff)[_i]), (LAS unsigned*)(lds + (bufoff) + ldsw + _i * 8192), 16, 0, 0); } while (0)
#define PG8_LDA(dst, b, h) do { _Pragma("unroll") for (int m = 0; m < 4; ++m) _Pragma("unroll") for (int k = 0; k < 2; ++k) dst[m][k] = *(const LAS bf16x8*)(lds + PG8_SA(b, h) + aoff + m * 2048 + k * 1024); } while (0)
#define PG8_LDB(dst, b, h) do { _Pragma("unroll") for (int n = 0; n < 2; ++n) _Pragma("unroll") for (int k = 0; k < 2; ++k) dst[n][k] = *(const LAS bf16x8*)(lds + PG8_SB(b, h) + boff + n * 2048 + k * 1024); } while (0)
#define PG8_MMA(ai, bj, At, Bt) do { __builtin_amdgcn_s_setprio(1); _Pragma("unroll") for (int m = 0; m < 4; ++m) _Pragma("unroll") for (int n = 0; n < 2; ++n) _Pragma("unroll") for (int k = 0; k < 2; ++k) \
        acc[ai][bj][m][n] = __builtin_amdgcn_mfma_f32_16x16x32_bf16(Bt[n][k], At[m][k], acc[ai][bj][m][n], 0, 0, 0); __builtin_amdgcn_s_setprio(0); } while (0)
#define PG8_WAIT_V(n) asm volatile("s_waitcnt vmcnt(" #n ")" ::: "memory")
#define PG8_WAIT_L(n) asm volatile("s_waitcnt lgkmcnt(" #n ")" ::: "memory")
#define PG8_BAR __builtin_amdgcn_s_barrier()
#define PG8_SCHED __builtin_amdgcn_sched_barrier(0)
    Unit cur, nxt; int ui = 0;
    if (!S.next(0, cur)) return;
    f32x4 acc[2][2][4][2];
#pragma unroll
    for (int a = 0; a < 2; ++a)
#pragma unroll
        for (int b = 0; b < 2; ++b)
#pragma unroll
            for (int m = 0; m < 4; ++m)
#pragma unroll
                for (int n = 0; n < 2; ++n) acc[a][b][m][n] = (f32x4){0.f, 0.f, 0.f, 0.f};
    bf16x8 At[4][2], B0[2][2], B1[2][2];
    const char* cA = (const char*)g.A + (size_t)cur.pm * tstep + (size_t)cur.koff * 2; const char* cB = (const char*)g.Bt + (size_t)cur.pn * tstep + (size_t)cur.koff * 2;
    PG8_STAGE(PG8_SB(0, 0), cB, voffB); PG8_STAGE(PG8_SB(0, 1), cB + hstep, voffB); PG8_STAGE(PG8_SA(0, 0), cA, voffA); PG8_STAGE(PG8_SA(0, 1), cA + hstep, voffA);
    if (wr == 1) PG8_BAR;
    PG8_WAIT_V(2); PG8_BAR;
    PG8_STAGE(PG8_SB(1, 0), cB + kstep, voffB); PG8_STAGE(PG8_SA(1, 0), cA + kstep, voffA); PG8_STAGE(PG8_SB(1, 1), cB + hstep + kstep, voffB);
    PG8_WAIT_V(6); PG8_BAR;
    for (;;) {
        const bool has_next = S.next(ui + 1, nxt);
        const char* nA = has_next ? (const char*)g.A + (size_t)nxt.pm * tstep + (size_t)nxt.koff * 2 : cA; const char* nB = has_next ? (const char*)g.Bt + (size_t)nxt.pn * tstep + (size_t)nxt.koff * 2 : cB;
        const int nt = cur.nt;
        for (int t = 0; t < nt; t += 2) {
            const bool last = (t == nt - 2);
            const char* a1 = cA + (size_t)(t + 1) * kstep;
            const char* a2 = last ? nA : cA + (size_t)(t + 2) * kstep; const char* b2 = last ? nB : cB + (size_t)(t + 2) * kstep;
            const char* a3 = a2 + kstep; const char* b3 = b2 + kstep;
            PG8_LDB(B0, 0, 0); PG8_LDB(B1, 0, 1); PG8_SCHED; PG8_LDA(At, 0, 0); PG8_STAGE(PG8_SA(1, 1), a1 + hstep, voffA);
            PG8_WAIT_V(8); PG8_WAIT_L(0); PG8_BAR; PG8_MMA(0, 0, At, B0); PG8_MMA(0, 1, At, B1); PG8_BAR; PG8_SCHED;
            PG8_LDA(At, 0, 1); PG8_STAGE(PG8_SB(0, 0), b2, voffB); PG8_STAGE(PG8_SB(0, 1), b2 + hstep, voffB); PG8_STAGE(PG8_SA(0, 0), a2, voffA);
            PG8_WAIT_V(8); PG8_WAIT_L(0); PG8_BAR; PG8_MMA(1, 0, At, B0); PG8_MMA(1, 1, At, B1); PG8_BAR; PG8_SCHED;
            PG8_LDB(B0, 1, 0); PG8_LDB(B1, 1, 1); PG8_SCHED; PG8_LDA(At, 1, 0); PG8_STAGE(PG8_SA(0, 1), a2 + hstep, voffA);
            PG8_WAIT_V(8); PG8_WAIT_L(0); PG8_BAR; PG8_MMA(0, 0, At, B0); PG8_MMA(0, 1, At, B1); PG8_BAR; PG8_SCHED;
            PG8_LDA(At, 1, 1); PG8_STAGE(PG8_SB(1, 0), b3, voffB); PG8_STAGE(PG8_SB(1, 1), b3 + hstep, voffB); PG8_STAGE(PG8_SA(1, 0), a3, voffA);
            PG8_WAIT_V(8); PG8_WAIT_L(0); PG8_BAR; PG8_MMA(1, 0, At, B0); PG8_MMA(1, 1, At, B1); PG8_BAR; PG8_SCHED;
        }
        if constexpr (ALIGN_EPI) { if (wr == 0) PG8_BAR; }
        E(acc, cur, wr, wc, fr, fq);
        if (!has_next) break;
        if (E.zero_after(cur)) {
#pragma unroll
            for (int a = 0; a < 2; ++a)
#pragma unroll
                for (int b = 0; b < 2; ++b)
#pragma unroll
                    for (int m = 0; m < 4; ++m)
#pragma unroll
                        for (int n = 0; n < 2; ++n) acc[a][b][m][n] = (f32x4){0.f, 0.f, 0.f, 0.f};
        }
        cur = nxt; cA = nA; cB = nB; ++ui;
        if constexpr (ALIGN_EPI) { if (wr == 1) PG8_BAR; }
    }
    PG8_WAIT_V(0);
    if constexpr (!ALIGN_EPI) { if (wr == 0) PG8_BAR; }
    PG8_BAR;
#undef PG8_SA
#undef PG8_SB
#undef PG8_STAGE
#undef PG8_LDA
#undef PG8_LDB
#undef PG8_MMA
#undef PG8_WAIT_V
#undef PG8_WAIT_L
#undef PG8_BAR
#undef PG8_SCHED
}
}

__device__ __forceinline__ int crow(int r, int hi) { return (r & 3) + 8 * (r >> 2) + 4 * hi; }
__device__ __forceinline__ s16x4 vtr(const LAS uchar* p) { return __builtin_bit_cast(s16x4, __builtin_amdgcn_ds_read_tr16_b64_v4i16((LAS s16x4*)p)); }
__device__ __forceinline__ float xhalf_max(float m) { auto rr = __builtin_amdgcn_permlane32_swap(__builtin_bit_cast(unsigned, m), __builtin_bit_cast(unsigned, m), false, false); return fmaxf(__builtin_bit_cast(float, rr[0]), __builtin_bit_cast(float, rr[1])); }
__device__ __forceinline__ float xhalf_sum(float m) { auto rr = __builtin_amdgcn_permlane32_swap(__builtin_bit_cast(unsigned, m), __builtin_bit_cast(unsigned, m), false, false); return __builtin_bit_cast(float, rr[0]) + __builtin_bit_cast(float, rr[1]); }

__device__ __forceinline__ void glds16(const void* gsrc, unsigned lds_dst) { unsigned keep;
    asm volatile("s_mov_b32 %0, m0\n\ts_mov_b32 m0, %2\n\ts_nop 0\n\tglobal_load_lds_dwordx4 %1, off\n\ts_mov_b32 m0, %0" : "=&s"(keep) : "v"(gsrc), "s"(lds_dst) : "memory"); }
constexpr int ATT_SLOT = 32768, ATT_WSF = 131072;
__device__ __forceinline__ void attn_unit(LAS uchar* lds, const bf16_t* proj, bf16_t* ocat, int bl, int h, int qb, float lam, float laminit, const float* sg) {
    const int tid = tid_fresh(), lane = tid & 63, r32 = lane & 31, hi = lane >> 5;
    const int wave = __builtin_amdgcn_readfirstlane(tid >> 6), mi = wave >> 2, rb = wave & 3;
    const size_t rowbase = (size_t)bl * SEQ;
    const int q0 = qb * 128 + rb * 32;
    const float m2 = exp2f(-2.f * (float)(h + 1)) * LOG2E;
    bf16x8 qf[4];
    const bf16_t* att = proj;
    const size_t hb = (size_t)(bl * 4 + h) * SEQ;
    { const bf16_t* qp = att + (hb + q0 + r32) * 384 + mi * 64 + hi * 8;
#pragma unroll
      for (int d0 = 0; d0 < 4; ++d0) qf[d0] = *(const bf16x8*)(qp + d0 * 16); }
    const int kkey = 4 * wave + (lane >> 4);
    const bf16_t* ksrc0 = att + (hb + kkey) * 384 + 128 + (((lane & 15) ^ (kkey & 15)) * 8);
    const bf16_t* ksrc1 = ksrc0 + (size_t)32 * 384;
    const bf16_t* vsrc0 = att + (hb + 16 * (wave & 3) + (lane >> 2)) * 384 + 256 + (wave >> 2) * 32 + (lane & 3) * 8;
    const bf16_t* vsrc1 = vsrc0 + 64;
    const unsigned lds0 = (unsigned)(uintptr_t)lds + (unsigned)wave * 1024u;
#define ATT_ISSUE(t, sb) do { const size_t go_ = (size_t)(t) * 64 * 384; const unsigned d_ = (unsigned)__builtin_amdgcn_readfirstlane((int)(lds0 + (unsigned)(sb))); \
        glds16(ksrc0 + go_, d_); glds16(ksrc1 + go_, d_ + 8192u); glds16(vsrc0 + go_, d_ + 16384u); glds16(vsrc1 + go_, d_ + 24576u); } while (0)
    LAS float* wsf = (LAS float*)(lds + ATT_WSF) + wave * 64;
    f32x16 o[4];
#pragma unroll
    for (int d = 0; d < 4; ++d)
#pragma unroll
        for (int r = 0; r < 16; ++r) o[d][r] = 0.f;
    float mhat = 0.f;
    f32x16 ol;
#pragma unroll
    for (int r = 0; r < 16; ++r) ol[r] = 0.f;
    const bf16x8 ones = (bf16x8){0x3F80, 0x3F80, 0x3F80, 0x3F80, 0x3F80, 0x3F80, 0x3F80, 0x3F80};
    int kfo[4];
#pragma unroll
    for (int d0 = 0; d0 < 4; ++d0) kfo[d0] = r32 * 256 + (((mi * 8 + 2 * d0 + hi) ^ (r32 & 15)) * 16);
    const int vfo = 16384 + ((lane >> 4) & 1) * 32 + (lane & 3) * 8 + (4 * hi + ((lane & 15) >> 2)) * 64;
    ATT_ISSUE(0, 0); ATT_ISSUE(1, ATT_SLOT);
    u32x4 pw[4];
#pragma unroll
    for (int k = 0; k < 4; ++k) pw[k] = (u32x4){0u, 0u, 0u, 0u};
#define ATT_VLD(i, L, H) do { L = vtr(sv_ + vfo + ((i) >> 2) * 4096 + ((i) & 3) * 1024); H = vtr(sv_ + vfo + ((i) >> 2) * 4096 + ((i) & 3) * 1024 + 512); } while (0)
#define ATT_PV(SLP) do { const LAS uchar* sv_ = (SLP); s16x4 fl_[3], fh_[3]; __builtin_amdgcn_s_setprio(1); \
        ATT_VLD(0, fl_[0], fh_[0]); ATT_VLD(1, fl_[1], fh_[1]); __builtin_amdgcn_sched_group_barrier(0x100, 4, 0); \
        _Pragma("unroll") for (int i = 0; i < 16; ++i) { \
            if (i + 2 < 16) ATT_VLD(i + 2, fl_[(i + 2) % 3], fh_[(i + 2) % 3]); \
            const s16x4 lo = fl_[i % 3], hh = fh_[i % 3]; \
            const bf16x8 vf = (bf16x8){lo[0], lo[1], lo[2], lo[3], hh[0], hh[1], hh[2], hh[3]}; \
            o[i >> 2] = __builtin_amdgcn_mfma_f32_32x32x16_bf16(__builtin_bit_cast(bf16x8, pw[i & 3]), vf, o[i >> 2], 0, 0, 0); \
            __builtin_amdgcn_sched_group_barrier(0x8, 1, 0); __builtin_amdgcn_sched_group_barrier(0x100, 2, 0); } \
        _Pragma("unroll") for (int ks = 0; ks < 4; ++ks) ol = __builtin_amdgcn_mfma_f32_32x32x16_bf16(__builtin_bit_cast(bf16x8, pw[ks]), ones, ol, 0, 0, 0); \
        __builtin_amdgcn_s_setprio(0); } while (0)
    for (int t = 0; t <= SEQ / 64; ++t) {
        if (t < SEQ / 64) {
            if (t + 1 < SEQ / 64) asm volatile("s_waitcnt vmcnt(4) lgkmcnt(0)" ::: "memory"); else asm volatile("s_waitcnt vmcnt(0) lgkmcnt(0)" ::: "memory");
            __builtin_amdgcn_s_barrier();
            asm volatile("" ::: "memory");
            if (t + 2 < SEQ / 64) ATT_ISSUE(t + 2, ((t + 2) & 3) * ATT_SLOT);
        }
        if (mi == 1 && t > 0) ATT_PV(lds + ((t - 1) & 3) * ATT_SLOT);
        if (t < SEQ / 64) {
            const LAS uchar* sl = lds + (t & 3) * ATT_SLOT;
        const float dq = (float)(q0 + r32 - 64 * t - 4 * hi);
        f32x16 p0, p1;
        const int side = (64 * t + 63 < q0) ? 1 : ((64 * t > q0 + 31) ? -1 : 0);
        if (side != 0) {
            const float sm = side > 0 ? m2 : -m2; const float base = __builtin_fmaf(-sm, dq, -mhat);
#pragma unroll
            for (int r = 0; r < 16; ++r) { const float kc = (float)((r & 3) + 8 * (r >> 2));
                p0[r] = __builtin_fmaf(sm, kc, base); p1[r] = __builtin_fmaf(sm, kc + 32.f, base); }
        } else {
#pragma unroll
            for (int r = 0; r < 16; ++r) { const float kc = (float)((r & 3) + 8 * (r >> 2));
                p0[r] = __builtin_fmaf(-m2, __builtin_fabsf(dq - kc), -mhat); p1[r] = __builtin_fmaf(-m2, __builtin_fabsf(dq - kc - 32.f), -mhat); }
        }
        __builtin_amdgcn_s_setprio(1);
#pragma unroll
        for (int d0 = 0; d0 < 4; ++d0) {
            const bf16x8 a0 = *(const LAS bf16x8*)(sl + kfo[d0]), a1 = *(const LAS bf16x8*)(sl + kfo[d0] + 8192);
            p0 = __builtin_amdgcn_mfma_f32_32x32x16_bf16(a0, qf[d0], p0, 0, 0, 0);
            p1 = __builtin_amdgcn_mfma_f32_32x32x16_bf16(a1, qf[d0], p1, 0, 0, 0); }
        __builtin_amdgcn_s_setprio(0);
        float rm = fmaxf(p0[0], p1[0]);
#pragma unroll
        for (int r = 1; r < 16; ++r) rm = fmaxf(rm, fmaxf(p0[r], p1[r]));
        rm = xhalf_max(rm);
        const bool first = (t == 0);
        if (first || __any(rm > 8.f)) {
            const float dl = first ? rm : fmaxf(rm, 0.f);
            mhat += dl;
#pragma unroll
            for (int r = 0; r < 16; ++r) { p0[r] -= dl; p1[r] -= dl; }
            if (!first) {
                const float f = __builtin_amdgcn_exp2f(-dl);
                if (hi == 0) wsf[r32] = f;
                float fr_[16];
#pragma unroll
                for (int r = 0; r < 16; ++r) fr_[r] = wsf[crow(r, hi)];
#pragma unroll
                for (int d = 0; d < 4; ++d)
#pragma unroll
                    for (int r = 0; r < 16; ++r) o[d][r] *= fr_[r];
#pragma unroll
                for (int r = 0; r < 16; ++r) ol[r] *= fr_[r];
            }
        }
#pragma unroll
        for (int r = 0; r < 16; ++r) { p0[r] = __builtin_amdgcn_exp2f(p0[r]); p1[r] = __builtin_amdgcn_exp2f(p1[r]); }
#pragma unroll
        for (int j = 0; j < 4; ++j) { pw[0][j] = cvt_pk_bf16(p0[2 * j], p0[2 * j + 1]); pw[1][j] = cvt_pk_bf16(p0[8 + 2 * j], p0[8 + 2 * j + 1]);
                                      pw[2][j] = cvt_pk_bf16(p1[2 * j], p1[2 * j + 1]); pw[3][j] = cvt_pk_bf16(p1[8 + 2 * j], p1[8 + 2 * j + 1]); }
            if (mi == 0) ATT_PV(sl);
        }
    }
#undef ATT_PV
#undef ATT_VLD
#undef ATT_ISSUE
    float fr_[16];
#pragma unroll
    for (int r = 0; r < 16; ++r) fr_[r] = (mi == 0 ? 1.f : lam) / ol[r];
    __syncthreads();
    LAS float* X = (LAS float*)lds + rb * 4096;
    if (mi == 1) {
#pragma unroll
        for (int d = 0; d < 4; ++d)
#pragma unroll
            for (int r = 0; r < 16; ++r) X[(d * 16 + r) * 64 + lane] = o[d][r] * fr_[r];
    }
    __syncthreads();
    if (mi == 0) {
        float ss[16];
#pragma unroll
        for (int r = 0; r < 16; ++r) ss[r] = 0.f;
#pragma unroll
        for (int d = 0; d < 4; ++d)
#pragma unroll
            for (int r = 0; r < 16; ++r) { const float v = o[d][r] * fr_[r] - X[(d * 16 + r) * 64 + lane]; o[d][r] = v; ss[r] += v * v; }
#pragma unroll
        for (int r = 0; r < 16; ++r) {
#pragma unroll
            for (int s = 1; s < 32; s <<= 1) ss[r] += __shfl_xor(ss[r], s);
            ss[r] = rsqrtf(ss[r] * (1.f / 128.f) + EPS) * (1.f - laminit); }
        float gv[4];
#pragma unroll
        for (int d = 0; d < 4; ++d) gv[d] = sg[d * 32 + r32];
#pragma unroll
        for (int r = 0; r < 16; ++r) { bf16_t* op = ocat + (rowbase + q0 + crow(r, hi)) * D + h * 128 + r32;
#pragma unroll
            for (int d = 0; d < 4; ++d) op[d * 32] = (bf16_t)f2bf(o[d][r] * ss[r] * gv[d]); }
    }
    __syncthreads();
}

template <int DK, bool HG>
__device__ __forceinline__ void scan_item(LAS uchar* lds, const bf16_t* proj, float* oraw0, float* oraw1, bf16_t* ocat, unsigned* done, int bl, int h, int dir, const float* lb  ,
                                          const float* normg  , const float* w2  , const float* gbias  ) {
    constexpr int KPW = DK / 8, TB = 32, NS = TB / 16, NR = TB / 8, GS = 4;
    LAS float* sA = (LAS float*)lds;
    LAS float* sK = sA + TB * DK;
    LAS float* sQ = sK + TB * DK;
    LAS float* sV = sQ + TB * DK;
    LAS float* sP = sV + TB * 64;
    const int tid = tid_fresh(), lane = tid & 63, wave = __builtin_amdgcn_readfirstlane(tid >> 6);
    const int ps = tid >> 5, pi = tid & 31;
    const size_t rowbase = (size_t)bl * SEQ;
    float* oraw = dir == 0 ? oraw0 : oraw1;
    __syncthreads();
    {
        float lb0 = 0.f, lb1 = 0.f, w2c[16], bias = 0.f;
        if (HG) { lb0 = lb[dir * 256 + h * 64 + pi]; lb1 = lb[dir * 256 + h * 64 + pi + 32]; }
        else {
#pragma unroll
            for (int r = 0; r < 16; ++r) w2c[r] = w2[(dir * 16 + r) * 128 + h * 32 + pi];
            bias = gbias[dir * 128 + h * 32 + pi]; }
        f32x2 S[KPW / 2];
#pragma unroll
        for (int j = 0; j < KPW / 2; ++j) S[j] = (f32x2){0.f, 0.f};
        bf16_t rz0[2][NS], rz1[2][NS], rq0[2][NS], rq1[2][NS], rv0[2][NS], rv1[2][NS], rk0[2][NS]; u32x4 rl0[2][NS], rl1[2][NS];
#pragma unroll
        for (int i = 0; i < NS; ++i) for (int e = 0; e < 2; ++e) { rz0[e][i] = rz1[e][i] = rq0[e][i] = rq1[e][i] = rv0[e][i] = rv1[e][i] = rk0[e][i] = 0; rl0[e][i] = rl1[e][i] = (u32x4){0, 0, 0, 0}; }
#define SCAN_LOAD(blk, E_) do { _Pragma("unroll") for (int i_ = 0; i_ < NS; ++i_) { const int st_ = (blk) * TB + ps + 16 * i_; const int tok_ = dir == 0 ? st_ : 2047 - st_; const bf16_t* pr_ = proj + (rowbase + tok_) * LDP; \
        if (HG) { const int zc_ = (dir == 0 ? BFF : BFB) + h * 64 + pi; rz0[E_][i_] = pr_[zc_]; rz1[E_][i_] = pr_[zc_ + 32]; rq0[E_][i_] = pr_[BQ + h * 64 + pi]; rq1[E_][i_] = pr_[BQ + h * 64 + pi + 32]; rv0[E_][i_] = pr_[BI + h * 64 + pi]; rv1[E_][i_] = pr_[BI + h * 64 + pi + 32]; } \
        else { const u32x4* lp_ = (const u32x4*)(pr_ + (dir == 0 ? GLF : GLB)); rl0[E_][i_] = lp_[0]; rl1[E_][i_] = lp_[1]; rk0[E_][i_] = pr_[GK + h * 32 + pi]; rq0[E_][i_] = pr_[GQ + h * 32 + pi]; rv0[E_][i_] = pr_[GV + h * 64 + pi]; rv1[E_][i_] = pr_[GV + h * 64 + pi + 32]; } } } while (0)
        SCAN_LOAD(0, 0); SCAN_LOAD(1, 1);
        for (int blk2 = 0; blk2 < SEQ / TB; blk2 += 2) {
            { const int blk = blk2;
#pragma unroll
            for (int i = 0; i < NS; ++i) {
                const int st = ps + 16 * i;
                if (HG) {
                    const float z0 = bf2f(rz0[0][i]), z1 = bf2f(rz1[0][i]);
                    const float s0 = __builtin_amdgcn_rcpf(1.f + __expf(-z0)), s1 = __builtin_amdgcn_rcpf(1.f + __expf(-z1));
                    sA[st * 64 + pi] = s0 * (1.f + lb0 * __expf(fminf(-z0, 80.f))); sA[st * 64 + pi + 32] = s1 * (1.f + lb1 * __expf(fminf(-z1, 80.f)));
                    sK[st * 64 + pi] = (1.f - lb0) * __builtin_amdgcn_rcpf(1.f + __expf(z0)); sK[st * 64 + pi + 32] = (1.f - lb1) * __builtin_amdgcn_rcpf(1.f + __expf(z1));
                    const float q0 = bf2f(rq0[0][i]), q1 = bf2f(rq1[0][i]);
                    sQ[st * 64 + pi] = q0 * __builtin_amdgcn_rcpf(1.f + __expf(-q0)) * 0.125f; sQ[st * 64 + pi + 32] = q1 * __builtin_amdgcn_rcpf(1.f + __expf(-q1)) * 0.125f;
                } else {
                    float z = bias;
#pragma unroll
                    for (int j = 0; j < 4; ++j) { z += bflo(rl0[0][i][j]) * w2c[2 * j] + bfhi(rl0[0][i][j]) * w2c[2 * j + 1]; z += bflo(rl1[0][i][j]) * w2c[8 + 2 * j] + bfhi(rl1[0][i][j]) * w2c[8 + 2 * j + 1]; }
                    const float ls = fminf(z, 0.f) - __logf(1.f + __expf(-fabsf(z)));
                    sA[st * 32 + pi] = __expf(ls * (1.f / 16.f));
                    sK[st * 32 + pi] = bf2f(rk0[0][i]);
                    sQ[st * 32 + pi] = bf2f(rq0[0][i]) * 0.17677669529663687f;
                }
                sV[st * 64 + pi] = bf2f(rv0[0][i]); sV[st * 64 + pi + 32] = bf2f(rv1[0][i]);
            }
            asm volatile("s_waitcnt lgkmcnt(0)" ::: "memory"); __builtin_amdgcn_s_barrier(); asm volatile("" ::: "memory");
            if (blk + 2 < SEQ / TB) SCAN_LOAD(blk + 2, 0);
            for (int s0_ = 0; s0_ < TB; s0_ += GS) {
                float vv[GS]; f32x4 a4[GS][KPW / 4], k4[GS][KPW / 4], q4[GS][KPW / 4];
#pragma unroll
                for (int g = 0; g < GS; ++g) { const int s = s0_ + g; vv[g] = sV[s * 64 + lane];
#pragma unroll
                    for (int j4 = 0; j4 < KPW / 4; ++j4) { a4[g][j4] = *(const LAS f32x4*)(sA + s * DK + wave * KPW + j4 * 4); k4[g][j4] = *(const LAS f32x4*)(sK + s * DK + wave * KPW + j4 * 4); q4[g][j4] = *(const LAS f32x4*)(sQ + s * DK + wave * KPW + j4 * 4); } }
                float po[GS];
#pragma unroll
                for (int g = 0; g < GS; ++g) {
                    f32x2 op = (f32x2){0.f, 0.f};
#pragma unroll
                    for (int j4 = 0; j4 < KPW / 4; ++j4) {
                        const f32x2 kv0 = (f32x2){k4[g][j4][0], k4[g][j4][1]} * vv[g], kv1 = (f32x2){k4[g][j4][2], k4[g][j4][3]} * vv[g];
                        S[2 * j4] = __builtin_elementwise_fma((f32x2){a4[g][j4][0], a4[g][j4][1]}, S[2 * j4], kv0);
                        S[2 * j4 + 1] = __builtin_elementwise_fma((f32x2){a4[g][j4][2], a4[g][j4][3]}, S[2 * j4 + 1], kv1);
                        op = __builtin_elementwise_fma((f32x2){q4[g][j4][0], q4[g][j4][1]}, S[2 * j4], op);
                        op = __builtin_elementwise_fma((f32x2){q4[g][j4][2], q4[g][j4][3]}, S[2 * j4 + 1], op); }
                    po[g] = op[0] + op[1]; }
#pragma unroll
                for (int g = 0; g < GS; ++g) sP[((s0_ + g) * 8 + wave) * 64 + lane] = po[g];
            }
            asm volatile("s_waitcnt lgkmcnt(0)" ::: "memory"); __builtin_amdgcn_s_barrier(); asm volatile("" ::: "memory");
#pragma unroll
            for (int j2 = 0; j2 < NR; ++j2) {
                const int s = wave + 8 * j2; const int tok = dir == 0 ? blk * TB + s : 2047 - (blk * TB + s);
                float sum = 0.f;
#pragma unroll
                for (int w = 0; w < 8; ++w) sum += sP[(s * 8 + w) * 64 + lane];
                oraw[(rowbase + tok) * 512 + (HG ? 0 : 256) + h * 64 + lane] = sum;
            }
            }
            { const int blk = blk2 + 1;
#pragma unroll
            for (int i = 0; i < NS; ++i) {
                const int st = ps + 16 * i;
                if (HG) {
                    const float z0 = bf2f(rz0[1][i]), z1 = bf2f(rz1[1][i]);
                    const float s0 = __builtin_amdgcn_rcpf(1.f + __expf(-z0)), s1 = __builtin_amdgcn_rcpf(1.f + __expf(-z1));
                    sA[st * 64 + pi] = s0 * (1.f + lb0 * __expf(fminf(-z0, 80.f))); sA[st * 64 + pi + 32] = s1 * (1.f + lb1 * __expf(fminf(-z1, 80.f)));
                    sK[st * 64 + pi] = (1.f - lb0) * __builtin_amdgcn_rcpf(1.f + __expf(z0)); sK[st * 64 + pi + 32] = (1.f - lb1) * __builtin_amdgcn_rcpf(1.f + __expf(z1));
                    const float q0 = bf2f(rq0[1][i]), q1 = bf2f(rq1[1][i]);
                    sQ[st * 64 + pi] = q0 * __builtin_amdgcn_rcpf(1.f + __expf(-q0)) * 0.125f; sQ[st * 64 + pi + 32] = q1 * __builtin_amdgcn_rcpf(1.f + __expf(-q1)) * 0.125f;
                } else {
                    float z = bias;
#pragma unroll
                    for (int j = 0; j < 4; ++j) { z += bflo(rl0[1][i][j]) * w2c[2 * j] + bfhi(rl0[1][i][j]) * w2c[2 * j + 1]; z += bflo(rl1[1][i][j]) * w2c[8 + 2 * j] + bfhi(rl1[1][i][j]) * w2c[8 + 2 * j + 1]; }
                    const float ls = fminf(z, 0.f) - __logf(1.f + __expf(-fabsf(z)));
                    sA[st * 32 + pi] = __expf(ls * (1.f / 16.f));
                    sK[st * 32 + pi] = bf2f(rk0[1][i]);
                    sQ[st * 32 + pi] = bf2f(rq0[1][i]) * 0.17677669529663687f;
                }
                sV[st * 64 + pi] = bf2f(rv0[1][i]); sV[st * 64 + pi + 32] = bf2f(rv1[1][i]);
            }
            asm volatile("s_waitcnt lgkmcnt(0)" ::: "memory"); __builtin_amdgcn_s_barrier(); asm volatile("" ::: "memory");
            if (blk + 2 < SEQ / TB) SCAN_LOAD(blk + 2, 1);
            for (int s0_ = 0; s0_ < TB; s0_ += GS) {
                float vv[GS]; f32x4 a4[GS][KPW / 4], k4[GS][KPW / 4], q4[GS][KPW / 4];
#pragma unroll
                for (int g = 0; g < GS; ++g) { const int s = s0_ + g; vv[g] = sV[s * 64 + lane];
#pragma unroll
                    for (int j4 = 0; j4 < KPW / 4; ++j4) { a4[g][j4] = *(const LAS f32x4*)(sA + s * DK + wave * KPW + j4 * 4); k4[g][j4] = *(const LAS f32x4*)(sK + s * DK + wave * KPW + j4 * 4); q4[g][j4] = *(const LAS f32x4*)(sQ + s * DK + wave * KPW + j4 * 4); } }
                float po[GS];
#pragma unroll
                for (int g = 0; g < GS; ++g) {
                    f32x2 op = (f32x2){0.f, 0.f};
#pragma unroll
                    for (int j4 = 0; j4 < KPW / 4; ++j4) {
                        const f32x2 kv0 = (f32x2){k4[g][j4][0], k4[g][j4][1]} * vv[g], kv1 = (f32x2){k4[g][j4][2], k4[g][j4][3]} * vv[g];
                        S[2 * j4] = __builtin_elementwise_fma((f32x2){a4[g][j4][0], a4[g][j4][1]}, S[2 * j4], kv0);
                        S[2 * j4 + 1] = __builtin_elementwise_fma((f32x2){a4[g][j4][2], a4[g][j4][3]}, S[2 * j4 + 1], kv1);
                        op = __builtin_elementwise_fma((f32x2){q4[g][j4][0], q4[g][j4][1]}, S[2 * j4], op);
                        op = __builtin_elementwise_fma((f32x2){q4[g][j4][2], q4[g][j4][3]}, S[2 * j4 + 1], op); }
                    po[g] = op[0] + op[1]; }
#pragma unroll
                for (int g = 0; g < GS; ++g) sP[((s0_ + g) * 8 + wave) * 64 + lane] = po[g];
            }
            asm volatile("s_waitcnt lgkmcnt(0)" ::: "memory"); __builtin_amdgcn_s_barrier(); asm volatile("" ::: "memory");
#pragma unroll
            for (int j2 = 0; j2 < NR; ++j2) {
                const int s = wave + 8 * j2; const int tok = dir == 0 ? blk * TB + s : 2047 - (blk * TB + s);
                float sum = 0.f;
#pragma unroll
                for (int w = 0; w < 8; ++w) sum += sP[(s * 8 + w) * 64 + lane];
                oraw[(rowbase + tok) * 512 + (HG ? 0 : 256) + h * 64 + lane] = sum;
            }
            }
        }
#undef SCAN_LOAD
    }
    asm volatile("s_waitcnt vmcnt(0)" ::: "memory");
    __syncthreads();
    LAS unsigned* flg = (LAS unsigned*)(lds + 147456 - 128);
    if (tid == 0) { __builtin_amdgcn_fence(__ATOMIC_RELEASE, "agent"); asm volatile("s_waitcnt vmcnt(0)" ::: "memory");
        const unsigned old = __hip_atomic_fetch_add(done, 1u, __ATOMIC_RELAXED, __HIP_MEMORY_SCOPE_AGENT);
        __builtin_amdgcn_fence(__ATOMIC_ACQUIRE, "agent"); asm volatile("s_waitcnt vmcnt(0)" ::: "memory");
        flg[0] = old; }
    __syncthreads();
    if (flg[0] == 1u) {
        if (lane == 0 && tid != 0) { __builtin_amdgcn_fence(__ATOMIC_ACQUIRE, "agent"); asm volatile("s_waitcnt vmcnt(0)" ::: "memory"); }
        __syncthreads();
        const float ng = normg[lane];
        for (int t0 = wave * 16; t0 < SEQ; t0 += 128) {
            float fa[16], fb[16]; bf16_t gq[16];
#pragma unroll
            for (int i = 0; i < 16; ++i) { const size_t o = (rowbase + t0 + i) * 512 + (HG ? 0 : 256) + h * 64 + lane;
                fa[i] = __hip_atomic_load(oraw0 + o, __ATOMIC_RELAXED, __HIP_MEMORY_SCOPE_AGENT); fb[i] = __hip_atomic_load(oraw1 + o, __ATOMIC_RELAXED, __HIP_MEMORY_SCOPE_AGENT);
                gq[i] = proj[(rowbase + t0 + i) * LDP + (HG ? BG : GG) + h * 64 + lane]; }
#pragma unroll
            for (int i = 0; i < 16; ++i) {
                const float tot = fa[i] + fb[i];
                const float ssq = wave_sum(tot * tot);
                const float gvv = bf2f(gq[i]);
                const float outv = tot * rsqrtf(ssq * (1.f / 64.f) + EPS) * ng * (gvv * __builtin_amdgcn_rcpf(1.f + __expf(-gvv)));
                ocat[(rowbase + t0 + i) * D + (HG ? 512 : 768) + h * 64 + lane] = (bf16_t)f2bf(outv);
            }
        }
    }
    __syncthreads();
}

__device__ __forceinline__ void norm_rows_mod(const float* src, bf16_t* dst, const float* g, const float* modl  , int grow0, int shoff, int scoff) {
    const int tid = tid_fresh(), lane = tid & 63, gw = blockIdx.x * 8 + __builtin_amdgcn_readfirstlane(tid >> 6), NGW = gridDim.x * 8;
    const f32x4* gr = (const f32x4*)g + lane;
    f32x4 gg[4];
#pragma unroll
    for (int j = 0; j < 4; ++j) gg[j] = gr[64 * j];
    for (int m0 = gw; m0 < TG; m0 += 2 * NGW) {
        f32x4 v[2][4]; float s[2];
#pragma unroll
        for (int e = 0; e < 2; ++e) { const int m = m0 + e * NGW; const f32x4* xr = (const f32x4*)(src + (size_t)m * D) + lane;
#pragma unroll
            for (int j = 0; j < 4; ++j) v[e][j] = xr[64 * j]; }
#pragma unroll
        for (int e = 0; e < 2; ++e) { s[e] = 0.f;
#pragma unroll
            for (int j = 0; j < 4; ++j) s[e] += (v[e][j].x * v[e][j].x + v[e][j].y * v[e][j].y) + (v[e][j].z * v[e][j].z + v[e][j].w * v[e][j].w); }
#pragma unroll
        for (int e = 0; e < 2; ++e) { const int m = m0 + e * NGW; const int b = (grow0 + m) >> 11;
            const f32x4* sh = (const f32x4*)(modl + (size_t)b * (NMOD * D) + shoff) + lane; const f32x4* sc = (const f32x4*)(modl + (size_t)b * (NMOD * D) + scoff) + lane;
            const float r = rsqrtf(wave_sum(s[e]) * (1.f / D) + EPS);
            unsigned long long* o8 = (unsigned long long*)(dst + (size_t)m * D) + lane;
#pragma unroll
            for (int j = 0; j < 4; ++j) { const f32x4 y = v[e][j] * r * gg[j] * (1.f + sc[64 * j]) + sh[64 * j];
                o8[64 * j] = (unsigned long long)pk2(y.x, y.y) | ((unsigned long long)pk2(y.z, y.w) << 32); } }
    }
}
__device__ __forceinline__ void norm_rows_final(float* x, const float* g) {
    const int tid = tid_fresh(), lane = tid & 63, gw = blockIdx.x * 8 + __builtin_amdgcn_readfirstlane(tid >> 6), NGW = gridDim.x * 8;
    for (int m = gw; m < TG; m += NGW) {
        f32x4* xr = (f32x4*)(x + (size_t)m * D) + lane; const f32x4* gr = (const f32x4*)g + lane;
        f32x4 v[4]; float s = 0.f;
#pragma unroll
        for (int j = 0; j < 4; ++j) { v[j] = xr[64 * j]; s += (v[j].x * v[j].x + v[j].y * v[j].y) + (v[j].z * v[j].z + v[j].w * v[j].w); }
        const float r = rsqrtf(wave_sum(s) * (1.f / D) + EPS);
#pragma unroll
        for (int j = 0; j < 4; ++j) xr[64 * j] = v[j] * r * gr[64 * j];
    }
}

__device__ __forceinline__ void transpose_item(const float* W, int ldw, bf16_t* WT, int ldt, int row_off, int k_off, LAS float* scr, int kb, int nb, int lane) {
    const int k0 = 64 * kb, n0 = 32 * nb;
#pragma unroll 8
    for (int i = 0; i < 32; ++i) { const int kk = 2 * i + (lane >> 5); scr[kk * 33 + (lane & 31)] = W[(size_t)(k0 + kk) * ldw + n0 + (lane & 31)]; }
    asm volatile("s_waitcnt lgkmcnt(0)" ::: "memory");
    const int c = lane & 7;
#pragma unroll
    for (int j = 0; j < 4; ++j) { const int n = (lane >> 3) + 8 * j; const LAS float* s = scr + (8 * c) * 33 + n;
        u32x4 o; o.x = pk2(s[0 * 33], s[1 * 33]); o.y = pk2(s[2 * 33], s[3 * 33]); o.z = pk2(s[4 * 33], s[5 * 33]); o.w = pk2(s[6 * 33], s[7 * 33]);
        *(u32x4*)(WT + (size_t)(row_off + n0 + n) * ldt + k_off + k0 + 8 * c) = o; }
    asm volatile("s_waitcnt lgkmcnt(0)" ::: "memory");
}

#define XB_TMO      128
#define XB_XCNT(j)  (256  + 64 * (j))
#define XB_XSUB(j)  (1280 + 64 * (j))
#define XB_XGEN(j)  (2304 + 64 * (j))
#define XB_TOP      3328
#define XB_TOPGEN   3392
#define XCD_BAR_WORDS 3456
#define XB_SPIN_CAP (1u << 18)

__device__ __forceinline__ unsigned xb_ld(unsigned* p)              { return __hip_atomic_load(p, __ATOMIC_RELAXED, __HIP_MEMORY_SCOPE_AGENT); }
__device__ __forceinline__ unsigned xb_add(unsigned* p, unsigned v) { return __hip_atomic_fetch_add(p, v, __ATOMIC_RELAXED, __HIP_MEMORY_SCOPE_AGENT); }
__device__ __forceinline__ unsigned xb_xcc_id() { return (unsigned)__builtin_amdgcn_s_getreg((3 << 11) | 20) & 0xFu; }
#define XB_SPIN(cond, bar) do { unsigned _sp = 0; while (cond) { __builtin_amdgcn_s_sleep(1); \
    if ((++_sp & 255u) == 0u) { if (xb_ld(&(bar)[XB_TMO])) break; if (_sp > XB_SPIN_CAP) { atomicAdd(&(bar)[XB_TMO], 1u); break; } } } } while (0)

struct XcdBarrier {
    unsigned* bar; unsigned x;
    volatile LAS unsigned* st;
};

__device__ __forceinline__ XcdBarrier xcd_barrier_post(unsigned* bar, volatile LAS unsigned* st) {
    XcdBarrier b; b.bar = bar; b.x = xb_xcc_id(); b.st = st;
    if (threadIdx.x == 0) (void)xb_add(&bar[XB_XCNT(b.x)], 1u);
    return b;
}
__device__ __forceinline__ void xcd_barrier_complete(unsigned* bar, unsigned x, unsigned& nloc, unsigned& nx) {
    const unsigned G = gridDim.x * gridDim.y * gridDim.z;
    unsigned sum, cnt, mine, sp = 0u;
    for (;;) {
        sum = 0u; cnt = 0u; mine = 0u;
#pragma unroll
        for (unsigned j = 0; j < 16; ++j) { const unsigned c = xb_ld(&bar[XB_XCNT(j)]); sum += c; cnt += (c > 0u) ? 1u : 0u; mine = (j == x) ? c : mine; }
        if (sum == G) break;
        __builtin_amdgcn_s_sleep(1);
        if ((++sp & 255u) == 0u) { if (xb_ld(&bar[XB_TMO])) break; if (sp > XB_SPIN_CAP) { atomicAdd(&bar[XB_TMO], 1u); break; } }
    }
    nloc = mine > 0u ? mine : 1u; nx = cnt > 0u ? cnt : 1u;
}

__device__ __forceinline__ void xcd_barrier(const XcdBarrier& b) {
    asm volatile("s_waitcnt vmcnt(0)" ::: "memory");
    __syncthreads();
    if (threadIdx.x == 0) {
        unsigned* bar = b.bar;
        __builtin_amdgcn_s_waitcnt(0);
        unsigned nloc = b.st[0], nx = b.st[1];
        if (nloc == 0u) { xcd_barrier_complete(bar, b.x, nloc, nx); b.st[0] = nloc; b.st[1] = nx; }
        const unsigned old = xb_add(&bar[XB_XSUB(b.x)], 1u);
        const unsigned gen = old / nloc;
        if (old + 1u == (gen + 1u) * nloc) {
            __builtin_amdgcn_fence(__ATOMIC_RELEASE, "agent");
            asm volatile("s_waitcnt vmcnt(0)" ::: "memory");
            const unsigned og = xb_add(&bar[XB_TOP], 1u);
            const unsigned tg = og / nx;
            if (og + 1u == (tg + 1u) * nx) xb_add(&bar[XB_TOPGEN], 1u);
            else XB_SPIN(xb_ld(&bar[XB_TOPGEN]) == tg, bar);
            __builtin_amdgcn_fence(__ATOMIC_ACQUIRE, "agent");
            xb_add(&bar[XB_XGEN(b.x)], 1u);
            asm volatile("s_waitcnt vmcnt(0)" ::: "memory");
        } else {
            XB_SPIN(xb_ld(&bar[XB_XGEN(b.x)]) == gen, bar);
            __builtin_amdgcn_fence(__ATOMIC_ACQUIRE, "agent");
            asm volatile("s_waitcnt vmcnt(0)" ::: "memory");
        }
    }
    __syncthreads();
}


constexpr int CW_XBAR = 45056;
#define XSYNC() do { XcdBarrier xb_; xb_.bar = (unsigned*)(KWS() + WS_CTL) + CW_XBAR; xb_.x = xb_xcc_id(); xb_.st = (volatile LAS unsigned*)(lds + 147456 - 256); xcd_barrier(xb_); } while (0)

struct Args { const void* p[24]; };
enum { P_X = 0, P_C, P_ADAW, P_ADAB, P_NMIXG, P_NMLPG, P_WIN, P_DLAM, P_DSUBG, P_HLB, P_HNG, P_GW2, P_GB, P_GNG, P_WUA, P_WUB, P_WUC, P_WOUT, P_W1, P_W2, P_FNG, P_OUT, P_WS };
typedef const unsigned long long __attribute__((address_space(4)))* kargp_t;
__device__ __forceinline__ const void* karg(int i) { kargp_t kp = (kargp_t)__builtin_amdgcn_kernarg_segment_ptr(); asm volatile("" : "+s"(kp));
    const unsigned long long v = kp[i]; const __attribute__((address_space(1))) void* g = (const __attribute__((address_space(1))) void*)v; return (const void*)g; }
#define GRID_SYNC() do { asm volatile("s_waitcnt vmcnt(0) lgkmcnt(0)" ::: "memory"); __syncthreads(); grid.sync(); \
    if (threadIdx.x < 64) { __builtin_amdgcn_fence(__ATOMIC_ACQUIRE, "agent"); asm volatile("s_waitcnt vmcnt(0)" ::: "memory"); } __syncthreads(); } while (0)
#define KF(i) ((const float*)karg(i))
#define KWS() ((uchar*)karg(P_WS))

__global__ void __launch_bounds__(512, 2) fwd_megakernel(Args a_unused) {
    extern __shared__ __attribute__((aligned(16))) uchar lds_raw[];
    LAS uchar* lds = (LAS uchar*)lds_raw;
    cg::grid_group grid = cg::this_grid();
    {
    const int tid = tid_fresh(), lane = tid & 63, wave = __builtin_amdgcn_readfirstlane(tid >> 6);

    if (blockIdx.x == 0) {
        unsigned* ctl = (unsigned*)(KWS() + WS_CTL); float* ctlf = (float*)ctl;
        for (int i = tid; i < 1024; i += 512) { ctl[i] = 0u; ctl[40960 + i] = 0u; }
        for (int i = tid; i < XCD_BAR_WORDS; i += 512) ctl[CW_XBAR + i] = 0u;
        if (tid < 4) {
            const float* lp = KF(P_DLAM) + tid * 256; float s1 = 0.f, s2 = 0.f;
            for (int d = 0; d < 64; ++d) { s1 += lp[d] * lp[64 + d]; s2 += lp[128 + d] * lp[192 + d]; }
            const float li = 0.8f - 0.6f * expf(-0.3f * (float)tid);
            ctlf[1024 + tid] = expf(s1) - expf(s2) + li; ctlf[1028 + tid] = li;
        }
        {
            const float* lg = KF(P_HLB); const int j = tid;
            float v[4], mx = -1e30f;
#pragma unroll
            for (int l = 0; l < 4; ++l) { v[l] = lg[l * 512 + j]; mx = fmaxf(mx, v[l]); }
            float den = 0.f;
#pragma unroll
            for (int l = 0; l < 4; ++l) { v[l] = expf(v[l] - mx); den += v[l]; }
            float cum = 0.f; const float w0 = v[0] / den;
#pragma unroll
            for (int l = 0; l < 4; ++l) { cum += v[l] / den; ctlf[2048 + l * 512 + j] = cum - w0; }
        }
        {
            float* pv = ctlf + 8192;
            const float* s0 = KF(P_NMIXG); for (int i = tid; i < 4096; i += 512) pv[i] = s0[i];
            const float* s1 = KF(P_NMLPG); for (int i = tid; i < 4096; i += 512) pv[4096 + i] = s1[i];
            const float* s2 = KF(P_DSUBG); for (int i = tid; i < 512; i += 512) pv[8192 + i] = s2[i];
            const float* s3 = KF(P_HNG); for (int i = tid; i < 256; i += 512) pv[8704 + i] = s3[i];
            const float* s4 = KF(P_GW2); for (int i = tid; i < 16384; i += 512) pv[8960 + i] = s4[i];
            const float* s5 = KF(P_GB); for (int i = tid; i < 1024; i += 512) pv[25344 + i] = s5[i];
            const float* s6 = KF(P_GNG); for (int i = tid; i < 256; i += 512) pv[26368 + i] = s6[i];
            const float* s7 = KF(P_FNG); for (int i = tid; i < 1024; i += 512) pv[26624 + i] = s7[i];
        }
    }
#ifndef NO_MOD
    {
        LAS float* cond = (LAS float*)lds; LAS float* red = (LAS float*)(lds + 131072);
        float* mod = (float*)(KWS() + WS_MOD);
        const float* cin = KF(P_C); const float* adaw = KF(P_ADAW); const float* adab = KF(P_ADAB);
        bool loaded = false;
        for (int it = blockIdx.x; it < 4 * 96; it += gridDim.x) {
            if (!loaded) { for (int i = tid; i < 32 * 1024; i += 512) { const float cv = cin[i]; cond[i] = cv / (1.f + __expf(-cv)); } loaded = true; __syncthreads(); }
            const int l = it / 96, n0 = (it % 96) * 64;
            const float* W = adaw + (size_t)l * D * (NMOD * D) + n0 + lane;
            float acc[32];
#pragma unroll
            for (int b = 0; b < 32; ++b) acc[b] = 0.f;
            for (int k4 = 0; k4 < 32; ++k4) {
                const int k = wave * 128 + k4 * 4;
                const float w0 = W[(size_t)k * (NMOD * D)], w1 = W[(size_t)(k + 1) * (NMOD * D)], w2v = W[(size_t)(k + 2) * (NMOD * D)], w3 = W[(size_t)(k + 3) * (NMOD * D)];
#pragma unroll
                for (int b = 0; b < 32; ++b) { const f32x4 c4 = *(const LAS f32x4*)(cond + b * 1024 + k); acc[b] += c4.x * w0 + c4.y * w1 + c4.z * w2v + c4.w * w3; }
            }
#pragma unroll
            for (int rd = 0; rd < 4; ++rd) {
                __syncthreads();
#pragma unroll
                for (int bb = 0; bb < 8; ++bb) red[(wave * 8 + bb) * 64 + lane] = acc[rd * 8 + bb];
                __syncthreads();
                float s = 0.f;
#pragma unroll
                for (int w = 0; w < 8; ++w) s += red[(w * 8 + wave) * 64 + lane];
                const int b = rd * 8 + wave;
                mod[((size_t)l * 32 + b) * (NMOD * D) + n0 + lane] = s + adab[l * (NMOD * D) + n0 + lane];
            }
        }
        __syncthreads();
    }
#endif
#ifndef NO_WT
    {
        LAS float* scr = (LAS float*)(lds + wave * 8704);
        const int gw = blockIdx.x * 8 + wave, NGW = gridDim.x * 8;
        uchar* ws = KWS();
        bf16_t* win_t = (bf16_t*)(ws + WS_WIN); bf16_t* wup_t = (bf16_t*)(ws + WS_WUP); bf16_t* wout_t = (bf16_t*)(ws + WS_WOUT);
        bf16_t* w1_t = (bf16_t*)(ws + WS_W1); bf16_t* w2_t = (bf16_t*)(ws + WS_W2);
        constexpr int I_IN = 16 * 209, I_UA = 8 * 32, I_UB = 4 * 32, I_UC = 4 * 32, I_O = 16 * 32, I_1 = 16 * 128, I_2 = 64 * 32;
        constexpr int I_L = I_IN + I_UA + I_UB + I_UC + I_O + I_1 + I_2;
        for (int it = gw; it < 4 * I_L; it += NGW) {
            const int l = it / I_L; int r = it % I_L;
            if (r < I_IN) { transpose_item(KF(P_WIN) + (size_t)l * D * DIN, DIN, win_t + (size_t)l * LDP * D, D, 0, 0, scr, r / 209, r % 209, lane); continue; } r -= I_IN;
            if (r < I_UA) { transpose_item(KF(P_WUA) + (size_t)l * 512 * D, D, wup_t + (size_t)l * D * D, D, 0, 0, scr, r / 32, r % 32, lane); continue; } r -= I_UA;
            if (r < I_UB) { transpose_item(KF(P_WUB) + (size_t)l * 256 * D, D, wup_t + (size_t)l * D * D, D, 0, 512, scr, r / 32, r % 32, lane); continue; } r -= I_UB;
            if (r < I_UC) { transpose_item(KF(P_WUC) + (size_t)l * 256 * D, D, wup_t + (size_t)l * D * D, D, 0, 768, scr, r / 32, r % 32, lane); continue; } r -= I_UC;
            if (r < I_O) { transpose_item(KF(P_WOUT) + (size_t)l * D * D, D, wout_t + (size_t)l * D * D, D, 0, 0, scr, r / 32, r % 32, lane); continue; } r -= I_O;
            if (r < I_1) { transpose_item(KF(P_W1) + (size_t)l * D * DFF, DFF, w1_t + (size_t)l * DFF * D, D, 0, 0, scr, r / 128, r % 128, lane); continue; } r -= I_1;
            transpose_item(KF(P_W2) + (size_t)l * DFF * D, D, w2_t + (size_t)l * D * DFF, DFF, 0, 0, scr, r / 32, r % 32, lane);
        }
        for (int i = blockIdx.x * 512 + tid; i < 4 * 28672; i += gridDim.x * 512) { const int l = i / 28672, r = i % 28672;
            *(u32x4*)(win_t + (size_t)l * LDP * D + (size_t)DIN * D + (size_t)r * 8) = (u32x4){0u, 0u, 0u, 0u}; }
    }
#endif
    }
    GRID_SYNC();
    if (threadIdx.x < 2) ((LAS unsigned*)(lds + 147456 - 256))[threadIdx.x] = 0u;
    (void)xcd_barrier_post((unsigned*)(KWS() + WS_CTL) + CW_XBAR, (volatile LAS unsigned*)(lds + 147456 - 256));

    for (int grp = 0; grp < NGRP; ++grp) {
        for (int l = 0; l < DEPTH; ++l) {
            {
                uchar* ws = KWS(); const float* pv = (const float*)(ws + WS_CTL) + 8192;
                const float* src = (l == 0 ? KF(P_X) : (const float*)karg(P_OUT)) + (size_t)grp * TG * D;
                norm_rows_mod(src, (bf16_t*)(ws + WS_HB), pv + l * D, (const float*)(ws + WS_MOD) + (size_t)l * 32 * (NMOD * D), grp * TG, 0, D);
            }
            XSYNC();
            { uchar* ws = KWS(); pg8::Gemm g{(const bf16_t*)(ws + WS_HB), (const bf16_t*)(ws + WS_WIN) + (size_t)l * LDP * D, D}; pg8::Order S; S.init(TG, LDP, D, gridDim.x, blockIdx.x, 1); pg8::EpiProj E{(bf16_t*)(ws + WS_PROJ), (bf16_t*)(ws + WS_ATT)};
#ifndef NO_EPIPROJ
              pg8::gemm_phase<pg8::EpiProj>(lds, g, S, E);
#endif
            }
            XSYNC();
            {
                uchar* ws = KWS(); const float* ctlf = (const float*)(ws + WS_CTL); const float* pv = ctlf + 8192;
                const int xq = blockIdx.x & 7; unsigned* ctr = (unsigned*)(ws + WS_CTL) + ((grp * DEPTH + l) * 8 + xq) * 4;
                const float lam = ctlf[1024 + l], laminit = ctlf[1028 + l];
                const bf16_t* PROJ = (const bf16_t*)(ws + WS_PROJ); bf16_t* OCAT = (bf16_t*)(ws + WS_OCAT); float* OFWD = (float*)(ws + WS_OFWD);
                LAS int* itm = (LAS int*)(lds + 147456 - 64);
                const int tid = tid_fresh();
                for (;;) {
                    __syncthreads();
                    if (tid == 0) itm[0] = (int)atomicAdd(ctr, 1u);
                    __syncthreads();
                    const int it = itm[0];
                    constexpr int NPQ = GB * 4 / 8;
                    if (it >= 4 * NPQ + NPQ * 16) break;
                    float* OBWD = (float*)(ws + WS_OBWD);
                    if (it < 2 * NPQ) { const int p = (it >> 1) * 8 + xq; unsigned* dn = (unsigned*)(ws + WS_CTL) + 40960 + (((grp * DEPTH + l) * GB * 4 + p) * 2);
                        scan_item<64, true>(lds, PROJ, OFWD, OBWD, OCAT, dn, p >> 2, p & 3, it & 1, ctlf + 2048 + l * 512, pv + 8704 + l * 64, nullptr, nullptr);
                    } else if (it < 4 * NPQ) { const int i2 = it - 2 * NPQ; const int p = (i2 >> 1) * 8 + xq; unsigned* dn = (unsigned*)(ws + WS_CTL) + 40960 + (((grp * DEPTH + l) * GB * 4 + p) * 2 + 1);
                        scan_item<32, false>(lds, PROJ, OFWD, OBWD, OCAT, dn, p >> 2, p & 3, i2 & 1, nullptr, pv + 26368 + l * 64, pv + 8960 + l * 4096, pv + 25344 + l * 256);
                    } else { const int u = it - 4 * NPQ, p = (u >> 4) * 8 + xq;
                        attn_unit(lds, (const bf16_t*)(ws + WS_ATT), OCAT, p >> 2, p & 3, u & 15, lam, laminit, pv + 8192 + l * 128);
                    }
                }
            }
            XSYNC();
            { uchar* ws = KWS(); pg8::Gemm g{(const bf16_t*)(ws + WS_OCAT), (const bf16_t*)(ws + WS_WUP) + (size_t)l * D * D, D}; pg8::Order S; S.init(TG, D, D, gridDim.x, blockIdx.x, 3); pg8::EpiMerge E{(const bf16_t*)(ws + WS_PROJ), (bf16_t*)(ws + WS_HB)};
#ifndef NO_EPIMERGE
              pg8::gemm_phase<pg8::EpiMerge>(lds, g, S, E);
#endif
            }
            XSYNC();
            { uchar* ws = KWS(); pg8::Gemm g{(const bf16_t*)(ws + WS_HB), (const bf16_t*)(ws + WS_WOUT) + (size_t)l * D * D, D}; pg8::Order S; S.init(TG, D, D, gridDim.x, blockIdx.x, 1);
              float* xg = (float*)karg(P_OUT) + (size_t)grp * TG * D;
              pg8::EpiRes E{l == 0 ? KF(P_X) + (size_t)grp * TG * D : xg, xg, (const float*)(ws + WS_MOD) + ((size_t)l * 32 + grp * GB) * (NMOD * D) + 2 * D};
#ifndef NO_EPIRES
              pg8::gemm_phase<pg8::EpiRes>(lds, g, S, E);
#endif
            }
            XSYNC();
            {
                uchar* ws = KWS(); const float* pv = (const float*)(ws + WS_CTL) + 8192;
                norm_rows_mod((const float*)karg(P_OUT) + (size_t)grp * TG * D, (bf16_t*)(ws + WS_HB), pv + 4096 + l * D, (const float*)(ws + WS_MOD) + (size_t)l * 32 * (NMOD * D), grp * TG, 3 * D, 4 * D);
            }
            XSYNC();
            { uchar* ws = KWS(); pg8::Gemm g{(const bf16_t*)(ws + WS_HB), (const bf16_t*)(ws + WS_W1) + (size_t)l * DFF * D, D}; pg8::Order S; S.init(TG, DFF, D, gridDim.x, blockIdx.x, 1); pg8::EpiRelu2 E{(bf16_t*)(ws + WS_U)};
#ifndef NO_EPIRELU2
              pg8::gemm_phase<pg8::EpiRelu2>(lds, g, S, E);
#endif
            }
            XSYNC();
            { uchar* ws = KWS(); pg8::Gemm g{(const bf16_t*)(ws + WS_U), (const bf16_t*)(ws + WS_W2) + (size_t)l * D * DFF, DFF}; pg8::Order S; S.init(TG, D, DFF, gridDim.x, blockIdx.x, 1);
              float* xg = (float*)karg(P_OUT) + (size_t)grp * TG * D;
              pg8::EpiRes E{xg, xg, (const float*)(ws + WS_MOD) + ((size_t)l * 32 + grp * GB) * (NMOD * D) + 5 * D};
#ifndef NO_EPIRES
              pg8::gemm_phase<pg8::EpiRes>(lds, g, S, E);
#endif
            }
            XSYNC();
        }
        norm_rows_final((float*)karg(P_OUT) + (size_t)grp * TG * D, (const float*)(KWS() + WS_CTL) + 8192 + 26624);
    }
}

extern "C" void kernel_launch(void* const* d_in, const int* in_sizes, int n_in, void* d_out, int out_size, void* d_ws, size_t ws_size, hipStream_t stream) {
    static int grid = 0;
    if (grid == 0) {
        if (n_in != 21 || ws_size < WS_END) { fprintf(stderr, "kernel_launch: unexpected n_in %d / ws %zu\n", n_in, ws_size); grid = -1; return; }
        int dev = 0, cus = 0, per_cu = 0;
        if (hipGetDevice(&dev) != hipSuccess || hipDeviceGetAttribute(&cus, hipDeviceAttributeMultiprocessorCount, dev) != hipSuccess) { grid = -1; return; }
        if (hipFuncSetAttribute((const void*)fwd_megakernel, hipFuncAttributeMaxDynamicSharedMemorySize, LDS_BYTES) != hipSuccess) { fprintf(stderr, "kernel_launch: hipFuncSetAttribute failed\n"); grid = -1; return; }
        if (hipOccupancyMaxActiveBlocksPerMultiprocessor(&per_cu, (const void*)fwd_megakernel, 512, LDS_BYTES) != hipSuccess || per_cu < 1) { fprintf(stderr, "kernel_launch: occupancy query says %d\n", per_cu); per_cu = 1; }
        (void)hipGetLastError();
        grid = cus;
    }
    if (grid < 0) return;
    Args a{};
    for (int i = 0; i < 21; ++i) a.p[i] = d_in[i];
    a.p[21] = d_out; a.p[22] = d_ws; a.p[23] = nullptr;
    void* args[] = {&a};
    hipError_t e = hipLaunchCooperativeKernel((void*)fwd_megakernel, dim3(grid), dim3(512), args, LDS_BYTES, stream);
    if (e != hipSuccess) fprintf(stderr, "kernel_launch: cooperative launch failed: %s (grid %d)\n", hipGetErrorString(e), grid);
}
```

```cpp
#include <hip/hip_runtime.h>
#include <hip/hip_cooperative_groups.h>
#include <cstdio>
#include <cstdint>
namespace cg = cooperative_groups;

#define LAS __attribute__((address_space(3)))
typedef unsigned short bf16_t;
typedef short bf16x8 __attribute__((ext_vector_type(8)));
typedef float f32x4 __attribute__((ext_vector_type(4)));
typedef float f32x2 __attribute__((ext_vector_type(2)));
typedef float f32x16 __attribute__((ext_vector_type(16)));
typedef unsigned u32x4 __attribute__((ext_vector_type(4)));
typedef short s16x4 __attribute__((ext_vector_type(4)));
typedef unsigned char uchar;

constexpr int D = 1024, SEQ = 2048, BATCH = 32, DEPTH = 4, DIN = 6688, LDP = 6912, DFF = 4096, NMOD = 6;
constexpr int GB = 16, TG = GB * SEQ, NGRP = BATCH / GB;
constexpr int CQ = 0, CK = 512, CV = 1024, BQ = 1536, BFF = 1792, BFB = 2048, BI = 2304, BG = 2560;
constexpr int GQ = 2816, GK = 2944, GV = 3072, GG = 3328, GLF = 3584, GLB = 3600, GATE = 3616;
constexpr float EPS = 1e-6f, LOG2E = 1.4426950408889634f;
constexpr float QSCALE = 0.125f * LOG2E;

constexpr size_t MiB = 1u << 20;
constexpr size_t WS_CTL = 0;
constexpr size_t WS_MOD = 1 * MiB;
constexpr size_t WS_WIN = 4 * MiB;
constexpr size_t WS_WUP = 58 * MiB;
constexpr size_t WS_WOUT = 66 * MiB;
constexpr size_t WS_W1 = 74 * MiB;
constexpr size_t WS_W2 = 106 * MiB;
constexpr size_t WS_HB = 138 * MiB;
constexpr size_t WS_OCAT = 202 * MiB;
constexpr size_t WS_OFWD = 266 * MiB;
constexpr size_t WS_PROJ = 330 * MiB;
constexpr size_t WS_U = WS_PROJ;
constexpr size_t WS_OBWD = 762 * MiB;
constexpr size_t WS_ATT = 826 * MiB;
constexpr size_t WS_END = 922 * MiB;
constexpr int LDS_BYTES = 148 * 1024;

__device__ __forceinline__ unsigned f2bf(float f) { unsigned u = __builtin_bit_cast(unsigned, f); return (u + 0x7fffu + ((u >> 16) & 1u)) >> 16; }
__device__ __forceinline__ unsigned pk2(float lo, float hi) { return f2bf(lo) | (f2bf(hi) << 16); }
__device__ __forceinline__ float bf2f(bf16_t v) { return __builtin_bit_cast(float, (unsigned)v << 16); }
__device__ __forceinline__ float bflo(unsigned u) { return __builtin_bit_cast(float, u << 16); }
__device__ __forceinline__ float bfhi(unsigned u) { return __builtin_bit_cast(float, u & 0xffff0000u); }
typedef __bf16 bf16x2_t __attribute__((ext_vector_type(2)));
__device__ __forceinline__ unsigned cvt_pk_bf16(float lo, float hi) { f32x2 v = {lo, hi}; bf16x2_t b = __builtin_convertvector(v, bf16x2_t); return __builtin_bit_cast(unsigned, b); }
__device__ __forceinline__ float wave_sum(float v) {
#pragma unroll
    for (int o = 1; o < 64; o <<= 1) v += __shfl_xor(v, o);
    return v;
}
__device__ __forceinline__ int tid_fresh() { int t = threadIdx.x; asm volatile("" : "+v"(t)); return t; }
__device__ __forceinline__ float sigmoidf_(float z) { return 1.f / (1.f + __expf(-z)); }

namespace pg8 {
constexpr int BM = 256, BK = 64, HALF = 128, HTB = HALF * BK * 2, STAGE_BYTES = 8 * HTB, NXCD = 8, WGM = 8;
__host__ __device__ __forceinline__ int lds_byte(int r, int c) { const int st = (r >> 4) * 2 + (c >> 5), rr = r & 15, cc = c & 31, ob = rr * 64 + cc * 2; return st * 1024 + (ob ^ (((ob >> 9) & 1) << 5)); }
__host__ __device__ __forceinline__ void stage_rc(int b, int& R, int& C) { const int st = b / 1024, sb = b % 1024, swz = sb ^ (((sb >> 9) & 1) << 5); R = (st >> 1) * 16 + swz / 64; C = (st & 1) * 32 + (swz % 64) / 2; }
__host__ __device__ __forceinline__ int perm32(int rho) { const int n = rho >> 4, i = rho & 15; return 8 * (i >> 2) + 4 * n + (i & 3); }

struct Unit { int pm, pn, koff, nt, seg; };
struct Gemm { const bf16_t* A; const bf16_t* Bt; int K; };

struct Order {
    int nM, nN, nwg, G, c, nseg, ntfull;
    __device__ void init(int M, int N, int K, int G_, int c_, int nseg_) { nM = M / BM; nN = N / BM; nwg = nM * nN; G = G_; c = c_; nseg = nseg_; ntfull = K / BK; }
    __device__ bool next(int i, Unit& u) const {
        int ti = i, seg = 0;
        if (nseg == 3) { ti = i / 3; seg = i - ti * 3; }
        const long L = (long)ti * G + c; if (L >= nwg) return false;
        int wgid = (int)L; { const int q = nwg / NXCD, r = nwg % NXCD, xcd = wgid % NXCD, off = wgid / NXCD; wgid = (xcd < r ? xcd * (q + 1) : r * (q + 1) + (xcd - r) * q) + off; }
        const int nig = WGM * nN, gid = wgid / nig, fm = gid * WGM, gsz = (nM - fm) < WGM ? (nM - fm) : WGM;
        u.pm = fm + ((wgid % nig) % gsz); u.pn = (wgid % nig) / gsz; u.seg = seg;
        if (nseg == 3) { u.koff = seg == 0 ? 0 : (seg == 1 ? 512 : 768); u.nt = seg == 0 ? 8 : 4; } else { u.koff = 0; u.nt = ntfull; }
        return true;
    }
};

struct EpiProj {
    bf16_t* O; bf16_t* att;
    __device__ __forceinline__ bool zero_after(const Unit&) const { return true; }
    __device__ __forceinline__ void operator()(f32x4 (&acc)[2][2][4][2], const Unit& u, int wr, int wc, int fr, int fq) const {
        const int row0 = u.pm * BM + wr * 64 + fr, col0 = u.pn * BM + wc * 32 + 8 * fq;
        const float sc = (u.pn < 2) ? QSCALE : 1.f;
        const bool toatt = u.pn < 6;
#pragma unroll
        for (int ai = 0; ai < 2; ++ai)
#pragma unroll
            for (int m = 0; m < 4; ++m) { const int row = row0 + ai * HALF + m * 16; bf16_t* rowp = O + (size_t)row * LDP + col0;
#pragma unroll
                for (int bj = 0; bj < 2; ++bj) { f32x4 v0 = acc[ai][bj][m][0] * sc, v1 = acc[ai][bj][m][1] * sc;
                    u32x4 w; w.x = cvt_pk_bf16(v0[0], v0[1]); w.y = cvt_pk_bf16(v0[2], v0[3]); w.z = cvt_pk_bf16(v1[0], v1[1]); w.w = cvt_pk_bf16(v1[2], v1[3]);
                    if (toatt) { const int seg = u.pn * 2 + bj, typ = seg >> 2, hh = seg & 3;
                        *(u32x4*)(att + ((size_t)(((row >> 11) * 4 + hh) * SEQ + (row & 2047))) * 384 + typ * 128 + wc * 32 + 8 * fq) = w; }
                    else *(u32x4*)(rowp + bj * HALF) = w; } }
    }
};
struct EpiRelu2 {
    bf16_t* O;
    __device__ __forceinline__ bool zero_after(const Unit&) const { return true; }
    __device__ __forceinline__ void operator()(f32x4 (&acc)[2][2][4][2], const Unit& u, int wr, int wc, int fr, int fq) const {
        const int row0 = u.pm * BM + wr * 64 + fr, col0 = u.pn * BM + wc * 32 + 8 * fq;
#pragma unroll
        for (int ai = 0; ai < 2; ++ai)
#pragma unroll
            for (int m = 0; m < 4; ++m) { bf16_t* rowp = O + (size_t)(row0 + ai * HALF + m * 16) * DFF + col0;
#pragma unroll
                for (int bj = 0; bj < 2; ++bj) { f32x4 v0 = acc[ai][bj][m][0], v1 = acc[ai][bj][m][1];
#pragma unroll
                    for (int j = 0; j < 4; ++j) { float a = fmaxf(v0[j], 0.f), b = fmaxf(v1[j], 0.f); v0[j] = a * a; v1[j] = b * b; }
                    u32x4 w; w.x = cvt_pk_bf16(v0[0], v0[1]); w.y = cvt_pk_bf16(v0[2], v0[3]); w.z = cvt_pk_bf16(v1[0], v1[1]); w.w = cvt_pk_bf16(v1[2], v1[3]);
                    *(u32x4*)(rowp + bj * HALF) = w; } }
    }
};
struct EpiRes {
    const float* base; float* out; const float* gate;
    __device__ __forceinline__ bool zero_after(const Unit&) const { return true; }
    __device__ __forceinline__ void operator()(f32x4 (&acc)[2][2][4][2], const Unit& u, int wr, int wc, int fr, int fq) const {
        const int row0 = u.pm * BM + wr * 64 + fr, col0 = u.pn * BM + wc * 32 + 8 * fq;
        const float* gp = gate + (size_t)((u.pm * BM) >> 11) * (NMOD * D) + col0;
#pragma unroll
        for (int bj = 0; bj < 2; ++bj) {
            const f32x4 g0 = *(const f32x4*)(gp + bj * HALF), g1 = *(const f32x4*)(gp + bj * HALF + 4);
#pragma unroll
            for (int ai = 0; ai < 2; ++ai) {
#pragma unroll
                for (int m = 0; m < 4; ++m) { const size_t off = (size_t)(row0 + ai * HALF + m * 16) * D + col0 + bj * HALF;
                    const f32x4 b0 = *(const f32x4*)(base + off), b1 = *(const f32x4*)(base + off + 4);
                    *(f32x4*)(out + off) = b0 + g0 * acc[ai][bj][m][0];
                    *(f32x4*)(out + off + 4) = b1 + g1 * acc[ai][bj][m][1];
                    if (m & 1) asm volatile("" ::: "memory"); }
            }
        }
    }
};
struct EpiMerge {
    const bf16_t* proj; bf16_t* O;
    __device__ __forceinline__ bool zero_after(const Unit& u) const { return u.seg == 2; }
    __device__ __forceinline__ void operator()(f32x4 (&acc)[2][2][4][2], const Unit& u, int wr, int wc, int fr, int fq) const {
        const int row0 = u.pm * BM + wr * 64 + fr, col0 = u.pn * BM + wc * 32 + 8 * fq;
        const int seg = u.seg;
#pragma unroll
        for (int ai = 0; ai < 2; ++ai)
#pragma unroll
            for (int m = 0; m < 4; ++m) { const size_t row = (size_t)(row0 + ai * HALF + m * 16); const bf16_t* gp = proj + row * LDP + GATE + col0;
#pragma unroll
                for (int bj = 0; bj < 2; ++bj) {
                    if (seg < 2) {
                        const u32x4 ga = *(const u32x4*)(gp + seg * D + bj * HALF), gb = *(const u32x4*)(gp + (seg + 1) * D + bj * HALF);
                        float r[8];
#pragma unroll
                        for (int j = 0; j < 4; ++j) {
                            const float a0 = fminf(fmaxf(bflo(ga[j]), -40.f), 40.f), a1 = fminf(fmaxf(bfhi(ga[j]), -40.f), 40.f);
                            const float b0 = fminf(fmaxf(bflo(gb[j]), -40.f), 40.f), b1 = fminf(fmaxf(bfhi(gb[j]), -40.f), 40.f);
                            r[2 * j] = (1.f + __expf(-b0)) * __builtin_amdgcn_rcpf(1.f + __expf(-a0));
                            r[2 * j + 1] = (1.f + __expf(-b1)) * __builtin_amdgcn_rcpf(1.f + __expf(-a1)); }
                        acc[ai][bj][m][0] = acc[ai][bj][m][0] * (f32x4){r[0], r[1], r[2], r[3]};
                        acc[ai][bj][m][1] = acc[ai][bj][m][1] * (f32x4){r[4], r[5], r[6], r[7]};
                    } else {
                        const u32x4 gc = *(const u32x4*)(gp + 2 * D + bj * HALF);
                        float r[8];
#pragma unroll
                        for (int j = 0; j < 4; ++j) {
                            const float c0 = fminf(fmaxf(bflo(gc[j]), -40.f), 40.f), c1 = fminf(fmaxf(bfhi(gc[j]), -40.f), 40.f);
                            r[2 * j] = __builtin_amdgcn_rcpf(1.f + __expf(-c0)); r[2 * j + 1] = __builtin_amdgcn_rcpf(1.f + __expf(-c1)); }
                        const f32x4 v0 = acc[ai][bj][m][0] * (f32x4){r[0], r[1], r[2], r[3]}, v1 = acc[ai][bj][m][1] * (f32x4){r[4], r[5], r[6], r[7]};
                        u32x4 w; w.x = cvt_pk_bf16(v0[0], v0[1]); w.y = cvt_pk_bf16(v0[2], v0[3]); w.z = cvt_pk_bf16(v1[0], v1[1]); w.w = cvt_pk_bf16(v1[2], v1[3]);
                        *(u32x4*)(O + row * D + col0 + bj * HALF) = w;
                    } } }
    }
};

template <class Epi, bool ALIGN_EPI = true>
__device__ __forceinline__ void gemm_phase(LAS uchar* lds, const Gemm g, const Order& S, const Epi& E) {
    const int tid = tid_fresh(), wid = __builtin_amdgcn_readfirstlane(tid >> 6), lane = tid & 63, wr = wid >> 2, wc = wid & 3, fr = lane & 15, fq = lane >> 4;
    const int K = g.K;
    unsigned voffA[2], voffB[2];
#pragma unroll
    for (int i = 0; i < 2; ++i) { int R, C; stage_rc(tid * 16 + i * 8192, R, C); const int Rb = (R & ~31) + perm32(R & 31);
        voffA[i] = (unsigned)(R * K + C) * 2u; voffB[i] = (unsigned)(Rb * K + C) * 2u; }
    const size_t kstep = (size_t)(BK * 2);
    const size_t hstep = (size_t)HALF * K * 2;
    const size_t tstep = 2 * hstep;
    const unsigned ldsw = (unsigned)wid * 1024u;
    const int aoff = lds_byte(wr * 64 + fr, fq * 8), boff = lds_byte(wc * 32 + fr, fq * 8);
#define PG8_SA(b, h) (((b) * 2 + (h)) * HTB)
#define PG8_SB(b, h) ((4 + (b) * 2 + (h)) * HTB)
#define PG8_STAGE(bufoff, gbase, voff) do { _Pragma("unroll") for (int _i = 0; _i < 2; ++_i) \
        __builtin_amdgcn_global_load_lds((const unsigned*)((const char*)(gbase) + (voff)[_i]), (LAS unsigned*)(lds + (bufoff) + ldsw + _i * 8192), 16, 0, 0); } while (0)
#define PG8_LDA(dst, b, h) do { _Pragma("unroll") for (int m = 0; m < 4; ++m) _Pragma("unroll") for (int k = 0; k < 2; ++k) dst[m][k] = *(const LAS bf16x8*)(lds + PG8_SA(b, h) + aoff + m * 2048 + k * 1024); } while (0)
#define PG8_LDB(dst, b, h) do { _Pragma("unroll") for (int n = 0; n < 2; ++n) _Pragma("unroll") for (int k = 0; k < 2; ++k) dst[n][k] = *(const LAS bf16x8*)(lds + PG8_SB(b, h) + boff + n * 2048 + k * 1024); } while (0)
#define PG8_MMA(ai, bj, At, Bt) do { __builtin_amdgcn_s_setprio(1); _Pragma("unroll") for (int m = 0; m < 4; ++m) _Pragma("unroll") for (int n = 0; n < 2; ++n) _Pragma("unroll") for (int k = 0; k < 2; ++k) \
        acc[ai][bj][m][n] = __builtin_amdgcn_mfma_f32_16x16x32_bf16(Bt[n][k], At[m][k], acc[ai][bj][m][n], 0, 0, 0); __builtin_amdgcn_s_setprio(0); } while (0)
#define PG8_WAIT_V(n) asm volatile("s_waitcnt vmcnt(" #n ")" ::: "memory")
#define PG8_WAIT_L(n) asm volatile("s_waitcnt lgkmcnt(" #n ")" ::: "memory")
#define PG8_BAR __builtin_amdgcn_s_barrier()
#define PG8_SCHED __builtin_amdgcn_sched_barrier(0)
    Unit cur, nxt; int ui = 0;
    if (!S.next(0, cur)) return;
    f32x4 acc[2][2][4][2];
#pragma unroll
    for (int a = 0; a < 2; ++a)
#pragma unroll
        for (int b = 0; b < 2; ++b)
#pragma unroll
            for (int m = 0; m < 4; ++m)
#pragma unroll
                for (int n = 0; n < 2; ++n) acc[a][b][m][n] = (f32x4){0.f, 0.f, 0.f, 0.f};
    bf16x8 At[4][2], B0[2][2], B1[2][2];
    const char* cA = (const char*)g.A + (size_t)cur.pm * tstep + (size_t)cur.koff * 2; const char* cB = (const char*)g.Bt + (size_t)cur.pn * tstep + (size_t)cur.koff * 2;
    PG8_STAGE(PG8_SB(0, 0), cB, voffB); PG8_STAGE(PG8_SB(0, 1), cB + hstep, voffB); PG8_STAGE(PG8_SA(0, 0), cA, voffA); PG8_STAGE(PG8_SA(0, 1), cA + hstep, voffA);
    if (wr == 1) PG8_BAR;
    PG8_WAIT_V(2); PG8_BAR;
    PG8_STAGE(PG8_SB(1, 0), cB + kstep, voffB); PG8_STAGE(PG8_SA(1, 0), cA + kstep, voffA); PG8_STAGE(PG8_SB(1, 1), cB + hstep + kstep, voffB);
    PG8_WAIT_V(6); PG8_BAR;
    for (;;) {
        const bool has_next = S.next(ui + 1, nxt);
        const char* nA = has_next ? (const char*)g.A + (size_t)nxt.pm * tstep + (size_t)nxt.koff * 2 : cA; const char* nB = has_next ? (const char*)g.Bt + (size_t)nxt.pn * tstep + (size_t)nxt.koff * 2 : cB;
        const int nt = cur.nt;
        for (int t = 0; t < nt; t += 2) {
            const bool last = (t == nt - 2);
            const char* a1 = cA + (size_t)(t + 1) * kstep;
            const char* a2 = last ? nA : cA + (size_t)(t + 2) * kstep; const char* b2 = last ? nB : cB + (size_t)(t + 2) * kstep;
            const char* a3 = a2 + kstep; const char* b3 = b2 + kstep;
            PG8_LDB(B0, 0, 0); PG8_LDB(B1, 0, 1); PG8_SCHED; PG8_LDA(At, 0, 0); PG8_STAGE(PG8_SA(1, 1), a1 + hstep, voffA);
            PG8_WAIT_V(8); PG8_WAIT_L(0); PG8_BAR; PG8_MMA(0, 0, At, B0); PG8_MMA(0, 1, At, B1); PG8_BAR; PG8_SCHED;
            PG8_LDA(At, 0, 1); PG8_STAGE(PG8_SB(0, 0), b2, voffB); PG8_STAGE(PG8_SB(0, 1), b2 + hstep, voffB); PG8_STAGE(PG8_SA(0, 0), a2, voffA);
            PG8_WAIT_V(8); PG8_WAIT_L(0); PG8_BAR; PG8_MMA(1, 0, At, B0); PG8_MMA(1, 1, At, B1); PG8_BAR; PG8_SCHED;
            PG8_LDB(B0, 1, 0); PG8_LDB(B1, 1, 1); PG8_SCHED; PG8_LDA(At, 1, 0); PG8_STAGE(PG8_SA(0, 1), a2 + hstep, voffA);
            PG8_WAIT_V(8); PG8_WAIT_L(0); PG8_BAR; PG8_MMA(0, 0, At, B0); PG8_MMA(0, 1, At, B1); PG8_BAR; PG8_SCHED;
            PG8_LDA(At, 1, 1); PG8_STAGE(PG8_SB(1, 0), b3, voffB); PG8_STAGE(PG8_SB(1, 1), b3 + hstep, voffB); PG8_STAGE(PG8_SA(1, 0), a3, voffA);
            PG8_WAIT_V(8); PG8_WAIT_L(0); PG8_BAR; PG8_MMA(1, 0, At, B0); PG8_MMA(1, 1, At, B1); PG8_BAR; PG8_SCHED;
        }
        if constexpr (ALIGN_EPI) { if (wr == 0) PG8_BAR; }
        E(acc, cur, wr, wc, fr, fq);
        if (!has_next) break;
        if (E.zero_after(cur)) {
#pragma unroll
            for (int a = 0; a < 2; ++a)
#pragma unroll
                for (int b = 0; b < 2; ++b)
#pragma unroll
                    for (int m = 0; m < 4; ++m)
#pragma unroll
                        for (int n = 0; n < 2; ++n) acc[a][b][m][n] = (f32x4){0.f, 0.f, 0.f, 0.f};
        }
        cur = nxt; cA = nA; cB = nB; ++ui;
        if constexpr (ALIGN_EPI) { if (wr == 1) PG8_BAR; }
    }
    PG8_WAIT_V(0);
    if constexpr (!ALIGN_EPI) { if (wr == 0) PG8_BAR; }
    PG8_BAR;
#undef PG8_SA
#undef PG8_SB
#undef PG8_STAGE
#undef PG8_LDA
#undef PG8_LDB
#undef PG8_MMA
#undef PG8_WAIT_V
#undef PG8_WAIT_L
#undef PG8_BAR
#undef PG8_SCHED
}
}

__device__ __forceinline__ int crow(int r, int hi) { return (r & 3) + 8 * (r >> 2) + 4 * hi; }
__device__ __forceinline__ s16x4 vtr(const LAS uchar* p) { return __builtin_bit_cast(s16x4, __builtin_amdgcn_ds_read_tr16_b64_v4i16((LAS s16x4*)p)); }
__device__ __forceinline__ float xhalf_max(float m) { auto rr = __builtin_amdgcn_permlane32_swap(__builtin_bit_cast(unsigned, m), __builtin_bit_cast(unsigned, m), false, false); return fmaxf(__builtin_bit_cast(float, rr[0]), __builtin_bit_cast(float, rr[1])); }
__device__ __forceinline__ float xhalf_sum(float m) { auto rr = __builtin_amdgcn_permlane32_swap(__builtin_bit_cast(unsigned, m), __builtin_bit_cast(unsigned, m), false, false); return __builtin_bit_cast(float, rr[0]) + __builtin_bit_cast(float, rr[1]); }

__device__ __forceinline__ void glds16(const void* gsrc, unsigned lds_dst) { unsigned keep;
    asm volatile("s_mov_b32 %0, m0\n\ts_mov_b32 m0, %2\n\ts_nop 0\n\tglobal_load_lds_dwordx4 %1, off\n\ts_mov_b32 m0, %0" : "=&s"(keep) : "v"(gsrc), "s"(lds_dst) : "memory"); }
constexpr int ATT_SLOT = 32768, ATT_WSF = 131072;
__device__ __forceinline__ void attn_unit(LAS uchar* lds, const bf16_t* proj, bf16_t* ocat, int bl, int h, int qb, float lam, float laminit, const float* sg) {
    const int tid = tid_fresh(), lane = tid & 63, r32 = lane & 31, hi = lane >> 5;
    const int wave = __builtin_amdgcn_readfirstlane(tid >> 6), mi = wave >> 2, rb = wave & 3;
    const size_t rowbase = (size_t)bl * SEQ;
    const int q0 = qb * 128 + rb * 32;
    const float m2 = exp2f(-2.f * (float)(h + 1)) * LOG2E;
    bf16x8 qf[4];
    const bf16_t* att = proj;
    const size_t hb = (size_t)(bl * 4 + h) * SEQ;
    { const bf16_t* qp = att + (hb + q0 + r32) * 384 + mi * 64 + hi * 8;
#pragma unroll
      for (int d0 = 0; d0 < 4; ++d0) qf[d0] = *(const bf16x8*)(qp + d0 * 16); }
    const int kkey = 4 * wave + (lane >> 4);
    const bf16_t* ksrc0 = att + (hb + kkey) * 384 + 128 + (((lane & 15) ^ (kkey & 15)) * 8);
    const bf16_t* ksrc1 = ksrc0 + (size_t)32 * 384;
    const bf16_t* vsrc0 = att + (hb + 16 * (wave & 3) + (lane >> 2)) * 384 + 256 + (wave >> 2) * 32 + (lane & 3) * 8;
    const bf16_t* vsrc1 = vsrc0 + 64;
    const unsigned lds0 = (unsigned)(uintptr_t)lds + (unsigned)wave * 1024u;
#define ATT_ISSUE(t, sb) do { const size_t go_ = (size_t)(t) * 64 * 384; const unsigned d_ = (unsigned)__builtin_amdgcn_readfirstlane((int)(lds0 + (unsigned)(sb))); \
        glds16(ksrc0 + go_, d_); glds16(ksrc1 + go_, d_ + 8192u); glds16(vsrc0 + go_, d_ + 16384u); glds16(vsrc1 + go_, d_ + 24576u); } while (0)
    LAS float* wsf = (LAS float*)(lds + ATT_WSF) + wave * 64;
    f32x16 o[4];
#pragma unroll
    for (int d = 0; d < 4; ++d)
#pragma unroll
        for (int r = 0; r < 16; ++r) o[d][r] = 0.f;
    float mhat = 0.f;
    f32x16 ol;
#pragma unroll
    for (int r = 0; r < 16; ++r) ol[r] = 0.f;
    const bf16x8 ones = (bf16x8){0x3F80, 0x3F80, 0x3F80, 0x3F80, 0x3F80, 0x3F80, 0x3F80, 0x3F80};
    int kfo[4];
#pragma unroll
    for (int d0 = 0; d0 < 4; ++d0) kfo[d0] = r32 * 256 + (((mi * 8 + 2 * d0 + hi) ^ (r32 & 15)) * 16);
    const int vfo = 16384 + ((lane >> 4) & 1) * 32 + (lane & 3) * 8 + (4 * hi + ((lane & 15) >> 2)) * 64;
    ATT_ISSUE(0, 0); ATT_ISSUE(1, ATT_SLOT);
    u32x4 pw[4];
#pragma unroll
    for (int k = 0; k < 4; ++k) pw[k] = (u32x4){0u, 0u, 0u, 0u};
#define ATT_VLD(i, L, H) do { L = vtr(sv_ + vfo + ((i) >> 2) * 4096 + ((i) & 3) * 1024); H = vtr(sv_ + vfo + ((i) >> 2) * 4096 + ((i) & 3) * 1024 + 512); } while (0)
#define ATT_PV(SLP) do { const LAS uchar* sv_ = (SLP); s16x4 fl_[3], fh_[3]; __builtin_amdgcn_s_setprio(1); \
        ATT_VLD(0, fl_[0], fh_[0]); ATT_VLD(1, fl_[1], fh_[1]); __builtin_amdgcn_sched_group_barrier(0x100, 4, 0); \
        _Pragma("unroll") for (int i = 0; i < 16; ++i) { \
            if (i + 2 < 16) ATT_VLD(i + 2, fl_[(i + 2) % 3], fh_[(i + 2) % 3]); \
            const s16x4 lo = fl_[i % 3], hh = fh_[i % 3]; \
            const bf16x8 vf = (bf16x8){lo[0], lo[1], lo[2], lo[3], hh[0], hh[1], hh[2], hh[3]}; \
            o[i >> 2] = __builtin_amdgcn_mfma_f32_32x32x16_bf16(__builtin_bit_cast(bf16x8, pw[i & 3]), vf, o[i >> 2], 0, 0, 0); \
            __builtin_amdgcn_sched_group_barrier(0x8, 1, 0); __builtin_amdgcn_sched_group_barrier(0x100, 2, 0); } \
        _Pragma("unroll") for (int ks = 0; ks < 4; ++ks) ol = __builtin_amdgcn_mfma_f32_32x32x16_bf16(__builtin_bit_cast(bf16x8, pw[ks]), ones, ol, 0, 0, 0); \
        __builtin_amdgcn_s_setprio(0); } while (0)
    for (int t = 0; t <= SEQ / 64; ++t) {
        if (t < SEQ / 64) {
            if (t + 1 < SEQ / 64) asm volatile("s_waitcnt vmcnt(4) lgkmcnt(0)" ::: "memory"); else asm volatile("s_waitcnt vmcnt(0) lgkmcnt(0)" ::: "memory");
            __builtin_amdgcn_s_barrier();
            asm volatile("" ::: "memory");
            if (t + 2 < SEQ / 64) ATT_ISSUE(t + 2, ((t + 2) & 3) * ATT_SLOT);
        }
        if (mi == 1 && t > 0) ATT_PV(lds + ((t - 1) & 3) * ATT_SLOT);
        if (t < SEQ / 64) {
            const LAS uchar* sl = lds + (t & 3) * ATT_SLOT;
        const float dq = (float)(q0 + r32 - 64 * t - 4 * hi);
        f32x16 p0, p1;
        const int side = (64 * t + 63 < q0) ? 1 : ((64 * t > q0 + 31) ? -1 : 0);
        if (side != 0) {
            const float sm = side > 0 ? m2 : -m2; const float base = __builtin_fmaf(-sm, dq, -mhat);
#pragma unroll
            for (int r = 0; r < 16; ++r) { const float kc = (float)((r & 3) + 8 * (r >> 2));
                p0[r] = __builtin_fmaf(sm, kc, base); p1[r] = __builtin_fmaf(sm, kc + 32.f, base); }
        } else {
#pragma unroll
            for (int r = 0; r < 16; ++r) { const float kc = (float)((r & 3) + 8 * (r >> 2));
                p0[r] = __builtin_fmaf(-m2, __builtin_fabsf(dq - kc), -mhat); p1[r] = __builtin_fmaf(-m2, __builtin_fabsf(dq - kc - 32.f), -mhat); }
        }
        __builtin_amdgcn_s_setprio(1);
#pragma unroll
        for (int d0 = 0; d0 < 4; ++d0) {
            const bf16x8 a0 = *(const LAS bf16x8*)(sl + kfo[d0]), a1 = *(const LAS bf16x8*)(sl + kfo[d0] + 8192);
            p0 = __builtin_amdgcn_mfma_f32_32x32x16_bf16(a0, qf[d0], p0, 0, 0, 0);
            p1 = __builtin_amdgcn_mfma_f32_32x32x16_bf16(a1, qf[d0], p1, 0, 0, 0); }
        __builtin_amdgcn_s_setprio(0);
        float rm = fmaxf(p0[0], p1[0]);
#pragma unroll
        for (int r = 1; r < 16; ++r) rm = fmaxf(rm, fmaxf(p0[r], p1[r]));
        rm = xhalf_max(rm);
        const bool first = (t == 0);
        if (first || __any(rm > 60.f)) {
            const float dl = first ? rm : fmaxf(rm, 0.f);
            mhat += dl;
#pragma unroll
            for (int r = 0; r < 16; ++r) { p0[r] -= dl; p1[r] -= dl; }
            if (!first) {
                const float f = __builtin_amdgcn_exp2f(-dl);
                if (hi == 0) wsf[r32] = f;
                float fr_[16];
#pragma unroll
                for (int r = 0; r < 16; ++r) fr_[r] = wsf[crow(r, hi)];
#pragma unroll
                for (int d = 0; d < 4; ++d)
#pragma unroll
                    for (int r = 0; r < 16; ++r) o[d][r] *= fr_[r];
#pragma unroll
                for (int r = 0; r < 16; ++r) ol[r] *= fr_[r];
            }
        }
#pragma unroll
        for (int r = 0; r < 16; ++r) { p0[r] = __builtin_amdgcn_exp2f(p0[r]); p1[r] = __builtin_amdgcn_exp2f(p1[r]); }
#pragma unroll
        for (int j = 0; j < 4; ++j) { pw[0][j] = cvt_pk_bf16(p0[2 * j], p0[2 * j + 1]); pw[1][j] = cvt_pk_bf16(p0[8 + 2 * j], p0[8 + 2 * j + 1]);
                                      pw[2][j] = cvt_pk_bf16(p1[2 * j], p1[2 * j + 1]); pw[3][j] = cvt_pk_bf16(p1[8 + 2 * j], p1[8 + 2 * j + 1]); }
            if (mi == 0) ATT_PV(sl);
        }
    }
#undef ATT_PV
#undef ATT_VLD
#undef ATT_ISSUE
    float fr_[16];
#pragma unroll
    for (int r = 0; r < 16; ++r) fr_[r] = (mi == 0 ? 1.f : lam) / ol[r];
    __syncthreads();
    LAS float* X = (LAS float*)lds + rb * 4096;
    if (mi == 1) {
#pragma unroll
        for (int d = 0; d < 4; ++d)
#pragma unroll
            for (int r = 0; r < 16; ++r) X[(d * 16 + r) * 64 + lane] = o[d][r] * fr_[r];
    }
    __syncthreads();
    if (mi == 0) {
        float ss[16];
#pragma unroll
        for (int r = 0; r < 16; ++r) ss[r] = 0.f;
#pragma unroll
        for (int d = 0; d < 4; ++d)
#pragma unroll
            for (int r = 0; r < 16; ++r) { const float v = o[d][r] * fr_[r] - X[(d * 16 + r) * 64 + lane]; o[d][r] = v; ss[r] += v * v; }
#pragma unroll
        for (int r = 0; r < 16; ++r) {
#pragma unroll
            for (int s = 1; s < 32; s <<= 1) ss[r] += __shfl_xor(ss[r], s);
            ss[r] = rsqrtf(ss[r] * (1.f / 128.f) + EPS) * (1.f - laminit); }
        float gv[4];
#pragma unroll
        for (int d = 0; d < 4; ++d) gv[d] = sg[d * 32 + r32];
#pragma unroll
        for (int r = 0; r < 16; ++r) { bf16_t* op = ocat + (rowbase + q0 + crow(r, hi)) * D + h * 128 + r32;
#pragma unroll
            for (int d = 0; d < 4; ++d) op[d * 32] = (bf16_t)f2bf(o[d][r] * ss[r] * gv[d]); }
    }
    __syncthreads();
}

template <int DK, bool HG>
__device__ __forceinline__ void scan_item(LAS uchar* lds, const bf16_t* proj, float* oraw0, float* oraw1, bf16_t* ocat, unsigned* done, int bl, int h, int dir, const float* lb  ,
                                          const float* normg  , const float* w2  , const float* gbias  ) {
    constexpr int KPW = DK / 8, TB = 32, NS = TB / 16, NR = TB / 8, GS = 4;
    LAS float* sA = (LAS float*)lds;
    LAS float* sK = sA + TB * DK;
    LAS float* sQ = sK + TB * DK;
    LAS float* sV = sQ + TB * DK;
    LAS float* sP = sV + TB * 64;
    const int tid = tid_fresh(), lane = tid & 63, wave = __builtin_amdgcn_readfirstlane(tid >> 6);
    const int ps = tid >> 5, pi = tid & 31;
    const size_t rowbase = (size_t)bl * SEQ;
    float* oraw = dir == 0 ? oraw0 : oraw1;
    __syncthreads();
    {
        float lb0 = 0.f, lb1 = 0.f, w2c[16], bias = 0.f;
        if (HG) { lb0 = lb[dir * 256 + h * 64 + pi]; lb1 = lb[dir * 256 + h * 64 + pi + 32]; }
        else {
#pragma unroll
            for (int r = 0; r < 16; ++r) w2c[r] = w2[(dir * 16 + r) * 128 + h * 32 + pi];
            bias = gbias[dir * 128 + h * 32 + pi]; }
        f32x2 S[KPW / 2];
#pragma unroll
        for (int j = 0; j < KPW / 2; ++j) S[j] = (f32x2){0.f, 0.f};
        bf16_t rz0[2][NS], rz1[2][NS], rq0[2][NS], rq1[2][NS], rv0[2][NS], rv1[2][NS], rk0[2][NS]; u32x4 rl0[2][NS], rl1[2][NS];
#pragma unroll
        for (int i = 0; i < NS; ++i) for (int e = 0; e < 2; ++e) { rz0[e][i] = rz1[e][i] = rq0[e][i] = rq1[e][i] = rv0[e][i] = rv1[e][i] = rk0[e][i] = 0; rl0[e][i] = rl1[e][i] = (u32x4){0, 0, 0, 0}; }
#define SCAN_LOAD(blk, E_) do { _Pragma("unroll") for (int i_ = 0; i_ < NS; ++i_) { const int st_ = (blk) * TB + ps + 16 * i_; const int tok_ = dir == 0 ? st_ : 2047 - st_; const bf16_t* pr_ = proj + (rowbase + tok_) * LDP; \
        if (HG) { const int zc_ = (dir == 0 ? BFF : BFB) + h * 64 + pi; rz0[E_][i_] = pr_[zc_]; rz1[E_][i_] = pr_[zc_ + 32]; rq0[E_][i_] = pr_[BQ + h * 64 + pi]; rq1[E_][i_] = pr_[BQ + h * 64 + pi + 32]; rv0[E_][i_] = pr_[BI + h * 64 + pi]; rv1[E_][i_] = pr_[BI + h * 64 + pi + 32]; } \
        else { const u32x4* lp_ = (const u32x4*)(pr_ + (dir == 0 ? GLF : GLB)); rl0[E_][i_] = lp_[0]; rl1[E_][i_] = lp_[1]; rk0[E_][i_] = pr_[GK + h * 32 + pi]; rq0[E_][i_] = pr_[GQ + h * 32 + pi]; rv0[E_][i_] = pr_[GV + h * 64 + pi]; rv1[E_][i_] = pr_[GV + h * 64 + pi + 32]; } } } while (0)
        SCAN_LOAD(0, 0); SCAN_LOAD(1, 1);
        for (int blk2 = 0; blk2 < SEQ / TB; blk2 += 2) {
            { const int blk = blk2;
#pragma unroll
            for (int i = 0; i < NS; ++i) {
                const int st = ps + 16 * i;
                if (HG) {
                    const float z0 = bf2f(rz0[0][i]), z1 = bf2f(rz1[0][i]);
                    const float s0 = __builtin_amdgcn_rcpf(1.f + __expf(-z0)), s1 = __builtin_amdgcn_rcpf(1.f + __expf(-z1));
                    sA[st * 64 + pi] = s0 * (1.f + lb0 * __expf(fminf(-z0, 80.f))); sA[st * 64 + pi + 32] = s1 * (1.f + lb1 * __expf(fminf(-z1, 80.f)));
                    sK[st * 64 + pi] = (1.f - lb0) * __builtin_amdgcn_rcpf(1.f + __expf(z0)); sK[st * 64 + pi + 32] = (1.f - lb1) * __builtin_amdgcn_rcpf(1.f + __expf(z1));
                    const float q0 = bf2f(rq0[0][i]), q1 = bf2f(rq1[0][i]);
                    sQ[st * 64 + pi] = q0 * __builtin_amdgcn_rcpf(1.f + __expf(-q0)) * 0.125f; sQ[st * 64 + pi + 32] = q1 * __builtin_amdgcn_rcpf(1.f + __expf(-q1)) * 0.125f;
                } else {
                    float z = bias;
#pragma unroll
                    for (int j = 0; j < 4; ++j) { z += bflo(rl0[0][i][j]) * w2c[2 * j] + bfhi(rl0[0][i][j]) * w2c[2 * j + 1]; z += bflo(rl1[0][i][j]) * w2c[8 + 2 * j] + bfhi(rl1[0][i][j]) * w2c[8 + 2 * j + 1]; }
                    const float ls = fminf(z, 0.f) - __logf(1.f + __expf(-fabsf(z)));
                    sA[st * 32 + pi] = __expf(ls * (1.f / 16.f));
                    sK[st * 32 + pi] = bf2f(rk0[0][i]);
                    sQ[st * 32 + pi] = bf2f(rq0[0][i]) * 0.17677669529663687f;
                }
                sV[st * 64 + pi] = bf2f(rv0[0][i]); sV[st * 64 + pi + 32] = bf2f(rv1[0][i]);
            }
            asm volatile("s_waitcnt lgkmcnt(0)" ::: "memory"); __builtin_amdgcn_s_barrier(); asm volatile("" ::: "memory");
            if (blk + 2 < SEQ / TB) SCAN_LOAD(blk + 2, 0);
            for (int s0_ = 0; s0_ < TB; s0_ += GS) {
                float vv[GS]; f32x4 a4[GS][KPW / 4], k4[GS][KPW / 4], q4[GS][KPW / 4];
#pragma unroll
                for (int g = 0; g < GS; ++g) { const int s = s0_ + g; vv[g] = sV[s * 64 + lane];
#pragma unroll
                    for (int j4 = 0; j4 < KPW / 4; ++j4) { a4[g][j4] = *(const LAS f32x4*)(sA + s * DK + wave * KPW + j4 * 4); k4[g][j4] = *(const LAS f32x4*)(sK + s * DK + wave * KPW + j4 * 4); q4[g][j4] = *(const LAS f32x4*)(sQ + s * DK + wave * KPW + j4 * 4); } }
                float po[GS];
#pragma unroll
                for (int g = 0; g < GS; ++g) {
                    f32x2 op = (f32x2){0.f, 0.f};
#pragma unroll
                    for (int j4 = 0; j4 < KPW / 4; ++j4) {
                        const f32x2 kv0 = (f32x2){k4[g][j4][0], k4[g][j4][1]} * vv[g], kv1 = (f32x2){k4[g][j4][2], k4[g][j4][3]} * vv[g];
                        S[2 * j4] = __builtin_elementwise_fma((f32x2){a4[g][j4][0], a4[g][j4][1]}, S[2 * j4], kv0);
                        S[2 * j4 + 1] = __builtin_elementwise_fma((f32x2){a4[g][j4][2], a4[g][j4][3]}, S[2 * j4 + 1], kv1);
                        op = __builtin_elementwise_fma((f32x2){q4[g][j4][0], q4[g][j4][1]}, S[2 * j4], op);
                        op = __builtin_elementwise_fma((f32x2){q4[g][j4][2], q4[g][j4][3]}, S[2 * j4 + 1], op); }
                    po[g] = op[0] + op[1]; }
#pragma unroll
                for (int g = 0; g < GS; ++g) sP[((s0_ + g) * 8 + wave) * 64 + lane] = po[g];
            }
            asm volatile("s_waitcnt lgkmcnt(0)" ::: "memory"); __builtin_amdgcn_s_barrier(); asm volatile("" ::: "memory");
#pragma unroll
            for (int j2 = 0; j2 < NR; ++j2) {
                const int s = wave + 8 * j2; const int tok = dir == 0 ? blk * TB + s : 2047 - (blk * TB + s);
                float sum = 0.f;
#pragma unroll
                for (int w = 0; w < 8; ++w) sum += sP[(s * 8 + w) * 64 + lane];
                oraw[(rowbase + tok) * 512 + (HG ? 0 : 256) + h * 64 + lane] = sum;
            }
            }
            { const int blk = blk2 + 1;
#pragma unroll
            for (int i = 0; i < NS; ++i) {
                const int st = ps + 16 * i;
                if (HG) {
                    const float z0 = bf2f(rz0[1][i]), z1 = bf2f(rz1[1][i]);
                    const float s0 = __builtin_amdgcn_rcpf(1.f + __expf(-z0)), s1 = __builtin_amdgcn_rcpf(1.f + __expf(-z1));
                    sA[st * 64 + pi] = s0 * (1.f + lb0 * __expf(fminf(-z0, 80.f))); sA[st * 64 + pi + 32] = s1 * (1.f + lb1 * __expf(fminf(-z1, 80.f)));
                    sK[st * 64 + pi] = (1.f - lb0) * __builtin_amdgcn_rcpf(1.f + __expf(z0)); sK[st * 64 + pi + 32] = (1.f - lb1) * __builtin_amdgcn_rcpf(1.f + __expf(z1));
                    const float q0 = bf2f(rq0[1][i]), q1 = bf2f(rq1[1][i]);
                    sQ[st * 64 + pi] = q0 * __builtin_amdgcn_rcpf(1.f + __expf(-q0)) * 0.125f; sQ[st * 64 + pi + 32] = q1 * __builtin_amdgcn_rcpf(1.f + __expf(-q1)) * 0.125f;
                } else {
                    float z = bias;
#pragma unroll
                    for (int j = 0; j < 4; ++j) { z += bflo(rl0[1][i][j]) * w2c[2 * j] + bfhi(rl0[1][i][j]) * w2c[2 * j + 1]; z += bflo(rl1[1][i][j]) * w2c[8 + 2 * j] + bfhi(rl1[1][i][j]) * w2c[8 + 2 * j + 1]; }
                    const float ls = fminf(z, 0.f) - __logf(1.f + __expf(-fabsf(z)));
                    sA[st * 32 + pi] = __expf(ls * (1.f / 16.f));
                    sK[st * 32 + pi] = bf2f(rk0[1][i]);
                    sQ[st * 32 + pi] = bf2f(rq0[1][i]) * 0.17677669529663687f;
                }
                sV[st * 64 + pi] = bf2f(rv0[1][i]); sV[st * 64 + pi + 32] = bf2f(rv1[1][i]);
            }
            asm volatile("s_waitcnt lgkmcnt(0)" ::: "memory"); __builtin_amdgcn_s_barrier(); asm volatile("" ::: "memory");
            if (blk + 2 < SEQ / TB) SCAN_LOAD(blk + 2, 1);
            for (int s0_ = 0; s0_ < TB; s0_ += GS) {
                float vv[GS]; f32x4 a4[GS][KPW / 4], k4[GS][KPW / 4], q4[GS][KPW / 4];
#pragma unroll
                for (int g = 0; g < GS; ++g) { const int s = s0_ + g; vv[g] = sV[s * 64 + lane];
#pragma unroll
                    for (int j4 = 0; j4 < KPW / 4; ++j4) { a4[g][j4] = *(const LAS f32x4*)(sA + s * DK + wave * KPW + j4 * 4); k4[g][j4] = *(const LAS f32x4*)(sK + s * DK + wave * KPW + j4 * 4); q4[g][j4] = *(const LAS f32x4*)(sQ + s * DK + wave * KPW + j4 * 4); } }
                float po[GS];
#pragma unroll
                for (int g = 0; g < GS; ++g) {
                    f32x2 op = (f32x2){0.f, 0.f};
#pragma unroll
                    for (int j4 = 0; j4 < KPW / 4; ++j4) {
                        const f32x2 kv0 = (f32x2){k4[g][j4][0], k4[g][j4][1]} * vv[g], kv1 = (f32x2){k4[g][j4][2], k4[g][j4][3]} * vv[g];
                        S[2 * j4] = __builtin_elementwise_fma((f32x2){a4[g][j4][0], a4[g][j4][1]}, S[2 * j4], kv0);
                        S[2 * j4 + 1] = __builtin_elementwise_fma((f32x2){a4[g][j4][2], a4[g][j4][3]}, S[2 * j4 + 1], kv1);
                        op = __builtin_elementwise_fma((f32x2){q4[g][j4][0], q4[g][j4][1]}, S[2 * j4], op);
                        op = __builtin_elementwise_fma((f32x2){q4[g][j4][2], q4[g][j4][3]}, S[2 * j4 + 1], op); }
                    po[g] = op[0] + op[1]; }
#pragma unroll
                for (int g = 0; g < GS; ++g) sP[((s0_ + g) * 8 + wave) * 64 + lane] = po[g];
            }
            asm volatile("s_waitcnt lgkmcnt(0)" ::: "memory"); __builtin_amdgcn_s_barrier(); asm volatile("" ::: "memory");
#pragma unroll
            for (int j2 = 0; j2 < NR; ++j2) {
                const int s = wave + 8 * j2; const int tok = dir == 0 ? blk * TB + s : 2047 - (blk * TB + s);
                float sum = 0.f;
#pragma unroll
                for (int w = 0; w < 8; ++w) sum += sP[(s * 8 + w) * 64 + lane];
                oraw[(rowbase + tok) * 512 + (HG ? 0 : 256) + h * 64 + lane] = sum;
            }
            }
        }
#undef SCAN_LOAD
    }
    asm volatile("s_waitcnt vmcnt(0)" ::: "memory");
    __syncthreads();
    LAS unsigned* flg = (LAS unsigned*)(lds + 147456 - 128);
    if (tid == 0) { __builtin_amdgcn_fence(__ATOMIC_RELEASE, "agent"); asm volatile("s_waitcnt vmcnt(0)" ::: "memory");
        const unsigned old = __hip_atomic_fetch_add(done, 1u, __ATOMIC_RELAXED, __HIP_MEMORY_SCOPE_AGENT);
        __builtin_amdgcn_fence(__ATOMIC_ACQUIRE, "agent"); asm volatile("s_waitcnt vmcnt(0)" ::: "memory");
        flg[0] = old; }
    __syncthreads();
    if (flg[0] == 1u) {
        if (lane == 0 && tid != 0) { __builtin_amdgcn_fence(__ATOMIC_ACQUIRE, "agent"); asm volatile("s_waitcnt vmcnt(0)" ::: "memory"); }
        __syncthreads();
        const float ng = normg[lane];
        for (int t0 = wave * 16; t0 < SEQ; t0 += 128) {
            float fa[16], fb[16]; bf16_t gq[16];
#pragma unroll
            for (int i = 0; i < 16; ++i) { const size_t o = (rowbase + t0 + i) * 512 + (HG ? 0 : 256) + h * 64 + lane;
                fa[i] = __hip_atomic_load(oraw0 + o, __ATOMIC_RELAXED, __HIP_MEMORY_SCOPE_AGENT); fb[i] = __hip_atomic_load(oraw1 + o, __ATOMIC_RELAXED, __HIP_MEMORY_SCOPE_AGENT);
                gq[i] = proj[(rowbase + t0 + i) * LDP + (HG ? BG : GG) + h * 64 + lane]; }
#pragma unroll
            for (int i = 0; i < 16; ++i) {
                const float tot = fa[i] + fb[i];
                const float ssq = wave_sum(tot * tot);
                const float gvv = bf2f(gq[i]);
                const float outv = tot * rsqrtf(ssq * (1.f / 64.f) + EPS) * ng * (gvv * __builtin_amdgcn_rcpf(1.f + __expf(-gvv)));
                ocat[(rowbase + t0 + i) * D + (HG ? 512 : 768) + h * 64 + lane] = (bf16_t)f2bf(outv);
            }
        }
    }
    __syncthreads();
}

__device__ __forceinline__ void norm_rows_mod(const float* src, bf16_t* dst, const float* g, const float* modl  , int grow0, int shoff, int scoff) {
    const int tid = tid_fresh(), lane = tid & 63, gw = blockIdx.x * 8 + __builtin_amdgcn_readfirstlane(tid >> 6), NGW = gridDim.x * 8;
    const f32x4* gr = (const f32x4*)g + lane;
    f32x4 gg[4];
#pragma unroll
    for (int j = 0; j < 4; ++j) gg[j] = gr[64 * j];
    for (int m0 = gw; m0 < TG; m0 += 2 * NGW) {
        f32x4 v[2][4]; float s[2];
#pragma unroll
        for (int e = 0; e < 2; ++e) { const int m = m0 + e * NGW; const f32x4* xr = (const f32x4*)(src + (size_t)m * D) + lane;
#pragma unroll
            for (int j = 0; j < 4; ++j) v[e][j] = xr[64 * j]; }
#pragma unroll
        for (int e = 0; e < 2; ++e) { s[e] = 0.f;
#pragma unroll
            for (int j = 0; j < 4; ++j) s[e] += (v[e][j].x * v[e][j].x + v[e][j].y * v[e][j].y) + (v[e][j].z * v[e][j].z + v[e][j].w * v[e][j].w); }
#pragma unroll
        for (int e = 0; e < 2; ++e) { const int m = m0 + e * NGW; const int b = (grow0 + m) >> 11;
            const f32x4* sh = (const f32x4*)(modl + (size_t)b * (NMOD * D) + shoff) + lane; const f32x4* sc = (const f32x4*)(modl + (size_t)b * (NMOD * D) + scoff) + lane;
            const float r = rsqrtf(wave_sum(s[e]) * (1.f / D) + EPS);
            unsigned long long* o8 = (unsigned long long*)(dst + (size_t)m * D) + lane;
#pragma unroll
            for (int j = 0; j < 4; ++j) { const f32x4 y = v[e][j] * r * gg[j] * (1.f + sc[64 * j]) + sh[64 * j];
                o8[64 * j] = (unsigned long long)pk2(y.x, y.y) | ((unsigned long long)pk2(y.z, y.w) << 32); } }
    }
}
__device__ __forceinline__ void norm_rows_final(float* x, const float* g) {
    const int tid = tid_fresh(), lane = tid & 63, gw = blockIdx.x * 8 + __builtin_amdgcn_readfirstlane(tid >> 6), NGW = gridDim.x * 8;
    for (int m = gw; m < TG; m += NGW) {
        f32x4* xr = (f32x4*)(x + (size_t)m * D) + lane; const f32x4* gr = (const f32x4*)g + lane;
        f32x4 v[4]; float s = 0.f;
#pragma unroll
        for (int j = 0; j < 4; ++j) { v[j] = xr[64 * j]; s += (v[j].x * v[j].x + v[j].y * v[j].y) + (v[j].z * v[j].z + v[j].w * v[j].w); }
        const float r = rsqrtf(wave_sum(s) * (1.f / D) + EPS);
#pragma unroll
        for (int j = 0; j < 4; ++j) xr[64 * j] = v[j] * r * gr[64 * j];
    }
}

__device__ __forceinline__ void transpose_item(const float* W, int ldw, bf16_t* WT, int ldt, int row_off, int k_off, LAS float* scr, int kb, int nb, int lane) {
    const int k0 = 64 * kb, n0 = 32 * nb;
#pragma unroll 8
    for (int i = 0; i < 32; ++i) { const int kk = 2 * i + (lane >> 5); scr[kk * 33 + (lane & 31)] = W[(size_t)(k0 + kk) * ldw + n0 + (lane & 31)]; }
    asm volatile("s_waitcnt lgkmcnt(0)" ::: "memory");
    const int c = lane & 7;
#pragma unroll
    for (int j = 0; j < 4; ++j) { const int n = (lane >> 3) + 8 * j; const LAS float* s = scr + (8 * c) * 33 + n;
        u32x4 o; o.x = pk2(s[0 * 33], s[1 * 33]); o.y = pk2(s[2 * 33], s[3 * 33]); o.z = pk2(s[4 * 33], s[5 * 33]); o.w = pk2(s[6 * 33], s[7 * 33]);
        *(u32x4*)(WT + (size_t)(row_off + n0 + n) * ldt + k_off + k0 + 8 * c) = o; }
    asm volatile("s_waitcnt lgkmcnt(0)" ::: "memory");
}

#define XB_TMO      128
#define XB_XCNT(j)  (256  + 64 * (j))
#define XB_XSUB(j)  (1280 + 64 * (j))
#define XB_XGEN(j)  (2304 + 64 * (j))
#define XB_TOP      3328
#define XB_TOPGEN   3392
#define XCD_BAR_WORDS 3456
#define XB_SPIN_CAP (1u << 18)

__device__ __forceinline__ unsigned xb_ld(unsigned* p)              { return __hip_atomic_load(p, __ATOMIC_RELAXED, __HIP_MEMORY_SCOPE_AGENT); }
__device__ __forceinline__ unsigned xb_add(unsigned* p, unsigned v) { return __hip_atomic_fetch_add(p, v, __ATOMIC_RELAXED, __HIP_MEMORY_SCOPE_AGENT); }
__device__ __forceinline__ unsigned xb_xcc_id() { return (unsigned)__builtin_amdgcn_s_getreg((3 << 11) | 20) & 0xFu; }
#define XB_SPIN(cond, bar) do { unsigned _sp = 0; while (cond) { __builtin_amdgcn_s_sleep(1); \
    if ((++_sp & 255u) == 0u) { if (xb_ld(&(bar)[XB_TMO])) break; if (_sp > XB_SPIN_CAP) { atomicAdd(&(bar)[XB_TMO], 1u); break; } } } } while (0)

struct XcdBarrier {
    unsigned* bar; unsigned x;
    volatile LAS unsigned* st;
};

__device__ __forceinline__ XcdBarrier xcd_barrier_post(unsigned* bar, volatile LAS unsigned* st) {
    XcdBarrier b; b.bar = bar; b.x = xb_xcc_id(); b.st = st;
    if (threadIdx.x == 0) (void)xb_add(&bar[XB_XCNT(b.x)], 1u);
    return b;
}
__device__ __forceinline__ void xcd_barrier_complete(unsigned* bar, unsigned x, unsigned& nloc, unsigned& nx) {
    const unsigned G = gridDim.x * gridDim.y * gridDim.z;
    unsigned sum, cnt, mine, sp = 0u;
    for (;;) {
        sum = 0u; cnt = 0u; mine = 0u;
#pragma unroll
        for (unsigned j = 0; j < 16; ++j) { const unsigned c = xb_ld(&bar[XB_XCNT(j)]); sum += c; cnt += (c > 0u) ? 1u : 0u; mine = (j == x) ? c : mine; }
        if (sum == G) break;
        __builtin_amdgcn_s_sleep(1);
        if ((++sp & 255u) == 0u) { if (xb_ld(&bar[XB_TMO])) break; if (sp > XB_SPIN_CAP) { atomicAdd(&bar[XB_TMO], 1u); break; } }
    }
    nloc = mine > 0u ? mine : 1u; nx = cnt > 0u ? cnt : 1u;
}

__device__ __forceinline__ void xcd_barrier(const XcdBarrier& b) {
    asm volatile("s_waitcnt vmcnt(0)" ::: "memory");
    __syncthreads();
    if (threadIdx.x == 0) {
        unsigned* bar = b.bar;
        __builtin_amdgcn_s_waitcnt(0);
        unsigned nloc = b.st[0], nx = b.st[1];
        if (nloc == 0u) { xcd_barrier_complete(bar, b.x, nloc, nx); b.st[0] = nloc; b.st[1] = nx; }
        const unsigned old = xb_add(&bar[XB_XSUB(b.x)], 1u);
        const unsigned gen = old / nloc;
        if (old + 1u == (gen + 1u) * nloc) {
            __builtin_amdgcn_fence(__ATOMIC_RELEASE, "agent");
            asm volatile("s_waitcnt vmcnt(0)" ::: "memory");
            const unsigned og = xb_add(&bar[XB_TOP], 1u);
            const unsigned tg = og / nx;
            if (og + 1u == (tg + 1u) * nx) xb_add(&bar[XB_TOPGEN], 1u);
            else XB_SPIN(xb_ld(&bar[XB_TOPGEN]) == tg, bar);
            __builtin_amdgcn_fence(__ATOMIC_ACQUIRE, "agent");
            xb_add(&bar[XB_XGEN(b.x)], 1u);
            asm volatile("s_waitcnt vmcnt(0)" ::: "memory");
        } else {
            XB_SPIN(xb_ld(&bar[XB_XGEN(b.x)]) == gen, bar);
            __builtin_amdgcn_fence(__ATOMIC_ACQUIRE, "agent");
            asm volatile("s_waitcnt vmcnt(0)" ::: "memory");
        }
    }
    __syncthreads();
}


constexpr int CW_XBAR = 45056;
#define XSYNC() do { XcdBarrier xb_; xb_.bar = (unsigned*)(KWS() + WS_CTL) + CW_XBAR; xb_.x = xb_xcc_id(); xb_.st = (volatile LAS unsigned*)(lds + 147456 - 256); xcd_barrier(xb_); } while (0)

struct Args { const void* p[24]; };
enum { P_X = 0, P_C, P_ADAW, P_ADAB, P_NMIXG, P_NMLPG, P_WIN, P_DLAM, P_DSUBG, P_HLB, P_HNG, P_GW2, P_GB, P_GNG, P_WUA, P_WUB, P_WUC, P_WOUT, P_W1, P_W2, P_FNG, P_OUT, P_WS };
typedef const unsigned long long __attribute__((address_space(4)))* kargp_t;
__device__ __forceinline__ const void* karg(int i) { kargp_t kp = (kargp_t)__builtin_amdgcn_kernarg_segment_ptr(); asm volatile("" : "+s"(kp));
    const unsigned long long v = kp[i]; const __attribute__((address_space(1))) void* g = (const __attribute__((address_space(1))) void*)v; return (const void*)g; }
#define GRID_SYNC() do { asm volatile("s_waitcnt vmcnt(0) lgkmcnt(0)" ::: "memory"); __syncthreads(); grid.sync(); \
    if (threadIdx.x < 64) { __builtin_amdgcn_fence(__ATOMIC_ACQUIRE, "agent"); asm volatile("s_waitcnt vmcnt(0)" ::: "memory"); } __syncthreads(); } while (0)
#define KF(i) ((const float*)karg(i))
#define KWS() ((uchar*)karg(P_WS))

__global__ void __launch_bounds__(512, 2) fwd_megakernel(Args a_unused) {
    extern __shared__ __attribute__((aligned(16))) uchar lds_raw[];
    LAS uchar* lds = (LAS uchar*)lds_raw;
    cg::grid_group grid = cg::this_grid();
    {
    const int tid = tid_fresh(), lane = tid & 63, wave = __builtin_amdgcn_readfirstlane(tid >> 6);

    if (blockIdx.x == 0) {
        unsigned* ctl = (unsigned*)(KWS() + WS_CTL); float* ctlf = (float*)ctl;
        for (int i = tid; i < 1024; i += 512) { ctl[i] = 0u; ctl[40960 + i] = 0u; }
        for (int i = tid; i < XCD_BAR_WORDS; i += 512) ctl[CW_XBAR + i] = 0u;
        if (tid < 4) {
            const float* lp = KF(P_DLAM) + tid * 256; float s1 = 0.f, s2 = 0.f;
            for (int d = 0; d < 64; ++d) { s1 += lp[d] * lp[64 + d]; s2 += lp[128 + d] * lp[192 + d]; }
            const float li = 0.8f - 0.6f * expf(-0.3f * (float)tid);
            ctlf[1024 + tid] = expf(s1) - expf(s2) + li; ctlf[1028 + tid] = li;
        }
        {
            const float* lg = KF(P_HLB); const int j = tid;
            float v[4], mx = -1e30f;
#pragma unroll
            for (int l = 0; l < 4; ++l) { v[l] = lg[l * 512 + j]; mx = fmaxf(mx, v[l]); }
            float den = 0.f;
#pragma unroll
            for (int l = 0; l < 4; ++l) { v[l] = expf(v[l] - mx); den += v[l]; }
            float cum = 0.f; const float w0 = v[0] / den;
#pragma unroll
            for (int l = 0; l < 4; ++l) { cum += v[l] / den; ctlf[2048 + l * 512 + j] = cum - w0; }
        }
        {
            float* pv = ctlf + 8192;
            const float* s0 = KF(P_NMIXG); for (int i = tid; i < 4096; i += 512) pv[i] = s0[i];
            const float* s1 = KF(P_NMLPG); for (int i = tid; i < 4096; i += 512) pv[4096 + i] = s1[i];
            const float* s2 = KF(P_DSUBG); for (int i = tid; i < 512; i += 512) pv[8192 + i] = s2[i];
            const float* s3 = KF(P_HNG); for (int i = tid; i < 256; i += 512) pv[8704 + i] = s3[i];
            const float* s4 = KF(P_GW2); for (int i = tid; i < 16384; i += 512) pv[8960 + i] = s4[i];
            const float* s5 = KF(P_GB); for (int i = tid; i < 1024; i += 512) pv[25344 + i] = s5[i];
            const float* s6 = KF(P_GNG); for (int i = tid; i < 256; i += 512) pv[26368 + i] = s6[i];
            const float* s7 = KF(P_FNG); for (int i = tid; i < 1024; i += 512) pv[26624 + i] = s7[i];
        }
    }
#ifndef NO_MOD
    {
        LAS float* cond = (LAS float*)lds; LAS float* red = (LAS float*)(lds + 131072);
        float* mod = (float*)(KWS() + WS_MOD);
        const float* cin = KF(P_C); const float* adaw = KF(P_ADAW); const float* adab = KF(P_ADAB);
        bool loaded = false;
        for (int it = blockIdx.x; it < 4 * 96; it += gridDim.x) {
            if (!loaded) { for (int i = tid; i < 32 * 1024; i += 512) { const float cv = cin[i]; cond[i] = cv / (1.f + __expf(-cv)); } loaded = true; __syncthreads(); }
            const int l = it / 96, n0 = (it % 96) * 64;
            const float* W = adaw + (size_t)l * D * (NMOD * D) + n0 + lane;
            float acc[32];
#pragma unroll
            for (int b = 0; b < 32; ++b) acc[b] = 0.f;
            for (int k4 = 0; k4 < 32; ++k4) {
                const int k = wave * 128 + k4 * 4;
                const float w0 = W[(size_t)k * (NMOD * D)], w1 = W[(size_t)(k + 1) * (NMOD * D)], w2v = W[(size_t)(k + 2) * (NMOD * D)], w3 = W[(size_t)(k + 3) * (NMOD * D)];
#pragma unroll
                for (int b = 0; b < 32; ++b) { const f32x4 c4 = *(const LAS f32x4*)(cond + b * 1024 + k); acc[b] += c4.x * w0 + c4.y * w1 + c4.z * w2v + c4.w * w3; }
            }
#pragma unroll
            for (int rd = 0; rd < 4; ++rd) {
                __syncthreads();
#pragma unroll
                for (int bb = 0; bb < 8; ++bb) red[(wave * 8 + bb) * 64 + lane] = acc[rd * 8 + bb];
                __syncthreads();
                float s = 0.f;
#pragma unroll
                for (int w = 0; w < 8; ++w) s += red[(w * 8 + wave) * 64 + lane];
                const int b = rd * 8 + wave;
                mod[((size_t)l * 32 + b) * (NMOD * D) + n0 + lane] = s + adab[l * (NMOD * D) + n0 + lane];
            }
        }
        __syncthreads();
    }
#endif
#ifndef NO_WT
    {
        LAS float* scr = (LAS float*)(lds + wave * 8704);
        const int gw = blockIdx.x * 8 + wave, NGW = gridDim.x * 8;
        uchar* ws = KWS();
        bf16_t* win_t = (bf16_t*)(ws + WS_WIN); bf16_t* wup_t = (bf16_t*)(ws + WS_WUP); bf16_t* wout_t = (bf16_t*)(ws + WS_WOUT);
        bf16_t* w1_t = (bf16_t*)(ws + WS_W1); bf16_t* w2_t = (bf16_t*)(ws + WS_W2);
        constexpr int I_IN = 16 * 209, I_UA = 8 * 32, I_UB = 4 * 32, I_UC = 4 * 32, I_O = 16 * 32, I_1 = 16 * 128, I_2 = 64 * 32;
        constexpr int I_L = I_IN + I_UA + I_UB + I_UC + I_O + I_1 + I_2;
        for (int it = gw; it < 4 * I_L; it += NGW) {
            const int l = it / I_L; int r = it % I_L;
            if (r < I_IN) { transpose_item(KF(P_WIN) + (size_t)l * D * DIN, DIN, win_t + (size_t)l * LDP * D, D, 0, 0, scr, r / 209, r % 209, lane); continue; } r -= I_IN;
            if (r < I_UA) { transpose_item(KF(P_WUA) + (size_t)l * 512 * D, D, wup_t + (size_t)l * D * D, D, 0, 0, scr, r / 32, r % 32, lane); continue; } r -= I_UA;
            if (r < I_UB) { transpose_item(KF(P_WUB) + (size_t)l * 256 * D, D, wup_t + (size_t)l * D * D, D, 0, 512, scr, r / 32, r % 32, lane); continue; } r -= I_UB;
            if (r < I_UC) { transpose_item(KF(P_WUC) + (size_t)l * 256 * D, D, wup_t + (size_t)l * D * D, D, 0, 768, scr, r / 32, r % 32, lane); continue; } r -= I_UC;
            if (r < I_O) { transpose_item(KF(P_WOUT) + (size_t)l * D * D, D, wout_t + (size_t)l * D * D, D, 0, 0, scr, r / 32, r % 32, lane); continue; } r -= I_O;
            if (r < I_1) { transpose_item(KF(P_W1) + (size_t)l * D * DFF, DFF, w1_t + (size_t)l * DFF * D, D, 0, 0, scr, r / 128, r % 128, lane); continue; } r -= I_1;
            transpose_item(KF(P_W2) + (size_t)l * DFF * D, D, w2_t + (size_t)l * D * DFF, DFF, 0, 0, scr, r / 32, r % 32, lane);
        }
        for (int i = blockIdx.x * 512 + tid; i < 4 * 28672; i += gridDim.x * 512) { const int l = i / 28672, r = i % 28672;
            *(u32x4*)(win_t + (size_t)l * LDP * D + (size_t)DIN * D + (size_t)r * 8) = (u32x4){0u, 0u, 0u, 0u}; }
    }
#endif
    }
    GRID_SYNC();
    if (threadIdx.x < 2) ((LAS unsigned*)(lds + 147456 - 256))[threadIdx.x] = 0u;
    (void)xcd_barrier_post((unsigned*)(KWS() + WS_CTL) + CW_XBAR, (volatile LAS unsigned*)(lds + 147456 - 256));

    for (int grp = 0; grp < NGRP; ++grp) {
        for (int l = 0; l < DEPTH; ++l) {
            {
                uchar* ws = KWS(); const float* pv = (const float*)(ws + WS_CTL) + 8192;
                const float* src = (l == 0 ? KF(P_X) : (const float*)karg(P_OUT)) + (size_t)grp * TG * D;
                norm_rows_mod(src, (bf16_t*)(ws + WS_HB), pv + l * D, (const float*)(ws + WS_MOD) + (size_t)l * 32 * (NMOD * D), grp * TG, 0, D);
            }
            XSYNC();
            { uchar* ws = KWS(); pg8::Gemm g{(const bf16_t*)(ws + WS_HB), (const bf16_t*)(ws + WS_WIN) + (size_t)l * LDP * D, D}; pg8::Order S; S.init(TG, LDP, D, gridDim.x, blockIdx.x, 1); pg8::EpiProj E{(bf16_t*)(ws + WS_PROJ), (bf16_t*)(ws + WS_ATT)};
#ifndef NO_EPIPROJ
              pg8::gemm_phase<pg8::EpiProj>(lds, g, S, E);
#endif
            }
            XSYNC();
            {
                uchar* ws = KWS(); const float* ctlf = (const float*)(ws + WS_CTL); const float* pv = ctlf + 8192;
                const int xq = blockIdx.x & 7; unsigned* ctr = (unsigned*)(ws + WS_CTL) + ((grp * DEPTH + l) * 8 + xq) * 4;
                const float lam = ctlf[1024 + l], laminit = ctlf[1028 + l];
                const bf16_t* PROJ = (const bf16_t*)(ws + WS_PROJ); bf16_t* OCAT = (bf16_t*)(ws + WS_OCAT); float* OFWD = (float*)(ws + WS_OFWD);
                LAS int* itm = (LAS int*)(lds + 147456 - 64);
                const int tid = tid_fresh();
                for (;;) {
                    __syncthreads();
                    if (tid == 0) itm[0] = (int)atomicAdd(ctr, 1u);
                    __syncthreads();
                    const int it = itm[0];
                    constexpr int NPQ = GB * 4 / 8;
                    if (it >= 4 * NPQ + NPQ * 16) break;
                    float* OBWD = (float*)(ws + WS_OBWD);
                    if (it < 2 * NPQ) { const int p = (it >> 1) * 8 + xq; unsigned* dn = (unsigned*)(ws + WS_CTL) + 40960 + (((grp * DEPTH + l) * GB * 4 + p) * 2);
                        scan_item<64, true>(lds, PROJ, OFWD, OBWD, OCAT, dn, p >> 2, p & 3, it & 1, ctlf + 2048 + l * 512, pv + 8704 + l * 64, nullptr, nullptr);
                    } else if (it < 4 * NPQ) { const int i2 = it - 2 * NPQ; const int p = (i2 >> 1) * 8 + xq; unsigned* dn = (unsigned*)(ws + WS_CTL) + 40960 + (((grp * DEPTH + l) * GB * 4 + p) * 2 + 1);
                        scan_item<32, false>(lds, PROJ, OFWD, OBWD, OCAT, dn, p >> 2, p & 3, i2 & 1, nullptr, pv + 26368 + l * 64, pv + 8960 + l * 4096, pv + 25344 + l * 256);
                    } else { const int u = it - 4 * NPQ, p = (u >> 4) * 8 + xq;
                        attn_unit(lds, (const bf16_t*)(ws + WS_ATT), OCAT, p >> 2, p & 3, u & 15, lam, laminit, pv + 8192 + l * 128);
                    }
                }
            }
            XSYNC();
            { uchar* ws = KWS(); pg8::Gemm g{(const bf16_t*)(ws + WS_OCAT), (const bf16_t*)(ws + WS_WUP) + (size_t)l * D * D, D}; pg8::Order S; S.init(TG, D, D, gridDim.x, blockIdx.x, 3); pg8::EpiMerge E{(const bf16_t*)(ws + WS_PROJ), (bf16_t*)(ws + WS_HB)};
#ifndef NO_EPIMERGE
              pg8::gemm_phase<pg8::EpiMerge>(lds, g, S, E);
#endif
            }
            XSYNC();
            { uchar* ws = KWS(); pg8::Gemm g{(const bf16_t*)(ws + WS_HB), (const bf16_t*)(ws + WS_WOUT) + (size_t)l * D * D, D}; pg8::Order S; S.init(TG, D, D, gridDim.x, blockIdx.x, 1);
              float* xg = (float*)karg(P_OUT) + (size_t)grp * TG * D;
              pg8::EpiRes E{l == 0 ? KF(P_X) + (size_t)grp * TG * D : xg, xg, (const float*)(ws + WS_MOD) + ((size_t)l * 32 + grp * GB) * (NMOD * D) + 2 * D};
#ifndef NO_EPIRES
              pg8::gemm_phase<pg8::EpiRes>(lds, g, S, E);
#endif
            }
            XSYNC();
            {
                uchar* ws = KWS(); const float* pv = (const float*)(ws + WS_CTL) + 8192;
                norm_rows_mod((const float*)karg(P_OUT) + (size_t)grp * TG * D, (bf16_t*)(ws + WS_HB), pv + 4096 + l * D, (const float*)(ws + WS_MOD) + (size_t)l * 32 * (NMOD * D), grp * TG, 3 * D, 4 * D);
            }
            XSYNC();
            { uchar* ws = KWS(); pg8::Gemm g{(const bf16_t*)(ws + WS_HB), (const bf16_t*)(ws + WS_W1) + (size_t)l * DFF * D, D}; pg8::Order S; S.init(TG, DFF, D, gridDim.x, blockIdx.x, 1); pg8::EpiRelu2 E{(bf16_t*)(ws + WS_U)};
#ifndef NO_EPIRELU2
              pg8::gemm_phase<pg8::EpiRelu2>(lds, g, S, E);
#endif
            }
            XSYNC();
            { uchar* ws = KWS(); pg8::Gemm g{(const bf16_t*)(ws + WS_U), (const bf16_t*)(ws + WS_W2) + (size_t)l * D * DFF, DFF}; pg8::Order S; S.init(TG, D, DFF, gridDim.x, blockIdx.x, 1);
              float* xg = (float*)karg(P_OUT) + (size_t)grp * TG * D;
              pg8::EpiRes E{xg, xg, (const float*)(ws + WS_MOD) + ((size_t)l * 32 + grp * GB) * (NMOD * D) + 5 * D};
#ifndef NO_EPIRES
              pg8::gemm_phase<pg8::EpiRes>(lds, g, S, E);
#endif
            }
            XSYNC();
        }
        norm_rows_final((float*)karg(P_OUT) + (size_t)grp * TG * D, (const float*)(KWS() + WS_CTL) + 8192 + 26624);
    }
}

extern "C" void kernel_launch(void* const* d_in, const int* in_sizes, int n_in, void* d_out, int out_size, void* d_ws, size_t ws_size, hipStream_t stream) {
    static int grid = 0;
    if (grid == 0) {
        if (n_in != 21 || ws_size < WS_END) { fprintf(stderr, "kernel_launch: unexpected n_in %d / ws %zu\n", n_in, ws_size); grid = -1; return; }
        int dev = 0, cus = 0, per_cu = 0;
        if (hipGetDevice(&dev) != hipSuccess || hipDeviceGetAttribute(&cus, hipDeviceAttributeMultiprocessorCount, dev) != hipSuccess) { grid = -1; return; }
        if (hipFuncSetAttribute((const void*)fwd_megakernel, hipFuncAttributeMaxDynamicSharedMemorySize, LDS_BYTES) != hipSuccess) { fprintf(stderr, "kernel_launch: hipFuncSetAttribute failed\n"); grid = -1; return; }
        if (hipOccupancyMaxActiveBlocksPerMultiprocessor(&per_cu, (const void*)fwd_megakernel, 512, LDS_BYTES) != hipSuccess || per_cu < 1) { fprintf(stderr, "kernel_launch: occupancy query says %d\n", per_cu); per_cu = 1; }
        (void)hipGetLastError();
        grid = cus;
    }
    if (grid < 0) return;
    Args a{};
    for (int i = 0; i < 21; ++i) a.p[i] = d_in[i];
    a.p[21] = d_out; a.p[22] = d_ws; a.p[23] = nullptr;
    void* args[] = {&a};
    hipError_t e = hipLaunchCooperativeKernel((void*)fwd_megakernel, dim3(grid), dim3(512), args, LDS_BYTES, stream);
    if (e != hipSuccess) fprintf(stderr, "kernel_launch: cooperative launch failed: %s (grid %d)\n", hipGetErrorString(e), grid);
}
```

```cpp
#include <hip/hip_runtime.h>
#include <hip/hip_cooperative_groups.h>
#include <cstdio>
#include <cstdint>
namespace cg = cooperative_groups;

#define LAS __attribute__((address_space(3)))
typedef unsigned short bf16_t;
typedef short bf16x8 __attribute__((ext_vector_type(8)));
typedef float f32x4 __attribute__((ext_vector_type(4)));
typedef float f32x2 __attribute__((ext_vector_type(2)));
typedef float f32x16 __attribute__((ext_vector_type(16)));
typedef unsigned u32x4 __attribute__((ext_vector_type(4)));
typedef short s16x4 __attribute__((ext_vector_type(4)));
typedef unsigned char uchar;

constexpr int D = 1024, SEQ = 2048, BATCH = 32, DEPTH = 4, DIN = 6688, LDP = 6912, DFF = 4096, NMOD = 6;
constexpr int GB = 16, TG = GB * SEQ, NGRP = BATCH / GB;
constexpr int CQ = 0, CK = 512, CV = 1024, BQ = 1536, BFF = 1792, BFB = 2048, BI = 2304, BG = 2560;
constexpr int GQ = 2816, GK = 2944, GV = 3072, GG = 3328, GLF = 3584, GLB = 3600, GATE = 3616;
constexpr float EPS = 1e-6f, LOG2E = 1.4426950408889634f;
constexpr float QSCALE = 0.125f * LOG2E;

constexpr size_t MiB = 1u << 20;
constexpr size_t WS_CTL = 0;
constexpr size_t WS_MOD = 1 * MiB;
constexpr size_t WS_WIN = 4 * MiB;
constexpr size_t WS_WUP = 58 * MiB;
constexpr size_t WS_WOUT = 66 * MiB;
constexpr size_t WS_W1 = 74 * MiB;
constexpr size_t WS_W2 = 106 * MiB;
constexpr size_t WS_HB = 138 * MiB;
constexpr size_t WS_OCAT = 202 * MiB;
constexpr size_t WS_OFWD = 266 * MiB;
constexpr size_t WS_PROJ = 330 * MiB;
constexpr size_t WS_U = WS_PROJ;
constexpr size_t WS_OBWD = 762 * MiB;
constexpr size_t WS_ATT = 826 * MiB;
constexpr size_t WS_END = 922 * MiB;
constexpr int LDS_BYTES = 148 * 1024;

__device__ __forceinline__ unsigned f2bf(float f) { unsigned u = __builtin_bit_cast(unsigned, f); return (u + 0x7fffu + ((u >> 16) & 1u)) >> 16; }
__device__ __forceinline__ unsigned pk2(float lo, float hi) { return f2bf(lo) | (f2bf(hi) << 16); }
__device__ __forceinline__ float bf2f(bf16_t v) { return __builtin_bit_cast(float, (unsigned)v << 16); }
__device__ __forceinline__ float bflo(unsigned u) { return __builtin_bit_cast(float, u << 16); }
__device__ __forceinline__ float bfhi(unsigned u) { return __builtin_bit_cast(float, u & 0xffff0000u); }
typedef __bf16 bf16x2_t __attribute__((ext_vector_type(2)));
__device__ __forceinline__ unsigned cvt_pk_bf16(float lo, float hi) { f32x2 v = {lo, hi}; bf16x2_t b = __builtin_convertvector(v, bf16x2_t); return __builtin_bit_cast(unsigned, b); }
__device__ __forceinline__ float wave_sum(float v) {
#pragma unroll
    for (int o = 1; o < 64; o <<= 1) v += __shfl_xor(v, o);
    return v;
}
__device__ __forceinline__ int tid_fresh() { int t = threadIdx.x; asm volatile("" : "+v"(t)); return t; }
__device__ __forceinline__ float sigmoidf_(float z) { return 1.f / (1.f + __expf(-z)); }

namespace pg8 {
constexpr int BM = 256, BK = 64, HALF = 128, HTB = HALF * BK * 2, STAGE_BYTES = 8 * HTB, NXCD = 8, WGM = 8;
__host__ __device__ __forceinline__ int lds_byte(int r, int c) { const int st = (r >> 4) * 2 + (c >> 5), rr = r & 15, cc = c & 31, ob = rr * 64 + cc * 2; return st * 1024 + (ob ^ (((ob >> 9) & 1) << 5)); }
__host__ __device__ __forceinline__ void stage_rc(int b, int& R, int& C) { const int st = b / 1024, sb = b % 1024, swz = sb ^ (((sb >> 9) & 1) << 5); R = (st >> 1) * 16 + swz / 64; C = (st & 1) * 32 + (swz % 64) / 2; }
__host__ __device__ __forceinline__ int perm32(int rho) { const int n = rho >> 4, i = rho & 15; return 8 * (i >> 2) + 4 * n + (i & 3); }

struct Unit { int pm, pn, koff, nt, seg; };
struct Gemm { const bf16_t* A; const bf16_t* Bt; int K; };

struct Order {
    int nM, nN, nwg, G, c, nseg, ntfull;
    __device__ void init(int M, int N, int K, int G_, int c_, int nseg_) { nM = M / BM; nN = N / BM; nwg = nM * nN; G = G_; c = c_; nseg = nseg_; ntfull = K / BK; }
    __device__ bool next(int i, Unit& u) const {
        int ti = i, seg = 0;
        if (nseg == 3) { ti = i / 3; seg = i - ti * 3; }
        const long L = (long)ti * G + c; if (L >= nwg) return false;
        int wgid = (int)L; { const int q = nwg / NXCD, r = nwg % NXCD, xcd = wgid % NXCD, off = wgid / NXCD; wgid = (xcd < r ? xcd * (q + 1) : r * (q + 1) + (xcd - r) * q) + off; }
        const int nig = WGM * nN, gid = wgid / nig, fm = gid * WGM, gsz = (nM - fm) < WGM ? (nM - fm) : WGM;
        u.pm = fm + ((wgid % nig) % gsz); u.pn = (wgid % nig) / gsz; u.seg = seg;
        if (nseg == 3) { u.koff = seg == 0 ? 0 : (seg == 1 ? 512 : 768); u.nt = seg == 0 ? 8 : 4; } else { u.koff = 0; u.nt = ntfull; }
        return true;
    }
};

struct EpiProj {
    bf16_t* O; bf16_t* att;
    __device__ __forceinline__ bool zero_after(const Unit&) const { return true; }
    __device__ __forceinline__ void operator()(f32x4 (&acc)[2][2][4][2], const Unit& u, int wr, int wc, int fr, int fq) const {
        const int row0 = u.pm * BM + wr * 64 + fr, col0 = u.pn * BM + wc * 32 + 8 * fq;
        const float sc = (u.pn < 2) ? QSCALE : 1.f;
        const bool toatt = u.pn < 6;
#pragma unroll
        for (int ai = 0; ai < 2; ++ai)
#pragma unroll
            for (int m = 0; m < 4; ++m) { const int row = row0 + ai * HALF + m * 16; bf16_t* rowp = O + (size_t)row * LDP + col0;
#pragma unroll
                for (int bj = 0; bj < 2; ++bj) { f32x4 v0 = acc[ai][bj][m][0] * sc, v1 = acc[ai][bj][m][1] * sc;
                    u32x4 w; w.x = cvt_pk_bf16(v0[0], v0[1]); w.y = cvt_pk_bf16(v0[2], v0[3]); w.z = cvt_pk_bf16(v1[0], v1[1]); w.w = cvt_pk_bf16(v1[2], v1[3]);
                    if (toatt) { const int seg = u.pn * 2 + bj, typ = seg >> 2, hh = seg & 3;
                        *(u32x4*)(att + ((size_t)(((row >> 11) * 4 + hh) * SEQ + (row & 2047))) * 384 + typ * 128 + wc * 32 + 8 * fq) = w; }
                    else *(u32x4*)(rowp + bj * HALF) = w; } }
    }
};
struct EpiRelu2 {
    bf16_t* O;
    __device__ __forceinline__ bool zero_after(const Unit&) const { return true; }
    __device__ __forceinline__ void operator()(f32x4 (&acc)[2][2][4][2], const Unit& u, int wr, int wc, int fr, int fq) const {
        const int row0 = u.pm * BM + wr * 64 + fr, col0 = u.pn * BM + wc * 32 + 8 * fq;
#pragma unroll
        for (int ai = 0; ai < 2; ++ai)
#pragma unroll
            for (int m = 0; m < 4; ++m) { bf16_t* rowp = O + (size_t)(row0 + ai * HALF + m * 16) * DFF + col0;
#pragma unroll
                for (int bj = 0; bj < 2; ++bj) { f32x4 v0 = acc[ai][bj][m][0], v1 = acc[ai][bj][m][1];
#pragma unroll
                    for (int j = 0; j < 4; ++j) { float a = fmaxf(v0[j], 0.f), b = fmaxf(v1[j], 0.f); v0[j] = a * a; v1[j] = b * b; }
                    u32x4 w; w.x = cvt_pk_bf16(v0[0], v0[1]); w.y = cvt_pk_bf16(v0[2], v0[3]); w.z = cvt_pk_bf16(v1[0], v1[1]); w.w = cvt_pk_bf16(v1[2], v1[3]);
                    *(u32x4*)(rowp + bj * HALF) = w; } }
    }
};
struct EpiRes {
    const float* base; float* out; const float* gate;
    __device__ __forceinline__ bool zero_after(const Unit&) const { return true; }
    __device__ __forceinline__ void operator()(f32x4 (&acc)[2][2][4][2], const Unit& u, int wr, int wc, int fr, int fq) const {
        const int row0 = u.pm * BM + wr * 64 + fr, col0 = u.pn * BM + wc * 32 + 8 * fq;
        const float* gp = gate + (size_t)((u.pm * BM) >> 11) * (NMOD * D) + col0;
#pragma unroll
        for (int bj = 0; bj < 2; ++bj) {
            const f32x4 g0 = *(const f32x4*)(gp + bj * HALF), g1 = *(const f32x4*)(gp + bj * HALF + 4);
#pragma unroll
            for (int ai = 0; ai < 2; ++ai) {
#pragma unroll
                for (int m = 0; m < 4; ++m) { const size_t off = (size_t)(row0 + ai * HALF + m * 16) * D + col0 + bj * HALF;
                    const f32x4 b0 = *(const f32x4*)(base + off), b1 = *(const f32x4*)(base + off + 4);
                    *(f32x4*)(out + off) = b0 + g0 * acc[ai][bj][m][0];
                    *(f32x4*)(out + off + 4) = b1 + g1 * acc[ai][bj][m][1];
                    if (m & 1) asm volatile("" ::: "memory"); }
            }
        }
    }
};
struct EpiMerge {
    const bf16_t* proj; bf16_t* O;
    __device__ __forceinline__ bool zero_after(const Unit& u) const { return u.seg == 2; }
    __device__ __forceinline__ void operator()(f32x4 (&acc)[2][2][4][2], const Unit& u, int wr, int wc, int fr, int fq) const {
        const int row0 = u.pm * BM + wr * 64 + fr, col0 = u.pn * BM + wc * 32 + 8 * fq;
        const int seg = u.seg;
#pragma unroll
        for (int ai = 0; ai < 2; ++ai)
#pragma unroll
            for (int m = 0; m < 4; ++m) { const size_t row = (size_t)(row0 + ai * HALF + m * 16); const bf16_t* gp = proj + row * LDP + GATE + col0;
#pragma unroll
                for (int bj = 0; bj < 2; ++bj) {
                    if (seg < 2) {
                        const u32x4 ga = *(const u32x4*)(gp + seg * D + bj * HALF), gb = *(const u32x4*)(gp + (seg + 1) * D + bj * HALF);
                        float r[8];
#pragma unroll
                        for (int j = 0; j < 4; ++j) {
                            const float a0 = fminf(fmaxf(bflo(ga[j]), -40.f), 40.f), a1 = fminf(fmaxf(bfhi(ga[j]), -40.f), 40.f);
                            const float b0 = fminf(fmaxf(bflo(gb[j]), -40.f), 40.f), b1 = fminf(fmaxf(bfhi(gb[j]), -40.f), 40.f);
                            r[2 * j] = (1.f + __expf(-b0)) * __builtin_amdgcn_rcpf(1.f + __expf(-a0));
                            r[2 * j + 1] = (1.f + __expf(-b1)) * __builtin_amdgcn_rcpf(1.f + __expf(-a1)); }
                        acc[ai][bj][m][0] = acc[ai][bj][m][0] * (f32x4){r[0], r[1], r[2], r[3]};
                        acc[ai][bj][m][1] = acc[ai][bj][m][1] * (f32x4){r[4], r[5], r[6], r[7]};
                    } else {
                        const u32x4 gc = *(const u32x4*)(gp + 2 * D + bj * HALF);
                        float r[8];
#pragma unroll
                        for (int j = 0; j < 4; ++j) {
                            const float c0 = fminf(fmaxf(bflo(gc[j]), -40.f), 40.f), c1 = fminf(fmaxf(bfhi(gc[j]), -40.f), 40.f);
                            r[2 * j] = __builtin_amdgcn_rcpf(1.f + __expf(-c0)); r[2 * j + 1] = __builtin_amdgcn_rcpf(1.f + __expf(-c1)); }
                        const f32x4 v0 = acc[ai][bj][m][0] * (f32x4){r[0], r[1], r[2], r[3]}, v1 = acc[ai][bj][m][1] * (f32x4){r[4], r[5], r[6], r[7]};
                        u32x4 w; w.x = cvt_pk_bf16(v0[0], v0[1]); w.y = cvt_pk_bf16(v0[2], v0[3]); w.z = cvt_pk_bf16(v1[0], v1[1]); w.w = cvt_pk_bf16(v1[2], v1[3]);
                        *(u32x4*)(O + row * D + col0 + bj * HALF) = w;
                    } } }
    }
};

template <class Epi, bool ALIGN_EPI = true>
__device__ __forceinline__ void gemm_phase(LAS uchar* lds, const Gemm g, const Order& S, const Epi& E) {
    const int tid = tid_fresh(), wid = __builtin_amdgcn_readfirstlane(tid >> 6), lane = tid & 63, wr = wid >> 2, wc = wid & 3, fr = lane & 15, fq = lane >> 4;
    const int K = g.K;
    unsigned voffA[2], voffB[2];
#pragma unroll
    for (int i = 0; i < 2; ++i) { int R, C; stage_rc(tid * 16 + i * 8192, R, C); const int Rb = (R & ~31) + perm32(R & 31);
        voffA[i] = (unsigned)(R * K + C) * 2u; voffB[i] = (unsigned)(Rb * K + C) * 2u; }
    const size_t kstep = (size_t)(BK * 2);
    const size_t hstep = (size_t)HALF * K * 2;
    const size_t tstep = 2 * hstep;
    const unsigned ldsw = (unsigned)wid * 1024u;
    const int aoff = lds_byte(wr * 64 + fr, fq * 8), boff = lds_byte(wc * 32 + fr, fq * 8);
#define PG8_SA(b, h) (((b) * 2 + (h)) * HTB)
#define PG8_SB(b, h) ((4 + (b) * 2 + (h)) * HTB)
#define PG8_STAGE(bufoff, gbase, voff) do { _Pragma("unroll") for (int _i = 0; _i < 2; ++_i) \
        __builtin_amdgcn_global_load_lds((const unsigned*)((const char*)(gbase) + (voff)[_i]), (LAS unsigned*)(lds + (bufoff) + ldsw + _i * 8192), 16, 0, 0); } while (0)
#define PG8_LDA(dst, b, h) do { _Pragma("unroll") for (int m = 0; m < 4; ++m) _Pragma("unroll") for (int k = 0; k < 2; ++k) dst[m][k] = *(const LAS bf16x8*)(lds + PG8_SA(b, h) + aoff + m * 2048 + k * 1024); } while (0)
#define PG8_LDB(dst, b, h) do { _Pragma("unroll") for (int n = 0; n < 2; ++n) _Pragma("unroll") for (int k = 0; k < 2; ++k) dst[n][k] = *(const LAS bf16x8*)(lds + PG8_SB(b, h) + boff + n * 2048 + k * 1024); } while (0)
#define PG8_MMA(ai, bj, At, Bt) do { __builtin_amdgcn_s_setprio(1); _Pragma("unroll") for (int m = 0; m < 4; ++m) _Pragma("unroll") for (int n = 0; n < 2; ++n) _Pragma("unroll") for (int k = 0; k < 2; ++k) \
        acc[ai][bj][m][n] = __builtin_amdgcn_mfma_f32_16x16x32_bf16(Bt[n][k], At[m][k], acc[ai][bj][m][n], 0, 0, 0); __builtin_amdgcn_s_setprio(0); } while (0)
#define PG8_WAIT_V(n) asm volatile("s_waitcnt vmcnt(" #n ")" ::: "memory")
#define PG8_WAIT_L(n) asm volatile("s_waitcnt lgkmcnt(" #n ")" ::: "memory")
#define PG8_BAR __builtin_amdgcn_s_barrier()
#define PG8_SCHED __builtin_amdgcn_sched_barrier(0)
    Unit cur, nxt; int ui = 0;
    if (!S.next(0, cur)) return;
    f32x4 acc[2][2][4][2];
#pragma unroll
    for (int a = 0; a < 2; ++a)
#pragma unroll
        for (int b = 0; b < 2; ++b)
#pragma unroll
            for (int m = 0; m < 4; ++m)
#pragma unroll
                for (int n = 0; n < 2; ++n) acc[a][b][m][n] = (f32x4){0.f, 0.f, 0.f, 0.f};
    bf16x8 At[4][2], B0[2][2], B1[2][2];
    const char* cA = (const char*)g.A + (size_t)cur.pm * tstep + (size_t)cur.koff * 2; const char* cB = (const char*)g.Bt + (size_t)cur.pn * tstep + (size_t)cur.koff * 2;
    PG8_STAGE(PG8_SB(0, 0), cB, voffB); PG8_STAGE(PG8_SB(0, 1), cB + hstep, voffB); PG8_STAGE(PG8_SA(0, 0), cA, voffA); PG8_STAGE(PG8_SA(0, 1), cA + hstep, voffA);
    if (wr == 1) PG8_BAR;
    PG8_WAIT_V(2); PG8_BAR;
    PG8_STAGE(PG8_SB(1, 0), cB + kstep, voffB); PG8_STAGE(PG8_SA(1, 0), cA + kstep, voffA); PG8_STAGE(PG8_SB(1, 1), cB + hstep + kstep, voffB);
    PG8_WAIT_V(6); PG8_BAR;
    for (;;) {
        const bool has_next = S.next(ui + 1, nxt);
        const char* nA = has_next ? (const char*)g.A + (size_t)nxt.pm * tstep + (size_t)nxt.koff * 2 : cA; const char* nB = has_next ? (const char*)g.Bt + (size_t)nxt.pn * tstep + (size_t)nxt.koff * 2 : cB;
        const int nt = cur.nt;
        for (int t = 0; t < nt; t += 2) {
            const bool last = (t == nt - 2);
            const char* a1 = cA + (size_t)(t + 1) * kstep;
            const char* a2 = last ? nA : cA + (size_t)(t + 2) * kstep; const char* b2 = last ? nB : cB + (size_t)(t + 2) * kstep;
            const char* a3 = a2 + kstep; const char* b3 = b2 + kstep;
            PG8_LDB(B0, 0, 0); PG8_LDB(B1, 0, 1); PG8_SCHED; PG8_LDA(At, 0, 0); PG8_STAGE(PG8_SA(1, 1), a1 + hstep, voffA);
            PG8_WAIT_V(8); PG8_WAIT_L(0); PG8_BAR; PG8_MMA(0, 0, At, B0); PG8_MMA(0, 1, At, B1); PG8_BAR; PG8_SCHED;
            PG8_LDA(At, 0, 1); PG8_STAGE(PG8_SB(0, 0), b2, voffB); PG8_STAGE(PG8_SB(0, 1), b2 + hstep, voffB); PG8_STAGE(PG8_SA(0, 0), a2, voffA);
            PG8_WAIT_V(8); PG8_WAIT_L(0); PG8_BAR; PG8_MMA(1, 0, At, B0); PG8_MMA(1, 1, At, B1); PG8_BAR; PG8_SCHED;
            PG8_LDB(B0, 1, 0); PG8_LDB(B1, 1, 1); PG8_SCHED; PG8_LDA(At, 1, 0); PG8_STAGE(PG8_SA(0, 1), a2 + hstep, voffA);
            PG8_WAIT_V(8); PG8_WAIT_L(0); PG8_BAR; PG8_MMA(0, 0, At, B0); PG8_MMA(0, 1, At, B1); PG8_BAR; PG8_SCHED;
            PG8_LDA(At, 1, 1); PG8_STAGE(PG8_SB(1, 0), b3, voffB); PG8_STAGE(PG8_SB(1, 1), b3 + hstep, voffB); PG8_STAGE(PG8_SA(1, 0), a3, voffA);
            PG8_WAIT_V(8); PG8_WAIT_L(0); PG8_BAR; PG8_MMA(1, 0, At, B0); PG8_MMA(1, 1, At, B1); PG8_BAR; PG8_SCHED;
        }
        if constexpr (ALIGN_EPI) { if (wr == 0) PG8_BAR; }
        E(acc, cur, wr, wc, fr, fq);
        if (!has_next) break;
        if (E.zero_after(cur)) {
#pragma unroll
            for (int a = 0; a < 2; ++a)
#pragma unroll
                for (int b = 0; b < 2; ++b)
#pragma unroll
                    for (int m = 0; m < 4; ++m)
#pragma unroll
                        for (int n = 0; n < 2; ++n) acc[a][b][m][n] = (f32x4){0.f, 0.f, 0.f, 0.f};
        }
        cur = nxt; cA = nA; cB = nB; ++ui;
        if constexpr (ALIGN_EPI) { if (wr == 1) PG8_BAR; }
    }
    PG8_WAIT_V(0);
    if constexpr (!ALIGN_EPI) { if (wr == 0) PG8_BAR; }
    PG8_BAR;
#undef PG8_SA
#undef PG8_SB
#undef PG8_STAGE
#undef PG8_LDA
#undef PG8_LDB
#undef PG8_MMA
#undef PG8_WAIT_V
#undef PG8_WAIT_L
#undef PG8_BAR
#undef PG8_SCHED
}
}

__device__ __forceinline__ int crow(int r, int hi) { return (r & 3) + 8 * (r >> 2) + 4 * hi; }
__device__ __forceinline__ s16x4 vtr(const LAS uchar* p) { return __builtin_bit_cast(s16x4, __builtin_amdgcn_ds_read_tr16_b64_v4i16((LAS s16x4*)p)); }
__device__ __forceinline__ float xhalf_max(float m) { auto rr = __builtin_amdgcn_permlane32_swap(__builtin_bit_cast(unsigned, m), __builtin_bit_cast(unsigned, m), false, false); return fmaxf(__builtin_bit_cast(float, rr[0]), __builtin_bit_cast(float, rr[1])); }
__device__ __forceinline__ float xhalf_sum(float m) { auto rr = __builtin_amdgcn_permlane32_swap(__builtin_bit_cast(unsigned, m), __builtin_bit_cast(unsigned, m), false, false); return __builtin_bit_cast(float, rr[0]) + __builtin_bit_cast(float, rr[1]); }

__device__ __forceinline__ void glds16(const void* gsrc, unsigned lds_dst) { unsigned keep;
    asm volatile("s_mov_b32 %0, m0\n\ts_mov_b32 m0, %2\n\ts_nop 0\n\tglobal_load_lds_dwordx4 %1, off\n\ts_mov_b32 m0, %0" : "=&s"(keep) : "v"(gsrc), "s"(lds_dst) : "memory"); }
constexpr int ATT_SLOT = 32768, ATT_WSF = 131072;
__device__ __forceinline__ void attn_unit(LAS uchar* lds, const bf16_t* proj, bf16_t* ocat, int bl, int h, int qb, float lam, float laminit, const float* sg) {
    const int tid = tid_fresh(), lane = tid & 63, r32 = lane & 31, hi = lane >> 5;
    const int wave = __builtin_amdgcn_readfirstlane(tid >> 6), mi = wave >> 2, rb = wave & 3;
    const size_t rowbase = (size_t)bl * SEQ;
    const int q0 = qb * 128 + rb * 32;
#define UNI(x) __builtin_bit_cast(float, __builtin_amdgcn_readfirstlane(__builtin_bit_cast(int, (float)(x))))
    const float m2 = UNI(exp2f(-2.f * (float)(h + 1)) * LOG2E);
    lam = UNI(lam); laminit = UNI(laminit);
#undef UNI
    bf16x8 qf[4];
    const bf16_t* att = proj;
    const size_t hb = (size_t)(bl * 4 + h) * SEQ;
    { const bf16_t* qp = att + (hb + q0 + r32) * 384 + mi * 64 + hi * 8;
#pragma unroll
      for (int d0 = 0; d0 < 4; ++d0) qf[d0] = *(const bf16x8*)(qp + d0 * 16); }
    const int kkey = 4 * wave + (lane >> 4);
    const bf16_t* ksrc0 = att + (hb + kkey) * 384 + 128 + (((lane & 15) ^ (kkey & 15)) * 8);
    const bf16_t* ksrc1 = ksrc0 + (size_t)32 * 384;
    const bf16_t* vsrc0 = att + (hb + 16 * (wave & 3) + (lane >> 2)) * 384 + 256 + (wave >> 2) * 32 + (lane & 3) * 8;
    const bf16_t* vsrc1 = vsrc0 + 64;
    const unsigned lds0 = (unsigned)(uintptr_t)lds + (unsigned)wave * 1024u;
#define ATT_ISSUE(t, sb) do { const size_t go_ = (size_t)(t) * 64 * 384; const unsigned d_ = (unsigned)__builtin_amdgcn_readfirstlane((int)(lds0 + (unsigned)(sb))); \
        glds16(ksrc0 + go_, d_); glds16(ksrc1 + go_, d_ + 8192u); glds16(vsrc0 + go_, d_ + 16384u); glds16(vsrc1 + go_, d_ + 24576u); } while (0)
    LAS float* wsf = (LAS float*)(lds + ATT_WSF) + wave * 64;
    f32x16 o[4];
#pragma unroll
    for (int d = 0; d < 4; ++d)
#pragma unroll
        for (int r = 0; r < 16; ++r) o[d][r] = 0.f;
    float mhat = 0.f;
    f32x16 ol;
#pragma unroll
    for (int r = 0; r < 16; ++r) ol[r] = 0.f;
    const bf16x8 ones = (bf16x8){0x3F80, 0x3F80, 0x3F80, 0x3F80, 0x3F80, 0x3F80, 0x3F80, 0x3F80};
    const int vfo = 16384 + ((lane >> 4) & 1) * 32 + (lane & 3) * 8 + (4 * hi + ((lane & 15) >> 2)) * 64;
    ATT_ISSUE(0, 0); ATT_ISSUE(1, ATT_SLOT);
    u32x4 pw[4];
#pragma unroll
    for (int k = 0; k < 4; ++k) pw[k] = (u32x4){0u, 0u, 0u, 0u};
    bool zflag = false;
#define ATT_VLD(i, L, H) do { L = vtr(sv_ + vfo + ((i) >> 2) * 4096 + ((i) & 3) * 1024); H = vtr(sv_ + vfo + ((i) >> 2) * 4096 + ((i) & 3) * 1024 + 512); } while (0)
#define ATT_PV(SLP) do { const LAS uchar* sv_ = (SLP); s16x4 fl_[3], fh_[3]; __builtin_amdgcn_s_setprio(1); \
        ATT_VLD(0, fl_[0], fh_[0]); ATT_VLD(1, fl_[1], fh_[1]); __builtin_amdgcn_sched_group_barrier(0x100, 4, 0); \
        _Pragma("unroll") for (int i = 0; i < 16; ++i) { \
            if (i + 2 < 16) ATT_VLD(i + 2, fl_[(i + 2) % 3], fh_[(i + 2) % 3]); \
            const s16x4 lo = fl_[i % 3], hh = fh_[i % 3]; \
            const bf16x8 vf = (bf16x8){lo[0], lo[1], lo[2], lo[3], hh[0], hh[1], hh[2], hh[3]}; \
            o[i >> 2] = __builtin_amdgcn_mfma_f32_32x32x16_bf16(__builtin_bit_cast(bf16x8, pw[i & 3]), vf, o[i >> 2], 0, 0, 0); \
            __builtin_amdgcn_sched_group_barrier(0x8, 1, 0); __builtin_amdgcn_sched_group_barrier(0x100, 2, 0); } \
        _Pragma("unroll") for (int ks = 0; ks < 4; ++ks) ol = __builtin_amdgcn_mfma_f32_32x32x16_bf16(__builtin_bit_cast(bf16x8, pw[ks]), ones, ol, 0, 0, 0); \
        __builtin_amdgcn_s_setprio(0); } while (0)
    for (int t = 0; t <= SEQ / 64; ++t) {
        if (t < SEQ / 64) {
            if (t + 1 < SEQ / 64) asm volatile("s_waitcnt vmcnt(4) lgkmcnt(0)" ::: "memory"); else asm volatile("s_waitcnt vmcnt(0) lgkmcnt(0)" ::: "memory");
            __builtin_amdgcn_s_barrier();
            asm volatile("" ::: "memory");
            if (t + 2 < SEQ / 64) ATT_ISSUE(t + 2, ((t + 2) & 3) * ATT_SLOT);
        }
        if (mi == 1 && t > 0 && !zflag) ATT_PV(lds + ((t - 1) & 3) * ATT_SLOT);
        if (t < SEQ / 64) {
            const LAS uchar* sl = lds + (t & 3) * ATT_SLOT;
        const float dq = (float)(q0 + r32 - 64 * t - 4 * hi);
        f32x16 p0, p1;
        const int side = (64 * t + 63 < q0) ? 1 : ((64 * t > q0 + 31) ? -1 : 0);
        if (side != 0) {
            const float sm = side > 0 ? m2 : -m2; const float base = __builtin_fmaf(-sm, dq, -mhat);
#pragma unroll
            for (int r = 0; r < 16; ++r) { const float kc = (float)((r & 3) + 8 * (r >> 2));
                p0[r] = __builtin_fmaf(sm, kc, base); p1[r] = __builtin_fmaf(sm, kc + 32.f, base); }
        } else {
#pragma unroll
            for (int r = 0; r < 16; ++r) { const float kc = (float)((r & 3) + 8 * (r >> 2));
                p0[r] = __builtin_fmaf(-m2, __builtin_fabsf(dq - kc), -mhat); p1[r] = __builtin_fmaf(-m2, __builtin_fabsf(dq - kc - 32.f), -mhat); }
        }
        int r32l = r32; asm volatile("" : "+v"(r32l));
        __builtin_amdgcn_s_setprio(1);
#pragma unroll
        for (int d0 = 0; d0 < 4; ++d0) {
            const int kfo_ = r32l * 256 + (((mi * 8 + 2 * d0 + hi) ^ (r32l & 15)) * 16);
            const bf16x8 a0 = *(const LAS bf16x8*)(sl + kfo_), a1 = *(const LAS bf16x8*)(sl + kfo_ + 8192);
            p0 = __builtin_amdgcn_mfma_f32_32x32x16_bf16(a0, qf[d0], p0, 0, 0, 0);
            p1 = __builtin_amdgcn_mfma_f32_32x32x16_bf16(a1, qf[d0], p1, 0, 0, 0); }
        __builtin_amdgcn_s_setprio(0);
        float rm = fmaxf(p0[0], p1[0]);
#pragma unroll
        for (int r = 1; r < 16; ++r) rm = fmaxf(rm, fmaxf(p0[r], p1[r]));
        rm = xhalf_max(rm);
        const bool first = (t == 0);
        zflag = !first && !__any(rm >= -150.f);
        if (!zflag) {
        if (first || __any(rm > 60.f)) {
            const float dl = first ? rm : fmaxf(rm, 0.f);
            mhat += dl;
#pragma unroll
            for (int r = 0; r < 16; ++r) { p0[r] -= dl; p1[r] -= dl; }
            if (!first) {
                const float f = __builtin_amdgcn_exp2f(-dl);
                if (hi == 0) wsf[r32] = f;
                float fr_[16];
#pragma unroll
                for (int r = 0; r < 16; ++r) fr_[r] = wsf[crow(r, hi)];
#pragma unroll
                for (int d = 0; d < 4; ++d)
#pragma unroll
                    for (int r = 0; r < 16; ++r) o[d][r] *= fr_[r];
#pragma unroll
                for (int r = 0; r < 16; ++r) ol[r] *= fr_[r];
            }
        }
#pragma unroll
        for (int r = 0; r < 16; ++r) { p0[r] = __builtin_amdgcn_exp2f(p0[r]); p1[r] = __builtin_amdgcn_exp2f(p1[r]); }
#pragma unroll
        for (int j = 0; j < 4; ++j) { pw[0][j] = cvt_pk_bf16(p0[2 * j], p0[2 * j + 1]); pw[1][j] = cvt_pk_bf16(p0[8 + 2 * j], p0[8 + 2 * j + 1]);
                                      pw[2][j] = cvt_pk_bf16(p1[2 * j], p1[2 * j + 1]); pw[3][j] = cvt_pk_bf16(p1[8 + 2 * j], p1[8 + 2 * j + 1]); }
        }
            if (mi == 0 && !zflag) ATT_PV(sl);
        }
    }
#undef ATT_PV
#undef ATT_VLD
#undef ATT_ISSUE
    float fr_[16];
#pragma unroll
    for (int r = 0; r < 16; ++r) fr_[r] = (mi == 0 ? 1.f : lam) / ol[r];
    __syncthreads();
    LAS float* X = (LAS float*)lds + rb * 4096;
    if (mi == 1) {
#pragma unroll
        for (int d = 0; d < 4; ++d)
#pragma unroll
            for (int r = 0; r < 16; ++r) X[(d * 16 + r) * 64 + lane] = o[d][r] * fr_[r];
    }
    __syncthreads();
    if (mi == 0) {
        float ss[16];
#pragma unroll
        for (int r = 0; r < 16; ++r) ss[r] = 0.f;
#pragma unroll
        for (int d = 0; d < 4; ++d)
#pragma unroll
            for (int r = 0; r < 16; ++r) { const float v = o[d][r] * fr_[r] - X[(d * 16 + r) * 64 + lane]; o[d][r] = v; ss[r] += v * v; }
#pragma unroll
        for (int r = 0; r < 16; ++r) {
#pragma unroll
            for (int s = 1; s < 32; s <<= 1) ss[r] += __shfl_xor(ss[r], s);
            ss[r] = rsqrtf(ss[r] * (1.f / 128.f) + EPS) * (1.f - laminit); }
        float gv[4];
#pragma unroll
        for (int d = 0; d < 4; ++d) gv[d] = sg[d * 32 + r32];
#pragma unroll
        for (int r = 0; r < 16; ++r) { bf16_t* op = ocat + (rowbase + q0 + crow(r, hi)) * D + h * 128 + r32;
#pragma unroll
            for (int d = 0; d < 4; ++d) op[d * 32] = (bf16_t)f2bf(o[d][r] * ss[r] * gv[d]); }
    }
    __syncthreads();
}

template <int DK, bool HG>
__device__ __forceinline__ void scan_item(LAS uchar* lds, const bf16_t* proj, float* oraw0, float* oraw1, bf16_t* ocat, unsigned* done, int bl, int h, int dir, const float* lb  ,
                                          const float* normg  , const float* w2  , const float* gbias  ) {
    constexpr int KPW = DK / 8, TB = 32, NS = TB / 16, NR = TB / 8, GS = 4;
    LAS float* sA = (LAS float*)lds;
    LAS float* sK = sA + TB * DK;
    LAS float* sQ = sK + TB * DK;
    LAS float* sV = sQ + TB * DK;
    LAS float* sP = sV + TB * 64;
    const int tid = tid_fresh(), lane = tid & 63, wave = __builtin_amdgcn_readfirstlane(tid >> 6);
    const int ps = tid >> 5, pi = tid & 31;
    const size_t rowbase = (size_t)bl * SEQ;
    float* oraw = dir == 0 ? oraw0 : oraw1;
    __syncthreads();
    {
        float lb0 = 0.f, lb1 = 0.f, w2c[16], bias = 0.f;
        if (HG) { lb0 = lb[dir * 256 + h * 64 + pi]; lb1 = lb[dir * 256 + h * 64 + pi + 32]; }
        else {
#pragma unroll
            for (int r = 0; r < 16; ++r) w2c[r] = w2[(dir * 16 + r) * 128 + h * 32 + pi];
            bias = gbias[dir * 128 + h * 32 + pi]; }
        f32x2 S[KPW / 2];
#pragma unroll
        for (int j = 0; j < KPW / 2; ++j) S[j] = (f32x2){0.f, 0.f};
        bf16_t rz0[2][NS], rz1[2][NS], rq0[2][NS], rq1[2][NS], rv0[2][NS], rv1[2][NS], rk0[2][NS]; u32x4 rl0[2][NS], rl1[2][NS];
#pragma unroll
        for (int i = 0; i < NS; ++i) for (int e = 0; e < 2; ++e) { rz0[e][i] = rz1[e][i] = rq0[e][i] = rq1[e][i] = rv0[e][i] = rv1[e][i] = rk0[e][i] = 0; rl0[e][i] = rl1[e][i] = (u32x4){0, 0, 0, 0}; }
#define SCAN_LOAD(blk, E_) do { _Pragma("unroll") for (int i_ = 0; i_ < NS; ++i_) { const int st_ = (blk) * TB + ps + 16 * i_; const int tok_ = dir == 0 ? st_ : 2047 - st_; const bf16_t* pr_ = proj + (rowbase + tok_) * LDP; \
        if (HG) { const int zc_ = (dir == 0 ? BFF : BFB) + h * 64 + pi; rz0[E_][i_] = pr_[zc_]; rz1[E_][i_] = pr_[zc_ + 32]; rq0[E_][i_] = pr_[BQ + h * 64 + pi]; rq1[E_][i_] = pr_[BQ + h * 64 + pi + 32]; rv0[E_][i_] = pr_[BI + h * 64 + pi]; rv1[E_][i_] = pr_[BI + h * 64 + pi + 32]; } \
        else { const u32x4* lp_ = (const u32x4*)(pr_ + (dir == 0 ? GLF : GLB)); rl0[E_][i_] = lp_[0]; rl1[E_][i_] = lp_[1]; rk0[E_][i_] = pr_[GK + h * 32 + pi]; rq0[E_][i_] = pr_[GQ + h * 32 + pi]; rv0[E_][i_] = pr_[GV + h * 64 + pi]; rv1[E_][i_] = pr_[GV + h * 64 + pi + 32]; } } } while (0)
        SCAN_LOAD(0, 0); SCAN_LOAD(1, 1);
        for (int blk2 = 0; blk2 < SEQ / TB; blk2 += 2) {
            { const int blk = blk2;
#pragma unroll
            for (int i = 0; i < NS; ++i) {
                const int st = ps + 16 * i;
                if (HG) {
                    const float z0 = bf2f(rz0[0][i]), z1 = bf2f(rz1[0][i]);
                    const float s0 = __builtin_amdgcn_rcpf(1.f + __expf(-z0)), s1 = __builtin_amdgcn_rcpf(1.f + __expf(-z1));
                    sA[st * 64 + pi] = s0 * (1.f + lb0 * __expf(fminf(-z0, 80.f))); sA[st * 64 + pi + 32] = s1 * (1.f + lb1 * __expf(fminf(-z1, 80.f)));
                    sK[st * 64 + pi] = (1.f - lb0) * __builtin_amdgcn_rcpf(1.f + __expf(z0)); sK[st * 64 + pi + 32] = (1.f - lb1) * __builtin_amdgcn_rcpf(1.f + __expf(z1));
                    const float q0 = bf2f(rq0[0][i]), q1 = bf2f(rq1[0][i]);
                    sQ[st * 64 + pi] = q0 * __builtin_amdgcn_rcpf(1.f + __expf(-q0)) * 0.125f; sQ[st * 64 + pi + 32] = q1 * __builtin_amdgcn_rcpf(1.f + __expf(-q1)) * 0.125f;
                } else {
                    float z = bias;
#pragma unroll
                    for (int j = 0; j < 4; ++j) { z += bflo(rl0[0][i][j]) * w2c[2 * j] + bfhi(rl0[0][i][j]) * w2c[2 * j + 1]; z += bflo(rl1[0][i][j]) * w2c[8 + 2 * j] + bfhi(rl1[0][i][j]) * w2c[8 + 2 * j + 1]; }
                    const float ls = fminf(z, 0.f) - __logf(1.f + __expf(-fabsf(z)));
                    sA[st * 32 + pi] = __expf(ls * (1.f / 16.f));
                    sK[st * 32 + pi] = bf2f(rk0[0][i]);
                    sQ[st * 32 + pi] = bf2f(rq0[0][i]) * 0.17677669529663687f;
                }
                sV[st * 64 + pi] = bf2f(rv0[0][i]); sV[st * 64 + pi + 32] = bf2f(rv1[0][i]);
            }
            asm volatile("s_waitcnt lgkmcnt(0)" ::: "memory"); __builtin_amdgcn_s_barrier(); asm volatile("" ::: "memory");
            if (blk + 2 < SEQ / TB) SCAN_LOAD(blk + 2, 0);
            for (int s0_ = 0; s0_ < TB; s0_ += GS) {
                float vv[GS]; f32x4 a4[GS][KPW / 4], k4[GS][KPW / 4], q4[GS][KPW / 4];
#pragma unroll
                for (int g = 0; g < GS; ++g) { const int s = s0_ + g; vv[g] = sV[s * 64 + lane];
#pragma unroll
                    for (int j4 = 0; j4 < KPW / 4; ++j4) { a4[g][j4] = *(const LAS f32x4*)(sA + s * DK + wave * KPW + j4 * 4); k4[g][j4] = *(const LAS f32x4*)(sK + s * DK + wave * KPW + j4 * 4); q4[g][j4] = *(const LAS f32x4*)(sQ + s * DK + wave * KPW + j4 * 4); } }
                float po[GS];
#pragma unroll
                for (int g = 0; g < GS; ++g) {
                    f32x2 op = (f32x2){0.f, 0.f};
#pragma unroll
                    for (int j4 = 0; j4 < KPW / 4; ++j4) {
                        const f32x2 kv0 = (f32x2){k4[g][j4][0], k4[g][j4][1]} * vv[g], kv1 = (f32x2){k4[g][j4][2], k4[g][j4][3]} * vv[g];
                        S[2 * j4] = __builtin_elementwise_fma((f32x2){a4[g][j4][0], a4[g][j4][1]}, S[2 * j4], kv0);
                        S[2 * j4 + 1] = __builtin_elementwise_fma((f32x2){a4[g][j4][2], a4[g][j4][3]}, S[2 * j4 + 1], kv1);
                        op = __builtin_elementwise_fma((f32x2){q4[g][j4][0], q4[g][j4][1]}, S[2 * j4], op);
                        op = __builtin_elementwise_fma((f32x2){q4[g][j4][2], q4[g][j4][3]}, S[2 * j4 + 1], op); }
                    po[g] = op[0] + op[1]; }
#pragma unroll
                for (int g = 0; g < GS; ++g) sP[((s0_ + g) * 8 + wave) * 64 + lane] = po[g];
            }
            asm volatile("s_waitcnt lgkmcnt(0)" ::: "memory"); __builtin_amdgcn_s_barrier(); asm volatile("" ::: "memory");
#pragma unroll
            for (int j2 = 0; j2 < NR; ++j2) {
                const int s = wave + 8 * j2; const int tok = dir == 0 ? blk * TB + s : 2047 - (blk * TB + s);
                float sum = 0.f;
#pragma unroll
                for (int w = 0; w < 8; ++w) sum += sP[(s * 8 + w) * 64 + lane];
                oraw[(rowbase + tok) * 512 + (HG ? 0 : 256) + h * 64 + lane] = sum;
            }
            }
            { const int blk = blk2 + 1;
#pragma unroll
            for (int i = 0; i < NS; ++i) {
                const int st = ps + 16 * i;
                if (HG) {
                    const float z0 = bf2f(rz0[1][i]), z1 = bf2f(rz1[1][i]);
                    const float s0 = __builtin_amdgcn_rcpf(1.f + __expf(-z0)), s1 = __builtin_amdgcn_rcpf(1.f + __expf(-z1));
                    sA[st * 64 + pi] = s0 * (1.f + lb0 * __expf(fminf(-z0, 80.f))); sA[st * 64 + pi + 32] = s1 * (1.f + lb1 * __expf(fminf(-z1, 80.f)));
                    sK[st * 64 + pi] = (1.f - lb0) * __builtin_amdgcn_rcpf(1.f + __expf(z0)); sK[st * 64 + pi + 32] = (1.f - lb1) * __builtin_amdgcn_rcpf(1.f + __expf(z1));
                    const float q0 = bf2f(rq0[1][i]), q1 = bf2f(rq1[1][i]);
                    sQ[st * 64 + pi] = q0 * __builtin_amdgcn_rcpf(1.f + __expf(-q0)) * 0.125f; sQ[st * 64 + pi + 32] = q1 * __builtin_amdgcn_rcpf(1.f + __expf(-q1)) * 0.125f;
                } else {
                    float z = bias;
#pragma unroll
                    for (int j = 0; j < 4; ++j) { z += bflo(rl0[1][i][j]) * w2c[2 * j] + bfhi(rl0[1][i][j]) * w2c[2 * j + 1]; z += bflo(rl1[1][i][j]) * w2c[8 + 2 * j] + bfhi(rl1[1][i][j]) * w2c[8 + 2 * j + 1]; }
                    const float ls = fminf(z, 0.f) - __logf(1.f + __expf(-fabsf(z)));
                    sA[st * 32 + pi] = __expf(ls * (1.f / 16.f));
                    sK[st * 32 + pi] = bf2f(rk0[1][i]);
                    sQ[st * 32 + pi] = bf2f(rq0[1][i]) * 0.17677669529663687f;
                }
                sV[st * 64 + pi] = bf2f(rv0[1][i]); sV[st * 64 + pi + 32] = bf2f(rv1[1][i]);
            }
            asm volatile("s_waitcnt lgkmcnt(0)" ::: "memory"); __builtin_amdgcn_s_barrier(); asm volatile("" ::: "memory");
            if (blk + 2 < SEQ / TB) SCAN_LOAD(blk + 2, 1);
            for (int s0_ = 0; s0_ < TB; s0_ += GS) {
                float vv[GS]; f32x4 a4[GS][KPW / 4], k4[GS][KPW / 4], q4[GS][KPW / 4];
#pragma unroll
                for (int g = 0; g < GS; ++g) { const int s = s0_ + g; vv[g] = sV[s * 64 + lane];
#pragma unroll
                    for (int j4 = 0; j4 < KPW / 4; ++j4) { a4[g][j4] = *(const LAS f32x4*)(sA + s * DK + wave * KPW + j4 * 4); k4[g][j4] = *(const LAS f32x4*)(sK + s * DK + wave * KPW + j4 * 4); q4[g][j4] = *(const LAS f32x4*)(sQ + s * DK + wave * KPW + j4 * 4); } }
                float po[GS];
#pragma unroll
                for (int g = 0; g < GS; ++g) {
                    f32x2 op = (f32x2){0.f, 0.f};
#pragma unroll
                    for (int j4 = 0; j4 < KPW / 4; ++j4) {
                        const f32x2 kv0 = (f32x2){k4[g][j4][0], k4[g][j4][1]} * vv[g], kv1 = (f32x2){k4[g][j4][2], k4[g][j4][3]} * vv[g];
                        S[2 * j4] = __builtin_elementwise_fma((f32x2){a4[g][j4][0], a4[g][j4][1]}, S[2 * j4], kv0);
                        S[2 * j4 + 1] = __builtin_elementwise_fma((f32x2){a4[g][j4][2], a4[g][j4][3]}, S[2 * j4 + 1], kv1);
                        op = __builtin_elementwise_fma((f32x2){q4[g][j4][0], q4[g][j4][1]}, S[2 * j4], op);
                        op = __builtin_elementwise_fma((f32x2){q4[g][j4][2], q4[g][j4][3]}, S[2 * j4 + 1], op); }
                    po[g] = op[0] + op[1]; }
#pragma unroll
                for (int g = 0; g < GS; ++g) sP[((s0_ + g) * 8 + wave) * 64 + lane] = po[g];
            }
            asm volatile("s_waitcnt lgkmcnt(0)" ::: "memory"); __builtin_amdgcn_s_barrier(); asm volatile("" ::: "memory");
#pragma unroll
            for (int j2 = 0; j2 < NR; ++j2) {
                const int s = wave + 8 * j2; const int tok = dir == 0 ? blk * TB + s : 2047 - (blk * TB + s);
                float sum = 0.f;
#pragma unroll
                for (int w = 0; w < 8; ++w) sum += sP[(s * 8 + w) * 64 + lane];
                oraw[(rowbase + tok) * 512 + (HG ? 0 : 256) + h * 64 + lane] = sum;
            }
            }
        }
#undef SCAN_LOAD
    }
    asm volatile("s_waitcnt vmcnt(0)" ::: "memory");
    __syncthreads();
    LAS unsigned* flg = (LAS unsigned*)(lds + 147456 - 128);
    if (tid == 0) { __builtin_amdgcn_fence(__ATOMIC_RELEASE, "agent"); asm volatile("s_waitcnt vmcnt(0)" ::: "memory");
        const unsigned old = __hip_atomic_fetch_add(done, 1u, __ATOMIC_RELAXED, __HIP_MEMORY_SCOPE_AGENT);
        __builtin_amdgcn_fence(__ATOMIC_ACQUIRE, "agent"); asm volatile("s_waitcnt vmcnt(0)" ::: "memory");
        flg[0] = old; }
    __syncthreads();
    if (flg[0] == 1u) {
        if (lane == 0 && tid != 0) { __builtin_amdgcn_fence(__ATOMIC_ACQUIRE, "agent"); asm volatile("s_waitcnt vmcnt(0)" ::: "memory"); }
        __syncthreads();
        const float ng = normg[lane];
        for (int t0 = wave * 16; t0 < SEQ; t0 += 128) {
            float fa[16], fb[16]; bf16_t gq[16];
#pragma unroll
            for (int i = 0; i < 16; ++i) { const size_t o = (rowbase + t0 + i) * 512 + (HG ? 0 : 256) + h * 64 + lane;
                fa[i] = __hip_atomic_load(oraw0 + o, __ATOMIC_RELAXED, __HIP_MEMORY_SCOPE_AGENT); fb[i] = __hip_atomic_load(oraw1 + o, __ATOMIC_RELAXED, __HIP_MEMORY_SCOPE_AGENT);
                gq[i] = proj[(rowbase + t0 + i) * LDP + (HG ? BG : GG) + h * 64 + lane]; }
#pragma unroll
            for (int i = 0; i < 16; ++i) {
                const float tot = fa[i] + fb[i];
                const float ssq = wave_sum(tot * tot);
                const float gvv = bf2f(gq[i]);
                const float outv = tot * rsqrtf(ssq * (1.f / 64.f) + EPS) * ng * (gvv * __builtin_amdgcn_rcpf(1.f + __expf(-gvv)));
                ocat[(rowbase + t0 + i) * D + (HG ? 512 : 768) + h * 64 + lane] = (bf16_t)f2bf(outv);
            }
        }
    }
    __syncthreads();
}

__device__ __forceinline__ void norm_rows_mod(const float* src, bf16_t* dst, const float* g, const float* modl  , int grow0, int shoff, int scoff) {
    const int tid = tid_fresh(), lane = tid & 63, gw = blockIdx.x * 8 + __builtin_amdgcn_readfirstlane(tid >> 6), NGW = gridDim.x * 8;
    const f32x4* gr = (const f32x4*)g + lane;
    f32x4 gg[4];
#pragma unroll
    for (int j = 0; j < 4; ++j) gg[j] = gr[64 * j];
    for (int m0 = gw; m0 < TG; m0 += 2 * NGW) {
        f32x4 v[2][4]; float s[2];
#pragma unroll
        for (int e = 0; e < 2; ++e) { const int m = m0 + e * NGW; const f32x4* xr = (const f32x4*)(src + (size_t)m * D) + lane;
#pragma unroll
            for (int j = 0; j < 4; ++j) v[e][j] = xr[64 * j]; }
#pragma unroll
        for (int e = 0; e < 2; ++e) { s[e] = 0.f;
#pragma unroll
            for (int j = 0; j < 4; ++j) s[e] += (v[e][j].x * v[e][j].x + v[e][j].y * v[e][j].y) + (v[e][j].z * v[e][j].z + v[e][j].w * v[e][j].w); }
#pragma unroll
        for (int e = 0; e < 2; ++e) { const int m = m0 + e * NGW; const int b = (grow0 + m) >> 11;
            const f32x4* sh = (const f32x4*)(modl + (size_t)b * (NMOD * D) + shoff) + lane; const f32x4* sc = (const f32x4*)(modl + (size_t)b * (NMOD * D) + scoff) + lane;
            const float r = rsqrtf(wave_sum(s[e]) * (1.f / D) + EPS);
            unsigned long long* o8 = (unsigned long long*)(dst + (size_t)m * D) + lane;
#pragma unroll
            for (int j = 0; j < 4; ++j) { const f32x4 y = v[e][j] * r * gg[j] * (1.f + sc[64 * j]) + sh[64 * j];
                o8[64 * j] = (unsigned long long)pk2(y.x, y.y) | ((unsigned long long)pk2(y.z, y.w) << 32); } }
    }
}
__device__ __forceinline__ void norm_rows_final(float* x, const float* g) {
    const int tid = tid_fresh(), lane = tid & 63, gw = blockIdx.x * 8 + __builtin_amdgcn_readfirstlane(tid >> 6), NGW = gridDim.x * 8;
    for (int m = gw; m < TG; m += NGW) {
        f32x4* xr = (f32x4*)(x + (size_t)m * D) + lane; const f32x4* gr = (const f32x4*)g + lane;
        f32x4 v[4]; float s = 0.f;
#pragma unroll
        for (int j = 0; j < 4; ++j) { v[j] = xr[64 * j]; s += (v[j].x * v[j].x + v[j].y * v[j].y) + (v[j].z * v[j].z + v[j].w * v[j].w); }
        const float r = rsqrtf(wave_sum(s) * (1.f / D) + EPS);
#pragma unroll
        for (int j = 0; j < 4; ++j) xr[64 * j] = v[j] * r * gr[64 * j];
    }
}

__device__ __forceinline__ void transpose_item(const float* W, int ldw, bf16_t* WT, int ldt, int row_off, int k_off, LAS float* scr, int kb, int nb, int lane) {
    const int k0 = 64 * kb, n0 = 32 * nb;
#pragma unroll 8
    for (int i = 0; i < 32; ++i) { const int kk = 2 * i + (lane >> 5); scr[kk * 33 + (lane & 31)] = W[(size_t)(k0 + kk) * ldw + n0 + (lane & 31)]; }
    asm volatile("s_waitcnt lgkmcnt(0)" ::: "memory");
    const int c = lane & 7;
#pragma unroll
    for (int j = 0; j < 4; ++j) { const int n = (lane >> 3) + 8 * j; const LAS float* s = scr + (8 * c) * 33 + n;
        u32x4 o; o.x = pk2(s[0 * 33], s[1 * 33]); o.y = pk2(s[2 * 33], s[3 * 33]); o.z = pk2(s[4 * 33], s[5 * 33]); o.w = pk2(s[6 * 33], s[7 * 33]);
        *(u32x4*)(WT + (size_t)(row_off + n0 + n) * ldt + k_off + k0 + 8 * c) = o; }
    asm volatile("s_waitcnt lgkmcnt(0)" ::: "memory");
}

#define XB_TMO      128
#define XB_XCNT(j)  (256  + 64 * (j))
#define XB_XSUB(j)  (1280 + 64 * (j))
#define XB_XGEN(j)  (2304 + 64 * (j))
#define XB_TOP      3328
#define XB_TOPGEN   3392
#define XCD_BAR_WORDS 3456
#define XB_SPIN_CAP (1u << 18)

__device__ __forceinline__ unsigned xb_ld(unsigned* p)              { return __hip_atomic_load(p, __ATOMIC_RELAXED, __HIP_MEMORY_SCOPE_AGENT); }
__device__ __forceinline__ unsigned xb_add(unsigned* p, unsigned v) { return __hip_atomic_fetch_add(p, v, __ATOMIC_RELAXED, __HIP_MEMORY_SCOPE_AGENT); }
__device__ __forceinline__ unsigned xb_xcc_id() { return (unsigned)__builtin_amdgcn_s_getreg((3 << 11) | 20) & 0xFu; }
#define XB_SPIN(cond, bar) do { unsigned _sp = 0; while (cond) { __builtin_amdgcn_s_sleep(1); \
    if ((++_sp & 255u) == 0u) { if (xb_ld(&(bar)[XB_TMO])) break; if (_sp > XB_SPIN_CAP) { atomicAdd(&(bar)[XB_TMO], 1u); break; } } } } while (0)

struct XcdBarrier {
    unsigned* bar; unsigned x;
    volatile LAS unsigned* st;
};

__device__ __forceinline__ XcdBarrier xcd_barrier_post(unsigned* bar, volatile LAS unsigned* st) {
    XcdBarrier b; b.bar = bar; b.x = xb_xcc_id(); b.st = st;
    if (threadIdx.x == 0) (void)xb_add(&bar[XB_XCNT(b.x)], 1u);
    return b;
}
__device__ __forceinline__ void xcd_barrier_complete(unsigned* bar, unsigned x, unsigned& nloc, unsigned& nx) {
    const unsigned G = gridDim.x * gridDim.y * gridDim.z;
    unsigned sum, cnt, mine, sp = 0u;
    for (;;) {
        sum = 0u; cnt = 0u; mine = 0u;
#pragma unroll
        for (unsigned j = 0; j < 16; ++j) { const unsigned c = xb_ld(&bar[XB_XCNT(j)]); sum += c; cnt += (c > 0u) ? 1u : 0u; mine = (j == x) ? c : mine; }
        if (sum == G) break;
        __builtin_amdgcn_s_sleep(1);
        if ((++sp & 255u) == 0u) { if (xb_ld(&bar[XB_TMO])) break; if (sp > XB_SPIN_CAP) { atomicAdd(&bar[XB_TMO], 1u); break; } }
    }
    nloc = mine > 0u ? mine : 1u; nx = cnt > 0u ? cnt : 1u;
}

__device__ __forceinline__ void xcd_barrier(const XcdBarrier& b) {
    asm volatile("s_waitcnt vmcnt(0)" ::: "memory");
    __syncthreads();
    if (threadIdx.x == 0) {
        unsigned* bar = b.bar;
        __builtin_amdgcn_s_waitcnt(0);
        unsigned nloc = b.st[0], nx = b.st[1];
        if (nloc == 0u) { xcd_barrier_complete(bar, b.x, nloc, nx); b.st[0] = nloc; b.st[1] = nx; }
        const unsigned old = xb_add(&bar[XB_XSUB(b.x)], 1u);
        const unsigned gen = old / nloc;
        if (old + 1u == (gen + 1u) * nloc) {
            __builtin_amdgcn_fence(__ATOMIC_RELEASE, "agent");
            asm volatile("s_waitcnt vmcnt(0)" ::: "memory");
            const unsigned og = xb_add(&bar[XB_TOP], 1u);
            const unsigned tg = og / nx;
            if (og + 1u == (tg + 1u) * nx) xb_add(&bar[XB_TOPGEN], 1u);
            else XB_SPIN(xb_ld(&bar[XB_TOPGEN]) == tg, bar);
            __builtin_amdgcn_fence(__ATOMIC_ACQUIRE, "agent");
            xb_add(&bar[XB_XGEN(b.x)], 1u);
            asm volatile("s_waitcnt vmcnt(0)" ::: "memory");
        } else {
            XB_SPIN(xb_ld(&bar[XB_XGEN(b.x)]) == gen, bar);
            __builtin_amdgcn_fence(__ATOMIC_ACQUIRE, "agent");
            asm volatile("s_waitcnt vmcnt(0)" ::: "memory");
        }
    }
    __syncthreads();
}


constexpr int CW_XBAR = 45056;
#define XSYNC() do { XcdBarrier xb_; xb_.bar = (unsigned*)(KWS() + WS_CTL) + CW_XBAR; xb_.x = xb_xcc_id(); xb_.st = (volatile LAS unsigned*)(lds + 147456 - 256); xcd_barrier(xb_); } while (0)

struct Args { const void* p[24]; };
enum { P_X = 0, P_C, P_ADAW, P_ADAB, P_NMIXG, P_NMLPG, P_WIN, P_DLAM, P_DSUBG, P_HLB, P_HNG, P_GW2, P_GB, P_GNG, P_WUA, P_WUB, P_WUC, P_WOUT, P_W1, P_W2, P_FNG, P_OUT, P_WS };
typedef const unsigned long long __attribute__((address_space(4)))* kargp_t;
__device__ __forceinline__ const void* karg(int i) { kargp_t kp = (kargp_t)__builtin_amdgcn_kernarg_segment_ptr(); asm volatile("" : "+s"(kp));
    const unsigned long long v = kp[i]; const __attribute__((address_space(1))) void* g = (const __attribute__((address_space(1))) void*)v; return (const void*)g; }
#define GRID_SYNC() do { asm volatile("s_waitcnt vmcnt(0) lgkmcnt(0)" ::: "memory"); __syncthreads(); grid.sync(); \
    if (threadIdx.x < 64) { __builtin_amdgcn_fence(__ATOMIC_ACQUIRE, "agent"); asm volatile("s_waitcnt vmcnt(0)" ::: "memory"); } __syncthreads(); } while (0)
#define KF(i) ((const float*)karg(i))
#define KWS() ((uchar*)karg(P_WS))

__global__ void __launch_bounds__(512, 2) fwd_megakernel(Args a_unused) {
    extern __shared__ __attribute__((aligned(16))) uchar lds_raw[];
    LAS uchar* lds = (LAS uchar*)lds_raw;
    cg::grid_group grid = cg::this_grid();
    {
    const int tid = tid_fresh(), lane = tid & 63, wave = __builtin_amdgcn_readfirstlane(tid >> 6);

    if (blockIdx.x == 0) {
        unsigned* ctl = (unsigned*)(KWS() + WS_CTL); float* ctlf = (float*)ctl;
        for (int i = tid; i < 1024; i += 512) { ctl[i] = 0u; ctl[40960 + i] = 0u; }
        for (int i = tid; i < XCD_BAR_WORDS; i += 512) ctl[CW_XBAR + i] = 0u;
        if (tid < 4) {
            const float* lp = KF(P_DLAM) + tid * 256; float s1 = 0.f, s2 = 0.f;
            for (int d = 0; d < 64; ++d) { s1 += lp[d] * lp[64 + d]; s2 += lp[128 + d] * lp[192 + d]; }
            const float li = 0.8f - 0.6f * expf(-0.3f * (float)tid);
            ctlf[1024 + tid] = expf(s1) - expf(s2) + li; ctlf[1028 + tid] = li;
        }
        {
            const float* lg = KF(P_HLB); const int j = tid;
            float v[4], mx = -1e30f;
#pragma unroll
            for (int l = 0; l < 4; ++l) { v[l] = lg[l * 512 + j]; mx = fmaxf(mx, v[l]); }
            float den = 0.f;
#pragma unroll
            for (int l = 0; l < 4; ++l) { v[l] = expf(v[l] - mx); den += v[l]; }
            float cum = 0.f; const float w0 = v[0] / den;
#pragma unroll
            for (int l = 0; l < 4; ++l) { cum += v[l] / den; ctlf[2048 + l * 512 + j] = cum - w0; }
        }
        {
            float* pv = ctlf + 8192;
            const float* s0 = KF(P_NMIXG); for (int i = tid; i < 4096; i += 512) pv[i] = s0[i];
            const float* s1 = KF(P_NMLPG); for (int i = tid; i < 4096; i += 512) pv[4096 + i] = s1[i];
            const float* s2 = KF(P_DSUBG); for (int i = tid; i < 512; i += 512) pv[8192 + i] = s2[i];
            const float* s3 = KF(P_HNG); for (int i = tid; i < 256; i += 512) pv[8704 + i] = s3[i];
            const float* s4 = KF(P_GW2); for (int i = tid; i < 16384; i += 512) pv[8960 + i] = s4[i];
            const float* s5 = KF(P_GB); for (int i = tid; i < 1024; i += 512) pv[25344 + i] = s5[i];
            const float* s6 = KF(P_GNG); for (int i = tid; i < 256; i += 512) pv[26368 + i] = s6[i];
            const float* s7 = KF(P_FNG); for (int i = tid; i < 1024; i += 512) pv[26624 + i] = s7[i];
        }
    }
#ifndef NO_MOD
    {
        LAS float* cond = (LAS float*)lds; LAS float* red = (LAS float*)(lds + 131072);
        float* mod = (float*)(KWS() + WS_MOD);
        const float* cin = KF(P_C); const float* adaw = KF(P_ADAW); const float* adab = KF(P_ADAB);
        bool loaded = false;
        for (int it = blockIdx.x; it < 4 * 96; it += gridDim.x) {
            if (!loaded) { for (int i = tid; i < 32 * 1024; i += 512) { const float cv = cin[i]; cond[i] = cv / (1.f + __expf(-cv)); } loaded = true; __syncthreads(); }
            const int l = it / 96, n0 = (it % 96) * 64;
            const float* W = adaw + (size_t)l * D * (NMOD * D) + n0 + lane;
            float acc[32];
#pragma unroll
            for (int b = 0; b < 32; ++b) acc[b] = 0.f;
            for (int k4 = 0; k4 < 32; ++k4) {
                const int k = wave * 128 + k4 * 4;
                const float w0 = W[(size_t)k * (NMOD * D)], w1 = W[(size_t)(k + 1) * (NMOD * D)], w2v = W[(size_t)(k + 2) * (NMOD * D)], w3 = W[(size_t)(k + 3) * (NMOD * D)];
#pragma unroll
                for (int b = 0; b < 32; ++b) { const f32x4 c4 = *(const LAS f32x4*)(cond + b * 1024 + k); acc[b] += c4.x * w0 + c4.y * w1 + c4.z * w2v + c4.w * w3; }
            }
#pragma unroll
            for (int rd = 0; rd < 4; ++rd) {
                __syncthreads();
#pragma unroll
                for (int bb = 0; bb < 8; ++bb) red[(wave * 8 + bb) * 64 + lane] = acc[rd * 8 + bb];
                __syncthreads();
                float s = 0.f;
#pragma unroll
                for (int w = 0; w < 8; ++w) s += red[(w * 8 + wave) * 64 + lane];
                const int b = rd * 8 + wave;
                mod[((size_t)l * 32 + b) * (NMOD * D) + n0 + lane] = s + adab[l * (NMOD * D) + n0 + lane];
            }
        }
        __syncthreads();
    }
#endif
#ifndef NO_WT
    {
        LAS float* scr = (LAS float*)(lds + wave * 8704);
        const int gw = blockIdx.x * 8 + wave, NGW = gridDim.x * 8;
        uchar* ws = KWS();
        bf16_t* win_t = (bf16_t*)(ws + WS_WIN); bf16_t* wup_t = (bf16_t*)(ws + WS_WUP); bf16_t* wout_t = (bf16_t*)(ws + WS_WOUT);
        bf16_t* w1_t = (bf16_t*)(ws + WS_W1); bf16_t* w2_t = (bf16_t*)(ws + WS_W2);
        constexpr int I_IN = 16 * 209, I_UA = 8 * 32, I_UB = 4 * 32, I_UC = 4 * 32, I_O = 16 * 32, I_1 = 16 * 128, I_2 = 64 * 32;
        constexpr int I_L = I_IN + I_UA + I_UB + I_UC + I_O + I_1 + I_2;
        for (int it = gw; it < 4 * I_L; it += NGW) {
            const int l = it / I_L; int r = it % I_L;
            if (r < I_IN) { transpose_item(KF(P_WIN) + (size_t)l * D * DIN, DIN, win_t + (size_t)l * LDP * D, D, 0, 0, scr, r / 209, r % 209, lane); continue; } r -= I_IN;
            if (r < I_UA) { transpose_item(KF(P_WUA) + (size_t)l * 512 * D, D, wup_t + (size_t)l * D * D, D, 0, 0, scr, r / 32, r % 32, lane); continue; } r -= I_UA;
            if (r < I_UB) { transpose_item(KF(P_WUB) + (size_t)l * 256 * D, D, wup_t + (size_t)l * D * D, D, 0, 512, scr, r / 32, r % 32, lane); continue; } r -= I_UB;
            if (r < I_UC) { transpose_item(KF(P_WUC) + (size_t)l * 256 * D, D, wup_t + (size_t)l * D * D, D, 0, 768, scr, r / 32, r % 32, lane); continue; } r -= I_UC;
            if (r < I_O) { transpose_item(KF(P_WOUT) + (size_t)l * D * D, D, wout_t + (size_t)l * D * D, D, 0, 0, scr, r / 32, r % 32, lane); continue; } r -= I_O;
            if (r < I_1) { transpose_item(KF(P_W1) + (size_t)l * D * DFF, DFF, w1_t + (size_t)l * DFF * D, D, 0, 0, scr, r / 128, r % 128, lane); continue; } r -= I_1;
            transpose_item(KF(P_W2) + (size_t)l * DFF * D, D, w2_t + (size_t)l * D * DFF, DFF, 0, 0, scr, r / 32, r % 32, lane);
        }
        for (int i = blockIdx.x * 512 + tid; i < 4 * 28672; i += gridDim.x * 512) { const int l = i / 28672, r = i % 28672;
            *(u32x4*)(win_t + (size_t)l * LDP * D + (size_t)DIN * D + (size_t)r * 8) = (u32x4){0u, 0u, 0u, 0u}; }
    }
#endif
    }
    GRID_SYNC();
    if (threadIdx.x < 2) ((LAS unsigned*)(lds + 147456 - 256))[threadIdx.x] = 0u;
    (void)xcd_barrier_post((unsigned*)(KWS() + WS_CTL) + CW_XBAR, (volatile LAS unsigned*)(lds + 147456 - 256));

    for (int grp = 0; grp < NGRP; ++grp) {
        for (int l = 0; l < DEPTH; ++l) {
            {
                uchar* ws = KWS(); const float* pv = (const float*)(ws + WS_CTL) + 8192;
                const float* src = (l == 0 ? KF(P_X) : (const float*)karg(P_OUT)) + (size_t)grp * TG * D;
                norm_rows_mod(src, (bf16_t*)(ws + WS_HB), pv + l * D, (const float*)(ws + WS_MOD) + (size_t)l * 32 * (NMOD * D), grp * TG, 0, D);
            }
            XSYNC();
            { uchar* ws = KWS(); pg8::Gemm g{(const bf16_t*)(ws + WS_HB), (const bf16_t*)(ws + WS_WIN) + (size_t)l * LDP * D, D}; pg8::Order S; S.init(TG, LDP, D, gridDim.x, blockIdx.x, 1); pg8::EpiProj E{(bf16_t*)(ws + WS_PROJ), (bf16_t*)(ws + WS_ATT)};
#ifndef NO_EPIPROJ
              pg8::gemm_phase<pg8::EpiProj>(lds, g, S, E);
#endif
            }
            XSYNC();
            {
                uchar* ws = KWS(); const float* ctlf = (const float*)(ws + WS_CTL); const float* pv = ctlf + 8192;
                const int xq = blockIdx.x & 7; unsigned* ctr = (unsigned*)(ws + WS_CTL) + ((grp * DEPTH + l) * 8 + xq) * 4;
                const float lam = ctlf[1024 + l], laminit = ctlf[1028 + l];
                const bf16_t* PROJ = (const bf16_t*)(ws + WS_PROJ); bf16_t* OCAT = (bf16_t*)(ws + WS_OCAT); float* OFWD = (float*)(ws + WS_OFWD);
                LAS int* itm = (LAS int*)(lds + 147456 - 64);
                const int tid = tid_fresh();
                for (;;) {
                    __syncthreads();
                    if (tid == 0) itm[0] = (int)atomicAdd(ctr, 1u);
                    __syncthreads();
                    const int it = itm[0];
                    constexpr int NPQ = GB * 4 / 8;
                    if (it >= 4 * NPQ + NPQ * 16) break;
                    float* OBWD = (float*)(ws + WS_OBWD);
                    if (it < 2 * NPQ) { const int p = (it >> 1) * 8 + xq; unsigned* dn = (unsigned*)(ws + WS_CTL) + 40960 + (((grp * DEPTH + l) * GB * 4 + p) * 2);
                        scan_item<64, true>(lds, PROJ, OFWD, OBWD, OCAT, dn, p >> 2, p & 3, it & 1, ctlf + 2048 + l * 512, pv + 8704 + l * 64, nullptr, nullptr);
                    } else if (it < 4 * NPQ) { const int i2 = it - 2 * NPQ; const int p = (i2 >> 1) * 8 + xq; unsigned* dn = (unsigned*)(ws + WS_CTL) + 40960 + (((grp * DEPTH + l) * GB * 4 + p) * 2 + 1);
                        scan_item<32, false>(lds, PROJ, OFWD, OBWD, OCAT, dn, p >> 2, p & 3, i2 & 1, nullptr, pv + 26368 + l * 64, pv + 8960 + l * 4096, pv + 25344 + l * 256);
                    } else { const int u = it - 4 * NPQ, p = (u >> 4) * 8 + xq;
                        attn_unit(lds, (const bf16_t*)(ws + WS_ATT), OCAT, p >> 2, p & 3, u & 15, lam, laminit, pv + 8192 + l * 128);
                    }
                }
            }
            XSYNC();
            { uchar* ws = KWS(); pg8::Gemm g{(const bf16_t*)(ws + WS_OCAT), (const bf16_t*)(ws + WS_WUP) + (size_t)l * D * D, D}; pg8::Order S; S.init(TG, D, D, gridDim.x, blockIdx.x, 3); pg8::EpiMerge E{(const bf16_t*)(ws + WS_PROJ), (bf16_t*)(ws + WS_HB)};
#ifndef NO_EPIMERGE
              pg8::gemm_phase<pg8::EpiMerge>(lds, g, S, E);
#endif
            }
            XSYNC();
            { uchar* ws = KWS(); pg8::Gemm g{(const bf16_t*)(ws + WS_HB), (const bf16_t*)(ws + WS_WOUT) + (size_t)l * D * D, D}; pg8::Order S; S.init(TG, D, D, gridDim.x, blockIdx.x, 1);
              float* xg = (float*)karg(P_OUT) + (size_t)grp * TG * D;
              pg8::EpiRes E{l == 0 ? KF(P_X) + (size_t)grp * TG * D : xg, xg, (const float*)(ws + WS_MOD) + ((size_t)l * 32 + grp * GB) * (NMOD * D) + 2 * D};
#ifndef NO_EPIRES
              pg8::gemm_phase<pg8::EpiRes>(lds, g, S, E);
#endif
            }
            XSYNC();
            {
                uchar* ws = KWS(); const float* pv = (const float*)(ws + WS_CTL) + 8192;
                norm_rows_mod((const float*)karg(P_OUT) + (size_t)grp * TG * D, (bf16_t*)(ws + WS_HB), pv + 4096 + l * D, (const float*)(ws + WS_MOD) + (size_t)l * 32 * (NMOD * D), grp * TG, 3 * D, 4 * D);
            }
            XSYNC();
            { uchar* ws = KWS(); pg8::Gemm g{(const bf16_t*)(ws + WS_HB), (const bf16_t*)(ws + WS_W1) + (size_t)l * DFF * D, D}; pg8::Order S; S.init(TG, DFF, D, gridDim.x, blockIdx.x, 1); pg8::EpiRelu2 E{(bf16_t*)(ws + WS_U)};
#ifndef NO_EPIRELU2
              pg8::gemm_phase<pg8::EpiRelu2>(lds, g, S, E);
#endif
            }
            XSYNC();
            { uchar* ws = KWS(); pg8::Gemm g{(const bf16_t*)(ws + WS_U), (const bf16_t*)(ws + WS_W2) + (size_t)l * D * DFF, DFF}; pg8::Order S; S.init(TG, D, DFF, gridDim.x, blockIdx.x, 1);
              float* xg = (float*)karg(P_OUT) + (size_t)grp * TG * D;
              pg8::EpiRes E{xg, xg, (const float*)(ws + WS_MOD) + ((size_t)l * 32 + grp * GB) * (NMOD * D) + 5 * D};
#ifndef NO_EPIRES
              pg8::gemm_phase<pg8::EpiRes>(lds, g, S, E);
#endif
            }
            XSYNC();
        }
        norm_rows_final((float*)karg(P_OUT) + (size_t)grp * TG * D, (const float*)(KWS() + WS_CTL) + 8192 + 26624);
    }
}

extern "C" void kernel_launch(void* const* d_in, const int* in_sizes, int n_in, void* d_out, int out_size, void* d_ws, size_t ws_size, hipStream_t stream) {
    static int grid = 0;
    if (grid == 0) {
        if (n_in != 21 || ws_size < WS_END) { fprintf(stderr, "kernel_launch: unexpected n_in %d / ws %zu\n", n_in, ws_size); grid = -1; return; }
        int dev = 0, cus = 0, per_cu = 0;
        if (hipGetDevice(&dev) != hipSuccess || hipDeviceGetAttribute(&cus, hipDeviceAttributeMultiprocessorCount, dev) != hipSuccess) { grid = -1; return; }
        if (hipFuncSetAttribute((const void*)fwd_megakernel, hipFuncAttributeMaxDynamicSharedMemorySize, LDS_BYTES) != hipSuccess) { fprintf(stderr, "kernel_launch: hipFuncSetAttribute failed\n"); grid = -1; return; }
        if (hipOccupancyMaxActiveBlocksPerMultiprocessor(&per_cu, (const void*)fwd_megakernel, 512, LDS_BYTES) != hipSuccess || per_cu < 1) { fprintf(stderr, "kernel_launch: occupancy query says %d\n", per_cu); per_cu = 1; }
        (void)hipGetLastError();
        grid = cus;
    }
    if (grid < 0) return;
    Args a{};
    for (int i = 0; i < 21; ++i) a.p[i] = d_in[i];
    a.p[21] = d_out; a.p[22] = d_ws; a.p[23] = nullptr;
    void* args[] = {&a};
    hipError_t e = hipLaunchCooperativeKernel((void*)fwd_megakernel, dim3(grid), dim3(512), args, LDS_BYTES, stream);
    if (e != hipSuccess) fprintf(stderr, "kernel_launch: cooperative launch failed: %s (grid %d)\n", hipGetErrorString(e), grid);
}
```

```cpp
#include <hip/hip_runtime.h>
#include <hip/hip_cooperative_groups.h>
#include <cstdio>
#include <cstdint>
namespace cg = cooperative_groups;

#define LAS __attribute__((address_space(3)))
typedef unsigned short bf16_t;
typedef short bf16x8 __attribute__((ext_vector_type(8)));
typedef float f32x4 __attribute__((ext_vector_type(4)));
typedef float f32x2 __attribute__((ext_vector_type(2)));
typedef float f32x16 __attribute__((ext_vector_type(16)));
typedef unsigned u32x4 __attribute__((ext_vector_type(4)));
typedef short s16x4 __attribute__((ext_vector_type(4)));
typedef unsigned char uchar;

constexpr int D = 1024, SEQ = 2048, BATCH = 32, DEPTH = 4, DIN = 6688, LDP = 6912, DFF = 4096, NMOD = 6;
constexpr int GB = 16, TG = GB * SEQ, NGRP = BATCH / GB;
constexpr int CQ = 0, CK = 512, CV = 1024, BQ = 1536, BFF = 1792, BFB = 2048, BI = 2304, BG = 2560;
constexpr int GQ = 2816, GK = 2944, GV = 3072, GG = 3328, GLF = 3584, GLB = 3600, GATE = 3616;
constexpr float EPS = 1e-6f, LOG2E = 1.4426950408889634f;
constexpr float QSCALE = 0.125f * LOG2E;

constexpr size_t MiB = 1u << 20;
constexpr size_t WS_CTL = 0;
constexpr size_t WS_MOD = 1 * MiB;
constexpr size_t WS_WIN = 4 * MiB;
constexpr size_t WS_WUP = 58 * MiB;
constexpr size_t WS_WOUT = 66 * MiB;
constexpr size_t WS_W1 = 74 * MiB;
constexpr size_t WS_W2 = 106 * MiB;
constexpr size_t WS_HB = 138 * MiB;
constexpr size_t WS_OCAT = 202 * MiB;
constexpr size_t WS_OFWD = 266 * MiB;
constexpr size_t WS_PROJ = 330 * MiB;
constexpr size_t WS_U = WS_PROJ;
constexpr size_t WS_OBWD = 762 * MiB;
constexpr size_t WS_ATT = 826 * MiB;
constexpr size_t WS_END = 922 * MiB;
constexpr int LDS_BYTES = 148 * 1024;

__device__ __forceinline__ unsigned f2bf(float f) { unsigned u = __builtin_bit_cast(unsigned, f); return (u + 0x7fffu + ((u >> 16) & 1u)) >> 16; }
__device__ __forceinline__ unsigned pk2(float lo, float hi) { return f2bf(lo) | (f2bf(hi) << 16); }
__device__ __forceinline__ float bf2f(bf16_t v) { return __builtin_bit_cast(float, (unsigned)v << 16); }
__device__ __forceinline__ float bflo(unsigned u) { return __builtin_bit_cast(float, u << 16); }
__device__ __forceinline__ float bfhi(unsigned u) { return __builtin_bit_cast(float, u & 0xffff0000u); }
typedef __bf16 bf16x2_t __attribute__((ext_vector_type(2)));
__device__ __forceinline__ unsigned cvt_pk_bf16(float lo, float hi) { f32x2 v = {lo, hi}; bf16x2_t b = __builtin_convertvector(v, bf16x2_t); return __builtin_bit_cast(unsigned, b); }
__device__ __forceinline__ float wave_sum(float v) {
#pragma unroll
    for (int o = 1; o < 64; o <<= 1) v += __shfl_xor(v, o);
    return v;
}
__device__ __forceinline__ int tid_fresh() { int t = threadIdx.x; asm volatile("" : "+v"(t)); return t; }
__device__ __forceinline__ float sigmoidf_(float z) { return 1.f / (1.f + __expf(-z)); }

namespace pg8 {
constexpr int BM = 256, BK = 64, HALF = 128, HTB = HALF * BK * 2, STAGE_BYTES = 8 * HTB, NXCD = 8, WGM = 8;
__host__ __device__ __forceinline__ int lds_byte(int r, int c) { const int st = (r >> 4) * 2 + (c >> 5), rr = r & 15, cc = c & 31, ob = rr * 64 + cc * 2; return st * 1024 + (ob ^ (((ob >> 9) & 1) << 5)); }
__host__ __device__ __forceinline__ void stage_rc(int b, int& R, int& C) { const int st = b / 1024, sb = b % 1024, swz = sb ^ (((sb >> 9) & 1) << 5); R = (st >> 1) * 16 + swz / 64; C = (st & 1) * 32 + (swz % 64) / 2; }
__host__ __device__ __forceinline__ int perm32(int rho) { const int n = rho >> 4, i = rho & 15; return 8 * (i >> 2) + 4 * n + (i & 3); }

struct Unit { int pm, pn, koff, nt, seg; };
struct Gemm { const bf16_t* A; const bf16_t* Bt; int K; };

struct Order {
    int nM, nN, nwg, G, c, nseg, ntfull;
    __device__ void init(int M, int N, int K, int G_, int c_, int nseg_) { nM = M / BM; nN = N / BM; nwg = nM * nN; G = G_; c = c_; nseg = nseg_; ntfull = K / BK; }
    __device__ bool next(int i, Unit& u) const {
        int ti = i, seg = 0;
        if (nseg == 3) { ti = i / 3; seg = i - ti * 3; }
        const long L = (long)ti * G + c; if (L >= nwg) return false;
        int wgid = (int)L; { const int q = nwg / NXCD, r = nwg % NXCD, xcd = wgid % NXCD, off = wgid / NXCD; wgid = (xcd < r ? xcd * (q + 1) : r * (q + 1) + (xcd - r) * q) + off; }
        const int nig = WGM * nN, gid = wgid / nig, fm = gid * WGM, gsz = (nM - fm) < WGM ? (nM - fm) : WGM;
        u.pm = fm + ((wgid % nig) % gsz); u.pn = (wgid % nig) / gsz; u.seg = seg;
        if (nseg == 3) { u.koff = seg == 0 ? 0 : (seg == 1 ? 512 : 768); u.nt = seg == 0 ? 8 : 4; } else { u.koff = 0; u.nt = ntfull; }
        return true;
    }
};

struct EpiProj {
    bf16_t* O; bf16_t* att;
    __device__ __forceinline__ bool zero_after(const Unit&) const { return true; }
    __device__ __forceinline__ void operator()(f32x4 (&acc)[2][2][4][2], const Unit& u, int wr, int wc, int fr, int fq) const {
        const int row0 = u.pm * BM + wr * 64 + fr, col0 = u.pn * BM + wc * 32 + 8 * fq;
        const float sc = (u.pn < 2) ? QSCALE : 1.f;
        const bool toatt = u.pn < 6;
#pragma unroll
        for (int ai = 0; ai < 2; ++ai)
#pragma unroll
            for (int m = 0; m < 4; ++m) { const int row = row0 + ai * HALF + m * 16; bf16_t* rowp = O + (size_t)row * LDP + col0;
#pragma unroll
                for (int bj = 0; bj < 2; ++bj) { f32x4 v0 = acc[ai][bj][m][0] * sc, v1 = acc[ai][bj][m][1] * sc;
                    u32x4 w; w.x = cvt_pk_bf16(v0[0], v0[1]); w.y = cvt_pk_bf16(v0[2], v0[3]); w.z = cvt_pk_bf16(v1[0], v1[1]); w.w = cvt_pk_bf16(v1[2], v1[3]);
                    if (toatt) { const int seg = u.pn * 2 + bj, typ = seg >> 2, hh = seg & 3;
                        *(u32x4*)(att + ((size_t)(((row >> 11) * 4 + hh) * SEQ + (row & 2047))) * 384 + typ * 128 + wc * 32 + 8 * fq) = w; }
                    else *(u32x4*)(rowp + bj * HALF) = w; } }
    }
};
struct EpiRelu2 {
    bf16_t* O;
    __device__ __forceinline__ bool zero_after(const Unit&) const { return true; }
    __device__ __forceinline__ void operator()(f32x4 (&acc)[2][2][4][2], const Unit& u, int wr, int wc, int fr, int fq) const {
        const int row0 = u.pm * BM + wr * 64 + fr, col0 = u.pn * BM + wc * 32 + 8 * fq;
#pragma unroll
        for (int ai = 0; ai < 2; ++ai)
#pragma unroll
            for (int m = 0; m < 4; ++m) { bf16_t* rowp = O + (size_t)(row0 + ai * HALF + m * 16) * DFF + col0;
#pragma unroll
                for (int bj = 0; bj < 2; ++bj) { f32x4 v0 = acc[ai][bj][m][0], v1 = acc[ai][bj][m][1];
#pragma unroll
                    for (int j = 0; j < 4; ++j) { float a = fmaxf(v0[j], 0.f), b = fmaxf(v1[j], 0.f); v0[j] = a * a; v1[j] = b * b; }
                    u32x4 w; w.x = cvt_pk_bf16(v0[0], v0[1]); w.y = cvt_pk_bf16(v0[2], v0[3]); w.z = cvt_pk_bf16(v1[0], v1[1]); w.w = cvt_pk_bf16(v1[2], v1[3]);
                    *(u32x4*)(rowp + bj * HALF) = w; } }
    }
};
struct EpiRes {
    const float* base; float* out; const float* gate;
    __device__ __forceinline__ bool zero_after(const Unit&) const { return true; }
    __device__ __forceinline__ void operator()(f32x4 (&acc)[2][2][4][2], const Unit& u, int wr, int wc, int fr, int fq) const {
        const int row0 = u.pm * BM + wr * 64 + fr, col0 = u.pn * BM + wc * 32 + 8 * fq;
        const float* gp = gate + (size_t)((u.pm * BM) >> 11) * (NMOD * D) + col0;
#pragma unroll
        for (int bj = 0; bj < 2; ++bj) {
            const f32x4 g0 = *(const f32x4*)(gp + bj * HALF), g1 = *(const f32x4*)(gp + bj * HALF + 4);
#pragma unroll
            for (int ai = 0; ai < 2; ++ai) {
#pragma unroll
                for (int m = 0; m < 4; ++m) { const size_t off = (size_t)(row0 + ai * HALF + m * 16) * D + col0 + bj * HALF;
                    const f32x4 b0 = *(const f32x4*)(base + off), b1 = *(const f32x4*)(base + off + 4);
                    *(f32x4*)(out + off) = b0 + g0 * acc[ai][bj][m][0];
                    *(f32x4*)(out + off + 4) = b1 + g1 * acc[ai][bj][m][1];
                    if (m & 1) asm volatile("" ::: "memory"); }
            }
        }
    }
};
struct EpiMerge {
    const bf16_t* proj; bf16_t* O;
    __device__ __forceinline__ bool zero_after(const Unit& u) const { return u.seg == 2; }
    __device__ __forceinline__ void operator()(f32x4 (&acc)[2][2][4][2], const Unit& u, int wr, int wc, int fr, int fq) const {
        const int row0 = u.pm * BM + wr * 64 + fr, col0 = u.pn * BM + wc * 32 + 8 * fq;
        const int seg = u.seg;
#pragma unroll
        for (int ai = 0; ai < 2; ++ai)
#pragma unroll
            for (int m = 0; m < 4; ++m) { const size_t row = (size_t)(row0 + ai * HALF + m * 16); const bf16_t* gp = proj + row * LDP + GATE + col0;
#pragma unroll
                for (int bj = 0; bj < 2; ++bj) {
                    if (seg < 2) {
                        const u32x4 ga = *(const u32x4*)(gp + seg * D + bj * HALF), gb = *(const u32x4*)(gp + (seg + 1) * D + bj * HALF);
                        float r[8];
#pragma unroll
                        for (int j = 0; j < 4; ++j) {
                            const float a0 = fminf(fmaxf(bflo(ga[j]), -40.f), 40.f), a1 = fminf(fmaxf(bfhi(ga[j]), -40.f), 40.f);
                            const float b0 = fminf(fmaxf(bflo(gb[j]), -40.f), 40.f), b1 = fminf(fmaxf(bfhi(gb[j]), -40.f), 40.f);
                            r[2 * j] = (1.f + __expf(-b0)) * __builtin_amdgcn_rcpf(1.f + __expf(-a0));
                            r[2 * j + 1] = (1.f + __expf(-b1)) * __builtin_amdgcn_rcpf(1.f + __expf(-a1)); }
                        acc[ai][bj][m][0] = acc[ai][bj][m][0] * (f32x4){r[0], r[1], r[2], r[3]};
                        acc[ai][bj][m][1] = acc[ai][bj][m][1] * (f32x4){r[4], r[5], r[6], r[7]};
                    } else {
                        const u32x4 gc = *(const u32x4*)(gp + 2 * D + bj * HALF);
                        float r[8];
#pragma unroll
                        for (int j = 0; j < 4; ++j) {
                            const float c0 = fminf(fmaxf(bflo(gc[j]), -40.f), 40.f), c1 = fminf(fmaxf(bfhi(gc[j]), -40.f), 40.f);
                            r[2 * j] = __builtin_amdgcn_rcpf(1.f + __expf(-c0)); r[2 * j + 1] = __builtin_amdgcn_rcpf(1.f + __expf(-c1)); }
                        const f32x4 v0 = acc[ai][bj][m][0] * (f32x4){r[0], r[1], r[2], r[3]}, v1 = acc[ai][bj][m][1] * (f32x4){r[4], r[5], r[6], r[7]};
                        u32x4 w; w.x = cvt_pk_bf16(v0[0], v0[1]); w.y = cvt_pk_bf16(v0[2], v0[3]); w.z = cvt_pk_bf16(v1[0], v1[1]); w.w = cvt_pk_bf16(v1[2], v1[3]);
                        *(u32x4*)(O + row * D + col0 + bj * HALF) = w;
                    } } }
    }
};

template <class Epi, bool ALIGN_EPI = true>
__device__ __forceinline__ void gemm_phase(LAS uchar* lds, const Gemm g, const Order& S, const Epi& E) {
    const int tid = tid_fresh(), wid = __builtin_amdgcn_readfirstlane(tid >> 6), lane = tid & 63, wr = wid >> 2, wc = wid & 3, fr = lane & 15, fq = lane >> 4;
    const int K = g.K;
    unsigned voffA[2], voffB[2];
#pragma unroll
    for (int i = 0; i < 2; ++i) { int R, C; stage_rc(tid * 16 + i * 8192, R, C); const int Rb = (R & ~31) + perm32(R & 31);
        voffA[i] = (unsigned)(R * K + C) * 2u; voffB[i] = (unsigned)(Rb * K + C) * 2u; }
    const size_t kstep = (size_t)(BK * 2);
    const size_t hstep = (size_t)HALF * K * 2;
    const size_t tstep = 2 * hstep;
    const unsigned ldsw = (unsigned)wid * 1024u;
    const int aoff = lds_byte(wr * 64 + fr, fq * 8), boff = lds_byte(wc * 32 + fr, fq * 8);
#define PG8_SA(b, h) (((b) * 2 + (h)) * HTB)
#define PG8_SB(b, h) ((4 + (b) * 2 + (h)) * HTB)
#define PG8_STAGE(bufoff, gbase, voff) do { _Pragma("unroll") for (int _i = 0; _i < 2; ++_i) \
        __builtin_amdgcn_global_load_lds((const unsigned*)((const char*)(gbase) + (voff)[_i]), (LAS unsigned*)(lds + (bufoff) + ldsw + _i * 8192), 16, 0, 0); } while (0)
#define PG8_LDA(dst, b, h) do { _Pragma("unroll") for (int m = 0; m < 4; ++m) _Pragma("unroll") for (int k = 0; k < 2; ++k) dst[m][k] = *(const LAS bf16x8*)(lds + PG8_SA(b, h) + aoff + m * 2048 + k * 1024); } while (0)
#define PG8_LDB(dst, b, h) do { _Pragma("unroll") for (int n = 0; n < 2; ++n) _Pragma("unroll") for (int k = 0; k < 2; ++k) dst[n][k] = *(const LAS bf16x8*)(lds + PG8_SB(b, h) + boff + n * 2048 + k * 1024); } while (0)
#define PG8_MMA(ai, bj, At, Bt) do { __builtin_amdgcn_s_setprio(1); _Pragma("unroll") for (int m = 0; m < 4; ++m) _Pragma("unroll") for (int n = 0; n < 2; ++n) _Pragma("unroll") for (int k = 0; k < 2; ++k) \
        acc[ai][bj][m][n] = __builtin_amdgcn_mfma_f32_16x16x32_bf16(Bt[n][k], At[m][k], acc[ai][bj][m][n], 0, 0, 0); __builtin_amdgcn_s_setprio(0); } while (0)
#define PG8_WAIT_V(n) asm volatile("s_waitcnt vmcnt(" #n ")" ::: "memory")
#define PG8_WAIT_L(n) asm volatile("s_waitcnt lgkmcnt(" #n ")" ::: "memory")
#define PG8_BAR __builtin_amdgcn_s_barrier()
#define PG8_SCHED __builtin_amdgcn_sched_barrier(0)
    Unit cur, nxt; int ui = 0;
    if (!S.next(0, cur)) return;
    f32x4 acc[2][2][4][2];
#pragma unroll
    for (int a = 0; a < 2; ++a)
#pragma unroll
        for (int b = 0; b < 2; ++b)
#pragma unroll
            for (int m = 0; m < 4; ++m)
#pragma unroll
                for (int n = 0; n < 2; ++n) acc[a][b][m][n] = (f32x4){0.f, 0.f, 0.f, 0.f};
    bf16x8 At[4][2], B0[2][2], B1[2][2];
    const char* cA = (const char*)g.A + (size_t)cur.pm * tstep + (size_t)cur.koff * 2; const char* cB = (const char*)g.Bt + (size_t)cur.pn * tstep + (size_t)cur.koff * 2;
    PG8_STAGE(PG8_SB(0, 0), cB, voffB); PG8_STAGE(PG8_SB(0, 1), cB + hstep, voffB); PG8_STAGE(PG8_SA(0, 0), cA, voffA); PG8_STAGE(PG8_SA(0, 1), cA + hstep, voffA);
    if (wr == 1) PG8_BAR;
    PG8_WAIT_V(2); PG8_BAR;
    PG8_STAGE(PG8_SB(1, 0), cB + kstep, voffB); PG8_STAGE(PG8_SA(1, 0), cA + kstep, voffA); PG8_STAGE(PG8_SB(1, 1), cB + hstep + kstep, voffB);
    PG8_WAIT_V(6); PG8_BAR;
    for (;;) {
        const bool has_next = S.next(ui + 1, nxt);
        const char* nA = has_next ? (const char*)g.A + (size_t)nxt.pm * tstep + (size_t)nxt.koff * 2 : cA; const char* nB = has_next ? (const char*)g.Bt + (size_t)nxt.pn * tstep + (size_t)nxt.koff * 2 : cB;
        const int nt = cur.nt;
        for (int t = 0; t < nt; t += 2) {
            const bool last = (t == nt - 2);
            const char* a1 = cA + (size_t)(t + 1) * kstep;
            const char* a2 = last ? nA : cA + (size_t)(t + 2) * kstep; const char* b2 = last ? nB : cB + (size_t)(t + 2) * kstep;
            const char* a3 = a2 + kstep; const char* b3 = b2 + kstep;
            PG8_LDB(B0, 0, 0); PG8_LDB(B1, 0, 1); PG8_SCHED; PG8_LDA(At, 0, 0); PG8_STAGE(PG8_SA(1, 1), a1 + hstep, voffA);
            PG8_WAIT_V(8); PG8_WAIT_L(0); PG8_BAR; PG8_MMA(0, 0, At, B0); PG8_MMA(0, 1, At, B1); PG8_BAR; PG8_SCHED;
            PG8_LDA(At, 0, 1); PG8_STAGE(PG8_SB(0, 0), b2, voffB); PG8_STAGE(PG8_SB(0, 1), b2 + hstep, voffB); PG8_STAGE(PG8_SA(0, 0), a2, voffA);
            PG8_WAIT_V(8); PG8_WAIT_L(0); PG8_BAR; PG8_MMA(1, 0, At, B0); PG8_MMA(1, 1, At, B1); PG8_BAR; PG8_SCHED;
            PG8_LDB(B0, 1, 0); PG8_LDB(B1, 1, 1); PG8_SCHED; PG8_LDA(At, 1, 0); PG8_STAGE(PG8_SA(0, 1), a2 + hstep, voffA);
            PG8_WAIT_V(8); PG8_WAIT_L(0); PG8_BAR; PG8_MMA(0, 0, At, B0); PG8_MMA(0, 1, At, B1); PG8_BAR; PG8_SCHED;
            PG8_LDA(At, 1, 1); PG8_STAGE(PG8_SB(1, 0), b3, voffB); PG8_STAGE(PG8_SB(1, 1), b3 + hstep, voffB); PG8_STAGE(PG8_SA(1, 0), a3, voffA);
            PG8_WAIT_V(8); PG8_WAIT_L(0); PG8_BAR; PG8_MMA(1, 0, At, B0); PG8_MMA(1, 1, At, B1); PG8_BAR; PG8_SCHED;
        }
        if constexpr (ALIGN_EPI) { if (wr == 0) PG8_BAR; }
        E(acc, cur, wr, wc, fr, fq);
        if (!has_next) break;
        if (E.zero_after(cur)) {
#pragma unroll
            for (int a = 0; a < 2; ++a)
#pragma unroll
                for (int b = 0; b < 2; ++b)
#pragma unroll
                    for (int m = 0; m < 4; ++m)
#pragma unroll
                        for (int n = 0; n < 2; ++n) acc[a][b][m][n] = (f32x4){0.f, 0.f, 0.f, 0.f};
        }
        cur = nxt; cA = nA; cB = nB; ++ui;
        if constexpr (ALIGN_EPI) { if (wr == 1) PG8_BAR; }
    }
    PG8_WAIT_V(0);
    if constexpr (!ALIGN_EPI) { if (wr == 0) PG8_BAR; }
    PG8_BAR;
#undef PG8_SA
#undef PG8_SB
#undef PG8_STAGE
#undef PG8_LDA
#undef PG8_LDB
#undef PG8_MMA
#undef PG8_WAIT_V
#undef PG8_WAIT_L
#undef PG8_BAR
#undef PG8_SCHED
}
}

__device__ __forceinline__ int crow(int r, int hi) { return (r & 3) + 8 * (r >> 2) + 4 * hi; }
__device__ __forceinline__ s16x4 vtr(const LAS uchar* p) { return __builtin_bit_cast(s16x4, __builtin_amdgcn_ds_read_tr16_b64_v4i16((LAS s16x4*)p)); }
__device__ __forceinline__ float xhalf_max(float m) { auto rr = __builtin_amdgcn_permlane32_swap(__builtin_bit_cast(unsigned, m), __builtin_bit_cast(unsigned, m), false, false); return fmaxf(__builtin_bit_cast(float, rr[0]), __builtin_bit_cast(float, rr[1])); }
__device__ __forceinline__ float xhalf_sum(float m) { auto rr = __builtin_amdgcn_permlane32_swap(__builtin_bit_cast(unsigned, m), __builtin_bit_cast(unsigned, m), false, false); return __builtin_bit_cast(float, rr[0]) + __builtin_bit_cast(float, rr[1]); }

__device__ __forceinline__ void glds16(const void* gsrc, unsigned lds_dst) { unsigned keep;
    asm volatile("s_mov_b32 %0, m0\n\ts_mov_b32 m0, %2\n\ts_nop 0\n\tglobal_load_lds_dwordx4 %1, off\n\ts_mov_b32 m0, %0" : "=&s"(keep) : "v"(gsrc), "s"(lds_dst) : "memory"); }
constexpr int ATT_SLOT = 32768, ATT_WSF = 131072;
__device__ __forceinline__ void attn_unit(LAS uchar* lds, const bf16_t* proj, bf16_t* ocat, int bl, int h, int qb, float lam, float laminit, const float* sg) {
    const int tid = tid_fresh(), lane = tid & 63, r32 = lane & 31, hi = lane >> 5;
    const int wave = __builtin_amdgcn_readfirstlane(tid >> 6), mi = wave >> 2, rb = wave & 3;
    const size_t rowbase = (size_t)bl * SEQ;
    const int q0 = qb * 128 + rb * 32;
#define UNI(x) __builtin_bit_cast(float, __builtin_amdgcn_readfirstlane(__builtin_bit_cast(int, (float)(x))))
    const float m2 = UNI(exp2f(-2.f * (float)(h + 1)) * LOG2E);
    lam = UNI(lam); laminit = UNI(laminit);
#undef UNI
    bf16x8 qf[4];
    const bf16_t* att = proj;
    const size_t hb = (size_t)(bl * 4 + h) * SEQ;
    { const bf16_t* qp = att + (hb + q0 + r32) * 384 + mi * 64 + hi * 8;
#pragma unroll
      for (int d0 = 0; d0 < 4; ++d0) qf[d0] = *(const bf16x8*)(qp + d0 * 16); }
    const int kkey = 4 * wave + (lane >> 4);
    const bf16_t* ksrc0 = att + (hb + kkey) * 384 + 128 + (((lane & 15) ^ (kkey & 15)) * 8);
    const bf16_t* ksrc1 = ksrc0 + (size_t)32 * 384;
    const bf16_t* vsrc0 = att + (hb + 16 * (wave & 3) + (lane >> 2)) * 384 + 256 + (wave >> 2) * 32 + (lane & 3) * 8;
    const bf16_t* vsrc1 = vsrc0 + 64;
    const unsigned lds0 = (unsigned)(uintptr_t)lds + (unsigned)wave * 1024u;
#define ATT_ISSUE(t, sb) do { const size_t go_ = (size_t)(t) * 64 * 384; const unsigned d_ = (unsigned)__builtin_amdgcn_readfirstlane((int)(lds0 + (unsigned)(sb))); \
        glds16(ksrc0 + go_, d_); glds16(ksrc1 + go_, d_ + 8192u); glds16(vsrc0 + go_, d_ + 16384u); glds16(vsrc1 + go_, d_ + 24576u); } while (0)
    LAS float* wsf = (LAS float*)(lds + ATT_WSF) + wave * 64;
    f32x16 o[4];
#pragma unroll
    for (int d = 0; d < 4; ++d)
#pragma unroll
        for (int r = 0; r < 16; ++r) o[d][r] = 0.f;
    float mhat = 0.f;
    f32x16 ol;
#pragma unroll
    for (int r = 0; r < 16; ++r) ol[r] = 0.f;
    const bf16x8 ones = (bf16x8){0x3F80, 0x3F80, 0x3F80, 0x3F80, 0x3F80, 0x3F80, 0x3F80, 0x3F80};
    const int vfo = 16384 + ((lane >> 4) & 1) * 32 + (lane & 3) * 8 + (4 * hi + ((lane & 15) >> 2)) * 64;
    ATT_ISSUE(0, 0); ATT_ISSUE(1, ATT_SLOT);
    u32x4 pw[4];
#pragma unroll
    for (int k = 0; k < 4; ++k) pw[k] = (u32x4){0u, 0u, 0u, 0u};
    bool zflag = false;
#define ATT_VLD(i, L, H) do { L = vtr(sv_ + vfo + ((i) >> 2) * 4096 + ((i) & 3) * 1024); H = vtr(sv_ + vfo + ((i) >> 2) * 4096 + ((i) & 3) * 1024 + 512); } while (0)
#define ATT_PV(SLP) do { const LAS uchar* sv_ = (SLP); s16x4 fl_[3], fh_[3]; __builtin_amdgcn_s_setprio(1); \
        ATT_VLD(0, fl_[0], fh_[0]); ATT_VLD(1, fl_[1], fh_[1]); __builtin_amdgcn_sched_group_barrier(0x100, 4, 0); \
        _Pragma("unroll") for (int i = 0; i < 16; ++i) { \
            if (i + 2 < 16) ATT_VLD(i + 2, fl_[(i + 2) % 3], fh_[(i + 2) % 3]); \
            const s16x4 lo = fl_[i % 3], hh = fh_[i % 3]; \
            const bf16x8 vf = (bf16x8){lo[0], lo[1], lo[2], lo[3], hh[0], hh[1], hh[2], hh[3]}; \
            o[i >> 2] = __builtin_amdgcn_mfma_f32_32x32x16_bf16(__builtin_bit_cast(bf16x8, pw[i & 3]), vf, o[i >> 2], 0, 0, 0); \
            __builtin_amdgcn_sched_group_barrier(0x8, 1, 0); __builtin_amdgcn_sched_group_barrier(0x100, 2, 0); } \
        _Pragma("unroll") for (int ks = 0; ks < 4; ++ks) ol = __builtin_amdgcn_mfma_f32_32x32x16_bf16(__builtin_bit_cast(bf16x8, pw[ks]), ones, ol, 0, 0, 0); \
        __builtin_amdgcn_s_setprio(0); } while (0)
    for (int t = 0; t <= SEQ / 64; ++t) {
        if (t < SEQ / 64) {
            if (t + 1 < SEQ / 64) asm volatile("s_waitcnt vmcnt(4) lgkmcnt(0)" ::: "memory"); else asm volatile("s_waitcnt vmcnt(0) lgkmcnt(0)" ::: "memory");
            __builtin_amdgcn_s_barrier();
            asm volatile("" ::: "memory");
            if (t + 2 < SEQ / 64) ATT_ISSUE(t + 2, ((t + 2) & 3) * ATT_SLOT);
        }
        if (mi == 1 && t > 0 && !zflag) ATT_PV(lds + ((t - 1) & 3) * ATT_SLOT);
        if (t < SEQ / 64) {
            const LAS uchar* sl = lds + (t & 3) * ATT_SLOT;
        const float dq = (float)(q0 + r32 - 64 * t - 4 * hi);
        f32x16 p0, p1;
        const int side = (64 * t + 63 < q0) ? 1 : ((64 * t > q0 + 31) ? -1 : 0);
        if (side != 0) {
            const float sm = side > 0 ? m2 : -m2; const float base = __builtin_fmaf(-sm, dq, -mhat);
#pragma unroll
            for (int r = 0; r < 16; ++r) { const float kc = (float)((r & 3) + 8 * (r >> 2));
                p0[r] = __builtin_fmaf(sm, kc, base); p1[r] = __builtin_fmaf(sm, kc + 32.f, base); }
        } else {
#pragma unroll
            for (int r = 0; r < 16; ++r) { const float kc = (float)((r & 3) + 8 * (r >> 2));
                p0[r] = __builtin_fmaf(-m2, __builtin_fabsf(dq - kc), -mhat); p1[r] = __builtin_fmaf(-m2, __builtin_fabsf(dq - kc - 32.f), -mhat); }
        }
        int r32l = r32; asm volatile("" : "+v"(r32l));
        __builtin_amdgcn_s_setprio(1);
#pragma unroll
        for (int d0 = 0; d0 < 4; ++d0) {
            const int kfo_ = r32l * 256 + (((mi * 8 + 2 * d0 + hi) ^ (r32l & 15)) * 16);
            const bf16x8 a0 = *(const LAS bf16x8*)(sl + kfo_), a1 = *(const LAS bf16x8*)(sl + kfo_ + 8192);
            p0 = __builtin_amdgcn_mfma_f32_32x32x16_bf16(a0, qf[d0], p0, 0, 0, 0);
            p1 = __builtin_amdgcn_mfma_f32_32x32x16_bf16(a1, qf[d0], p1, 0, 0, 0); }
        __builtin_amdgcn_s_setprio(0);
        float rm = fmaxf(p0[0], p1[0]), rm2 = fmaxf(p0[1], p1[1]);
#pragma unroll
        for (int r = 2; r < 16; r += 2) { rm = __builtin_fmaxf(__builtin_fmaxf(rm, p0[r]), p1[r]); rm2 = __builtin_fmaxf(__builtin_fmaxf(rm2, p0[r + 1]), p1[r + 1]); }
        rm = fmaxf(rm, rm2);
        rm = xhalf_max(rm);
        const bool first = (t == 0);
        zflag = !first && !__any(rm >= -150.f);
        if (!zflag) {
        if (first || __any(rm > 60.f)) {
            const float dl = first ? rm : fmaxf(rm, 0.f);
            mhat += dl;
#pragma unroll
            for (int r = 0; r < 16; ++r) { p0[r] -= dl; p1[r] -= dl; }
            if (!first) {
                const float f = __builtin_amdgcn_exp2f(-dl);
                if (hi == 0) wsf[r32] = f;
                float fr_[16];
#pragma unroll
                for (int r = 0; r < 16; ++r) fr_[r] = wsf[crow(r, hi)];
#pragma unroll
                for (int d = 0; d < 4; ++d)
#pragma unroll
                    for (int r = 0; r < 16; ++r) o[d][r] *= fr_[r];
#pragma unroll
                for (int r = 0; r < 16; ++r) ol[r] *= fr_[r];
            }
        }
#pragma unroll
        for (int r = 0; r < 16; ++r) { p0[r] = __builtin_amdgcn_exp2f(p0[r]); p1[r] = __builtin_amdgcn_exp2f(p1[r]); }
#pragma unroll
        for (int j = 0; j < 4; ++j) { pw[0][j] = cvt_pk_bf16(p0[2 * j], p0[2 * j + 1]); pw[1][j] = cvt_pk_bf16(p0[8 + 2 * j], p0[8 + 2 * j + 1]);
                                      pw[2][j] = cvt_pk_bf16(p1[2 * j], p1[2 * j + 1]); pw[3][j] = cvt_pk_bf16(p1[8 + 2 * j], p1[8 + 2 * j + 1]); }
        }
            if (mi == 0 && !zflag) ATT_PV(sl);
        }
    }
#undef ATT_PV
#undef ATT_VLD
#undef ATT_ISSUE
    float fr_[16];
#pragma unroll
    for (int r = 0; r < 16; ++r) fr_[r] = (mi == 0 ? 1.f : lam) / ol[r];
    __syncthreads();
    LAS float* X = (LAS float*)lds + rb * 4096;
    if (mi == 1) {
#pragma unroll
        for (int d = 0; d < 4; ++d)
#pragma unroll
            for (int r = 0; r < 16; ++r) X[(d * 16 + r) * 64 + lane] = o[d][r] * fr_[r];
    }
    __syncthreads();
    if (mi == 0) {
        float ss[16];
#pragma unroll
        for (int r = 0; r < 16; ++r) ss[r] = 0.f;
#pragma unroll
        for (int d = 0; d < 4; ++d)
#pragma unroll
            for (int r = 0; r < 16; ++r) { const float v = o[d][r] * fr_[r] - X[(d * 16 + r) * 64 + lane]; o[d][r] = v; ss[r] += v * v; }
#pragma unroll
        for (int r = 0; r < 16; ++r) {
#pragma unroll
            for (int s = 1; s < 32; s <<= 1) ss[r] += __shfl_xor(ss[r], s);
            ss[r] = rsqrtf(ss[r] * (1.f / 128.f) + EPS) * (1.f - laminit); }
        float gv[4];
#pragma unroll
        for (int d = 0; d < 4; ++d) gv[d] = sg[d * 32 + r32];
#pragma unroll
        for (int r = 0; r < 16; ++r) { bf16_t* op = ocat + (rowbase + q0 + crow(r, hi)) * D + h * 128 + r32;
#pragma unroll
            for (int d = 0; d < 4; ++d) op[d * 32] = (bf16_t)f2bf(o[d][r] * ss[r] * gv[d]); }
    }
    __syncthreads();
}

template <int DK, bool HG>
__device__ __forceinline__ void scan_item(LAS uchar* lds, const bf16_t* proj, float* oraw0, float* oraw1, bf16_t* ocat, unsigned* done, int bl, int h, int dir, const float* lb  ,
                                          const float* normg  , const float* w2  , const float* gbias  ) {
    constexpr int KPW = DK / 8, TB = 32, NS = TB / 16, NR = TB / 8, GS = 4;
    LAS float* sA = (LAS float*)lds;
    LAS float* sK = sA + TB * DK;
    LAS float* sQ = sK + TB * DK;
    LAS float* sV = sQ + TB * DK;
    LAS float* sP = sV + TB * 64;
    const int tid = tid_fresh(), lane = tid & 63, wave = __builtin_amdgcn_readfirstlane(tid >> 6);
    const int ps = tid >> 5, pi = tid & 31;
    const size_t rowbase = (size_t)bl * SEQ;
    float* oraw = dir == 0 ? oraw0 : oraw1;
    __syncthreads();
    {
        float lb0 = 0.f, lb1 = 0.f, w2c[16], bias = 0.f;
        if (HG) { lb0 = lb[dir * 256 + h * 64 + pi]; lb1 = lb[dir * 256 + h * 64 + pi + 32]; }
        else {
#pragma unroll
            for (int r = 0; r < 16; ++r) w2c[r] = w2[(dir * 16 + r) * 128 + h * 32 + pi];
            bias = gbias[dir * 128 + h * 32 + pi]; }
        f32x2 S[KPW / 2];
#pragma unroll
        for (int j = 0; j < KPW / 2; ++j) S[j] = (f32x2){0.f, 0.f};
        bf16_t rz0[2][NS], rz1[2][NS], rq0[2][NS], rq1[2][NS], rv0[2][NS], rv1[2][NS], rk0[2][NS]; u32x4 rl0[2][NS], rl1[2][NS];
#pragma unroll
        for (int i = 0; i < NS; ++i) for (int e = 0; e < 2; ++e) { rz0[e][i] = rz1[e][i] = rq0[e][i] = rq1[e][i] = rv0[e][i] = rv1[e][i] = rk0[e][i] = 0; rl0[e][i] = rl1[e][i] = (u32x4){0, 0, 0, 0}; }
#define SCAN_LOAD(blk, E_) do { _Pragma("unroll") for (int i_ = 0; i_ < NS; ++i_) { const int st_ = (blk) * TB + ps + 16 * i_; const int tok_ = dir == 0 ? st_ : 2047 - st_; const bf16_t* pr_ = proj + (rowbase + tok_) * LDP; \
        if (HG) { const int zc_ = (dir == 0 ? BFF : BFB) + h * 64 + pi; rz0[E_][i_] = pr_[zc_]; rz1[E_][i_] = pr_[zc_ + 32]; rq0[E_][i_] = pr_[BQ + h * 64 + pi]; rq1[E_][i_] = pr_[BQ + h * 64 + pi + 32]; rv0[E_][i_] = pr_[BI + h * 64 + pi]; rv1[E_][i_] = pr_[BI + h * 64 + pi + 32]; } \
        else { const u32x4* lp_ = (const u32x4*)(pr_ + (dir == 0 ? GLF : GLB)); rl0[E_][i_] = lp_[0]; rl1[E_][i_] = lp_[1]; rk0[E_][i_] = pr_[GK + h * 32 + pi]; rq0[E_][i_] = pr_[GQ + h * 32 + pi]; rv0[E_][i_] = pr_[GV + h * 64 + pi]; rv1[E_][i_] = pr_[GV + h * 64 + pi + 32]; } } } while (0)
        SCAN_LOAD(0, 0); SCAN_LOAD(1, 1);
        for (int blk2 = 0; blk2 < SEQ / TB; blk2 += 2) {
            { const int blk = blk2;
#pragma unroll
            for (int i = 0; i < NS; ++i) {
                const int st = ps + 16 * i;
                if (HG) {
                    const float z0 = bf2f(rz0[0][i]), z1 = bf2f(rz1[0][i]);
                    const float s0 = __builtin_amdgcn_rcpf(1.f + __expf(-z0)), s1 = __builtin_amdgcn_rcpf(1.f + __expf(-z1));
                    sA[st * 64 + pi] = s0 * (1.f + lb0 * __expf(fminf(-z0, 80.f))); sA[st * 64 + pi + 32] = s1 * (1.f + lb1 * __expf(fminf(-z1, 80.f)));
                    sK[st * 64 + pi] = (1.f - lb0) * __builtin_amdgcn_rcpf(1.f + __expf(z0)); sK[st * 64 + pi + 32] = (1.f - lb1) * __builtin_amdgcn_rcpf(1.f + __expf(z1));
                    const float q0 = bf2f(rq0[0][i]), q1 = bf2f(rq1[0][i]);
                    sQ[st * 64 + pi] = q0 * __builtin_amdgcn_rcpf(1.f + __expf(-q0)) * 0.125f; sQ[st * 64 + pi + 32] = q1 * __builtin_amdgcn_rcpf(1.f + __expf(-q1)) * 0.125f;
                } else {
                    float z = bias;
#pragma unroll
                    for (int j = 0; j < 4; ++j) { z += bflo(rl0[0][i][j]) * w2c[2 * j] + bfhi(rl0[0][i][j]) * w2c[2 * j + 1]; z += bflo(rl1[0][i][j]) * w2c[8 + 2 * j] + bfhi(rl1[0][i][j]) * w2c[8 + 2 * j + 1]; }
                    const float ls = fminf(z, 0.f) - __logf(1.f + __expf(-fabsf(z)));
                    sA[st * 32 + pi] = __expf(ls * (1.f / 16.f));
                    sK[st * 32 + pi] = bf2f(rk0[0][i]);
                    sQ[st * 32 + pi] = bf2f(rq0[0][i]) * 0.17677669529663687f;
                }
                sV[st * 64 + pi] = bf2f(rv0[0][i]); sV[st * 64 + pi + 32] = bf2f(rv1[0][i]);
            }
            asm volatile("s_waitcnt lgkmcnt(0)" ::: "memory"); __builtin_amdgcn_s_barrier(); asm volatile("" ::: "memory");
            if (blk + 2 < SEQ / TB) SCAN_LOAD(blk + 2, 0);
            for (int s0_ = 0; s0_ < TB; s0_ += GS) {
                float vv[GS]; f32x4 a4[GS][KPW / 4], k4[GS][KPW / 4], q4[GS][KPW / 4];
#pragma unroll
                for (int g = 0; g < GS; ++g) { const int s = s0_ + g; vv[g] = sV[s * 64 + lane];
#pragma unroll
                    for (int j4 = 0; j4 < KPW / 4; ++j4) { a4[g][j4] = *(const LAS f32x4*)(sA + s * DK + wave * KPW + j4 * 4); k4[g][j4] = *(const LAS f32x4*)(sK + s * DK + wave * KPW + j4 * 4); q4[g][j4] = *(const LAS f32x4*)(sQ + s * DK + wave * KPW + j4 * 4); } }
                float po[GS];
#pragma unroll
                for (int g = 0; g < GS; ++g) {
                    f32x2 op = (f32x2){0.f, 0.f};
#pragma unroll
                    for (int j4 = 0; j4 < KPW / 4; ++j4) {
                        const f32x2 kv0 = (f32x2){k4[g][j4][0], k4[g][j4][1]} * vv[g], kv1 = (f32x2){k4[g][j4][2], k4[g][j4][3]} * vv[g];
                        S[2 * j4] = __builtin_elementwise_fma((f32x2){a4[g][j4][0], a4[g][j4][1]}, S[2 * j4], kv0);
                        S[2 * j4 + 1] = __builtin_elementwise_fma((f32x2){a4[g][j4][2], a4[g][j4][3]}, S[2 * j4 + 1], kv1);
                        op = __builtin_elementwise_fma((f32x2){q4[g][j4][0], q4[g][j4][1]}, S[2 * j4], op);
                        op = __builtin_elementwise_fma((f32x2){q4[g][j4][2], q4[g][j4][3]}, S[2 * j4 + 1], op); }
                    po[g] = op[0] + op[1]; }
#pragma unroll
                for (int g = 0; g < GS; ++g) sP[((s0_ + g) * 8 + wave) * 64 + lane] = po[g];
            }
            asm volatile("s_waitcnt lgkmcnt(0)" ::: "memory"); __builtin_amdgcn_s_barrier(); asm volatile("" ::: "memory");
#pragma unroll
            for (int j2 = 0; j2 < NR; ++j2) {
                const int s = wave + 8 * j2; const int tok = dir == 0 ? blk * TB + s : 2047 - (blk * TB + s);
                float sum = 0.f;
#pragma unroll
                for (int w = 0; w < 8; ++w) sum += sP[(s * 8 + w) * 64 + lane];
                oraw[(rowbase + tok) * 512 + (HG ? 0 : 256) + h * 64 + lane] = sum;
            }
            }
            { const int blk = blk2 + 1;
#pragma unroll
            for (int i = 0; i < NS; ++i) {
                const int st = ps + 16 * i;
                if (HG) {
                    const float z0 = bf2f(rz0[1][i]), z1 = bf2f(rz1[1][i]);
                    const float s0 = __builtin_amdgcn_rcpf(1.f + __expf(-z0)), s1 = __builtin_amdgcn_rcpf(1.f + __expf(-z1));
                    sA[st * 64 + pi] = s0 * (1.f + lb0 * __expf(fminf(-z0, 80.f))); sA[st * 64 + pi + 32] = s1 * (1.f + lb1 * __expf(fminf(-z1, 80.f)));
                    sK[st * 64 + pi] = (1.f - lb0) * __builtin_amdgcn_rcpf(1.f + __expf(z0)); sK[st * 64 + pi + 32] = (1.f - lb1) * __builtin_amdgcn_rcpf(1.f + __expf(z1));
                    const float q0 = bf2f(rq0[1][i]), q1 = bf2f(rq1[1][i]);
                    sQ[st * 64 + pi] = q0 * __builtin_amdgcn_rcpf(1.f + __expf(-q0)) * 0.125f; sQ[st * 64 + pi + 32] = q1 * __builtin_amdgcn_rcpf(1.f + __expf(-q1)) * 0.125f;
                } else {
                    float z = bias;
#pragma unroll
                    for (int j = 0; j < 4; ++j) { z += bflo(rl0[1][i][j]) * w2c[2 * j] + bfhi(rl0[1][i][j]) * w2c[2 * j + 1]; z += bflo(rl1[1][i][j]) * w2c[8 + 2 * j] + bfhi(rl1[1][i][j]) * w2c[8 + 2 * j + 1]; }
                    const float ls = fminf(z, 0.f) - __logf(1.f + __expf(-fabsf(z)));
                    sA[st * 32 + pi] = __expf(ls * (1.f / 16.f));
                    sK[st * 32 + pi] = bf2f(rk0[1][i]);
                    sQ[st * 32 + pi] = bf2f(rq0[1][i]) * 0.17677669529663687f;
                }
                sV[st * 64 + pi] = bf2f(rv0[1][i]); sV[st * 64 + pi + 32] = bf2f(rv1[1][i]);
            }
            asm volatile("s_waitcnt lgkmcnt(0)" ::: "memory"); __builtin_amdgcn_s_barrier(); asm volatile("" ::: "memory");
            if (blk + 2 < SEQ / TB) SCAN_LOAD(blk + 2, 1);
            for (int s0_ = 0; s0_ < TB; s0_ += GS) {
                float vv[GS]; f32x4 a4[GS][KPW / 4], k4[GS][KPW / 4], q4[GS][KPW / 4];
#pragma unroll
                for (int g = 0; g < GS; ++g) { const int s = s0_ + g; vv[g] = sV[s * 64 + lane];
#pragma unroll
                    for (int j4 = 0; j4 < KPW / 4; ++j4) { a4[g][j4] = *(const LAS f32x4*)(sA + s * DK + wave * KPW + j4 * 4); k4[g][j4] = *(const LAS f32x4*)(sK + s * DK + wave * KPW + j4 * 4); q4[g][j4] = *(const LAS f32x4*)(sQ + s * DK + wave * KPW + j4 * 4); } }
                float po[GS];
#pragma unroll
                for (int g = 0; g < GS; ++g) {
                    f32x2 op = (f32x2){0.f, 0.f};
#pragma unroll
                    for (int j4 = 0; j4 < KPW / 4; ++j4) {
                        const f32x2 kv0 = (f32x2){k4[g][j4][0], k4[g][j4][1]} * vv[g], kv1 = (f32x2){k4[g][j4][2], k4[g][j4][3]} * vv[g];
                        S[2 * j4] = __builtin_elementwise_fma((f32x2){a4[g][j4][0], a4[g][j4][1]}, S[2 * j4], kv0);
                        S[2 * j4 + 1] = __builtin_elementwise_fma((f32x2){a4[g][j4][2], a4[g][j4][3]}, S[2 * j4 + 1], kv1);
                        op = __builtin_elementwise_fma((f32x2){q4[g][j4][0], q4[g][j4][1]}, S[2 * j4], op);
                        op = __builtin_elementwise_fma((f32x2){q4[g][j4][2], q4[g][j4][3]}, S[2 * j4 + 1], op); }
                    po[g] = op[0] + op[1]; }
#pragma unroll
                for (int g = 0; g < GS; ++g) sP[((s0_ + g) * 8 + wave) * 64 + lane] = po[g];
            }
            asm volatile("s_waitcnt lgkmcnt(0)" ::: "memory"); __builtin_amdgcn_s_barrier(); asm volatile("" ::: "memory");
#pragma unroll
            for (int j2 = 0; j2 < NR; ++j2) {
                const int s = wave + 8 * j2; const int tok = dir == 0 ? blk * TB + s : 2047 - (blk * TB + s);
                float sum = 0.f;
#pragma unroll
                for (int w = 0; w < 8; ++w) sum += sP[(s * 8 + w) * 64 + lane];
                oraw[(rowbase + tok) * 512 + (HG ? 0 : 256) + h * 64 + lane] = sum;
            }
            }
        }
#undef SCAN_LOAD
    }
    asm volatile("s_waitcnt vmcnt(0)" ::: "memory");
    __syncthreads();
    LAS unsigned* flg = (LAS unsigned*)(lds + 147456 - 128);
    if (tid == 0) { __builtin_amdgcn_fence(__ATOMIC_RELEASE, "agent"); asm volatile("s_waitcnt vmcnt(0)" ::: "memory");
        const unsigned old = __hip_atomic_fetch_add(done, 1u, __ATOMIC_RELAXED, __HIP_MEMORY_SCOPE_AGENT);
        __builtin_amdgcn_fence(__ATOMIC_ACQUIRE, "agent"); asm volatile("s_waitcnt vmcnt(0)" ::: "memory");
        flg[0] = old; }
    __syncthreads();
    if (flg[0] == 1u) {
        if (lane == 0 && tid != 0) { __builtin_amdgcn_fence(__ATOMIC_ACQUIRE, "agent"); asm volatile("s_waitcnt vmcnt(0)" ::: "memory"); }
        __syncthreads();
        const float ng = normg[lane];
        for (int t0 = wave * 16; t0 < SEQ; t0 += 128) {
            float fa[16], fb[16]; bf16_t gq[16];
#pragma unroll
            for (int i = 0; i < 16; ++i) { const size_t o = (rowbase + t0 + i) * 512 + (HG ? 0 : 256) + h * 64 + lane;
                fa[i] = __hip_atomic_load(oraw0 + o, __ATOMIC_RELAXED, __HIP_MEMORY_SCOPE_AGENT); fb[i] = __hip_atomic_load(oraw1 + o, __ATOMIC_RELAXED, __HIP_MEMORY_SCOPE_AGENT);
                gq[i] = proj[(rowbase + t0 + i) * LDP + (HG ? BG : GG) + h * 64 + lane]; }
#pragma unroll
            for (int i = 0; i < 16; ++i) {
                const float tot = fa[i] + fb[i];
                const float ssq = wave_sum(tot * tot);
                const float gvv = bf2f(gq[i]);
                const float outv = tot * rsqrtf(ssq * (1.f / 64.f) + EPS) * ng * (gvv * __builtin_amdgcn_rcpf(1.f + __expf(-gvv)));
                ocat[(rowbase + t0 + i) * D + (HG ? 512 : 768) + h * 64 + lane] = (bf16_t)f2bf(outv);
            }
        }
    }
    __syncthreads();
}

__device__ __forceinline__ void norm_rows_mod(const float* src, bf16_t* dst, const float* g, const float* modl  , int grow0, int shoff, int scoff) {
    const int tid = tid_fresh(), lane = tid & 63, gw = blockIdx.x * 8 + __builtin_amdgcn_readfirstlane(tid >> 6), NGW = gridDim.x * 8;
    const f32x4* gr = (const f32x4*)g + lane;
    f32x4 gg[4];
#pragma unroll
    for (int j = 0; j < 4; ++j) gg[j] = gr[64 * j];
    for (int m0 = gw; m0 < TG; m0 += 2 * NGW) {
        f32x4 v[2][4]; float s[2];
#pragma unroll
        for (int e = 0; e < 2; ++e) { const int m = m0 + e * NGW; const f32x4* xr = (const f32x4*)(src + (size_t)m * D) + lane;
#pragma unroll
            for (int j = 0; j < 4; ++j) v[e][j] = xr[64 * j]; }
#pragma unroll
        for (int e = 0; e < 2; ++e) { s[e] = 0.f;
#pragma unroll
            for (int j = 0; j < 4; ++j) s[e] += (v[e][j].x * v[e][j].x + v[e][j].y * v[e][j].y) + (v[e][j].z * v[e][j].z + v[e][j].w * v[e][j].w); }
#pragma unroll
        for (int e = 0; e < 2; ++e) { const int m = m0 + e * NGW; const int b = (grow0 + m) >> 11;
            const f32x4* sh = (const f32x4*)(modl + (size_t)b * (NMOD * D) + shoff) + lane; const f32x4* sc = (const f32x4*)(modl + (size_t)b * (NMOD * D) + scoff) + lane;
            const float r = rsqrtf(wave_sum(s[e]) * (1.f / D) + EPS);
            unsigned long long* o8 = (unsigned long long*)(dst + (size_t)m * D) + lane;
#pragma unroll
            for (int j = 0; j < 4; ++j) { const f32x4 y = v[e][j] * r * gg[j] * (1.f + sc[64 * j]) + sh[64 * j];
                o8[64 * j] = (unsigned long long)pk2(y.x, y.y) | ((unsigned long long)pk2(y.z, y.w) << 32); } }
    }
}
__device__ __forceinline__ void norm_rows_final(float* x, const float* g) {
    const int tid = tid_fresh(), lane = tid & 63, gw = blockIdx.x * 8 + __builtin_amdgcn_readfirstlane(tid >> 6), NGW = gridDim.x * 8;
    for (int m = gw; m < TG; m += NGW) {
        f32x4* xr = (f32x4*)(x + (size_t)m * D) + lane; const f32x4* gr = (const f32x4*)g + lane;
        f32x4 v[4]; float s = 0.f;
#pragma unroll
        for (int j = 0; j < 4; ++j) { v[j] = xr[64 * j]; s += (v[j].x * v[j].x + v[j].y * v[j].y) + (v[j].z * v[j].z + v[j].w * v[j].w); }
        const float r = rsqrtf(wave_sum(s) * (1.f / D) + EPS);
#pragma unroll
        for (int j = 0; j < 4; ++j) xr[64 * j] = v[j] * r * gr[64 * j];
    }
}

__device__ __forceinline__ void transpose_item(const float* W, int ldw, bf16_t* WT, int ldt, int row_off, int k_off, LAS float* scr, int kb, int nb, int lane) {
    const int k0 = 64 * kb, n0 = 32 * nb;
#pragma unroll 8
    for (int i = 0; i < 32; ++i) { const int kk = 2 * i + (lane >> 5); scr[kk * 33 + (lane & 31)] = W[(size_t)(k0 + kk) * ldw + n0 + (lane & 31)]; }
    asm volatile("s_waitcnt lgkmcnt(0)" ::: "memory");
    const int c = lane & 7;
#pragma unroll
    for (int j = 0; j < 4; ++j) { const int n = (lane >> 3) + 8 * j; const LAS float* s = scr + (8 * c) * 33 + n;
        u32x4 o; o.x = pk2(s[0 * 33], s[1 * 33]); o.y = pk2(s[2 * 33], s[3 * 33]); o.z = pk2(s[4 * 33], s[5 * 33]); o.w = pk2(s[6 * 33], s[7 * 33]);
        *(u32x4*)(WT + (size_t)(row_off + n0 + n) * ldt + k_off + k0 + 8 * c) = o; }
    asm volatile("s_waitcnt lgkmcnt(0)" ::: "memory");
}

#define XB_TMO      128
#define XB_XCNT(j)  (256  + 64 * (j))
#define XB_XSUB(j)  (1280 + 64 * (j))
#define XB_XGEN(j)  (2304 + 64 * (j))
#define XB_TOP      3328
#define XB_TOPGEN   3392
#define XCD_BAR_WORDS 3456
#define XB_SPIN_CAP (1u << 18)

__device__ __forceinline__ unsigned xb_ld(unsigned* p)              { return __hip_atomic_load(p, __ATOMIC_RELAXED, __HIP_MEMORY_SCOPE_AGENT); }
__device__ __forceinline__ unsigned xb_add(unsigned* p, unsigned v) { return __hip_atomic_fetch_add(p, v, __ATOMIC_RELAXED, __HIP_MEMORY_SCOPE_AGENT); }
__device__ __forceinline__ unsigned xb_xcc_id() { return (unsigned)__builtin_amdgcn_s_getreg((3 << 11) | 20) & 0xFu; }
#define XB_SPIN(cond, bar) do { unsigned _sp = 0; while (cond) { __builtin_amdgcn_s_sleep(1); \
    if ((++_sp & 255u) == 0u) { if (xb_ld(&(bar)[XB_TMO])) break; if (_sp > XB_SPIN_CAP) { atomicAdd(&(bar)[XB_TMO], 1u); break; } } } } while (0)

struct XcdBarrier {
    unsigned* bar; unsigned x;
    volatile LAS unsigned* st;
};

__device__ __forceinline__ XcdBarrier xcd_barrier_post(unsigned* bar, volatile LAS unsigned* st) {
    XcdBarrier b; b.bar = bar; b.x = xb_xcc_id(); b.st = st;
    if (threadIdx.x == 0) (void)xb_add(&bar[XB_XCNT(b.x)], 1u);
    return b;
}
__device__ __forceinline__ void xcd_barrier_complete(unsigned* bar, unsigned x, unsigned& nloc, unsigned& nx) {
    const unsigned G = gridDim.x * gridDim.y * gridDim.z;
    unsigned sum, cnt, mine, sp = 0u;
    for (;;) {
        sum = 0u; cnt = 0u; mine = 0u;
#pragma unroll
        for (unsigned j = 0; j < 16; ++j) { const unsigned c = xb_ld(&bar[XB_XCNT(j)]); sum += c; cnt += (c > 0u) ? 1u : 0u; mine = (j == x) ? c : mine; }
        if (sum == G) break;
        __builtin_amdgcn_s_sleep(1);
        if ((++sp & 255u) == 0u) { if (xb_ld(&bar[XB_TMO])) break; if (sp > XB_SPIN_CAP) { atomicAdd(&bar[XB_TMO], 1u); break; } }
    }
    nloc = mine > 0u ? mine : 1u; nx = cnt > 0u ? cnt : 1u;
}

__device__ __forceinline__ void xcd_barrier(const XcdBarrier& b) {
    asm volatile("s_waitcnt vmcnt(0)" ::: "memory");
    __syncthreads();
    if (threadIdx.x == 0) {
        unsigned* bar = b.bar;
        __builtin_amdgcn_s_waitcnt(0);
        unsigned nloc = b.st[0], nx = b.st[1];
        if (nloc == 0u) { xcd_barrier_complete(bar, b.x, nloc, nx); b.st[0] = nloc; b.st[1] = nx; }
        const unsigned old = xb_add(&bar[XB_XSUB(b.x)], 1u);
        const unsigned gen = old / nloc;
        if (old + 1u == (gen + 1u) * nloc) {
            __builtin_amdgcn_fence(__ATOMIC_RELEASE, "agent");
            asm volatile("s_waitcnt vmcnt(0)" ::: "memory");
            const unsigned og = xb_add(&bar[XB_TOP], 1u);
            const unsigned tg = og / nx;
            if (og + 1u == (tg + 1u) * nx) xb_add(&bar[XB_TOPGEN], 1u);
            else XB_SPIN(xb_ld(&bar[XB_TOPGEN]) == tg, bar);
            __builtin_amdgcn_fence(__ATOMIC_ACQUIRE, "agent");
            xb_add(&bar[XB_XGEN(b.x)], 1u);
            asm volatile("s_waitcnt vmcnt(0)" ::: "memory");
        } else {
            XB_SPIN(xb_ld(&bar[XB_XGEN(b.x)]) == gen, bar);
            __builtin_amdgcn_fence(__ATOMIC_ACQUIRE, "agent");
            asm volatile("s_waitcnt vmcnt(0)" ::: "memory");
        }
    }
    __syncthreads();
}


constexpr int CW_XBAR = 45056;
#define XSYNC() do { XcdBarrier xb_; xb_.bar = (unsigned*)(KWS() + WS_CTL) + CW_XBAR; xb_.x = xb_xcc_id(); xb_.st = (volatile LAS unsigned*)(lds + 147456 - 256); xcd_barrier(xb_); } while (0)

struct Args { const void* p[24]; };
enum { P_X = 0, P_C, P_ADAW, P_ADAB, P_NMIXG, P_NMLPG, P_WIN, P_DLAM, P_DSUBG, P_HLB, P_HNG, P_GW2, P_GB, P_GNG, P_WUA, P_WUB, P_WUC, P_WOUT, P_W1, P_W2, P_FNG, P_OUT, P_WS };
typedef const unsigned long long __attribute__((address_space(4)))* kargp_t;
__device__ __forceinline__ const void* karg(int i) { kargp_t kp = (kargp_t)__builtin_amdgcn_kernarg_segment_ptr(); asm volatile("" : "+s"(kp));
    const unsigned long long v = kp[i]; const __attribute__((address_space(1))) void* g = (const __attribute__((address_space(1))) void*)v; return (const void*)g; }
#define GRID_SYNC() do { asm volatile("s_waitcnt vmcnt(0) lgkmcnt(0)" ::: "memory"); __syncthreads(); grid.sync(); \
    if (threadIdx.x < 64) { __builtin_amdgcn_fence(__ATOMIC_ACQUIRE, "agent"); asm volatile("s_waitcnt vmcnt(0)" ::: "memory"); } __syncthreads(); } while (0)
#define KF(i) ((const float*)karg(i))
#define KWS() ((uchar*)karg(P_WS))

__global__ void __launch_bounds__(512, 2) fwd_megakernel(Args a_unused) {
    extern __shared__ __attribute__((aligned(16))) uchar lds_raw[];
    LAS uchar* lds = (LAS uchar*)lds_raw;
    cg::grid_group grid = cg::this_grid();
    {
    const int tid = tid_fresh(), lane = tid & 63, wave = __builtin_amdgcn_readfirstlane(tid >> 6);

    if (blockIdx.x == 0) {
        unsigned* ctl = (unsigned*)(KWS() + WS_CTL); float* ctlf = (float*)ctl;
        for (int i = tid; i < 1024; i += 512) { ctl[i] = 0u; ctl[40960 + i] = 0u; }
        for (int i = tid; i < XCD_BAR_WORDS; i += 512) ctl[CW_XBAR + i] = 0u;
        if (tid < 4) {
            const float* lp = KF(P_DLAM) + tid * 256; float s1 = 0.f, s2 = 0.f;
            for (int d = 0; d < 64; ++d) { s1 += lp[d] * lp[64 + d]; s2 += lp[128 + d] * lp[192 + d]; }
            const float li = 0.8f - 0.6f * expf(-0.3f * (float)tid);
            ctlf[1024 + tid] = expf(s1) - expf(s2) + li; ctlf[1028 + tid] = li;
        }
        {
            const float* lg = KF(P_HLB); const int j = tid;
            float v[4], mx = -1e30f;
#pragma unroll
            for (int l = 0; l < 4; ++l) { v[l] = lg[l * 512 + j]; mx = fmaxf(mx, v[l]); }
            float den = 0.f;
#pragma unroll
            for (int l = 0; l < 4; ++l) { v[l] = expf(v[l] - mx); den += v[l]; }
            float cum = 0.f; const float w0 = v[0] / den;
#pragma unroll
            for (int l = 0; l < 4; ++l) { cum += v[l] / den; ctlf[2048 + l * 512 + j] = cum - w0; }
        }
        {
            float* pv = ctlf + 8192;
            const float* s0 = KF(P_NMIXG); for (int i = tid; i < 4096; i += 512) pv[i] = s0[i];
            const float* s1 = KF(P_NMLPG); for (int i = tid; i < 4096; i += 512) pv[4096 + i] = s1[i];
            const float* s2 = KF(P_DSUBG); for (int i = tid; i < 512; i += 512) pv[8192 + i] = s2[i];
            const float* s3 = KF(P_HNG); for (int i = tid; i < 256; i += 512) pv[8704 + i] = s3[i];
            const float* s4 = KF(P_GW2); for (int i = tid; i < 16384; i += 512) pv[8960 + i] = s4[i];
            const float* s5 = KF(P_GB); for (int i = tid; i < 1024; i += 512) pv[25344 + i] = s5[i];
            const float* s6 = KF(P_GNG); for (int i = tid; i < 256; i += 512) pv[26368 + i] = s6[i];
            const float* s7 = KF(P_FNG); for (int i = tid; i < 1024; i += 512) pv[26624 + i] = s7[i];
        }
    }
#ifndef NO_MOD
    {
        LAS float* cond = (LAS float*)lds; LAS float* red = (LAS float*)(lds + 131072);
        float* mod = (float*)(KWS() + WS_MOD);
        const float* cin = KF(P_C); const float* adaw = KF(P_ADAW); const float* adab = KF(P_ADAB);
        bool loaded = false;
        for (int it = blockIdx.x; it < 4 * 96; it += gridDim.x) {
            if (!loaded) { for (int i = tid; i < 32 * 1024; i += 512) { const float cv = cin[i]; cond[i] = cv / (1.f + __expf(-cv)); } loaded = true; __syncthreads(); }
            const int l = it / 96, n0 = (it % 96) * 64;
            const float* W = adaw + (size_t)l * D * (NMOD * D) + n0 + lane;
            float acc[32];
#pragma unroll
            for (int b = 0; b < 32; ++b) acc[b] = 0.f;
            for (int k4 = 0; k4 < 32; ++k4) {
                const int k = wave * 128 + k4 * 4;
                const float w0 = W[(size_t)k * (NMOD * D)], w1 = W[(size_t)(k + 1) * (NMOD * D)], w2v = W[(size_t)(k + 2) * (NMOD * D)], w3 = W[(size_t)(k + 3) * (NMOD * D)];
#pragma unroll
                for (int b = 0; b < 32; ++b) { const f32x4 c4 = *(const LAS f32x4*)(cond + b * 1024 + k); acc[b] += c4.x * w0 + c4.y * w1 + c4.z * w2v + c4.w * w3; }
            }
#pragma unroll
            for (int rd = 0; rd < 4; ++rd) {
                __syncthreads();
#pragma unroll
                for (int bb = 0; bb < 8; ++bb) red[(wave * 8 + bb) * 64 + lane] = acc[rd * 8 + bb];
                __syncthreads();
                float s = 0.f;
#pragma unroll
                for (int w = 0; w < 8; ++w) s += red[(w * 8 + wave) * 64 + lane];
                const int b = rd * 8 + wave;
                mod[((size_t)l * 32 + b) * (NMOD * D) + n0 + lane] = s + adab[l * (NMOD * D) + n0 + lane];
            }
        }
        __syncthreads();
    }
#endif
#ifndef NO_WT
    {
        LAS float* scr = (LAS float*)(lds + wave * 8704);
        const int gw = blockIdx.x * 8 + wave, NGW = gridDim.x * 8;
        uchar* ws = KWS();
        bf16_t* win_t = (bf16_t*)(ws + WS_WIN); bf16_t* wup_t = (bf16_t*)(ws + WS_WUP); bf16_t* wout_t = (bf16_t*)(ws + WS_WOUT);
        bf16_t* w1_t = (bf16_t*)(ws + WS_W1); bf16_t* w2_t = (bf16_t*)(ws + WS_W2);
        constexpr int I_IN = 16 * 209, I_UA = 8 * 32, I_UB = 4 * 32, I_UC = 4 * 32, I_O = 16 * 32, I_1 = 16 * 128, I_2 = 64 * 32;
        constexpr int I_L = I_IN + I_UA + I_UB + I_UC + I_O + I_1 + I_2;
        for (int it = gw; it < 4 * I_L; it += NGW) {
            const int l = it / I_L; int r = it % I_L;
            if (r < I_IN) { transpose_item(KF(P_WIN) + (size_t)l * D * DIN, DIN, win_t + (size_t)l * LDP * D, D, 0, 0, scr, r / 209, r % 209, lane); continue; } r -= I_IN;
            if (r < I_UA) { transpose_item(KF(P_WUA) + (size_t)l * 512 * D, D, wup_t + (size_t)l * D * D, D, 0, 0, scr, r / 32, r % 32, lane); continue; } r -= I_UA;
            if (r < I_UB) { transpose_item(KF(P_WUB) + (size_t)l * 256 * D, D, wup_t + (size_t)l * D * D, D, 0, 512, scr, r / 32, r % 32, lane); continue; } r -= I_UB;
            if (r < I_UC) { transpose_item(KF(P_WUC) + (size_t)l * 256 * D, D, wup_t + (size_t)l * D * D, D, 0, 768, scr, r / 32, r % 32, lane); continue; } r -= I_UC;
            if (r < I_O) { transpose_item(KF(P_WOUT) + (size_t)l * D * D, D, wout_t + (size_t)l * D * D, D, 0, 0, scr, r / 32, r % 32, lane); continue; } r -= I_O;
            if (r < I_1) { transpose_item(KF(P_W1) + (size_t)l * D * DFF, DFF, w1_t + (size_t)l * DFF * D, D, 0, 0, scr, r / 128, r % 128, lane); continue; } r -= I_1;
            transpose_item(KF(P_W2) + (size_t)l * DFF * D, D, w2_t + (size_t)l * D * DFF, DFF, 0, 0, scr, r / 32, r % 32, lane);
        }
        for (int i = blockIdx.x * 512 + tid; i < 4 * 28672; i += gridDim.x * 512) { const int l = i / 28672, r = i % 28672;
            *(u32x4*)(win_t + (size_t)l * LDP * D + (size_t)DIN * D + (size_t)r * 8) = (u32x4){0u, 0u, 0u, 0u}; }
    }
#endif
    }
    GRID_SYNC();
    if (threadIdx.x < 2) ((LAS unsigned*)(lds + 147456 - 256))[threadIdx.x] = 0u;
    (void)xcd_barrier_post((unsigned*)(KWS() + WS_CTL) + CW_XBAR, (volatile LAS unsigned*)(lds + 147456 - 256));

    for (int grp = 0; grp < NGRP; ++grp) {
        for (int l = 0; l < DEPTH; ++l) {
            {
                uchar* ws = KWS(); const float* pv = (const float*)(ws + WS_CTL) + 8192;
                const float* src = (l == 0 ? KF(P_X) : (const float*)karg(P_OUT)) + (size_t)grp * TG * D;
                norm_rows_mod(src, (bf16_t*)(ws + WS_HB), pv + l * D, (const float*)(ws + WS_MOD) + (size_t)l * 32 * (NMOD * D), grp * TG, 0, D);
            }
            XSYNC();
            { uchar* ws = KWS(); pg8::Gemm g{(const bf16_t*)(ws + WS_HB), (const bf16_t*)(ws + WS_WIN) + (size_t)l * LDP * D, D}; pg8::Order S; S.init(TG, LDP, D, gridDim.x, blockIdx.x, 1); pg8::EpiProj E{(bf16_t*)(ws + WS_PROJ), (bf16_t*)(ws + WS_ATT)};
#ifndef NO_EPIPROJ
              pg8::gemm_phase<pg8::EpiProj>(lds, g, S, E);
#endif
            }
            XSYNC();
            {
                uchar* ws = KWS(); const float* ctlf = (const float*)(ws + WS_CTL); const float* pv = ctlf + 8192;
                const int xq = blockIdx.x & 7; unsigned* ctr = (unsigned*)(ws + WS_CTL) + ((grp * DEPTH + l) * 8 + xq) * 4;
                const float lam = ctlf[1024 + l], laminit = ctlf[1028 + l];
                const bf16_t* PROJ = (const bf16_t*)(ws + WS_PROJ); bf16_t* OCAT = (bf16_t*)(ws + WS_OCAT); float* OFWD = (float*)(ws + WS_OFWD);
                LAS int* itm = (LAS int*)(lds + 147456 - 64);
                const int tid = tid_fresh();
                for (;;) {
                    __syncthreads();
                    if (tid == 0) itm[0] = (int)atomicAdd(ctr, 1u);
                    __syncthreads();
                    const int it = itm[0];
                    constexpr int NPQ = GB * 4 / 8;
                    if (it >= 4 * NPQ + NPQ * 16) break;
                    float* OBWD = (float*)(ws + WS_OBWD);
                    if (it < 2 * NPQ) { const int p = (it >> 1) * 8 + xq; unsigned* dn = (unsigned*)(ws + WS_CTL) + 40960 + (((grp * DEPTH + l) * GB * 4 + p) * 2);
                        scan_item<64, true>(lds, PROJ, OFWD, OBWD, OCAT, dn, p >> 2, p & 3, it & 1, ctlf + 2048 + l * 512, pv + 8704 + l * 64, nullptr, nullptr);
                    } else if (it < 4 * NPQ) { const int i2 = it - 2 * NPQ; const int p = (i2 >> 1) * 8 + xq; unsigned* dn = (unsigned*)(ws + WS_CTL) + 40960 + (((grp * DEPTH + l) * GB * 4 + p) * 2 + 1);
                        scan_item<32, false>(lds, PROJ, OFWD, OBWD, OCAT, dn, p >> 2, p & 3, i2 & 1, nullptr, pv + 26368 + l * 64, pv + 8960 + l * 4096, pv + 25344 + l * 256);
                    } else { const int u = it - 4 * NPQ, p = (u >> 4) * 8 + xq;
                        attn_unit(lds, (const bf16_t*)(ws + WS_ATT), OCAT, p >> 2, p & 3, u & 15, lam, laminit, pv + 8192 + l * 128);
                    }
                }
            }
            XSYNC();
            { uchar* ws = KWS(); pg8::Gemm g{(const bf16_t*)(ws + WS_OCAT), (const bf16_t*)(ws + WS_WUP) + (size_t)l * D * D, D}; pg8::Order S; S.init(TG, D, D, gridDim.x, blockIdx.x, 3); pg8::EpiMerge E{(const bf16_t*)(ws + WS_PROJ), (bf16_t*)(ws + WS_HB)};
#ifndef NO_EPIMERGE
              pg8::gemm_phase<pg8::EpiMerge>(lds, g, S, E);
#endif
            }
            XSYNC();
            { uchar* ws = KWS(); pg8::Gemm g{(const bf16_t*)(ws + WS_HB), (const bf16_t*)(ws + WS_WOUT) + (size_t)l * D * D, D}; pg8::Order S; S.init(TG, D, D, gridDim.x, blockIdx.x, 1);
              float* xg = (float*)karg(P_OUT) + (size_t)grp * TG * D;
              pg8::EpiRes E{l == 0 ? KF(P_X) + (size_t)grp * TG * D : xg, xg, (const float*)(ws + WS_MOD) + ((size_t)l * 32 + grp * GB) * (NMOD * D) + 2 * D};
#ifndef NO_EPIRES
              pg8::gemm_phase<pg8::EpiRes>(lds, g, S, E);
#endif
            }
            XSYNC();
            {
                uchar* ws = KWS(); const float* pv = (const float*)(ws + WS_CTL) + 8192;
                norm_rows_mod((const float*)karg(P_OUT) + (size_t)grp * TG * D, (bf16_t*)(ws + WS_HB), pv + 4096 + l * D, (const float*)(ws + WS_MOD) + (size_t)l * 32 * (NMOD * D), grp * TG, 3 * D, 4 * D);
            }
            XSYNC();
            { uchar* ws = KWS(); pg8::Gemm g{(const bf16_t*)(ws + WS_HB), (const bf16_t*)(ws + WS_W1) + (size_t)l * DFF * D, D}; pg8::Order S; S.init(TG, DFF, D, gridDim.x, blockIdx.x, 1); pg8::EpiRelu2 E{(bf16_t*)(ws + WS_U)};
#ifndef NO_EPIRELU2
              pg8::gemm_phase<pg8::EpiRelu2>(lds, g, S, E);
#endif
            }
            XSYNC();
            { uchar* ws = KWS(); pg8::Gemm g{(const bf16_t*)(ws + WS_U), (const bf16_t*)(ws + WS_W2) + (size_t)l * D * DFF, DFF}; pg8::Order S; S.init(TG, D, DFF, gridDim.x, blockIdx.x, 1);
              float* xg = (float*)karg(P_OUT) + (size_t)grp * TG * D;
              pg8::EpiRes E{xg, xg, (const float*)(ws + WS_MOD) + ((size_t)l * 32 + grp * GB) * (NMOD * D) + 5 * D};
#ifndef NO_EPIRES
              pg8::gemm_phase<pg8::EpiRes>(lds, g, S, E);
#endif
            }
            XSYNC();
        }
        norm_rows_final((float*)karg(P_OUT) + (size_t)grp * TG * D, (const float*)(KWS() + WS_CTL) + 8192 + 26624);
    }
}

extern "C" void kernel_launch(void* const* d_in, const int* in_sizes, int n_in, void* d_out, int out_size, void* d_ws, size_t ws_size, hipStream_t stream) {
    static int grid = 0;
    if (grid == 0) {
        if (n_in != 21 || ws_size < WS_END) { fprintf(stderr, "kernel_launch: unexpected n_in %d / ws %zu\n", n_in, ws_size); grid = -1; return; }
        int dev = 0, cus = 0, per_cu = 0;
        if (hipGetDevice(&dev) != hipSuccess || hipDeviceGetAttribute(&cus, hipDeviceAttributeMultiprocessorCount, dev) != hipSuccess) { grid = -1; return; }
        if (hipFuncSetAttribute((const void*)fwd_megakernel, hipFuncAttributeMaxDynamicSharedMemorySize, LDS_BYTES) != hipSuccess) { fprintf(stderr, "kernel_launch: hipFuncSetAttribute failed\n"); grid = -1; return; }
        if (hipOccupancyMaxActiveBlocksPerMultiprocessor(&per_cu, (const void*)fwd_megakernel, 512, LDS_BYTES) != hipSuccess || per_cu < 1) { fprintf(stderr, "kernel_launch: occupancy query says %d\n", per_cu); per_cu = 1; }
        (void)hipGetLastError();
        grid = cus;
    }
    if (grid < 0) return;
    Args a{};
    for (int i = 0; i < 21; ++i) a.p[i] = d_in[i];
    a.p[21] = d_out; a.p[22] = d_ws; a.p[23] = nullptr;
    void* args[] = {&a};
    hipError_t e = hipLaunchCooperativeKernel((void*)fwd_megakernel, dim3(grid), dim3(512), args, LDS_BYTES, stream);
    if (e != hipSuccess) fprintf(stderr, "kernel_launch: cooperative launch failed: %s (grid %d)\n", hipGetErrorString(e), grid);
}
```
